# Optimizing an MI355X kernel written in HIP

```python
import jax, jax.numpy as jnp
from jax import lax
import numpy as np

D_MODEL = 1024
BATCH = 8
SEQ = 4096
DEPTH = 4

GRID_W = 64
CTX_LEN = 256
N_MIXERS = 3
N_LAYERS_A = (DEPTH + 2) // 3
N_LAYERS_B = (DEPTH + 1) // 3
N_LAYERS_C = DEPTH // 3
N_SUB = 3
N_MOD = 3 * N_SUB
D_FF = 256 * ((8 * D_MODEL // 3 + 255) // 256)
FFN_RES = 0.5
RET_DK = 256
RET_HEADS = D_MODEL // RET_DK
RET_DV = 2 * RET_DK
RET_CHUNK = 128
ROPE_BASE = 10000.0
NA_HEAD_DIM = 64
NA_HEADS = D_MODEL // NA_HEAD_DIM
NA_WIN_R = 8
NA_WIN_C = 16
NEG_INF = -1e30
LRU_WIDTH = D_MODEL
LRU_BLOCK_W = 256
LRU_BLOCKS = LRU_WIDTH // LRU_BLOCK_W
LRU_CONV_W = 4
LRU_C = 8.0
DEEPNORM_ALPHA = (2 * DEPTH) ** 0.25
DEEPNORM_BETA = (8 * DEPTH) ** -0.25
LN_EPS = 1e-5

kernel_name = 'hybrid_retention_natten_rglru_dit'


def layer_norm(x, g, b):
    xf = x.astype(jnp.float32)
    mu = jnp.mean(xf, axis=-1, keepdims=True)
    var = jnp.mean(jnp.square(xf - mu), axis=-1, keepdims=True)
    y = (xf - mu) * lax.rsqrt(var + LN_EPS) * g.astype(jnp.float32) + b.astype(jnp.float32)
    return y.astype(x.dtype)


def modulate(h, shift, scale):
    return h * (1.0 + scale) + shift


def post_norm(h, delta, g, b):
    return layer_norm(DEEPNORM_ALPHA * h + delta, g, b)


def swiglu(h, w_in, w_out):
    gate, up = jnp.split(h @ w_in, 2, axis=-1)
    return (jax.nn.silu(gate) * up) @ w_out


def half_ffn(h, shift, scale, gate, w_in, w_out, g, b):
    return post_norm(h, gate * (FFN_RES * swiglu(modulate(h, shift, scale), w_in, w_out)), g, b)


def retention_log_gammas(reverse):
    h = jnp.arange(RET_HEADS, dtype=jnp.float32)
    if reverse:
        h = h[::-1]
    return jnp.log1p(-jnp.exp2(-5.0 - h))


def axial_rope(t):
    n, dk = t.shape[2], t.shape[3]
    half = dk // 2
    pos = jnp.arange(n)
    freqs = ROPE_BASE ** (-jnp.arange(0, half, 2, dtype=jnp.float32) / half)

    def rot(u, p):
        ang = p.astype(jnp.float32)[:, None] * freqs
        cos, sin = jnp.cos(ang), jnp.sin(ang)
        u1, u2 = jnp.split(u, 2, axis=-1)
        return jnp.concatenate([u1 * cos - u2 * sin, u1 * sin + u2 * cos], axis=-1)

    return jnp.concatenate([rot(t[..., :half], pos // GRID_W), rot(t[..., half:], pos % GRID_W)], axis=-1)


def retention_scan(q, k, v, log_g, s0, inclusive):
    b, h, n, _ = q.shape
    nc = n // RET_CHUNK
    pos = jnp.arange(RET_CHUNK, dtype=jnp.float32)
    diff = pos[:, None] - pos[None, :]
    visible = diff >= 0 if inclusive else diff > 0
    intra = jnp.where(visible, jnp.exp(log_g[:, None, None] * jnp.maximum(diff, 0.0)), 0.0)
    q_dec = jnp.exp(log_g[:, None] * (pos + 1.0))[..., None]
    k_dec = jnp.exp(log_g[:, None] * (RET_CHUNK - 1.0 - pos))[..., None]
    chunk_dec = jnp.exp(log_g * RET_CHUNK)[:, None, None]

    def to_chunks(t):
        return jnp.moveaxis(t.reshape(b, h, nc, RET_CHUNK, t.shape[-1]), 2, 0)

    def step(state, blk):
        qb, kb, vb = blk
        att = jnp.einsum('bhid,bhjd->bhij', qb, kb) * intra
        o = jnp.einsum('bhij,bhjv->bhiv', att, vb) + jnp.einsum('bhid,bhdv->bhiv', qb * q_dec, state)
        state = state * chunk_dec + jnp.einsum('bhjd,bhjv->bhdv', kb * k_dec, vb)
        return state, o

    s_final, o = lax.scan(step, s0, (to_chunks(q), to_chunks(k), to_chunks(v)))
    o = jnp.moveaxis(o, 0, 2).reshape(b, h, n, v.shape[-1])
    return o, s_final


def retention_bidir(q, k, v, s0_f, s0_b):
    o_f, s_f = retention_scan(q, k, v, retention_log_gammas(False), s0_f, True)
    flip = lambda t: jnp.flip(t, axis=2)
    o_b, s_b = retention_scan(flip(q), flip(k), flip(v), retention_log_gammas(True), s0_b, False)
    return o_f + flip(o_b), s_f, s_b


def retention_mixer(h_lat, h_ctx, w_in, w_out, with_ctx):
    d_qk = RET_HEADS * RET_DK
    d_v = RET_HEADS * RET_DV

    def project(h, rope):
        b, n, _ = h.shape
        q, k, v, g = jnp.split(h @ w_in, [d_qk, 2 * d_qk, 2 * d_qk + d_v], axis=-1)
        heads = lambda t, d: t.reshape(b, n, RET_HEADS, d).transpose(0, 2, 1, 3).astype(jnp.float32)
        q = heads(q, RET_DK)
        k = heads(k, RET_DK) * (RET_DK ** -0.5)
        v = heads(v, RET_DV)
        if rope:
            q, k = axial_rope(q), axial_rope(k)
        return q, k, v, g

    def finish(o, g):
        mu = jnp.mean(o, axis=-1, keepdims=True)
        var = jnp.mean(jnp.square(o - mu), axis=-1, keepdims=True)
        o = (o - mu) * lax.rsqrt(var + LN_EPS)
        b, h, n, dv = o.shape
        o = o.transpose(0, 2, 1, 3).reshape(b, n, h * dv).astype(g.dtype)
        return (jax.nn.silu(g) * o) @ w_out

    qc, kc, vc, gc = project(h_ctx, False)
    zeros = jnp.zeros((h_ctx.shape[0], RET_HEADS, RET_DK, RET_DV), jnp.float32)
    o_ctx, s_f, s_b = retention_bidir(qc, kc, vc, zeros, zeros)
    ql, kl, vl, gl = project(h_lat, True)
    o_lat, _, _ = retention_bidir(ql, kl, vl, s_f, s_b)
    y_lat = finish(o_lat, gl)
    y_ctx = finish(o_ctx, gc) if with_ctx else None
    return y_lat, y_ctx


def neighborhood_mixer(h_lat, h_ctx, w_qkv, rpb, w_out, with_ctx):
    b, n, _ = h_lat.shape
    n_ctx = h_ctx.shape[1]
    rows = n // GRID_W
    kr = min(NA_WIN_R, rows)
    scale = NA_HEAD_DIM ** -0.5
    u = (h_lat @ w_qkv).reshape(b, rows, GRID_W, 3, NA_HEADS, NA_HEAD_DIM)
    q, k, v = u[:, :, :, 0], u[:, :, :, 1], u[:, :, :, 2]
    uc = (h_ctx @ w_qkv).reshape(b, n_ctx, 3, NA_HEADS, NA_HEAD_DIM)
    qc, kc, vc = uc[:, :, 0], uc[:, :, 1], uc[:, :, 2]

    col = jnp.arange(GRID_W)
    col_start = jnp.clip(col - NA_WIN_C // 2, 0, GRID_W - NA_WIN_C)
    col_ok = (col[None, :] >= col_start[:, None]) & (col[None, :] < col_start[:, None] + NA_WIN_C)
    rel_c = jnp.clip(col[None, :] - col[:, None] + NA_WIN_C - 1, 0, 2 * NA_WIN_C - 2)

    def row_block(r):
        rs = jnp.clip(r - kr // 2, 0, rows - kr)
        q_r = lax.dynamic_index_in_dim(q, r, axis=1, keepdims=False)
        k_r = lax.dynamic_slice_in_dim(k, rs, kr, axis=1)
        v_r = lax.dynamic_slice_in_dim(v, rs, kr, axis=1)
        rel_r = rs + jnp.arange(kr) - r + NA_WIN_R - 1
        bias = rpb[:, rel_r[None, :, None], rel_c[:, None, :]].astype(jnp.float32)
        bias = jnp.where(col_ok[None, :, None, :], bias, NEG_INF)
        s_loc = jnp.einsum('bqhd,bkwhd->bhqkw', q_r, k_r).astype(jnp.float32) * scale + bias
        s_loc = s_loc.reshape(b, NA_HEADS, GRID_W, kr * GRID_W)
        s_ctx = jnp.einsum('bqhd,blhd->bhql', q_r, kc).astype(jnp.float32) * scale
        p = jax.nn.softmax(jnp.concatenate([s_loc, s_ctx], axis=-1), axis=-1).astype(v.dtype)
        p_loc = p[..., :kr * GRID_W].reshape(b, NA_HEADS, GRID_W, kr, GRID_W)
        p_ctx = p[..., kr * GRID_W:]
        return jnp.einsum('bhqkw,bkwhd->bqhd', p_loc, v_r) + jnp.einsum('bhql,blhd->bqhd', p_ctx, vc)

    o = lax.map(row_block, jnp.arange(rows))
    y_lat = jnp.moveaxis(o, 0, 1).reshape(b, n, NA_HEADS * NA_HEAD_DIM) @ w_out
    y_ctx = None
    if with_ctx:
        s = jnp.einsum('bqhd,bkhd->bhqk', qc, kc).astype(jnp.float32) * scale
        p = jax.nn.softmax(s, axis=-1).astype(vc.dtype)
        oc = jnp.einsum('bhqk,bkhd->bqhd', p, vc).reshape(b, n_ctx, NA_HEADS * NA_HEAD_DIM)
        y_ctx = oc @ w_out
    return y_lat, y_ctx


def centred_depthwise_conv(x, w, bias):
    left = LRU_CONV_W // 2
    y = lax.conv_general_dilated(x, w[:, None, :], window_strides=(1,),
                                 padding=[(left, LRU_CONV_W - 1 - left)],
                                 dimension_numbers=('NWC', 'WIO', 'NWC'),
                                 feature_group_count=x.shape[-1])
    return y + bias


def linear_scan(a, u, h0):
    def combine(e1, e2):
        a1, b1 = e1
        a2, b2 = e2
        return a1 * a2, a2 * b1 + b2
    a_cum, h = lax.associative_scan(combine, (a, u), axis=1)
    return a_cum * h0[:, None, :] + h


def rglru_gates(x, w_a, b_a, w_x, b_x, lam):
    b, n, _ = x.shape
    xb = x.reshape(b, n, LRU_BLOCKS, LRU_BLOCK_W)
    r = jax.nn.sigmoid(jnp.einsum('bnki,kij->bnkj', xb, w_a.astype(jnp.float32)).reshape(b, n, LRU_WIDTH) + b_a.astype(jnp.float32))
    i = jax.nn.sigmoid(jnp.einsum('bnki,kij->bnkj', xb, w_x.astype(jnp.float32)).reshape(b, n, LRU_WIDTH) + b_x.astype(jnp.float32))
    log_a = -LRU_C * r * jax.nn.softplus(-lam.astype(jnp.float32))
    a = jnp.exp(log_a)
    return a, jnp.sqrt(-jnp.expm1(2.0 * log_a)) * (i * x)


def rglru_mixer(h_lat, h_ctx, w_in, conv_w, conv_b, w_a, b_a, w_x, b_x, lam, w_out, with_ctx):
    def branches(h):
        gate, xr = jnp.split(h @ w_in, 2, axis=-1)
        return gate, centred_depthwise_conv(xr, conv_w, conv_b).astype(jnp.float32)

    gate_ctx, x_ctx = branches(h_ctx)
    gate_lat, x_lat = branches(h_lat)
    h0 = jnp.zeros((h_ctx.shape[0], LRU_WIDTH), jnp.float32)
    outs_ctx, outs_lat = [], []
    for d in range(2):
        orient = (lambda t: jnp.flip(t, axis=1)) if d == 1 else (lambda t: t)
        a_c, u_c = rglru_gates(orient(x_ctx), w_a[d], b_a[d], w_x[d], b_x[d], lam[d])
        hc = linear_scan(a_c, u_c, h0)
        a_l, u_l = rglru_gates(orient(x_lat), w_a[d], b_a[d], w_x[d], b_x[d], lam[d])
        hl = linear_scan(a_l, u_l, hc[:, -1])
        outs_lat.append(orient(hl))
        if with_ctx:
            outs_ctx.append(orient(hc))
    y_lat = (jax.nn.gelu(gate_lat) * (outs_lat[0] + outs_lat[1]).astype(gate_lat.dtype)) @ w_out
    y_ctx = None
    if with_ctx:
        y_ctx = (jax.nn.gelu(gate_ctx) * (outs_ctx[0] + outs_ctx[1]).astype(gate_ctx.dtype)) @ w_out
    return y_lat, y_ctx


def setup_inputs(seed: int = 0) -> dict:
    key = jax.random.key(seed)
    ks = list(jax.random.split(key, 32))
    nrm = lambda shape, s: jax.random.normal(ks.pop(), shape, jnp.float32) * s
    D = D_MODEL
    x = nrm((BATCH, SEQ, D), 1.0)
    c = nrm((BATCH, D), 1.0)
    ctx = nrm((BATCH, CTX_LEN, D), 1.0)
    c_ctx = nrm((D,), 1.0)
    ada_w = nrm((DEPTH, D, N_MOD * D), D ** -0.5)
    ada_b = nrm((DEPTH, N_MOD * D), 0.02)
    ln_g = 1.0 + nrm((DEPTH, N_SUB, D), 0.02)
    ln_b = nrm((DEPTH, N_SUB, D), 0.02)
    ffn_w_in = nrm((DEPTH, 2, D, 2 * D_FF), D ** -0.5)
    ffn_w_out = nrm((DEPTH, 2, D_FF, D), D_FF ** -0.5 * DEEPNORM_BETA)
    ret_w_in = nrm((N_LAYERS_A, D, RET_HEADS * (2 * RET_DK + 2 * RET_DV)), D ** -0.5)
    ret_w_out = nrm((N_LAYERS_A, RET_HEADS * RET_DV, D), (RET_HEADS * RET_DV) ** -0.5 * DEEPNORM_BETA)
    na_w_qkv = nrm((N_LAYERS_B, D, 3 * NA_HEADS * NA_HEAD_DIM), D ** -0.5)
    na_rpb = nrm((N_LAYERS_B, NA_HEADS, 2 * NA_WIN_R - 1, 2 * NA_WIN_C - 1), 0.1)
    na_w_out = nrm((N_LAYERS_B, NA_HEADS * NA_HEAD_DIM, D), (NA_HEADS * NA_HEAD_DIM) ** -0.5 * DEEPNORM_BETA)
    lru_w_in = nrm((N_LAYERS_C, D, 2 * LRU_WIDTH), D ** -0.5)
    lru_conv_w = nrm((N_LAYERS_C, LRU_CONV_W, LRU_WIDTH), LRU_CONV_W ** -0.5)
    lru_conv_b = nrm((N_LAYERS_C, LRU_WIDTH), 0.02)
    lru_w_a = nrm((N_LAYERS_C, 2, LRU_BLOCKS, LRU_BLOCK_W, LRU_BLOCK_W), LRU_BLOCK_W ** -0.5)
    lru_b_a = nrm((N_LAYERS_C, 2, LRU_WIDTH), 0.02)
    lru_w_x = nrm((N_LAYERS_C, 2, LRU_BLOCKS, LRU_BLOCK_W, LRU_BLOCK_W), LRU_BLOCK_W ** -0.5)
    lru_b_x = nrm((N_LAYERS_C, 2, LRU_WIDTH), 0.02)
    u = jax.random.uniform(ks.pop(), (N_LAYERS_C, 2, LRU_WIDTH), jnp.float32, minval=0.9, maxval=0.999)
    a = u ** (1.0 / LRU_C)
    lru_lam = jnp.log(a) - jnp.log1p(-a)
    lru_w_out = nrm((N_LAYERS_C, LRU_WIDTH, D), LRU_WIDTH ** -0.5 * DEEPNORM_BETA)
    return {'x': x, 'c': c, 'ctx': ctx, 'c_ctx': c_ctx, 'ada_w': ada_w, 'ada_b': ada_b,
            'ln_g': ln_g, 'ln_b': ln_b, 'ffn_w_in': ffn_w_in, 'ffn_w_out': ffn_w_out,
            'ret_w_in': ret_w_in, 'ret_w_out': ret_w_out,
            'na_w_qkv': na_w_qkv, 'na_rpb': na_rpb, 'na_w_out': na_w_out,
            'lru_w_in': lru_w_in, 'lru_conv_w': lru_conv_w, 'lru_conv_b': lru_conv_b,
            'lru_w_a': lru_w_a, 'lru_b_a': lru_b_a, 'lru_w_x': lru_w_x, 'lru_b_x': lru_b_x,
            'lru_lam': lru_lam, 'lru_w_out': lru_w_out}


def reference(x, c, ctx, c_ctx, ada_w, ada_b, ln_g, ln_b, ffn_w_in, ffn_w_out,
              ret_w_in, ret_w_out, na_w_qkv, na_rpb, na_w_out,
              lru_w_in, lru_conv_w, lru_conv_b, lru_w_a, lru_b_a, lru_w_x, lru_b_x,
              lru_lam, lru_w_out):
    h_lat, h_ctx = x, ctx
    s_lat, s_ctx = jax.nn.silu(c), jax.nn.silu(c_ctx)
    for layer in range(DEPTH):
        last = layer == DEPTH - 1
        m_l = (s_lat @ ada_w[layer] + ada_b[layer]).reshape(-1, N_MOD, 1, D_MODEL)
        m_l = [m_l[:, j] for j in range(N_MOD)]
        m_c = (s_ctx @ ada_w[layer] + ada_b[layer]).reshape(N_MOD, D_MODEL)
        m_c = [m_c[j] for j in range(N_MOD)]
        g, bb = ln_g[layer], ln_b[layer]
        h_lat = half_ffn(h_lat, m_l[0], m_l[1], m_l[2], ffn_w_in[layer, 0], ffn_w_out[layer, 0], g[0], bb[0])
        h_ctx = half_ffn(h_ctx, m_c[0], m_c[1], m_c[2], ffn_w_in[layer, 0], ffn_w_out[layer, 0], g[0], bb[0])
        u_lat = modulate(h_lat, m_l[3], m_l[4])
        u_ctx = modulate(h_ctx, m_c[3], m_c[4])
        kind, idx = layer % N_MIXERS, layer // N_MIXERS
        if kind == 0:
            y_lat, y_ctx = retention_mixer(u_lat, u_ctx, ret_w_in[idx], ret_w_out[idx], not last)
        elif kind == 1:
            y_lat, y_ctx = neighborhood_mixer(u_lat, u_ctx, na_w_qkv[idx], na_rpb[idx], na_w_out[idx], not last)
        else:
            y_lat, y_ctx = rglru_mixer(u_lat, u_ctx, lru_w_in[idx], lru_conv_w[idx], lru_conv_b[idx],
                                       lru_w_a[idx], lru_b_a[idx], lru_w_x[idx], lru_b_x[idx],
                                       lru_lam[idx], lru_w_out[idx], not last)
        h_lat = post_norm(h_lat, m_l[5] * y_lat, g[1], bb[1])
        if not last:
            h_ctx = post_norm(h_ctx, m_c[5] * y_ctx, g[1], bb[1])
        h_lat = half_ffn(h_lat, m_l[6], m_l[7], m_l[8], ffn_w_in[layer, 1], ffn_w_out[layer, 1], g[2], bb[2])
        if not last:
            h_ctx = half_ffn(h_ctx, m_c[6], m_c[7], m_c[8], ffn_w_in[layer, 1], ffn_w_out[layer, 1], g[2], bb[2])
    return h_lat
```

```cpp
#include <hip/hip_runtime.h>
#include <hip/hip_cooperative_groups.h>
#include <cstdio>
namespace cg = cooperative_groups;

#define LAS __attribute__((address_space(3)))
typedef unsigned short bf16_t;
typedef short bf16x8 __attribute__((ext_vector_type(8)));
typedef float f32x4 __attribute__((ext_vector_type(4)));
typedef unsigned u32x4 __attribute__((ext_vector_type(4)));
typedef unsigned u32x2 __attribute__((ext_vector_type(2)));

constexpr int DM = 1024, NB = 8, SEQ = 4096, CTXL = 256, DFF = 2816;
constexpr int MCTX = NB * CTXL, MLAT = NB * SEQ, MTOT = MCTX + MLAT;
constexpr int NMOD = 9;
constexpr float DN_ALPHA = 1.681792830507429f;
constexpr float LN_EPS = 1e-5f;
constexpr float LOG2E = 1.4426950408889634f;
constexpr int LDS_BYTES = 147456;

constexpr size_t E_FFN_IN = 0;
constexpr size_t E_FFN_OUT = E_FFN_IN + (size_t)8 * 5632 * 1024;
constexpr size_t E_RET_IN = E_FFN_OUT + (size_t)8 * 1024 * 2816;
constexpr size_t E_RET_OUT = E_RET_IN + (size_t)2 * 6144 * 1024;
constexpr size_t E_NA_QKV = E_RET_OUT + (size_t)2 * 1024 * 2048;
constexpr size_t E_NA_OUT = E_NA_QKV + (size_t)3072 * 1024;
constexpr size_t E_LRU_IN = E_NA_OUT + (size_t)1024 * 1024;
constexpr size_t E_LRU_OUT = E_LRU_IN + (size_t)2048 * 1024;
constexpr size_t E_GATES = E_LRU_OUT + (size_t)1024 * 1024;
constexpr size_t E_WT_END = E_GATES + (size_t)2 * 2048 * 256;
constexpr size_t R1 = (size_t)MTOT * 1024 * 2;
constexpr size_t WS_WT = 0;
constexpr size_t WS_U = WS_WT + E_WT_END * 2;
constexpr size_t WS_HC = WS_U + R1;
constexpr size_t WS_MOD = WS_HC + (size_t)MCTX * 1024 * 4;
constexpr size_t WS_ROPE = WS_MOD + (size_t)4 * 9 * 9216 * 4;
constexpr size_t WS_CARRY = WS_ROPE + (size_t)2 * 4096 * 4;
constexpr size_t WS_BAR = WS_CARRY + (size_t)NB * 68 * 1024 * 2 * 4;
constexpr size_t WS_BIG = WS_BAR + 262144;
constexpr size_t WS_END = WS_BIG + 6 * R1;

struct Args {
    const float* x; const float* c; const float* ctx; const float* c_ctx; const float* ada_w; const float* ada_b; const float* ln_g; const float* ln_b;
    const float* ffn_w_in; const float* ffn_w_out; const float* ret_w_in; const float* ret_w_out; const float* na_w_qkv; const float* na_rpb; const float* na_w_out;
    const float* lru_w_in; const float* lru_conv_w; const float* lru_conv_b; const float* lru_w_a; const float* lru_b_a; const float* lru_w_x; const float* lru_b_x;
    const float* lru_lam; const float* lru_w_out;
    float* out; unsigned char* ws; int ph_lo, ph_hi;
};

struct Grp { int b_lo, nb, rank, gsize; };
__device__ __forceinline__ int grp_row(const Grp& g, int lr) { const int b = g.b_lo + lr / 4352, t = lr % 4352; return t < 256 ? b * 256 + t : MCTX + b * 4096 + (t - 256); }
__device__ __forceinline__ int grp_row_lat(const Grp& g, int lr) { return MCTX + (g.b_lo + (lr >> 12)) * 4096 + (lr & 4095); }
__device__ __forceinline__ int otid() { int t = threadIdx.x; asm volatile("" : "+v"(t)); return t; }
__device__ __forceinline__ float shx(float v, int lane, int m) { return __int_as_float(__builtin_amdgcn_ds_bpermute((lane ^ m) << 2, __float_as_int(v))); }
__device__ __forceinline__ unsigned cvt_pk_bf16(float lo, float hi) { unsigned r; asm volatile("v_cvt_pk_bf16_f32 %0, %1, %2" : "=v"(r) : "v"(lo), "v"(hi)); return r; }
__device__ __forceinline__ float bflo(unsigned w) { return __uint_as_float(w << 16); }
__device__ __forceinline__ float bfhi(unsigned w) { return __uint_as_float(w & 0xffff0000u); }
__device__ __forceinline__ float bf2f(bf16_t b) { return __uint_as_float(((unsigned)b) << 16); }
__device__ __forceinline__ bf16_t f2bf(float f) { return (bf16_t)(cvt_pk_bf16(f, 0.f) & 0xffffu); }
__device__ __forceinline__ float silu_f(float x) { return x * __builtin_amdgcn_rcpf(1.f + __expf(-x)); }
__device__ __forceinline__ float sigmoid_f(float x) { return __builtin_amdgcn_rcpf(1.f + __expf(-x)); }
__device__ __forceinline__ float gelu_tanh_f(float x) { const float z = 0.7978845608028654f * (x + 0.044715f * x * x * x); const float t = 1.f - 2.f * __builtin_amdgcn_rcpf(__expf(2.f * z) + 1.f); return 0.5f * x * (1.f + t); }

namespace pg8 {
constexpr int BM = 256, BK = 64, HALF = 128, HTB = HALF * BK * 2  , STAGE_BYTES = 8 * HTB, NXCD = 8, WGM = 8;
__host__ __device__ __forceinline__ int lds_byte(int r, int c) { const int st = (r >> 4) * 2 + (c >> 5), rr = r & 15, cc = c & 31, ob = rr * 64 + cc * 2; return st * 1024 + (ob ^ (((ob >> 9) & 1) << 5)); }
__host__ __device__ __forceinline__ void stage_rc(int b, int& R, int& C) { const int st = b / 1024, sb = b % 1024, swz = sb ^ (((sb >> 9) & 1) << 5); R = (st >> 1) * 16 + swz / 64; C = (st & 1) * 32 + (swz % 64) / 2; }
__host__ __device__ __forceinline__ int perm32(int rho) { const int n = rho >> 4, i = rho & 15; return 8 * (i >> 2) + 4 * n + (i & 3); }

struct Unit { int pm, pn; };
struct Gemm { const bf16_t* A; const bf16_t* Bt; int M, N, K, lda, a_sh, a_cols; };

struct StaticOrder {
    int nM, nN, nwg, G, c;
    __host__ __device__ void init(int M, int N, int G_, int c_) { nM = M / BM; nN = N / BM; nwg = nM * nN; G = G_; c = c_; }
    __host__ __device__ bool next(int i, Unit& u) const {
        const long L = (long)i * G + c; if (L >= nwg) return false;
        int wgid = (int)L; { const int q = nwg / NXCD, r = nwg % NXCD, xcd = wgid % NXCD, off = wgid / NXCD; wgid = (xcd < r ? xcd * (q + 1) : r * (q + 1) + (xcd - r) * q) + off; }
        const int nig = WGM * nN, gid = wgid / nig, fm = gid * WGM, gsz = (nM - fm) < WGM ? (nM - fm) : WGM;
        u.pm = fm + ((wgid % nig) % gsz); u.pn = (wgid % nig) / gsz; return true;
    }
    __device__ __forceinline__ void a_ready(const Unit&) const {}
    __device__ __forceinline__ void done(const Unit&) const {}
};

struct GroupOrder {
    int nP, nN, nwg, G, c, b_lo, per; unsigned* pcnt;
    __device__ void init(int nb, int b_lo_, bool skipctx, int N, int G_, int c_) { pcnt = nullptr; per = skipctx ? 16 : 17; nP = nb * per; nN = N / BM; nwg = nP * nN; G = G_; c = c_; b_lo = b_lo_; }
    __device__ bool next(int i, Unit& u) const {
        const long L = (long)i * G + c; if (L >= nwg) return false;
        const int wgid = (int)L, nig = WGM * nN, gid = wgid / nig, fm = gid * WGM, gsz = (nP - fm) < WGM ? (nP - fm) : WGM;
        const int lp = fm + ((wgid % nig) % gsz); u.pn = (wgid % nig) / gsz;
        const int b = b_lo + lp / per, j = lp % per;
        u.pm = (per == 16) ? 8 + 16 * b + j : (j == 0 ? b : 8 + 16 * b + j - 1);
        return true;
    }
    __device__ __forceinline__ void a_ready(const Unit&) const {}
    __device__ __forceinline__ void done(const Unit& u) const {
        if (pcnt) { asm volatile("s_waitcnt vmcnt(0)" ::: "memory");
            if ((threadIdx.x & 63) == 0) (void)__hip_atomic_fetch_add(pcnt + u.pm, 1u, __ATOMIC_RELAXED, __HIP_MEMORY_SCOPE_AGENT); }
    }
};

template <class Epi, class Sched>
__device__ __forceinline__ void gemm_phase(LAS unsigned char* lds, const Gemm g, const Sched& S, const Epi& E) {
    const int tid = otid(), wid = __builtin_amdgcn_readfirstlane(tid >> 6), lane = tid & 63, wr = wid >> 2, wc = wid & 3, fr = lane & 15, fq = lane >> 4;
    const int K = g.K, nt = K / BK, lda = g.lda;
    unsigned voffA[2], voffB[2];
#pragma unroll
    for (int i = 0; i < 2; ++i) { int R, C; stage_rc(tid * 16 + i * 8192, R, C); const int Rb = Epi::PERM ? ((R & ~31) + perm32(R & 31)) : R;
        voffA[i] = (unsigned)(R * lda + C) * 2u; voffB[i] = (unsigned)(Rb * K + C) * 2u; }
    const size_t kstep = (size_t)(BK * 2);
    const size_t hstepA = (size_t)HALF * lda * 2, hstepB = (size_t)HALF * K * 2;
    const size_t tstepA = 2 * hstepA, tstepB = 2 * hstepB;
    const unsigned ldsw = (unsigned)wid * 1024u;
    const int aoff = lds_byte(wr * 64 + fr, fq * 8), boff = lds_byte(wc * 32 + fr, fq * 8);
#define PG8_SA(b, h) (((b) * 2 + (h)) * HTB)
#define PG8_SB(b, h) ((4 + (b) * 2 + (h)) * HTB)
#define PG8_STAGE(bufoff, gbase, voff) do { _Pragma("unroll") for (int _i = 0; _i < 2; ++_i) \
        __builtin_amdgcn_global_load_lds((const unsigned*)((const char*)(gbase) + (voff)[_i]), (LAS unsigned*)(lds + (bufoff) + ldsw + _i * 8192), 16, 0, 0); } while (0)
#define PG8_LDA(dst, b, h) do { _Pragma("unroll") for (int m = 0; m < 4; ++m) _Pragma("unroll") for (int k = 0; k < 2; ++k) dst[m][k] = *(const LAS bf16x8*)(lds + PG8_SA(b, h) + aoff + m * 2048 + k * 1024); } while (0)
#define PG8_LDB(dst, b, h) do { _Pragma("unroll") for (int n = 0; n < 2; ++n) _Pragma("unroll") for (int k = 0; k < 2; ++k) dst[n][k] = *(const LAS bf16x8*)(lds + PG8_SB(b, h) + boff + n * 2048 + k * 1024); } while (0)
#define PG8_MMA(ai, bj, At, Bt) do { __builtin_amdgcn_s_setprio(1); _Pragma("unroll") for (int m = 0; m < 4; ++m) _Pragma("unroll") for (int n = 0; n < 2; ++n) _Pragma("unroll") for (int k = 0; k < 2; ++k) \
        acc[ai][bj][m][n] = __builtin_amdgcn_mfma_f32_16x16x32_bf16(Bt[n][k], At[m][k], acc[ai][bj][m][n], 0, 0, 0); __builtin_amdgcn_s_setprio(0); } while (0)
#define PG8_WAIT_V(n) asm volatile("s_waitcnt vmcnt(" #n ")" ::: "memory")
#define PG8_WAIT_L(n) asm volatile("s_waitcnt lgkmcnt(" #n ")" ::: "memory")
#define PG8_BAR __builtin_amdgcn_s_barrier()
#define PG8_SCHED __builtin_amdgcn_sched_barrier(0)
#define PG8_AOFF(u) ((size_t)(u).pm * tstepA + (size_t)(((u).pn >> g.a_sh) * g.a_cols) * 2)
    Unit cur, nxt; int ui = 0;
    if (!S.next(0, cur)) return;
    f32x4 acc[2][2][4][2];
#pragma unroll
    for (int a = 0; a < 2; ++a)
#pragma unroll
        for (int b = 0; b < 2; ++b)
#pragma unroll
            for (int m = 0; m < 4; ++m)
#pragma unroll
                for (int n = 0; n < 2; ++n) acc[a][b][m][n] = (f32x4){0.f, 0.f, 0.f, 0.f};
    bf16x8 At[4][2], B0[2][2], B1[2][2];
    const char* cA = (const char*)g.A + PG8_AOFF(cur); const char* cB = (const char*)g.Bt + (size_t)cur.pn * tstepB;
    S.a_ready(cur);
    PG8_STAGE(PG8_SB(0, 0), cB, voffB); PG8_STAGE(PG8_SA(0, 0), cA, voffA); PG8_STAGE(PG8_SB(0, 1), cB + hstepB, voffB); PG8_STAGE(PG8_SA(0, 1), cA + hstepA, voffA);
    if (wr == 1) PG8_BAR;
    PG8_WAIT_V(4); PG8_BAR;
    PG8_STAGE(PG8_SB(1, 0), cB + kstep, voffB); PG8_STAGE(PG8_SA(1, 0), cA + kstep, voffA); PG8_STAGE(PG8_SB(1, 1), cB + hstepB + kstep, voffB);
    PG8_WAIT_V(6); PG8_BAR;
    for (;;) {
        const bool has_next = S.next(ui + 1, nxt);
        const char* nA = has_next ? (const char*)g.A + PG8_AOFF(nxt) : cA; const char* nB = has_next ? (const char*)g.Bt + (size_t)nxt.pn * tstepB : cB;
        for (int t = 0; t < nt; t += 2) {
            const bool last = (t == nt - 2);
            const char* a1 = cA + (size_t)(t + 1) * kstep;
            const char* a2 = last ? nA : cA + (size_t)(t + 2) * kstep; const char* b2 = last ? nB : cB + (size_t)(t + 2) * kstep;
            const char* a3 = a2 + kstep; const char* b3 = b2 + kstep;
            if (last && has_next) S.a_ready(nxt);
            PG8_LDB(B0, 0, 0); PG8_SCHED; PG8_LDA(At, 0, 0); PG8_STAGE(PG8_SA(1, 1), a1 + hstepA, voffA);
            PG8_WAIT_L(8); PG8_BAR; PG8_WAIT_L(0); PG8_MMA(0, 0, At, B0); PG8_BAR; PG8_SCHED;
            PG8_LDB(B1, 0, 1); PG8_STAGE(PG8_SB(0, 0), b2, voffB);
            PG8_BAR; PG8_WAIT_L(0); PG8_MMA(0, 1, At, B1); PG8_BAR;
            PG8_LDA(At, 0, 1); PG8_STAGE(PG8_SA(0, 0), a2, voffA);
            PG8_BAR; PG8_WAIT_L(0); PG8_MMA(1, 0, At, B0); PG8_BAR; PG8_SCHED;
            PG8_STAGE(PG8_SB(0, 1), b2 + hstepB, voffB);
            PG8_WAIT_V(6); PG8_BAR; PG8_MMA(1, 1, At, B1); PG8_BAR;
            PG8_LDB(B0, 1, 0); PG8_SCHED; PG8_LDA(At, 1, 0); PG8_STAGE(PG8_SA(0, 1), a2 + hstepA, voffA);
            PG8_WAIT_L(8); PG8_BAR; PG8_WAIT_L(0); PG8_MMA(0, 0, At, B0); PG8_BAR; PG8_SCHED;
            PG8_LDB(B1, 1, 1); PG8_STAGE(PG8_SB(1, 0), b3, voffB);
            PG8_BAR; PG8_WAIT_L(0); PG8_MMA(0, 1, At, B1); PG8_BAR;
            PG8_LDA(At, 1, 1); PG8_STAGE(PG8_SA(1, 0), a3, voffA);
            PG8_BAR; PG8_WAIT_L(0); PG8_MMA(1, 0, At, B0); PG8_BAR; PG8_SCHED;
            PG8_STAGE(PG8_SB(1, 1), b3 + hstepB, voffB);
            PG8_WAIT_V(6); PG8_BAR; PG8_MMA(1, 1, At, B1); PG8_BAR;
        }
        E(acc, cur, wr, wc, fr, fq); S.done(cur);
        if (!has_next) break;
#pragma unroll
        for (int a = 0; a < 2; ++a)
#pragma unroll
            for (int b = 0; b < 2; ++b)
#pragma unroll
                for (int m = 0; m < 4; ++m)
#pragma unroll
                    for (int n = 0; n < 2; ++n) acc[a][b][m][n] = (f32x4){0.f, 0.f, 0.f, 0.f};
        cur = nxt; cA = nA; cB = nB; ++ui;
    }
    PG8_WAIT_V(0);
    if (wr == 0) PG8_BAR;
    PG8_BAR;
#undef PG8_SA
#undef PG8_SB
#undef PG8_STAGE
#undef PG8_LDA
#undef PG8_LDB
#undef PG8_MMA
#undef PG8_WAIT_V
#undef PG8_WAIT_L
#undef PG8_BAR
#undef PG8_SCHED
#undef PG8_AOFF
}
}

#define XB_TMO      128
#define XB_XCNT(j)  (256  + 64 * (j))
#define XB_XSUB(j)  (1280 + 64 * (j))
#define XB_XGEN(j)  (2304 + 64 * (j))
#define XB_TOP      3328
#define XB_TOPGEN   3392
#define XCD_BAR_WORDS 3456
#define XB_LSUB(j)  (3456 + 64 * (j))
#define XB_LGEN(j)  (3488 + 64 * (j))
#define XB_PCNT(p, pm) (4096 + (p) * 136 + (pm))
#define XB_RCTR(p, g)   (16384 + ((p) * 8 + (g)) * 64)
#define XB_SPIN_CAP (1u << 21)
__device__ __forceinline__ unsigned xb_ld(unsigned* p)              { return __hip_atomic_load(p, __ATOMIC_RELAXED, __HIP_MEMORY_SCOPE_AGENT); }
__device__ __forceinline__ unsigned xb_add(unsigned* p, unsigned v) { return __hip_atomic_fetch_add(p, v, __ATOMIC_RELAXED, __HIP_MEMORY_SCOPE_AGENT); }
__device__ __forceinline__ unsigned xb_xcc_id() { return (unsigned)__builtin_amdgcn_s_getreg((3 << 11) | 20) & 0xFu; }
#define XB_SPIN(cond, bar) do { unsigned _sp = 0; while (cond) { __builtin_amdgcn_s_sleep(1); \
    if ((++_sp & 255u) == 0u) { if (xb_ld(&(bar)[XB_TMO])) break; if (_sp > XB_SPIN_CAP) { atomicAdd(&(bar)[XB_TMO], 1u); break; } } } } while (0)
__device__ __forceinline__ void xcd_barrier_complete(unsigned* bar, unsigned x, unsigned& nloc, unsigned& nx) {
    const unsigned G = gridDim.x * gridDim.y * gridDim.z;
    unsigned sum, cnt, mine, sp = 0u;
    for (;;) {
        sum = 0u; cnt = 0u; mine = 0u;
#pragma unroll
        for (unsigned j = 0; j < 16; ++j) { const unsigned c = xb_ld(&bar[XB_XCNT(j)]); sum += c; cnt += (c > 0u) ? 1u : 0u; mine = (j == x) ? c : mine; }
        if (sum == G) break;
        __builtin_amdgcn_s_sleep(1);
        if ((++sp & 255u) == 0u) { if (xb_ld(&bar[XB_TMO])) break; if (sp > XB_SPIN_CAP) { atomicAdd(&bar[XB_TMO], 1u); break; } }
    }
    nloc = mine > 0u ? mine : 1u; nx = cnt > 0u ? cnt : 1u;
}
__device__ __forceinline__ void xcd_barrier(unsigned* bar, volatile LAS unsigned* st) {
    asm volatile("s_waitcnt vmcnt(0)" ::: "memory");
    __syncthreads();
    if (threadIdx.x == 0) {
        const unsigned x = xb_xcc_id();
        __builtin_amdgcn_s_waitcnt(0);
        unsigned nloc = st[0], nx = st[1];
        if (nloc == 0u) { xcd_barrier_complete(bar, x, nloc, nx); st[0] = nloc; st[1] = nx; }
        const unsigned old = xb_add(&bar[XB_XSUB(x)], 1u);
        const unsigned gen = old / nloc;
        if (old + 1u == (gen + 1u) * nloc) {
            __builtin_amdgcn_fence(__ATOMIC_RELEASE, "agent");
            asm volatile("s_waitcnt vmcnt(0)" ::: "memory");
            const unsigned og = xb_add(&bar[XB_TOP], 1u);
            const unsigned tg = og / nx;
            if (og + 1u == (tg + 1u) * nx) xb_add(&bar[XB_TOPGEN], 1u);
            else XB_SPIN(xb_ld(&bar[XB_TOPGEN]) == tg, bar);
            __builtin_amdgcn_fence(__ATOMIC_ACQUIRE, "agent");
            xb_add(&bar[XB_XGEN(x)], 1u);
            asm volatile("s_waitcnt vmcnt(0)" ::: "memory");
        } else {
            XB_SPIN(xb_ld(&bar[XB_XGEN(x)]) == gen, bar);
            __builtin_amdgcn_fence(__ATOMIC_ACQUIRE, "agent");
            asm volatile("s_waitcnt vmcnt(0)" ::: "memory");
        }
    }
    __syncthreads();
}

__device__ __forceinline__ void xcd_local_barrier(unsigned* bar, unsigned x, unsigned nloc) {
    asm volatile("s_waitcnt vmcnt(0)" ::: "memory");
    __syncthreads();
    if (threadIdx.x == 0) {
        __builtin_amdgcn_s_waitcnt(0);
        const unsigned old = xb_add(&bar[XB_LSUB(x)], 1u), gen = old / nloc;
        if (old + 1u == (gen + 1u) * nloc) xb_add(&bar[XB_LGEN(x)], 1u);
        else XB_SPIN(xb_ld(&bar[XB_LGEN(x)]) == gen, bar);
        __builtin_amdgcn_fence(__ATOMIC_ACQUIRE, "agent");
        asm volatile("s_waitcnt vmcnt(0)" ::: "memory");
    }
    __syncthreads();
}
struct EpiSwiGLU {
    static constexpr bool PERM = true;
    bf16_t* H; int row_off;
    __device__ __forceinline__ void operator()(const f32x4 (&acc)[2][2][4][2], const pg8::Unit& u, int wr, int wc, int fr, int fq) const {
        const int row0 = row_off + u.pm * 256 + wr * 64 + fr, hc = u.pn * 128 + wc * 32 + 8 * fq;
#pragma unroll
        for (int ai = 0; ai < 2; ++ai)
#pragma unroll
            for (int m = 0; m < 4; ++m) {
                bf16_t* rowp = H + (size_t)(row0 + ai * 128 + m * 16) * DFF + hc;
                const f32x4 g0 = acc[ai][0][m][0], g1 = acc[ai][0][m][1], u0 = acc[ai][1][m][0], u1 = acc[ai][1][m][1];
                u32x4 w;
                w.x = cvt_pk_bf16(silu_f(g0[0]) * u0[0], silu_f(g0[1]) * u0[1]); w.y = cvt_pk_bf16(silu_f(g0[2]) * u0[2], silu_f(g0[3]) * u0[3]);
                w.z = cvt_pk_bf16(silu_f(g1[0]) * u1[0], silu_f(g1[1]) * u1[1]); w.w = cvt_pk_bf16(silu_f(g1[2]) * u1[2], silu_f(g1[3]) * u1[3]);
                *(u32x4*)rowp = w;
            }
    }
};
struct EpiPlain {
    static constexpr bool PERM = true;
    bf16_t* O; int ldc; int row_off; int split_cols; size_t split_stride; float scale0; int headmajor;
    __device__ __forceinline__ void operator()(const f32x4 (&acc)[2][2][4][2], const pg8::Unit& u, int wr, int wc, int fr, int fq) const {
        const int row0 = row_off + u.pm * 256 + wr * 64 + fr; int colt = u.pn * 256; bf16_t* base = O; float sc = scale0; int t = 0;
        if (split_cols) { t = colt / split_cols; base += (size_t)t * split_stride; colt -= t * split_cols; if (t) sc = 1.f; }
        const int col0 = colt + wc * 32 + 8 * fq; const bool hm = headmajor && t > 0;
        const size_t rstride = hm ? 64 : (size_t)ldc;
        const size_t cofs0 = hm ? (size_t)(col0 >> 6) * MTOT * 64 + (col0 & 63) : (size_t)col0, cofs1 = hm ? (size_t)((col0 + 128) >> 6) * MTOT * 64 + ((col0 + 128) & 63) : (size_t)col0 + 128;
#pragma unroll
        for (int ai = 0; ai < 2; ++ai)
#pragma unroll
            for (int m = 0; m < 4; ++m) { bf16_t* rowp = base + (size_t)(row0 + ai * 128 + m * 16) * rstride;
#pragma unroll
                for (int bj = 0; bj < 2; ++bj) { const f32x4 v0 = acc[ai][bj][m][0] * sc, v1 = acc[ai][bj][m][1] * sc;
                    u32x4 w; w.x = cvt_pk_bf16(v0[0], v0[1]); w.y = cvt_pk_bf16(v0[2], v0[3]); w.z = cvt_pk_bf16(v1[0], v1[1]); w.w = cvt_pk_bf16(v1[2], v1[3]);
                    *(u32x4*)(rowp + (bj ? cofs1 : cofs0)) = w; } }
    }
};
struct EpiRetIn {
    static constexpr bool PERM = true;
    bf16_t* Q; bf16_t* K; bf16_t* V; const float* rcos; const float* rsin;
    __device__ __forceinline__ void operator()(const f32x4 (&acc)[2][2][4][2], const pg8::Unit& u, int wr, int wc, int fr, int fq) const {
        const int row0 = u.pm * 256 + wr * 64 + fr, cin = wc * 32 + 8 * fq;
        if (u.pn >= 8) {
#pragma unroll
            for (int ai = 0; ai < 2; ++ai)
#pragma unroll
                for (int m = 0; m < 4; ++m) { bf16_t* rowp = V + (size_t)(row0 + ai * 128 + m * 16) * 2048 + (u.pn - 8) * 256 + cin;
#pragma unroll
                    for (int bj = 0; bj < 2; ++bj) { const f32x4 v0 = acc[ai][bj][m][0], v1 = acc[ai][bj][m][1];
                        u32x4 w; w.x = cvt_pk_bf16(v0[0], v0[1]); w.y = cvt_pk_bf16(v0[2], v0[3]); w.z = cvt_pk_bf16(v1[0], v1[1]); w.w = cvt_pk_bf16(v1[2], v1[3]);
                        *(u32x4*)(rowp + bj * 128) = w; } }
        } else {
            bf16_t* T = (u.pn < 4) ? Q : K; const float mul = (u.pn < 4) ? 1.f : 0.0625f; const int f0 = wc * 16 + 4 * fq;
#pragma unroll
            for (int ai = 0; ai < 2; ++ai)
#pragma unroll
                for (int m = 0; m < 4; ++m) { const int row = row0 + ai * 128 + m * 16; bf16_t* rowp = T + (size_t)row * 1024 + (u.pn & 3) * 256 + cin;
                    const bool lat = row >= MCTX; const int t = (row - MCTX) & 4095;
#pragma unroll
                    for (int bj = 0; bj < 2; ++bj) { f32x4 v0 = acc[ai][bj][m][0] * mul, v1 = acc[ai][bj][m][1] * mul;
                        if (lat) { const int pos = bj ? (t & 63) : (t >> 6); const f32x4 cs = *(const f32x4*)(rcos + pos * 64 + f0), sn = *(const f32x4*)(rsin + pos * 64 + f0);
                            const f32x4 a0 = v0, a1 = v1;
                            v0[0] = a0[0] * cs[0] - a0[1] * sn[0]; v0[1] = a0[0] * sn[0] + a0[1] * cs[0]; v0[2] = a0[2] * cs[1] - a0[3] * sn[1]; v0[3] = a0[2] * sn[1] + a0[3] * cs[1];
                            v1[0] = a1[0] * cs[2] - a1[1] * sn[2]; v1[1] = a1[0] * sn[2] + a1[1] * cs[2]; v1[2] = a1[2] * cs[3] - a1[3] * sn[3]; v1[3] = a1[2] * sn[3] + a1[3] * cs[3]; }
                        u32x4 w; w.x = cvt_pk_bf16(v0[0], v0[1]); w.y = cvt_pk_bf16(v0[2], v0[3]); w.z = cvt_pk_bf16(v1[0], v1[1]); w.w = cvt_pk_bf16(v1[2], v1[3]);
                        *(u32x4*)(rowp + bj * 128) = w; } }
        }
    }
};
struct EpiGates {
    static constexpr bool PERM = true;
    bf16_t* GP;
    __device__ __forceinline__ void operator()(const f32x4 (&acc)[2][2][4][2], const pg8::Unit& u, int wr, int wc, int fr, int fq) const {
        const int row0 = u.pm * 256 + wr * 64 + fr, col0 = (u.pn & 1) * 1024 + (u.pn >> 1) * 256 + wc * 32 + 8 * fq;
#pragma unroll
        for (int ai = 0; ai < 2; ++ai)
#pragma unroll
            for (int m = 0; m < 4; ++m) { bf16_t* rowp = GP + (size_t)(row0 + ai * 128 + m * 16) * 2048 + col0;
#pragma unroll
                for (int bj = 0; bj < 2; ++bj) { const f32x4 v0 = acc[ai][bj][m][0], v1 = acc[ai][bj][m][1];
                    u32x4 w; w.x = cvt_pk_bf16(v0[0], v0[1]); w.y = cvt_pk_bf16(v0[2], v0[3]); w.z = cvt_pk_bf16(v1[0], v1[1]); w.w = cvt_pk_bf16(v1[2], v1[3]);
                    *(u32x4*)(rowp + bj * 128) = w; } }
    }
};

struct CvtJob { const float* src; bf16_t* dst; int K, N, ld, perm; };
__device__ __forceinline__ CvtJob get_job(const Args& a, int j) {
    bf16_t* wt = (bf16_t*)(a.ws + WS_WT); CvtJob r;
    if (j < 8)       { r.src = a.ffn_w_in + (size_t)j * 1024 * 5632; r.dst = wt + E_FFN_IN + (size_t)j * 5632 * 1024; r.K = 1024; r.N = 5632; r.ld = 5632; r.perm = 1; }
    else if (j < 16) { const int i = j - 8; r.src = a.ffn_w_out + (size_t)i * 2816 * 1024; r.dst = wt + E_FFN_OUT + (size_t)i * 1024 * 2816; r.K = 2816; r.N = 1024; r.ld = 1024; r.perm = 0; }
    else if (j < 18) { const int i = j - 16; r.src = a.ret_w_in + (size_t)i * 1024 * 6144; r.dst = wt + E_RET_IN + (size_t)i * 6144 * 1024; r.K = 1024; r.N = 6144; r.ld = 6144; r.perm = 2; }
    else if (j < 20) { const int i = j - 18; r.src = a.ret_w_out + (size_t)i * 2048 * 1024; r.dst = wt + E_RET_OUT + (size_t)i * 1024 * 2048; r.K = 2048; r.N = 1024; r.ld = 1024; r.perm = 0; }
    else if (j == 20) { r.src = a.na_w_qkv; r.dst = wt + E_NA_QKV; r.K = 1024; r.N = 3072; r.ld = 3072; r.perm = 0; }
    else if (j == 21) { r.src = a.na_w_out; r.dst = wt + E_NA_OUT; r.K = 1024; r.N = 1024; r.ld = 1024; r.perm = 0; }
    else if (j == 22) { r.src = a.lru_w_in; r.dst = wt + E_LRU_IN; r.K = 1024; r.N = 2048; r.ld = 2048; r.perm = 0; }
    else if (j == 23) { r.src = a.lru_w_out; r.dst = wt + E_LRU_OUT; r.K = 1024; r.N = 1024; r.ld = 1024; r.perm = 0; }
    else { const int gI = j - 24, dir = gI >> 3, type = (gI >> 2) & 1, k = gI & 3;
        r.src = (type ? a.lru_w_x : a.lru_w_a) + (size_t)(dir * 4 + k) * 256 * 256; r.dst = wt + E_GATES + (size_t)dir * 2048 * 256 + (size_t)((k * 2 + type) * 256) * 256; r.K = 256; r.N = 256; r.ld = 256; r.perm = 0; }
    return r;
}
__device__ __forceinline__ int perm_col(int perm, int n) {
    if (perm == 1) return ((n & 255) >> 7) * 2816 + (n >> 8) * 128 + (n & 127);
    if (perm == 2) { if (n < 2048) { const int hb = n >> 8, dp = n & 255, p = dp >> 1, e = dp & 1; const int d = (p < 64) ? (p + 64 * e) : (128 + (p - 64) + 64 * e); return hb * 256 + d; } return n; }
    return n;
}
__device__ __forceinline__ void phase_prologue(const Args& a, LAS unsigned char* lds) {
    const int tid = otid(), G = gridDim.x;
    { LAS bf16_t* tile = (LAS bf16_t*)lds;
      int cum = 0;
      for (int j = 0; j < 40; ++j) {
          const CvtJob jb = get_job(a, j);
          const int tn = jb.N >> 6, ntile = tn * (jb.K >> 6);
          const int first = (int)((blockIdx.x + G - (cum % G)) % G);
          for (int t = first; t < ntile; t += G) {
              const int n0 = (t % tn) * 64, k0 = (t / tn) * 64, c = tid & 63, kr = tid >> 6;
              const float* sp = jb.src + (size_t)k0 * jb.ld + perm_col(jb.perm, n0 + c);
              float v[8];
#pragma unroll
              for (int i = 0; i < 8; ++i) v[i] = sp[(size_t)(kr + 8 * i) * jb.ld];
#pragma unroll
              for (int i = 0; i < 8; ++i) tile[c * 72 + kr + 8 * i] = f2bf(v[i]);
              __syncthreads();
              const int row = tid >> 3, ch = tid & 7;
              const u32x4 w = *(const LAS u32x4*)(tile + row * 72 + ch * 8);
              *(u32x4*)(jb.dst + (size_t)(n0 + row) * jb.K + k0 + ch * 8) = w;
              __syncthreads();
          }
          cum += ntile;
      } }
    { LAS float* sv = (LAS float*)lds; LAS float* red = sv + 9 * 1024; float* MOD = (float*)(a.ws + WS_MOD);
      for (int i = tid; i < 9 * 1024; i += 512) { const int r = i >> 10, k = i & 1023; const float cv = (r < 8) ? a.c[r * 1024 + k] : a.c_ctx[k]; sv[i] = cv / (1.f + expf(-cv)); }
      __syncthreads();
      for (int it = blockIdx.x; it < 288; it += G) {
          const int l = it / 72, cb = it % 72, cl = tid & 127, kq = tid >> 7;
          const float* W = a.ada_w + (size_t)l * 1024 * 9216 + cb * 128 + cl;
          float acc[9];
#pragma unroll
          for (int r = 0; r < 9; ++r) acc[r] = 0.f;
          for (int k = kq * 256; k < kq * 256 + 256; k += 4) {
              float w[4];
#pragma unroll
              for (int q = 0; q < 4; ++q) w[q] = W[(size_t)(k + q) * 9216];
#pragma unroll
              for (int q = 0; q < 4; ++q)
#pragma unroll
                  for (int r = 0; r < 9; ++r) acc[r] += sv[r * 1024 + k + q] * w[q];
          }
#pragma unroll
          for (int r = 0; r < 9; ++r) red[(kq * 9 + r) * 128 + cl] = acc[r];
          __syncthreads();
          for (int o = tid; o < 9 * 128; o += 512) { const int r = o >> 7, cc = o & 127, col = cb * 128 + cc;
              const float s = (red[(0 * 9 + r) * 128 + cc] + red[(1 * 9 + r) * 128 + cc]) + (red[(2 * 9 + r) * 128 + cc] + red[(3 * 9 + r) * 128 + cc]);
              MOD[(size_t)(l * 9 + r) * 9216 + col] = s + a.ada_b[l * 9216 + col]; }
          __syncthreads();
      } }
    { float* rc = (float*)(a.ws + WS_ROPE); float* rs = rc + 4096;
      for (int i = blockIdx.x * 512 + tid; i < 4096; i += G * 512) { const int pos = i >> 6, f = i & 63; const float fr = expf(-(float)(2 * f) * (1.f / 128.f) * 9.210340371976184f); const float ang = (float)pos * fr;
          rc[i] = cosf(ang); rs[i] = sinf(ang); } }
}

__device__ __forceinline__ void phase_u0(const Args& a, const Grp& gp) {
    const float* MOD = (const float*)(a.ws + WS_MOD); bf16_t* U = (bf16_t*)(a.ws + WS_U);
    for (int i = gp.rank * 512 + otid(); i < gp.nb * 4352 * 128; i += gp.gsize * 512) {
        const int row = grp_row(gp, i >> 7), c8 = (i & 127) * 8; const int r9 = row < MCTX ? 8 : (row - MCTX) >> 12;
        const float* hp = (row < MCTX ? a.ctx + (size_t)row * 1024 : a.x + (size_t)(row - MCTX) * 1024) + c8;
        const float* sh = MOD + (size_t)(r9 * 9 + 0) * 1024 + c8; const float* sc = sh + 1024;
        const f32x4 h0 = *(const f32x4*)hp, h1 = *(const f32x4*)(hp + 4), s0 = *(const f32x4*)sh, s1 = *(const f32x4*)(sh + 4), c0 = *(const f32x4*)sc, c1 = *(const f32x4*)(sc + 4);
        const f32x4 o0 = h0 * (c0 + 1.f) + s0, o1 = h1 * (c1 + 1.f) + s1;
        u32x4 w; w.x = cvt_pk_bf16(o0[0], o0[1]); w.y = cvt_pk_bf16(o0[2], o0[3]); w.z = cvt_pk_bf16(o1[0], o1[1]); w.w = cvt_pk_bf16(o1[2], o1[3]);
        *(u32x4*)(U + (size_t)row * 1024 + c8) = w;
    }
}

__device__ __forceinline__ void phase_postnorm(const Args& a, bool first, const bf16_t* Y, const float* modl, int gate_j, float ymul, const float* lng, const float* lnb,
                                               const float* modn, int sh_j, int row_begin, const Grp& gp) {
    const int tid = otid(), lane = tid & 63, gw = gp.rank * 8 + (tid >> 6), nw = gp.gsize * 8;
    const int nrows = gp.nb * (row_begin ? 4096 : 4352);
    float* HC = (float*)(a.ws + WS_HC); bf16_t* U = (bf16_t*)(a.ws + WS_U);
    f32x4 hr[2][4]; u32x2 yr[2][4];
#define PN_MAP(lr) (row_begin ? grp_row_lat(gp, (lr)) : grp_row(gp, (lr)))
#define PN_ROW(t, lA) PN_MAP((t) ? (((lA) + nw < nrows) ? (lA) + nw : (lA)) : (lA))
#define PN_LOAD(dstH, dstY, rA) do { _Pragma("unroll") for (int t = 0; t < 2; ++t) { const int row = PN_ROW(t, rA); const bool isc = row < MCTX; \
        const float* hin = first ? (isc ? a.ctx + (size_t)row * 1024 : a.x + (size_t)(row - MCTX) * 1024) : (isc ? HC + (size_t)row * 1024 : a.out + (size_t)(row - MCTX) * 1024); \
        const bf16_t* yp = Y + (size_t)row * 1024; \
        _Pragma("unroll") for (int c = 0; c < 4; ++c) { const int col = c * 256 + lane * 4; dstH[t][c] = *(const f32x4*)(hin + col); dstY[t][c] = *(const u32x2*)(yp + col); } } } while (0)
    f32x4 gv[4], bv[4];
#pragma unroll
    for (int c = 0; c < 4; ++c) { gv[c] = *(const f32x4*)(lng + c * 256 + lane * 4); bv[c] = *(const f32x4*)(lnb + c * 256 + lane * 4); }
    int rowA = gw;
    if (rowA < nrows) PN_LOAD(hr, yr, rowA);
    for (; rowA < nrows; rowA += 2 * nw) {
        const bool hasB = rowA + nw < nrows;
        f32x4 v[2][4]; float s[2] = {0.f, 0.f}, q[2] = {0.f, 0.f};
#pragma unroll
        for (int t = 0; t < 2; ++t) { const int row = PN_ROW(t, rowA); const int r9 = row < MCTX ? 8 : (row - MCTX) >> 12;
            const float* gate = modl + (size_t)(r9 * 9 + gate_j) * 1024;
#pragma unroll
            for (int c = 0; c < 4; ++c) { const int col = c * 256 + lane * 4; const f32x4 gt = *(const f32x4*)(gate + col);
                const f32x4 y = {bflo(yr[t][c].x), bfhi(yr[t][c].x), bflo(yr[t][c].y), bfhi(yr[t][c].y)};
                v[t][c] = hr[t][c] * DN_ALPHA + gt * y * ymul; s[t] += (v[t][c][0] + v[t][c][1]) + (v[t][c][2] + v[t][c][3]);
                q[t] += (v[t][c][0] * v[t][c][0] + v[t][c][1] * v[t][c][1]) + (v[t][c][2] * v[t][c][2] + v[t][c][3] * v[t][c][3]); } }
        const int rowN = rowA + 2 * nw;
        if (rowN < nrows) PN_LOAD(hr, yr, rowN);
#pragma unroll
        for (int o = 32; o >= 1; o >>= 1) { const float s0 = shx(s[0], lane, o), s1 = shx(s[1], lane, o), q0 = shx(q[0], lane, o), q1 = shx(q[1], lane, o); s[0] += s0; s[1] += s1; q[0] += q0; q[1] += q1; }
#pragma unroll
        for (int t = 0; t < 2; ++t) { if (t && !hasB) break; const int row = PN_MAP(t ? rowA + nw : rowA);
            const bool isc = row < MCTX; const int r9 = isc ? 8 : (row - MCTX) >> 12;
            float* hout = isc ? HC + (size_t)row * 1024 : a.out + (size_t)(row - MCTX) * 1024;
            const float mean = s[t] * (1.f / 1024.f); const float var = fmaxf(q[t] * (1.f / 1024.f) - mean * mean, 0.f);
            const float rstd = 1.0f / sqrtf(var + LN_EPS);
#pragma unroll
            for (int c = 0; c < 4; ++c) { const int col = c * 256 + lane * 4;
                const f32x4 hn = (v[t][c] - mean) * rstd * gv[c] + bv[c]; *(f32x4*)(hout + col) = hn;
                if (sh_j >= 0) { const f32x4 sh = *(const f32x4*)(modn + (size_t)(r9 * 9 + sh_j) * 1024 + col), sc = *(const f32x4*)(modn + (size_t)(r9 * 9 + sh_j + 1) * 1024 + col);
                    const f32x4 o = hn * (sc + 1.f) + sh; u32x2 w; w.x = cvt_pk_bf16(o[0], o[1]); w.y = cvt_pk_bf16(o[2], o[3]); *(u32x2*)(U + (size_t)row * 1024 + col) = w; } } }
    }
#undef PN_LOAD
#undef PN_ROW
#undef PN_MAP
}

__device__ __forceinline__ void phase_postnorm_dyn(const Args& a, bool first, const bf16_t* Y, const float* modl, int gate_j, float ymul, const float* lng, const float* lnb,
                                                   const float* modn, int sh_j, bool skipctx, const Grp& gp, unsigned* pcnt, unsigned* rctr) {
    const int tid = otid(), lane = tid & 63, b = gp.b_lo, nrows = skipctx ? 4096 : 4352, npan = skipctx ? 16 : 17;
    float* HC = (float*)(a.ws + WS_HC); bf16_t* U = (bf16_t*)(a.ws + WS_U);
    f32x4 gv[4], bv[4];
#pragma unroll
    for (int c = 0; c < 4; ++c) { gv[c] = *(const f32x4*)(lng + c * 256 + lane * 4); bv[c] = *(const f32x4*)(lnb + c * 256 + lane * 4); }
    const int pmj = skipctx ? 8 + 16 * b + lane : (lane == 0 ? b : 8 + 16 * b + lane - 1);
    int done_upto = 0;
    f32x4 hr[2][4]; u32x2 yr[2][4];
#define PD_DEQ(dst) do { int _i = 0; if (lane == 0) _i = (int)__hip_atomic_fetch_add(rctr, 1u, __ATOMIC_RELAXED, __HIP_MEMORY_SCOPE_AGENT); dst = 8 * __builtin_amdgcn_readfirstlane(_i); } while (0)
#define PD_ROW(lr) (skipctx ? grp_row_lat(gp, (lr)) : grp_row(gp, (lr)))
#define PD_WAIT(ix) do { const int _lp = (ix) >> 8; if (_lp >= done_upto) { \
        for (unsigned _sp = 0; _sp < (1u << 14); ++_sp) { \
            const unsigned _cj = (lane < npan) ? __hip_atomic_load(pcnt + pmj, __ATOMIC_RELAXED, __HIP_MEMORY_SCOPE_AGENT) : 32u; \
            const unsigned long long _m = __ballot(_cj >= 32u); int _du = (_m == ~0ull) ? 64 : __builtin_ctzll(~_m); if (_du > npan) _du = npan; \
            if (_lp < _du) { done_upto = _du; break; } \
            __builtin_amdgcn_s_sleep(127); __builtin_amdgcn_s_sleep(127); } \
        __builtin_amdgcn_fence(__ATOMIC_ACQUIRE, "agent"); asm volatile("s_waitcnt vmcnt(0)" ::: "memory"); } } while (0)
#define PD_LOAD(ix) do { _Pragma("unroll") for (int t = 0; t < 2; ++t) { const int row = PD_ROW((ix) + t); const bool isc = row < MCTX; \
        const float* hin = first ? (isc ? a.ctx + (size_t)row * 1024 : a.x + (size_t)(row - MCTX) * 1024) : (isc ? HC + (size_t)row * 1024 : a.out + (size_t)(row - MCTX) * 1024); \
        const bf16_t* yp = Y + (size_t)row * 1024; \
        _Pragma("unroll") for (int c = 0; c < 4; ++c) { const int col = c * 256 + lane * 4; hr[t][c] = *(const f32x4*)(hin + col); yr[t][c] = *(const u32x2*)(yp + col); } } } while (0)
    int idx, left = 3; PD_DEQ(idx);
    if (idx >= nrows) return;
    PD_WAIT(idx); PD_LOAD(idx);
    for (;;) {
        int nxt; if (left > 0) { nxt = idx + 2; --left; } else { PD_DEQ(nxt); left = 3; }
        f32x4 v[2][4]; float s[2] = {0.f, 0.f}, q[2] = {0.f, 0.f};
#pragma unroll
        for (int t = 0; t < 2; ++t) { const int row = PD_ROW(idx + t); const int r9 = row < MCTX ? 8 : (row - MCTX) >> 12;
            const float* gate = modl + (size_t)(r9 * 9 + gate_j) * 1024;
#pragma unroll
            for (int c = 0; c < 4; ++c) { const int col = c * 256 + lane * 4; const f32x4 gt = *(const f32x4*)(gate + col);
                const f32x4 y = {bflo(yr[t][c].x), bfhi(yr[t][c].x), bflo(yr[t][c].y), bfhi(yr[t][c].y)};
                v[t][c] = hr[t][c] * DN_ALPHA + gt * y * ymul; s[t] += (v[t][c][0] + v[t][c][1]) + (v[t][c][2] + v[t][c][3]);
                q[t] += (v[t][c][0] * v[t][c][0] + v[t][c][1] * v[t][c][1]) + (v[t][c][2] * v[t][c][2] + v[t][c][3] * v[t][c][3]); } }
        if (nxt < nrows) { PD_WAIT(nxt); PD_LOAD(nxt); }
#pragma unroll
        for (int o = 32; o >= 1; o >>= 1) { const float s0 = shx(s[0], lane, o), s1 = shx(s[1], lane, o), q0 = shx(q[0], lane, o), q1 = shx(q[1], lane, o); s[0] += s0; s[1] += s1; q[0] += q0; q[1] += q1; }
#pragma unroll
        for (int t = 0; t < 2; ++t) { const int row = PD_ROW(idx + t); const bool isc = row < MCTX; const int r9 = isc ? 8 : (row - MCTX) >> 12;
            float* hout = isc ? HC + (size_t)row * 1024 : a.out + (size_t)(row - MCTX) * 1024;
            const float mean = s[t] * (1.f / 1024.f); const float var = fmaxf(q[t] * (1.f / 1024.f) - mean * mean, 0.f);
            const float rstd = 1.0f / sqrtf(var + LN_EPS);
#pragma unroll
            for (int c = 0; c < 4; ++c) { const int col = c * 256 + lane * 4;
                const f32x4 hn = (v[t][c] - mean) * rstd * gv[c] + bv[c]; *(f32x4*)(hout + col) = hn;
                if (sh_j >= 0) { const f32x4 sh = *(const f32x4*)(modn + (size_t)(r9 * 9 + sh_j) * 1024 + col), sc = *(const f32x4*)(modn + (size_t)(r9 * 9 + sh_j + 1) * 1024 + col);
                    const f32x4 o = hn * (sc + 1.f) + sh; u32x2 w; w.x = cvt_pk_bf16(o[0], o[1]); w.y = cvt_pk_bf16(o[2], o[3]); *(u32x2*)(U + (size_t)row * 1024 + col) = w; } } }
        if (nxt >= nrows) break;
        idx = nxt;
    }
#undef PD_DEQ
#undef PD_ROW
#undef PD_WAIT
#undef PD_LOAD
}
template <int RABL>
__device__ __forceinline__ void phase_retention(const Args& a, LAS unsigned char* lds, const Grp& gp) {
    const bf16_t* Qg = (const bf16_t*)(a.ws + WS_BIG); const bf16_t* Kg = (const bf16_t*)(a.ws + WS_BIG + R1); const bf16_t* Vg = (const bf16_t*)(a.ws + WS_BIG + 2 * R1); bf16_t* Og = (bf16_t*)(a.ws + WS_BIG + 4 * R1);
    const int tid = otid(), w = __builtin_amdgcn_readfirstlane(tid >> 6), lane = tid & 63, c = lane & 15, g = lane >> 4;
    const int ib = w & 3, vh = w >> 2, vb2 = w & 3, dbase = (w >> 2) * 8;
    constexpr int QS = 0, KS = 32768, VS = 65536, ST = 73728;
    typedef short s16x4 __attribute__((ext_vector_type(4)));
    for (int item = gp.rank; item < gp.nb * 32; item += gp.gsize) {
        const int b = gp.b_lo + (item >> 5), h = (item >> 3) & 3, vs = item & 7;
        f32x4 accS[8]; u32x4 qreg[4], kreg[4], vreg; float lg = 0.f, g64 = 0.f;
        { const int row0 = b * 256;
#pragma unroll
          for (int i = 0; i < 4; ++i) { const int idx = tid + 512 * i, row = idx >> 5, ch = idx & 31; const size_t o = (size_t)(row0 + row) * 1024 + h * 256 + ch * 8; qreg[i] = *(const u32x4*)(Qg + o); kreg[i] = *(const u32x4*)(Kg + o); }
          vreg = *(const u32x4*)(Vg + (size_t)(row0 + (tid >> 3)) * 2048 + h * 512 + vs * 64 + (tid & 7) * 8); }
        for (int step = 0; step < 136; ++step) {
            const int dir = step >= 68 ? 1 : 0, s = step - 68 * dir;
            if (s == 0) {
#pragma unroll
                for (int x = 0; x < 8; ++x) accS[x] = (f32x4){0.f, 0.f, 0.f, 0.f};
                const int hh = dir ? 3 - h : h; lg = log2f(1.0f - exp2f(-5.0f - (float)hh)); g64 = exp2f(64.f * lg);
            }
            const int row0 = dir ? (s < 4 ? b * 256 + 64 * (3 - s) : MCTX + b * 4096 + 64 * (63 - (s - 4))) : (s < 4 ? b * 256 + 64 * s : MCTX + b * 4096 + 64 * (s - 4));
            __syncthreads();
            if (RABL != 1)
#pragma unroll
            for (int x = 0; x < 8; ++x) { const int d = 16 * (dbase + x) + c;
#pragma unroll
                for (int r = 0; r < 4; ++r) { const int v = 16 * vb2 + 4 * g + r; *(LAS bf16_t*)(lds + ST + v * 512 + (((d >> 3) ^ (v & 15)) << 4) + (d & 7) * 2) = f2bf(accS[x][r]); } }
#pragma unroll
            for (int i = 0; i < 4; ++i) { const int idx = tid + 512 * i, row = idx >> 5, ch = idx & 31; const int off = row * 512 + ((ch ^ (row & 15)) << 4);
                *(LAS u32x4*)(lds + QS + off) = qreg[i]; *(LAS u32x4*)(lds + KS + off) = kreg[i]; }
            { const int j = tid >> 3, ch = tid & 7; *(LAS u32x4*)(lds + VS + j * 128 + ((ch ^ ((j >> 1) & 7)) << 4)) = vreg; }
            __syncthreads();
            if (step + 1 < 136) { const int st2 = step + 1, dir2 = st2 >= 68 ? 1 : 0, s2 = st2 - 68 * dir2;
                const int nrow0 = dir2 ? (s2 < 4 ? b * 256 + 64 * (3 - s2) : MCTX + b * 4096 + 64 * (63 - (s2 - 4))) : (s2 < 4 ? b * 256 + 64 * s2 : MCTX + b * 4096 + 64 * (s2 - 4));
#pragma unroll
                for (int i = 0; i < 4; ++i) { const int idx = tid + 512 * i, row = idx >> 5, ch = idx & 31; const size_t o = (size_t)(nrow0 + row) * 1024 + h * 256 + ch * 8; qreg[i] = *(const u32x4*)(Qg + o); kreg[i] = *(const u32x4*)(Kg + o); }
                vreg = *(const u32x4*)(Vg + (size_t)(nrow0 + (tid >> 3)) * 2048 + h * 512 + vs * 64 + (tid & 7) * 8); }
            if (RABL == 2) continue;
            const int iq = 16 * ib + c;
            f32x4 accs[4], acco[2];
#pragma unroll
            for (int jb = 0; jb < 4; ++jb) accs[jb] = (f32x4){0.f, 0.f, 0.f, 0.f};
            acco[0] = (f32x4){0.f, 0.f, 0.f, 0.f}; acco[1] = (f32x4){0.f, 0.f, 0.f, 0.f};
#pragma unroll 1
            for (int ks = 0; ks < 8; ++ks) {
                const int sw = ((4 * ks + g) ^ c) << 4;
                const bf16x8 qf = *(const LAS bf16x8*)(lds + QS + iq * 512 + sw);
#pragma unroll
                for (int jb = 0; jb < 4; ++jb) { const bf16x8 kf = *(const LAS bf16x8*)(lds + KS + (16 * jb + c) * 512 + sw); accs[jb] = __builtin_amdgcn_mfma_f32_16x16x32_bf16(kf, qf, accs[jb], 0, 0, 0); }
#pragma unroll
                for (int vb = 0; vb < 2; ++vb) { const bf16x8 sf = *(const LAS bf16x8*)(lds + ST + (16 * (2 * vh + vb) + c) * 512 + sw); acco[vb] = __builtin_amdgcn_mfma_f32_16x16x32_bf16(sf, qf, acco[vb], 0, 0, 0); }
            }
            { const float qd = __builtin_amdgcn_exp2f(lg * (float)(dir ? 64 - iq : iq + 1)); acco[0] *= qd; acco[1] *= qd; }
#pragma unroll
            for (int jb = 0; jb < 4; ++jb)
#pragma unroll
                for (int r = 0; r < 4; ++r) { const int j = 16 * jb + 4 * g + r; const int df = dir ? j - iq : iq - j; const bool vis = dir ? (df > 0) : (df >= 0);
                    accs[jb][r] = vis ? accs[jb][r] * __builtin_amdgcn_exp2f(lg * (float)df) : 0.f; }
#pragma unroll
            for (int s2 = 0; s2 < 2; ++s2) {
                u32x4 pw; pw.x = cvt_pk_bf16(accs[2 * s2][0], accs[2 * s2][1]); pw.y = cvt_pk_bf16(accs[2 * s2][2], accs[2 * s2][3]); pw.z = cvt_pk_bf16(accs[2 * s2 + 1][0], accs[2 * s2 + 1][1]); pw.w = cvt_pk_bf16(accs[2 * s2 + 1][2], accs[2 * s2 + 1][3]);
                const bf16x8 pf = __builtin_bit_cast(bf16x8, pw);
#pragma unroll
                for (int vb = 0; vb < 2; ++vb) { const int vblk = 2 * vh + vb, ra = 32 * s2 + 4 * g + (c >> 2), rbb = ra + 16, cch = 2 * vblk + ((c & 3) >> 1);
                    const s16x4 lo = __builtin_amdgcn_ds_read_tr16_b64_v4i16((LAS s16x4*)(lds + VS + ra * 128 + ((cch ^ ((ra >> 1) & 7)) << 4) + 8 * (c & 1)));
                    const s16x4 hi = __builtin_amdgcn_ds_read_tr16_b64_v4i16((LAS s16x4*)(lds + VS + rbb * 128 + ((cch ^ ((rbb >> 1) & 7)) << 4) + 8 * (c & 1)));
                    const bf16x8 vf = {lo[0], lo[1], lo[2], lo[3], hi[0], hi[1], hi[2], hi[3]};
                    acco[vb] = __builtin_amdgcn_mfma_f32_16x16x32_bf16(vf, pf, acco[vb], 0, 0, 0); }
            }
#pragma unroll
            for (int vb = 0; vb < 2; ++vb) { bf16_t* op = Og + (size_t)(row0 + iq) * 2048 + h * 512 + vs * 64 + 16 * (2 * vh + vb) + 4 * g; f32x4 o = acco[vb];
                if (dir) { const u32x2 pv = *(const u32x2*)op; o[0] += bflo(pv.x); o[1] += bfhi(pv.x); o[2] += bflo(pv.y); o[3] += bfhi(pv.y); }
                u32x2 ow; ow.x = cvt_pk_bf16(o[0], o[1]); ow.y = cvt_pk_bf16(o[2], o[3]); *(u32x2*)op = ow; }
            { bf16x8 af[2];
              const int tq = c >> 2, tp = c & 3;
#pragma unroll
              for (int k2 = 0; k2 < 2; ++k2) { const int r0 = 32 * k2 + 8 * g + tq, r1 = r0 + 4, cch = 2 * vb2 + (tp >> 1);
                  const s16x4 t0 = __builtin_amdgcn_ds_read_tr16_b64_v4i16((LAS s16x4*)(lds + VS + r0 * 128 + ((cch ^ ((r0 >> 1) & 7)) << 4) + 8 * (tp & 1)));
                  const s16x4 t1 = __builtin_amdgcn_ds_read_tr16_b64_v4i16((LAS s16x4*)(lds + VS + r1 * 128 + ((cch ^ ((r1 >> 1) & 7)) << 4) + 8 * (tp & 1)));
                  const int j0 = 32 * k2 + 8 * g; float kd[8];
#pragma unroll
                  for (int e = 0; e < 8; ++e) kd[e] = __builtin_amdgcn_exp2f(lg * (float)(dir ? j0 + e : 63 - j0 - e));
                  u32x4 aw; aw.x = cvt_pk_bf16(bf2f((bf16_t)t0[0]) * kd[0], bf2f((bf16_t)t0[1]) * kd[1]); aw.y = cvt_pk_bf16(bf2f((bf16_t)t0[2]) * kd[2], bf2f((bf16_t)t0[3]) * kd[3]);
                  aw.z = cvt_pk_bf16(bf2f((bf16_t)t1[0]) * kd[4], bf2f((bf16_t)t1[1]) * kd[5]); aw.w = cvt_pk_bf16(bf2f((bf16_t)t1[2]) * kd[6], bf2f((bf16_t)t1[3]) * kd[7]);
                  af[k2] = __builtin_bit_cast(bf16x8, aw); }
#pragma unroll
              for (int x = 0; x < 8; ++x) { accS[x] *= g64; const int db = dbase + x;
#pragma unroll
                  for (int k2 = 0; k2 < 2; ++k2) { const int r0 = 32 * k2 + 8 * g + tq, r1 = r0 + 4;
                      const s16x4 t0 = __builtin_amdgcn_ds_read_tr16_b64_v4i16((LAS s16x4*)(lds + KS + r0 * 512 + (((2 * db + (tp >> 1)) ^ (r0 & 15)) << 4) + 8 * (tp & 1)));
                      const s16x4 t1 = __builtin_amdgcn_ds_read_tr16_b64_v4i16((LAS s16x4*)(lds + KS + r1 * 512 + (((2 * db + (tp >> 1)) ^ (r1 & 15)) << 4) + 8 * (tp & 1)));
                      const bf16x8 bfr = {t0[0], t0[1], t0[2], t0[3], t1[0], t1[1], t1[2], t1[3]};
                      accS[x] = __builtin_amdgcn_mfma_f32_16x16x32_bf16(af[k2], bfr, accS[x], 0, 0, 0); }
                  __builtin_amdgcn_sched_barrier(0); } }
        }
        __syncthreads();
    }
}

__device__ __forceinline__ void phase_ret_finish(const Args& a, int row_begin, const Grp& gp) {
    bf16_t* Og = (bf16_t*)(a.ws + WS_BIG + 4 * R1); const bf16_t* Gg = (const bf16_t*)(a.ws + WS_BIG);
    const int tid = otid(), lane = tid & 63, gw = gp.rank * 8 + (tid >> 6), nw = gp.gsize * 8, nrows = gp.nb * (row_begin ? 4096 : 4352);
    for (int lr = gw; lr < nrows; lr += nw) { const int row = row_begin ? grp_row_lat(gp, lr) : grp_row(gp, lr);
        const size_t base = (size_t)row * 2048 + (lane >> 4) * 512 + (lane & 15) * 32;
        float v[32]; float s = 0.f;
#pragma unroll
        for (int q = 0; q < 4; ++q) { const u32x4 w = *(const u32x4*)(Og + base + q * 8);
            v[q * 8 + 0] = bflo(w.x); v[q * 8 + 1] = bfhi(w.x); v[q * 8 + 2] = bflo(w.y); v[q * 8 + 3] = bfhi(w.y); v[q * 8 + 4] = bflo(w.z); v[q * 8 + 5] = bfhi(w.z); v[q * 8 + 6] = bflo(w.w); v[q * 8 + 7] = bfhi(w.w); }
#pragma unroll
        for (int i = 0; i < 32; ++i) s += v[i];
        s += shx(s, lane, 1); s += shx(s, lane, 2); s += shx(s, lane, 4); s += shx(s, lane, 8);
        const float mean = s * (1.f / 512.f); float qv = 0.f;
#pragma unroll
        for (int i = 0; i < 32; ++i) { const float d = v[i] - mean; qv += d * d; }
        qv += shx(qv, lane, 1); qv += shx(qv, lane, 2); qv += shx(qv, lane, 4); qv += shx(qv, lane, 8);
        const float rstd = 1.0f / sqrtf(qv * (1.f / 512.f) + LN_EPS);
#pragma unroll
        for (int q = 0; q < 4; ++q) { const u32x4 gwd = *(const u32x4*)(Gg + base + q * 8); const unsigned gw4[4] = {gwd.x, gwd.y, gwd.z, gwd.w}; unsigned ow[4];
#pragma unroll
            for (int p = 0; p < 4; ++p) { const float g0 = bflo(gw4[p]), g1 = bfhi(gw4[p]);
                ow[p] = cvt_pk_bf16(silu_f(g0) * (v[q * 8 + 2 * p] - mean) * rstd, silu_f(g1) * (v[q * 8 + 2 * p + 1] - mean) * rstd); }
            u32x4 o; o.x = ow[0]; o.y = ow[1]; o.z = ow[2]; o.w = ow[3]; *(u32x4*)(Og + base + q * 8) = o; }
    }
}

template <int ABL>
__device__ __forceinline__ void phase_na(const Args& a, LAS unsigned char* lds0, bf16_t* Odst, const Grp& gp) {
    const bf16_t* Qg = (const bf16_t*)(a.ws + WS_BIG); const bf16_t* Kg = (const bf16_t*)(a.ws + WS_BIG + R1); const bf16_t* Vg = (const bf16_t*)(a.ws + WS_BIG + 2 * R1);
    const int tid = otid(), w = __builtin_amdgcn_readfirstlane(tid >> 6), lane = tid & 63, c = lane & 15, g = lane >> 4, hb = w >> 2, w4 = w & 3, t2 = tid & 255;
    LAS unsigned char* lds = lds0 + hb * 65536;
    constexpr int QS = 0, KS = 32768, VT = 40960, RP = 49152;
    float mk[4][4]; int rco[4][4];
    { const int q0 = 16 * w4 + c, cs0 = min(max(q0 - 8, 0), 48);
#pragma unroll
      for (int kb = 0; kb < 4; ++kb)
#pragma unroll
          for (int e = 0; e < 4; ++e) { const int kc = 16 * kb + 4 * g + e; mk[kb][e] = (kc >= cs0 && kc < cs0 + 16) ? 0.f : -1e30f; rco[kb][e] = min(max(kc - q0 + 15, 0), 30) * 4; } }
    const int kb_lo = min(max(16 * w4 - 8, 0), 48) >> 4, kb_hi = (min(max(16 * w4 + 7, 0), 48) + 15) >> 4;
    for (int base_it = gp.rank * 2; base_it < gp.nb * 272; base_it += gp.gsize * 2) {
        const int it = base_it + hb, bb = it / 272, idx = it - bb * 272; const bool isl = (base_it % 272) < 256;
        const int b = gp.b_lo + bb; int h, r0 = 0, kr_lo = 0, kr_hi = 0;
        if (isl) { h = idx >> 4; r0 = (idx & 15) * 4; kr_lo = min(max(r0 - 4, 0), 56); kr_hi = min(max(r0 - 1, 0), 56) + 7; }
        else { h = idx - 256; }
        const int ntile = isl ? 15 : 4;
        __syncthreads();
#pragma unroll
        for (int i = 0; i < 8; ++i) { const int idx = t2 + 256 * i, row = idx >> 3, ch = idx & 7, rr = row >> 6, qi = row & 63;
            const int grow = isl ? MCTX + b * 4096 + (r0 + rr) * 64 + qi : b * 256 + rr * 64 + qi;
            *(LAS u32x4*)(lds + QS + row * 128 + ((ch ^ ((row >> 1) & 7)) << 4)) = *(const u32x4*)(Qg + (size_t)grow * 1024 + h * 64 + ch * 8); }
        for (int i = t2; i < 465; i += 256) *(LAS float*)(lds + RP + i * 4) = a.na_rpb[h * 465 + i];
        u32x4 kreg[2], vreg[2];
        { const int row0 = isl ? MCTX + b * 4096 + kr_lo * 64 : b * 256;
#pragma unroll
          for (int i = 0; i < 2; ++i) { const int idx = t2 + 256 * i, row = idx >> 3, ch = idx & 7; const size_t o = ((size_t)h * MTOT + row0 + row) * 64 + ch * 8; kreg[i] = *(const u32x4*)(Kg + o); vreg[i] = *(const u32x4*)(Vg + o); } }
        const int q = 16 * w4 + c;
        f32x4 oacc[4][4]; float mrun[4], lrun[4];
#pragma unroll
        for (int rr = 0; rr < 4; ++rr) { mrun[rr] = -1e30f; lrun[rr] = 0.f;
#pragma unroll
            for (int db = 0; db < 4; ++db) oacc[rr][db] = (f32x4){0.f, 0.f, 0.f, 0.f}; }
        for (int tl = 0; tl < ntile; ++tl) {
            if (ABL == 3) break;
            if (ABL == 4) { __syncthreads(); __syncthreads(); continue; }
            __syncthreads();
#pragma unroll
            for (int i = 0; i < 2; ++i) { const int idx = t2 + 256 * i, row = idx >> 3, ch = idx & 7;
                *(LAS u32x4*)(lds + KS + row * 128 + ((ch ^ ((row >> 1) & 7)) << 4)) = kreg[i];
                const unsigned vw[4] = {vreg[i].x, vreg[i].y, vreg[i].z, vreg[i].w};
#pragma unroll
                for (int e = 0; e < 8; ++e) { const int d = ch * 8 + e; const bf16_t val = (bf16_t)((e & 1) ? (vw[e >> 1] >> 16) : (vw[e >> 1] & 0xffffu));
                    *(LAS bf16_t*)(lds + VT + d * 128 + (((row >> 3) ^ ((d >> 1) & 7)) << 4) + (row & 7) * 2) = val; } }
            __syncthreads();
            if (tl + 1 < ntile) { const int t1 = tl + 1;
                const int row0 = isl ? (t1 < 11 ? MCTX + b * 4096 + min(kr_lo + t1, kr_hi) * 64 : b * 256 + (t1 - 11) * 64) : b * 256 + t1 * 64;
#pragma unroll
                for (int i = 0; i < 2; ++i) { const int idx = t2 + 256 * i, row = idx >> 3, ch = idx & 7; const size_t o = ((size_t)h * MTOT + row0 + row) * 64 + ch * 8; kreg[i] = *(const u32x4*)(Kg + o); vreg[i] = *(const u32x4*)(Vg + o); } }
            if (ABL == 2) continue;
            const bool local = isl && tl < 11; const int krow = kr_lo + tl;
            if (local && krow > kr_hi) continue;
#pragma unroll
            for (int rr = 0; rr < 4; ++rr) {
                const int r = r0 + rr, rs = min(max(r - 4, 0), 56);
                if (local && (krow < rs || krow >= rs + 8)) continue;
                bf16x8 qf[2];
#pragma unroll
                for (int ks = 0; ks < 2; ++ks) { const int qrow = rr * 64 + q; qf[ks] = *(const LAS bf16x8*)(lds + QS + qrow * 128 + (((4 * ks + g) ^ ((qrow >> 1) & 7)) << 4)); }
                f32x4 sT[4];
#pragma unroll
                for (int kb = 0; kb < 4; ++kb) { const bool skip = local && (kb < kb_lo || kb > kb_hi);
                    if (skip) { sT[kb] = (f32x4){-1e30f, -1e30f, -1e30f, -1e30f}; continue; }
                    sT[kb] = (f32x4){0.f, 0.f, 0.f, 0.f}; const int kr = 16 * kb + c;
#pragma unroll
                    for (int ks = 0; ks < 2; ++ks) { const bf16x8 kf = *(const LAS bf16x8*)(lds + KS + kr * 128 + (((4 * ks + g) ^ ((kr >> 1) & 7)) << 4)); sT[kb] = __builtin_amdgcn_mfma_f32_16x16x32_bf16(kf, qf[ks], sT[kb], 0, 0, 0); }
                    if (local) { const int rbase = RP + (krow - r + 7) * 124;
#pragma unroll
                        for (int e = 0; e < 4; ++e) sT[kb][e] = (sT[kb][e] + *(const LAS float*)(lds + rbase + rco[kb][e])) + mk[kb][e]; } }
                if (ABL == 1) { oacc[rr][0] += sT[0] + sT[1] + sT[2] + sT[3]; continue; }
                float mx = -1e30f;
#pragma unroll
                for (int kb = 0; kb < 4; ++kb) mx = fmaxf(mx, fmaxf(fmaxf(sT[kb][0], sT[kb][1]), fmaxf(sT[kb][2], sT[kb][3])));
                mx = fmaxf(mx, shx(mx, lane, 16)); mx = fmaxf(mx, shx(mx, lane, 32));
                const float mnew = fmaxf(mrun[rr], mx), alpha = __builtin_amdgcn_exp2f((mrun[rr] - mnew) * LOG2E); mrun[rr] = mnew;
                float ps = 0.f;
#pragma unroll
                for (int kb = 0; kb < 4; ++kb)
#pragma unroll
                    for (int e = 0; e < 4; ++e) { const float p = __builtin_amdgcn_exp2f((sT[kb][e] - mnew) * LOG2E); sT[kb][e] = p; ps += p; }
                ps += shx(ps, lane, 16); ps += shx(ps, lane, 32);
                lrun[rr] = lrun[rr] * alpha + ps;
#pragma unroll
                for (int db = 0; db < 4; ++db) oacc[rr][db] *= alpha;
#pragma unroll
                for (int s2 = 0; s2 < 2; ++s2) {
                    if (local && (2 * s2 + 1 < kb_lo || 2 * s2 > kb_hi)) continue;
                    u32x4 pw; pw.x = cvt_pk_bf16(sT[2 * s2][0], sT[2 * s2][1]); pw.y = cvt_pk_bf16(sT[2 * s2][2], sT[2 * s2][3]); pw.z = cvt_pk_bf16(sT[2 * s2 + 1][0], sT[2 * s2 + 1][1]); pw.w = cvt_pk_bf16(sT[2 * s2 + 1][2], sT[2 * s2 + 1][3]);
                    const bf16x8 pf = __builtin_bit_cast(bf16x8, pw);
#pragma unroll
                    for (int db = 0; db < 4; ++db) { const int vrow = 16 * db + c; const int sw = (vrow >> 1) & 7;
                        const u32x2 lo = *(const LAS u32x2*)(lds + VT + vrow * 128 + (((4 * s2 + (g >> 1)) ^ sw) << 4) + (g & 1) * 8);
                        const u32x2 hi = *(const LAS u32x2*)(lds + VT + vrow * 128 + (((4 * s2 + 2 + (g >> 1)) ^ sw) << 4) + (g & 1) * 8);
                        u32x4 vw; vw.x = lo.x; vw.y = lo.y; vw.z = hi.x; vw.w = hi.y;
                        oacc[rr][db] = __builtin_amdgcn_mfma_f32_16x16x32_bf16(__builtin_bit_cast(bf16x8, vw), pf, oacc[rr][db], 0, 0, 0); }
                }
            }
        }
        __syncthreads();
#pragma unroll
        for (int rr = 0; rr < 4; ++rr) { const float inv = 1.0f / lrun[rr]; const int orow = rr * 64 + q;
#pragma unroll
            for (int db = 0; db < 4; ++db) { const f32x4 o = oacc[rr][db] * inv; u32x2 ow; ow.x = cvt_pk_bf16(o[0], o[1]); ow.y = cvt_pk_bf16(o[2], o[3]);
                *(LAS u32x2*)(lds + QS + orow * 128 + (((2 * db + (g >> 1)) ^ ((orow >> 1) & 7)) << 4) + (g & 1) * 8) = ow; } }
        __syncthreads();
#pragma unroll
        for (int i = 0; i < 8; ++i) { const int idx = t2 + 256 * i, row = idx >> 3, ch = idx & 7, rr = row >> 6, qi = row & 63;
            const int grow = isl ? MCTX + b * 4096 + (r0 + rr) * 64 + qi : b * 256 + rr * 64 + qi;
            *(u32x4*)(Odst + (size_t)grow * 1024 + h * 64 + ch * 8) = *(const LAS u32x4*)(lds + QS + row * 128 + ((ch ^ ((row >> 1) & 7)) << 4)); }
    }
    __syncthreads();
}

__device__ __forceinline__ void phase_lru_conv(const Args& a, const Grp& gp) {
    const bf16_t* XR = (const bf16_t*)(a.ws + WS_BIG + R1); bf16_t* XC = (bf16_t*)(a.ws + WS_BIG + 2 * R1);
    for (int i = gp.rank * 512 + otid(); i < gp.nb * 4352 * 128; i += gp.gsize * 512) {
        const int row = grp_row(gp, i >> 7), c8 = (i & 127) * 8; const bool isc = row < MCTX; const int t = isc ? (row & 255) : ((row - MCTX) & 4095), len = isc ? 256 : 4096;
        float acc[8];
        { const f32x4 b0 = *(const f32x4*)(a.lru_conv_b + c8), b1 = *(const f32x4*)(a.lru_conv_b + c8 + 4); acc[0] = b0[0]; acc[1] = b0[1]; acc[2] = b0[2]; acc[3] = b0[3]; acc[4] = b1[0]; acc[5] = b1[1]; acc[6] = b1[2]; acc[7] = b1[3]; }
#pragma unroll
        for (int j = 0; j < 4; ++j) { const int tt = t - 2 + j;
            if (tt >= 0 && tt < len) { const u32x4 xw = *(const u32x4*)(XR + (size_t)(row - 2 + j) * 1024 + c8); const f32x4 w0 = *(const f32x4*)(a.lru_conv_w + j * 1024 + c8), w1 = *(const f32x4*)(a.lru_conv_w + j * 1024 + c8 + 4);
                acc[0] += w0[0] * bflo(xw.x); acc[1] += w0[1] * bfhi(xw.x); acc[2] += w0[2] * bflo(xw.y); acc[3] += w0[3] * bfhi(xw.y);
                acc[4] += w1[0] * bflo(xw.z); acc[5] += w1[1] * bfhi(xw.z); acc[6] += w1[2] * bflo(xw.w); acc[7] += w1[3] * bfhi(xw.w); } }
        u32x4 o; o.x = cvt_pk_bf16(acc[0], acc[1]); o.y = cvt_pk_bf16(acc[2], acc[3]); o.z = cvt_pk_bf16(acc[4], acc[5]); o.w = cvt_pk_bf16(acc[6], acc[7]);
        *(u32x4*)(XC + (size_t)row * 1024 + c8) = o;
    }
}
__device__ __forceinline__ void phase_lru_scan(const Args& a, int dir, int pass, const Grp& gp) {
    const bf16_t* GATE = (const bf16_t*)(a.ws + WS_BIG); bf16_t* HF = (bf16_t*)(a.ws + WS_BIG + R1); const bf16_t* XC = (const bf16_t*)(a.ws + WS_BIG + 2 * R1); const bf16_t* GP = (const bf16_t*)(a.ws + WS_BIG + 3 * R1);
    float* CARRY = (float*)(a.ws + WS_CARRY);
    for (int idx = gp.rank * 512 + otid(); idx < gp.nb * 68 * 256; idx += gp.gsize * 512) {
        const int cq = idx & 255, chunk = (idx >> 8) % 68, b = gp.b_lo + idx / (256 * 68), c0 = cq * 4;
        float ba[4], bx[4], sp[4], h[4], P[4];
        { const f32x4 t0 = *(const f32x4*)(a.lru_b_a + dir * 1024 + c0), t1 = *(const f32x4*)(a.lru_b_x + dir * 1024 + c0), t2 = *(const f32x4*)(a.lru_lam + dir * 1024 + c0);
#pragma unroll
          for (int k = 0; k < 4; ++k) { ba[k] = t0[k]; bx[k] = t1[k]; sp[k] = -8.f * log1pf(expf(-t2[k])); h[k] = 0.f; P[k] = 1.f; } }
        if (pass == 2) { for (int cc = 0; cc < chunk; ++cc) { const float* cp = CARRY + ((size_t)(b * 68 + cc) * 256 + cq) * 8; const f32x4 pp = *(const f32x4*)cp, ll = *(const f32x4*)(cp + 4);
#pragma unroll
            for (int k = 0; k < 4; ++k) h[k] = pp[k] * h[k] + ll[k]; } }
        for (int t8 = 0; t8 < 8; ++t8) {
            u32x2 rw[8], iw[8], xw[8], hw[8], gw[8]; int rows[8];
#pragma unroll
            for (int j = 0; j < 8; ++j) { const int p = chunk * 64 + t8 * 8 + j;
                const int row = dir ? (p < 256 ? b * 256 + (255 - p) : MCTX + b * 4096 + (4095 - (p - 256))) : (p < 256 ? b * 256 + p : MCTX + b * 4096 + (p - 256));
                rows[j] = row;
                rw[j] = *(const u32x2*)(GP + (size_t)row * 2048 + c0); iw[j] = *(const u32x2*)(GP + (size_t)row * 2048 + 1024 + c0); xw[j] = *(const u32x2*)(XC + (size_t)row * 1024 + c0);
                if (pass == 2 && dir == 1) { hw[j] = *(const u32x2*)(HF + (size_t)row * 1024 + c0); gw[j] = *(const u32x2*)(GATE + (size_t)row * 1024 + c0); } }
#pragma unroll
            for (int j = 0; j < 8; ++j) {
                const float rp[4] = {bflo(rw[j].x), bfhi(rw[j].x), bflo(rw[j].y), bfhi(rw[j].y)}, ip[4] = {bflo(iw[j].x), bfhi(iw[j].x), bflo(iw[j].y), bfhi(iw[j].y)}, xv[4] = {bflo(xw[j].x), bfhi(xw[j].x), bflo(xw[j].y), bfhi(xw[j].y)};
#pragma unroll
                for (int k = 0; k < 4; ++k) { const float la = sp[k] * sigmoid_f(rp[k] + ba[k]); const float av = __expf(la); const float m = sqrtf(fmaxf(-expm1f(2.f * la), 0.f));
                    h[k] = av * h[k] + m * sigmoid_f(ip[k] + bx[k]) * xv[k]; if (pass == 1) P[k] *= av; }
                if (pass == 2) { bf16_t* hp = HF + (size_t)rows[j] * 1024 + c0; u32x2 o;
                    if (dir == 0) { o.x = cvt_pk_bf16(h[0], h[1]); o.y = cvt_pk_bf16(h[2], h[3]); }
                    else { o.x = cvt_pk_bf16(gelu_tanh_f(bflo(gw[j].x)) * (bflo(hw[j].x) + h[0]), gelu_tanh_f(bfhi(gw[j].x)) * (bfhi(hw[j].x) + h[1]));
                           o.y = cvt_pk_bf16(gelu_tanh_f(bflo(gw[j].y)) * (bflo(hw[j].y) + h[2]), gelu_tanh_f(bfhi(gw[j].y)) * (bfhi(hw[j].y) + h[3])); }
                    *(u32x2*)hp = o; }
            }
        }
        if (pass == 1) { float* cp = CARRY + ((size_t)(b * 68 + chunk) * 256 + cq) * 8; *(f32x4*)cp = (f32x4){P[0], P[1], P[2], P[3]}; *(f32x4*)(cp + 4) = (f32x4){h[0], h[1], h[2], h[3]}; }
    }
}
constexpr int NPHASE = 52;
enum { OP_PROLOGUE, OP_U0, OP_GEMM_SWIGLU, OP_GEMM_PLAIN, OP_GEMM_RETIN, OP_GEMM_GATES, OP_POSTNORM, OP_RETSCAN, OP_RETFIN, OP_NAATT, OP_LRUCONV, OP_LRUSCAN };

typedef const Args __attribute__((address_space(4)))* KArgsPtr;
__global__ void __launch_bounds__(512) hybrid_fwd(Args a_in) {
    extern __shared__ __attribute__((aligned(16))) unsigned char lds_raw[];
    LAS unsigned char* lds = (LAS unsigned char*)lds_raw;
    const int ph_lo = a_in.ph_lo, ph_hi = a_in.ph_hi;
    volatile LAS unsigned* xb_st = (volatile LAS unsigned*)(lds + LDS_BYTES - 16);
    unsigned* xb_bar = (unsigned*)(a_in.ws + WS_BAR);
    if (threadIdx.x < 4) xb_st[threadIdx.x] = 0u;
    __syncthreads();
    if (threadIdx.x == 0) { const unsigned x = xb_xcc_id(); const unsigned r = xb_add(&xb_bar[XB_XCNT(x)], 1u); xb_st[2] = r | (x << 8); }
    int nexec = 0;
#ifdef PROBE_DBL
    for (int pp = 2 * ph_lo; pp < 2 * ph_hi; ++pp) { const int p = pp >> 1;
#else
    for (int p = ph_lo; p < ph_hi; ++p) {
#endif
#if defined(__HIP_DEVICE_COMPILE__)
        KArgsPtr ka = (KArgsPtr)__builtin_amdgcn_kernarg_segment_ptr(); asm volatile("" : "+s"(ka));
        Args a; __builtin_memcpy(&a, ka, sizeof(Args));
#else
        const Args a = a_in;
#endif
        bf16_t* WT = (bf16_t*)(a.ws + WS_WT); bf16_t* U = (bf16_t*)(a.ws + WS_U); unsigned char* BIG = a.ws + WS_BIG; const float* MOD = (const float*)(a.ws + WS_MOD);
        int op = OP_PROLOGUE, l = 0, s = 0, kind = 0, mi = 0, rb = 0, gsel = 0, sdir = 0, spass = 0; bool mixpn = false;
        if (p == 0) op = OP_PROLOGUE;
        else if (p == 1) op = OP_U0;
        else {
            const int q = p - 2; int li;
            if (q < 12) { l = 0; li = q; } else if (q < 22) { l = 1; li = q - 12; } else if (q < 38) { l = 2; li = q - 22; } else { l = 3; li = q - 38; }
            kind = l % 3; mi = l / 3; const int nmix = kind == 0 ? 6 : (kind == 1 ? 4 : 10);
            rb = (l == 3 && li >= 5) ? MCTX : 0;
            if (li < 3 || li >= 3 + nmix) {
                s = li < 3 ? 0 : 1; const int fs = li < 3 ? li : li - 3 - nmix;
                if (fs == 0) op = OP_GEMM_SWIGLU; else if (fs == 1) { op = OP_GEMM_PLAIN; gsel = 0; } else op = OP_POSTNORM;
            } else {
                const int ms = li - 3;
                if (ms == nmix - 1) { op = OP_POSTNORM; mixpn = true; }
                else if (kind == 0) { if (ms == 0) op = OP_GEMM_RETIN; else if (ms == 1) op = OP_RETSCAN; else if (ms == 2) { op = OP_GEMM_PLAIN; gsel = 1; } else if (ms == 3) op = OP_RETFIN; else { op = OP_GEMM_PLAIN; gsel = 2; } }
                else if (kind == 1) { if (ms == 0) { op = OP_GEMM_PLAIN; gsel = 3; } else if (ms == 1) op = OP_NAATT; else { op = OP_GEMM_PLAIN; gsel = 4; } }
                else { if (ms == 0) { op = OP_GEMM_PLAIN; gsel = 5; } else if (ms == 1) op = OP_LRUCONV; else if (ms == 2 || ms == 5) { op = OP_GEMM_GATES; sdir = ms == 5 ? 1 : 0; }
                       else if (ms == 3 || ms == 4) { op = OP_LRUSCAN; sdir = 0; spass = ms - 2; } else if (ms == 6 || ms == 7) { op = OP_LRUSCAN; sdir = 1; spass = ms - 5; } else { op = OP_GEMM_PLAIN; gsel = 6; } }
            }
        }
#ifdef PROBE_DBL
#if PROBE_DBL == 10
        if ((pp & 1) && p != 0) continue;
#else
        if (pp & 1) { const bool pdbl = (PROBE_DBL == 1) ? (op == OP_GEMM_SWIGLU || op == OP_GEMM_PLAIN || op == OP_GEMM_RETIN || op == OP_GEMM_GATES)
                        : (PROBE_DBL == 3) ? (op == OP_RETSCAN) : (PROBE_DBL == 10) ? (op == OP_PROLOGUE) : (PROBE_DBL == 8) ? (op == OP_GEMM_SWIGLU) : (PROBE_DBL == 5) ? (op == OP_NAATT) : (PROBE_DBL == 6) ? (op == OP_LRUCONV || (op == OP_LRUSCAN && !(sdir == 1 && spass == 2))) : (PROBE_DBL == 2) ? (op == OP_POSTNORM && l == 0 && s == 0 && !mixpn) : false;
            if (!pdbl) continue; }
#endif
#endif
#ifndef PROBE_DONE_ONLY
        if (op == OP_POSTNORM && __builtin_amdgcn_readfirstlane((int)xb_st[3])) continue;
#endif
        { const unsigned xm = (unsigned)__builtin_amdgcn_readfirstlane((int)xb_st[3]);
          const bool relayout = op == OP_GEMM_SWIGLU || op == OP_GEMM_RETIN || (op == OP_GEMM_PLAIN && (gsel == 1 || gsel == 3 || gsel == 5));
          if (nexec == 1) cg::this_grid().sync();
          else if (nexec > 1) { if (xm && !relayout) xcd_local_barrier((unsigned*)(a.ws + WS_BAR), ((unsigned)__builtin_amdgcn_readfirstlane((int)xb_st[2]) >> 8) & 0xffu, 32u);
                                else xcd_barrier((unsigned*)(a.ws + WS_BAR), xb_st); } }
        if (nexec == 1 && ph_lo == 0) {
            if (threadIdx.x == 0) { bool ok = gridDim.x == 256;
                for (unsigned j = 0; j < 16; ++j) { const unsigned cnt = xb_ld(&xb_bar[XB_XCNT(j)]); ok = ok && (j < 8 ? cnt == 32u : cnt == 0u); }
#ifdef PROBE_NO_XMODE
                ok = false;
#endif
                xb_st[3] = ok ? 1u : 0u; }
            __syncthreads(); }
        ++nexec;
        const unsigned gword = (unsigned)__builtin_amdgcn_readfirstlane((int)xb_st[2]), xmode = (unsigned)__builtin_amdgcn_readfirstlane((int)xb_st[3]);
        Grp grp; if (xmode) { grp.b_lo = (int)((gword >> 8) & 0xffu); grp.nb = 1; grp.rank = (int)(gword & 0xffu); grp.gsize = 32; } else { grp.b_lo = 0; grp.nb = 8; grp.rank = (int)blockIdx.x; grp.gsize = (int)gridDim.x; }
        switch (op) {
#ifndef NO_OP_PROLOGUE
            case OP_PROLOGUE: phase_prologue(a, lds); break;
#endif
#ifndef NO_OP_U0
            case OP_U0: phase_u0(a, grp); break;
#endif
#ifndef NO_OP_GEMM_SWIGLU
            case OP_GEMM_SWIGLU: { const pg8::Gemm gg{U, WT + E_FFN_IN + (size_t)(l * 2 + s) * 5632 * 1024, MTOT, 5632, 1024, 1024, 0, 0};
                pg8::GroupOrder S; S.init(grp.nb, grp.b_lo, rb != 0, gg.N, grp.gsize, grp.rank); EpiSwiGLU E{(bf16_t*)BIG, 0}; pg8::gemm_phase<EpiSwiGLU, pg8::GroupOrder>(lds, gg, S, E); } break;
#endif
#ifndef NO_OP_GEMM_PLAIN
            case OP_GEMM_PLAIN: { const bf16_t* gA; const bf16_t* gB; int gN, gK, glda; bf16_t* eO; int eldc = 1024, esplit = 0, ehm = 0; size_t estride = 0; float escale = 1.f;
                if (gsel == 0)      { gA = (const bf16_t*)BIG; gB = WT + E_FFN_OUT + (size_t)(l * 2 + s) * 1024 * 2816; gN = 1024; gK = 2816; glda = 2816; eO = (bf16_t*)(BIG + 3 * R1); }
                else if (gsel == 1) { gA = U; gB = WT + E_RET_IN + (size_t)mi * 6144 * 1024 + (size_t)4096 * 1024; gN = 2048; gK = 1024; glda = 1024; eO = (bf16_t*)BIG; eldc = 2048; }
                else if (gsel == 2) { gA = (const bf16_t*)(BIG + 4 * R1); gB = WT + E_RET_OUT + (size_t)mi * 1024 * 2048; gN = 1024; gK = 2048; glda = 2048; eO = (bf16_t*)(BIG + 2 * R1); }
                else if (gsel == 3) { gA = U; gB = WT + E_NA_QKV; gN = 3072; gK = 1024; glda = 1024; eO = (bf16_t*)BIG; esplit = 1024; estride = R1 / 2; escale = 0.125f; ehm = 1; }
                else if (gsel == 4) { gA = (const bf16_t*)BIG; gB = WT + E_NA_OUT; gN = 1024; gK = 1024; glda = 1024; eO = (bf16_t*)(BIG + 3 * R1); }
                else if (gsel == 5) { gA = U; gB = WT + E_LRU_IN; gN = 2048; gK = 1024; glda = 1024; eO = (bf16_t*)BIG; esplit = 1024; estride = R1 / 2; }
                else                { gA = (const bf16_t*)(BIG + R1); gB = WT + E_LRU_OUT; gN = 1024; gK = 1024; glda = 1024; eO = (bf16_t*)(BIG + 2 * R1); }
                const pg8::Gemm gg{gA, gB, MTOT, gN, gK, glda, 0, 0}; pg8::GroupOrder S; S.init(grp.nb, grp.b_lo, rb != 0, gg.N, grp.gsize, grp.rank);
                const bool fuse = xmode && (gsel == 0 || gsel == 2 || gsel == 4 || gsel == 6);
                if (fuse) S.pcnt = (unsigned*)(a.ws + WS_BAR) + XB_PCNT(p, 0);
                EpiPlain E{eO, eldc, 0, esplit, estride, escale, ehm}; pg8::gemm_phase<EpiPlain, pg8::GroupOrder>(lds, gg, S, E);
#ifdef PROBE_DONE_ONLY
                if (false) {
#else
                if (fuse) {
#endif
                    const float* modl = MOD + (size_t)l * 9 * 9216; unsigned* bw = (unsigned*)(a.ws + WS_BAR);
                    const bf16_t* Yp = (const bf16_t*)(BIG + (gsel == 0 || gsel == 4 ? 3 : 2) * R1);
                    if (gsel != 0) phase_postnorm_dyn(a, false, Yp, modl, 5, 1.f, a.ln_g + (size_t)(l * 3 + 1) * 1024, a.ln_b + (size_t)(l * 3 + 1) * 1024, modl, 6, rb != 0, grp, bw + XB_PCNT(p, 0), bw + XB_RCTR(p, grp.b_lo));
                    else { const int li3 = l * 3 + (s == 0 ? 0 : 2); const float* modn = (s == 0) ? modl : MOD + (size_t)(l < 3 ? l + 1 : l) * 9 * 9216; const int psh = (s == 0) ? 3 : (l < 3 ? 0 : -1);
                        phase_postnorm_dyn(a, l == 0 && s == 0, Yp, modl, s == 0 ? 2 : 8, 0.5f, a.ln_g + (size_t)li3 * 1024, a.ln_b + (size_t)li3 * 1024, modn, psh, rb != 0, grp, bw + XB_PCNT(p, 0), bw + XB_RCTR(p, grp.b_lo)); } } } break;
#endif
#ifndef NO_OP_GEMM_RETIN
            case OP_GEMM_RETIN: { const pg8::Gemm gg{U, WT + E_RET_IN + (size_t)mi * 6144 * 1024, MTOT, 4096, 1024, 1024, 0, 0}; pg8::GroupOrder S; S.init(grp.nb, grp.b_lo, false, gg.N, grp.gsize, grp.rank);
                EpiRetIn E{(bf16_t*)BIG, (bf16_t*)(BIG + R1), (bf16_t*)(BIG + 2 * R1), (const float*)(a.ws + WS_ROPE), (const float*)(a.ws + WS_ROPE) + 4096}; pg8::gemm_phase<EpiRetIn, pg8::GroupOrder>(lds, gg, S, E); } break;
#endif
#ifndef NO_OP_GEMM_GATES
            case OP_GEMM_GATES: { const pg8::Gemm gg{(const bf16_t*)(BIG + 2 * R1), WT + E_GATES + (size_t)sdir * 2048 * 256, MTOT, 2048, 256, 1024, 1, 256}; pg8::GroupOrder S; S.init(grp.nb, grp.b_lo, false, gg.N, grp.gsize, grp.rank);
                EpiGates E{(bf16_t*)(BIG + 3 * R1)}; pg8::gemm_phase<EpiGates, pg8::GroupOrder>(lds, gg, S, E); } break;
#endif
#ifndef NO_OP_POSTNORM
            case OP_POSTNORM: { const float* modl = MOD + (size_t)l * 9 * 9216;
                if (mixpn) phase_postnorm(a, false, (const bf16_t*)(BIG + (kind == 1 ? 3 : 2) * R1), modl, 5, 1.f, a.ln_g + (size_t)(l * 3 + 1) * 1024, a.ln_b + (size_t)(l * 3 + 1) * 1024, modl, 6, rb, grp);
                else { const int li3 = l * 3 + (s == 0 ? 0 : 2); const float* modn = (s == 0) ? modl : MOD + (size_t)(l < 3 ? l + 1 : l) * 9 * 9216; const int psh = (s == 0) ? 3 : (l < 3 ? 0 : -1);
                    phase_postnorm(a, l == 0 && s == 0, (const bf16_t*)(BIG + 3 * R1), modl, s == 0 ? 2 : 8, 0.5f, a.ln_g + (size_t)li3 * 1024, a.ln_b + (size_t)li3 * 1024, modn, psh, rb, grp); } } break;
#endif
#ifndef NO_OP_RETSCAN
#if defined(PROBE_DBL) && PROBE_DBL == 3
#ifndef PROBE_RET_ABL
#define PROBE_RET_ABL 0
#endif
            case OP_RETSCAN: if (pp & 1) phase_retention<0>(a, lds, grp); else phase_retention<PROBE_RET_ABL>(a, lds, grp); break;
#else
            case OP_RETSCAN: phase_retention<0>(a, lds, grp); break;
#endif
#endif
#ifndef NO_OP_RETFIN
            case OP_RETFIN: phase_ret_finish(a, rb, grp); break;
#endif
#ifndef NO_OP_NAATT
#if defined(PROBE_DBL) && PROBE_DBL == 5
#ifndef PROBE_NA_ABL
#define PROBE_NA_ABL 0
#endif
            case OP_NAATT: if (pp & 1) phase_na<0>(a, lds, (bf16_t*)BIG, grp); else phase_na<PROBE_NA_ABL>(a, lds, (bf16_t*)(BIG + 3 * R1), grp); break;
#else
            case OP_NAATT: phase_na<0>(a, lds, (bf16_t*)BIG, grp); break;
#endif
#endif
#ifndef NO_OP_LRUCONV
            case OP_LRUCONV: phase_lru_conv(a, grp); break;
#endif
#ifndef NO_OP_LRUSCAN
            case OP_LRUSCAN: phase_lru_scan(a, sdir, spass, grp); break;
#endif
            default: break;
        }
    }
}

#ifndef MK_PER_PHASE
#define MK_PER_PHASE 0
#endif
extern "C" void kernel_launch(void* const* d_in, const int* in_sizes, int n_in, void* d_out, int out_size, void* d_ws, size_t ws_size, hipStream_t stream) {
    static int grid = 0;
    if (grid == 0) {
        if (n_in != 24 || out_size != MLAT * 1024 || ws_size < WS_END) { fprintf(stderr, "kernel_launch: unexpected shapes: n_in %d out %d ws %zu (need %zu)\n", n_in, out_size, ws_size, (size_t)WS_END); grid = -1; return; }
        int dev = 0, cus = 0, per_cu = 0;
        if (hipGetDevice(&dev) != hipSuccess || hipDeviceGetAttribute(&cus, hipDeviceAttributeMultiprocessorCount, dev) != hipSuccess) { grid = -1; return; }
        if (hipFuncSetAttribute((const void*)hybrid_fwd, hipFuncAttributeMaxDynamicSharedMemorySize, LDS_BYTES) != hipSuccess) { fprintf(stderr, "kernel_launch: hipFuncSetAttribute failed\n"); grid = -1; return; }
        if (hipOccupancyMaxActiveBlocksPerMultiprocessor(&per_cu, (const void*)hybrid_fwd, 512, LDS_BYTES) != hipSuccess || per_cu < 1) { fprintf(stderr, "kernel_launch: occupancy query says %d\n", per_cu); per_cu = 1; }
        (void)hipGetLastError();
        grid = cus * 1;
    }
    if (grid < 0) return;
    if (hipMemsetAsync((char*)d_ws + WS_BAR, 0, 262144, stream) != hipSuccess) { fprintf(stderr, "kernel_launch: barrier memset failed\n"); return; }
    Args a{};
    const float** pp = (const float**)&a;
    for (int i = 0; i < 24; ++i) pp[i] = (const float*)d_in[i];
    a.out = (float*)d_out; a.ws = (unsigned char*)d_ws;
#if MK_PER_PHASE
    for (int p = 0; p < NPHASE; ++p) { a.ph_lo = p; a.ph_hi = p + 1; hipLaunchKernelGGL(hybrid_fwd, dim3(grid), dim3(512), LDS_BYTES, stream, a); }
#else
    a.ph_lo = 0; a.ph_hi = NPHASE;
    void* args[] = {&a};
    hipError_t e = hipLaunchCooperativeKernel((const void*)hybrid_fwd, dim3(grid), dim3(512), args, LDS_BYTES, stream);
    if (e != hipSuccess) fprintf(stderr, "cooperative launch failed: %s (grid %d)\n", hipGetErrorString(e), grid);
#endif
}
```

```cpp
#include <hip/hip_runtime.h>
#include <hip/hip_cooperative_groups.h>
#include <cstdio>
namespace cg = cooperative_groups;

#define LAS __attribute__((address_space(3)))
typedef unsigned short bf16_t;
typedef short bf16x8 __attribute__((ext_vector_type(8)));
typedef float f32x4 __attribute__((ext_vector_type(4)));
typedef unsigned u32x4 __attribute__((ext_vector_type(4)));
typedef unsigned u32x2 __attribute__((ext_vector_type(2)));

constexpr int DM = 1024, NB = 8, SEQ = 4096, CTXL = 256, DFF = 2816;
constexpr int MCTX = NB * CTXL, MLAT = NB * SEQ, MTOT = MCTX + MLAT;
constexpr int NMOD = 9;
constexpr float DN_ALPHA = 1.681792830507429f;
constexpr float LN_EPS = 1e-5f;
constexpr float LOG2E = 1.4426950408889634f;
constexpr int LDS_BYTES = 147456;

constexpr size_t E_FFN_IN = 0;
constexpr size_t E_FFN_OUT = E_FFN_IN + (size_t)8 * 5632 * 1024;
constexpr size_t E_RET_IN = E_FFN_OUT + (size_t)8 * 1024 * 2816;
constexpr size_t E_RET_OUT = E_RET_IN + (size_t)2 * 6144 * 1024;
constexpr size_t E_NA_QKV = E_RET_OUT + (size_t)2 * 1024 * 2048;
constexpr size_t E_NA_OUT = E_NA_QKV + (size_t)3072 * 1024;
constexpr size_t E_LRU_IN = E_NA_OUT + (size_t)1024 * 1024;
constexpr size_t E_LRU_OUT = E_LRU_IN + (size_t)2048 * 1024;
constexpr size_t E_GATES = E_LRU_OUT + (size_t)1024 * 1024;
constexpr size_t E_WT_END = E_GATES + (size_t)2 * 2048 * 256;
constexpr size_t R1 = (size_t)MTOT * 1024 * 2;
constexpr size_t WS_WT = 0;
constexpr size_t WS_U = WS_WT + E_WT_END * 2;
constexpr size_t WS_HC = WS_U + R1;
constexpr size_t WS_MOD = WS_HC + (size_t)MCTX * 1024 * 4;
constexpr size_t WS_ROPE = WS_MOD + (size_t)4 * 9 * 9216 * 4;
constexpr size_t WS_CARRY = WS_ROPE + (size_t)2 * 4096 * 4;
constexpr size_t WS_BAR = WS_CARRY + (size_t)NB * 68 * 1024 * 2 * 4;
constexpr size_t WS_BIG = WS_BAR + 16384;
constexpr size_t WS_END = WS_BIG + 6 * R1;

struct Args {
    const float* x; const float* c; const float* ctx; const float* c_ctx; const float* ada_w; const float* ada_b; const float* ln_g; const float* ln_b;
    const float* ffn_w_in; const float* ffn_w_out; const float* ret_w_in; const float* ret_w_out; const float* na_w_qkv; const float* na_rpb; const float* na_w_out;
    const float* lru_w_in; const float* lru_conv_w; const float* lru_conv_b; const float* lru_w_a; const float* lru_b_a; const float* lru_w_x; const float* lru_b_x;
    const float* lru_lam; const float* lru_w_out;
    float* out; unsigned char* ws; int ph_lo, ph_hi;
};

struct Grp { int b_lo, nb, rank, gsize; };
__device__ __forceinline__ int grp_row(const Grp& g, int lr) { const int b = g.b_lo + lr / 4352, t = lr % 4352; return t < 256 ? b * 256 + t : MCTX + b * 4096 + (t - 256); }
__device__ __forceinline__ int grp_row_lat(const Grp& g, int lr) { return MCTX + (g.b_lo + (lr >> 12)) * 4096 + (lr & 4095); }
__device__ __forceinline__ int otid() { int t = threadIdx.x; asm volatile("" : "+v"(t)); return t; }
__device__ __forceinline__ float shx(float v, int lane, int m) { return __int_as_float(__builtin_amdgcn_ds_bpermute((lane ^ m) << 2, __float_as_int(v))); }
__device__ __forceinline__ unsigned cvt_pk_bf16(float lo, float hi) { unsigned r; asm volatile("v_cvt_pk_bf16_f32 %0, %1, %2" : "=v"(r) : "v"(lo), "v"(hi)); return r; }
__device__ __forceinline__ float bflo(unsigned w) { return __uint_as_float(w << 16); }
__device__ __forceinline__ float bfhi(unsigned w) { return __uint_as_float(w & 0xffff0000u); }
__device__ __forceinline__ float bf2f(bf16_t b) { return __uint_as_float(((unsigned)b) << 16); }
__device__ __forceinline__ bf16_t f2bf(float f) { return (bf16_t)(cvt_pk_bf16(f, 0.f) & 0xffffu); }
__device__ __forceinline__ float silu_f(float x) { return x * __builtin_amdgcn_rcpf(1.f + __expf(-x)); }
__device__ __forceinline__ float sigmoid_f(float x) { return __builtin_amdgcn_rcpf(1.f + __expf(-x)); }
__device__ __forceinline__ float gelu_tanh_f(float x) { const float z = 0.7978845608028654f * (x + 0.044715f * x * x * x); const float t = 1.f - 2.f * __builtin_amdgcn_rcpf(__expf(2.f * z) + 1.f); return 0.5f * x * (1.f + t); }

namespace pg8 {
constexpr int BM = 256, BK = 64, HALF = 128, HTB = HALF * BK * 2  , STAGE_BYTES = 8 * HTB, NXCD = 8, WGM = 8;
__host__ __device__ __forceinline__ int lds_byte(int r, int c) { const int st = (r >> 4) * 2 + (c >> 5), rr = r & 15, cc = c & 31, ob = rr * 64 + cc * 2; return st * 1024 + (ob ^ (((ob >> 9) & 1) << 5)); }
__host__ __device__ __forceinline__ void stage_rc(int b, int& R, int& C) { const int st = b / 1024, sb = b % 1024, swz = sb ^ (((sb >> 9) & 1) << 5); R = (st >> 1) * 16 + swz / 64; C = (st & 1) * 32 + (swz % 64) / 2; }
__host__ __device__ __forceinline__ int perm32(int rho) { const int n = rho >> 4, i = rho & 15; return 8 * (i >> 2) + 4 * n + (i & 3); }

struct Unit { int pm, pn; };
struct Gemm { const bf16_t* A; const bf16_t* Bt; int M, N, K, lda, a_sh, a_cols; };

struct StaticOrder {
    int nM, nN, nwg, G, c;
    __host__ __device__ void init(int M, int N, int G_, int c_) { nM = M / BM; nN = N / BM; nwg = nM * nN; G = G_; c = c_; }
    __host__ __device__ bool next(int i, Unit& u) const {
        const long L = (long)i * G + c; if (L >= nwg) return false;
        int wgid = (int)L; { const int q = nwg / NXCD, r = nwg % NXCD, xcd = wgid % NXCD, off = wgid / NXCD; wgid = (xcd < r ? xcd * (q + 1) : r * (q + 1) + (xcd - r) * q) + off; }
        const int nig = WGM * nN, gid = wgid / nig, fm = gid * WGM, gsz = (nM - fm) < WGM ? (nM - fm) : WGM;
        u.pm = fm + ((wgid % nig) % gsz); u.pn = (wgid % nig) / gsz; return true;
    }
    __device__ __forceinline__ void a_ready(const Unit&) const {}
    __device__ __forceinline__ void done(const Unit&) const {}
};

struct GroupOrder {
    int nP, nN, nwg, G, c, b_lo, per;
    __device__ void init(int nb, int b_lo_, bool skipctx, int N, int G_, int c_) { per = skipctx ? 16 : 17; nP = nb * per; nN = N / BM; nwg = nP * nN; G = G_; c = c_; b_lo = b_lo_; }
    __device__ bool next(int i, Unit& u) const {
        const long L = (long)i * G + c; if (L >= nwg) return false;
        const int wgid = (int)L, nig = WGM * nN, gid = wgid / nig, fm = gid * WGM, gsz = (nP - fm) < WGM ? (nP - fm) : WGM;
        const int lp = fm + ((wgid % nig) % gsz); u.pn = (wgid % nig) / gsz;
        const int b = b_lo + lp / per, j = lp % per;
        u.pm = (per == 16) ? 8 + 16 * b + j : (j == 0 ? b : 8 + 16 * b + j - 1);
        return true;
    }
    __device__ __forceinline__ void a_ready(const Unit&) const {}
    __device__ __forceinline__ void done(const Unit&) const {}
};

template <class Epi, class Sched>
__device__ __forceinline__ void gemm_phase(LAS unsigned char* lds, const Gemm g, const Sched& S, const Epi& E) {
    const int tid = otid(), wid = __builtin_amdgcn_readfirstlane(tid >> 6), lane = tid & 63, wr = wid >> 2, wc = wid & 3, fr = lane & 15, fq = lane >> 4;
    const int K = g.K, nt = K / BK, lda = g.lda;
    unsigned voffA[2], voffB[2];
#pragma unroll
    for (int i = 0; i < 2; ++i) { int R, C; stage_rc(tid * 16 + i * 8192, R, C); const int Rb = Epi::PERM ? ((R & ~31) + perm32(R & 31)) : R;
        voffA[i] = (unsigned)(R * lda + C) * 2u; voffB[i] = (unsigned)(Rb * K + C) * 2u; }
    const size_t kstep = (size_t)(BK * 2);
    const size_t hstepA = (size_t)HALF * lda * 2, hstepB = (size_t)HALF * K * 2;
    const size_t tstepA = 2 * hstepA, tstepB = 2 * hstepB;
    const unsigned ldsw = (unsigned)wid * 1024u;
    const int aoff = lds_byte(wr * 64 + fr, fq * 8), boff = lds_byte(wc * 32 + fr, fq * 8);
#define PG8_SA(b, h) (((b) * 2 + (h)) * HTB)
#define PG8_SB(b, h) ((4 + (b) * 2 + (h)) * HTB)
#define PG8_STAGE(bufoff, gbase, voff) do { _Pragma("unroll") for (int _i = 0; _i < 2; ++_i) \
        __builtin_amdgcn_global_load_lds((const unsigned*)((const char*)(gbase) + (voff)[_i]), (LAS unsigned*)(lds + (bufoff) + ldsw + _i * 8192), 16, 0, 0); } while (0)
#define PG8_LDA(dst, b, h) do { _Pragma("unroll") for (int m = 0; m < 4; ++m) _Pragma("unroll") for (int k = 0; k < 2; ++k) dst[m][k] = *(const LAS bf16x8*)(lds + PG8_SA(b, h) + aoff + m * 2048 + k * 1024); } while (0)
#define PG8_LDB(dst, b, h) do { _Pragma("unroll") for (int n = 0; n < 2; ++n) _Pragma("unroll") for (int k = 0; k < 2; ++k) dst[n][k] = *(const LAS bf16x8*)(lds + PG8_SB(b, h) + boff + n * 2048 + k * 1024); } while (0)
#define PG8_MMA(ai, bj, At, Bt) do { __builtin_amdgcn_s_setprio(1); _Pragma("unroll") for (int m = 0; m < 4; ++m) _Pragma("unroll") for (int n = 0; n < 2; ++n) _Pragma("unroll") for (int k = 0; k < 2; ++k) \
        acc[ai][bj][m][n] = __builtin_amdgcn_mfma_f32_16x16x32_bf16(Bt[n][k], At[m][k], acc[ai][bj][m][n], 0, 0, 0); __builtin_amdgcn_s_setprio(0); } while (0)
#define PG8_WAIT_V(n) asm volatile("s_waitcnt vmcnt(" #n ")" ::: "memory")
#define PG8_WAIT_L(n) asm volatile("s_waitcnt lgkmcnt(" #n ")" ::: "memory")
#define PG8_BAR __builtin_amdgcn_s_barrier()
#define PG8_SCHED __builtin_amdgcn_sched_barrier(0)
#define PG8_AOFF(u) ((size_t)(u).pm * tstepA + (size_t)(((u).pn >> g.a_sh) * g.a_cols) * 2)
    Unit cur, nxt; int ui = 0;
    if (!S.next(0, cur)) return;
    f32x4 acc[2][2][4][2];
#pragma unroll
    for (int a = 0; a < 2; ++a)
#pragma unroll
        for (int b = 0; b < 2; ++b)
#pragma unroll
            for (int m = 0; m < 4; ++m)
#pragma unroll
                for (int n = 0; n < 2; ++n) acc[a][b][m][n] = (f32x4){0.f, 0.f, 0.f, 0.f};
    bf16x8 At[4][2], B0[2][2], B1[2][2];
    const char* cA = (const char*)g.A + PG8_AOFF(cur); const char* cB = (const char*)g.Bt + (size_t)cur.pn * tstepB;
    S.a_ready(cur);
    PG8_STAGE(PG8_SB(0, 0), cB, voffB); PG8_STAGE(PG8_SA(0, 0), cA, voffA); PG8_STAGE(PG8_SB(0, 1), cB + hstepB, voffB); PG8_STAGE(PG8_SA(0, 1), cA + hstepA, voffA);
    if (wr == 1) PG8_BAR;
    PG8_WAIT_V(4); PG8_BAR;
    PG8_STAGE(PG8_SB(1, 0), cB + kstep, voffB); PG8_STAGE(PG8_SA(1, 0), cA + kstep, voffA); PG8_STAGE(PG8_SB(1, 1), cB + hstepB + kstep, voffB);
    PG8_WAIT_V(6); PG8_BAR;
    for (;;) {
        const bool has_next = S.next(ui + 1, nxt);
        const char* nA = has_next ? (const char*)g.A + PG8_AOFF(nxt) : cA; const char* nB = has_next ? (const char*)g.Bt + (size_t)nxt.pn * tstepB : cB;
        for (int t = 0; t < nt; t += 2) {
            const bool last = (t == nt - 2);
            const char* a1 = cA + (size_t)(t + 1) * kstep;
            const char* a2 = last ? nA : cA + (size_t)(t + 2) * kstep; const char* b2 = last ? nB : cB + (size_t)(t + 2) * kstep;
            const char* a3 = a2 + kstep; const char* b3 = b2 + kstep;
            if (last && has_next) S.a_ready(nxt);
            PG8_LDB(B0, 0, 0); PG8_SCHED; PG8_LDA(At, 0, 0); PG8_STAGE(PG8_SA(1, 1), a1 + hstepA, voffA);
            PG8_WAIT_L(8); PG8_BAR; PG8_WAIT_L(0); PG8_MMA(0, 0, At, B0); PG8_BAR; PG8_SCHED;
            PG8_LDB(B1, 0, 1); PG8_STAGE(PG8_SB(0, 0), b2, voffB);
            PG8_BAR; PG8_WAIT_L(0); PG8_MMA(0, 1, At, B1); PG8_BAR;
            PG8_LDA(At, 0, 1); PG8_STAGE(PG8_SA(0, 0), a2, voffA);
            PG8_BAR; PG8_WAIT_L(0); PG8_MMA(1, 0, At, B0); PG8_BAR; PG8_SCHED;
            PG8_STAGE(PG8_SB(0, 1), b2 + hstepB, voffB);
            PG8_WAIT_V(6); PG8_BAR; PG8_MMA(1, 1, At, B1); PG8_BAR;
            PG8_LDB(B0, 1, 0); PG8_SCHED; PG8_LDA(At, 1, 0); PG8_STAGE(PG8_SA(0, 1), a2 + hstepA, voffA);
            PG8_WAIT_L(8); PG8_BAR; PG8_WAIT_L(0); PG8_MMA(0, 0, At, B0); PG8_BAR; PG8_SCHED;
            PG8_LDB(B1, 1, 1); PG8_STAGE(PG8_SB(1, 0), b3, voffB);
            PG8_BAR; PG8_WAIT_L(0); PG8_MMA(0, 1, At, B1); PG8_BAR;
            PG8_LDA(At, 1, 1); PG8_STAGE(PG8_SA(1, 0), a3, voffA);
            PG8_BAR; PG8_WAIT_L(0); PG8_MMA(1, 0, At, B0); PG8_BAR; PG8_SCHED;
            PG8_STAGE(PG8_SB(1, 1), b3 + hstepB, voffB);
            PG8_WAIT_V(6); PG8_BAR; PG8_MMA(1, 1, At, B1); PG8_BAR;
        }
        E(acc, cur, wr, wc, fr, fq); S.done(cur);
        if (!has_next) break;
#pragma unroll
        for (int a = 0; a < 2; ++a)
#pragma unroll
            for (int b = 0; b < 2; ++b)
#pragma unroll
                for (int m = 0; m < 4; ++m)
#pragma unroll
                    for (int n = 0; n < 2; ++n) acc[a][b][m][n] = (f32x4){0.f, 0.f, 0.f, 0.f};
        cur = nxt; cA = nA; cB = nB; ++ui;
    }
    PG8_WAIT_V(0);
    if (wr == 0) PG8_BAR;
    PG8_BAR;
#undef PG8_SA
#undef PG8_SB
#undef PG8_STAGE
#undef PG8_LDA
#undef PG8_LDB
#undef PG8_MMA
#undef PG8_WAIT_V
#undef PG8_WAIT_L
#undef PG8_BAR
#undef PG8_SCHED
#undef PG8_AOFF
}
}

#define XB_TMO      128
#define XB_XCNT(j)  (256  + 64 * (j))
#define XB_XSUB(j)  (1280 + 64 * (j))
#define XB_XGEN(j)  (2304 + 64 * (j))
#define XB_TOP      3328
#define XB_TOPGEN   3392
#define XCD_BAR_WORDS 3456
#define XB_LSUB(j)  (3456 + 64 * (j))
#define XB_LGEN(j)  (3488 + 64 * (j))
#define XB_SPIN_CAP (1u << 21)
__device__ __forceinline__ unsigned xb_ld(unsigned* p)              { return __hip_atomic_load(p, __ATOMIC_RELAXED, __HIP_MEMORY_SCOPE_AGENT); }
__device__ __forceinline__ unsigned xb_add(unsigned* p, unsigned v) { return __hip_atomic_fetch_add(p, v, __ATOMIC_RELAXED, __HIP_MEMORY_SCOPE_AGENT); }
__device__ __forceinline__ unsigned xb_xcc_id() { return (unsigned)__builtin_amdgcn_s_getreg((3 << 11) | 20) & 0xFu; }
#define XB_SPIN(cond, bar) do { unsigned _sp = 0; while (cond) { __builtin_amdgcn_s_sleep(1); \
    if ((++_sp & 255u) == 0u) { if (xb_ld(&(bar)[XB_TMO])) break; if (_sp > XB_SPIN_CAP) { atomicAdd(&(bar)[XB_TMO], 1u); break; } } } } while (0)
__device__ __forceinline__ void xcd_barrier_complete(unsigned* bar, unsigned x, unsigned& nloc, unsigned& nx) {
    const unsigned G = gridDim.x * gridDim.y * gridDim.z;
    unsigned sum, cnt, mine, sp = 0u;
    for (;;) {
        sum = 0u; cnt = 0u; mine = 0u;
#pragma unroll
        for (unsigned j = 0; j < 16; ++j) { const unsigned c = xb_ld(&bar[XB_XCNT(j)]); sum += c; cnt += (c > 0u) ? 1u : 0u; mine = (j == x) ? c : mine; }
        if (sum == G) break;
        __builtin_amdgcn_s_sleep(1);
        if ((++sp & 255u) == 0u) { if (xb_ld(&bar[XB_TMO])) break; if (sp > XB_SPIN_CAP) { atomicAdd(&bar[XB_TMO], 1u); break; } }
    }
    nloc = mine > 0u ? mine : 1u; nx = cnt > 0u ? cnt : 1u;
}
__device__ __forceinline__ void xcd_barrier(unsigned* bar, volatile LAS unsigned* st) {
    asm volatile("s_waitcnt vmcnt(0)" ::: "memory");
    __syncthreads();
    if (threadIdx.x == 0) {
        const unsigned x = xb_xcc_id();
        __builtin_amdgcn_s_waitcnt(0);
        unsigned nloc = st[0], nx = st[1];
        if (nloc == 0u) { xcd_barrier_complete(bar, x, nloc, nx); st[0] = nloc; st[1] = nx; }
        const unsigned old = xb_add(&bar[XB_XSUB(x)], 1u);
        const unsigned gen = old / nloc;
        if (old + 1u == (gen + 1u) * nloc) {
            __builtin_amdgcn_fence(__ATOMIC_RELEASE, "agent");
            asm volatile("s_waitcnt vmcnt(0)" ::: "memory");
            const unsigned og = xb_add(&bar[XB_TOP], 1u);
            const unsigned tg = og / nx;
            if (og + 1u == (tg + 1u) * nx) xb_add(&bar[XB_TOPGEN], 1u);
            else XB_SPIN(xb_ld(&bar[XB_TOPGEN]) == tg, bar);
            __builtin_amdgcn_fence(__ATOMIC_ACQUIRE, "agent");
            xb_add(&bar[XB_XGEN(x)], 1u);
            asm volatile("s_waitcnt vmcnt(0)" ::: "memory");
        } else {
            XB_SPIN(xb_ld(&bar[XB_XGEN(x)]) == gen, bar);
            __builtin_amdgcn_fence(__ATOMIC_ACQUIRE, "agent");
            asm volatile("s_waitcnt vmcnt(0)" ::: "memory");
        }
    }
    __syncthreads();
}

__device__ __forceinline__ void xcd_local_barrier(unsigned* bar, unsigned x, unsigned nloc) {
    asm volatile("s_waitcnt vmcnt(0)" ::: "memory");
    __syncthreads();
    if (threadIdx.x == 0) {
        __builtin_amdgcn_s_waitcnt(0);
        const unsigned old = xb_add(&bar[XB_LSUB(x)], 1u), gen = old / nloc;
        if (old + 1u == (gen + 1u) * nloc) xb_add(&bar[XB_LGEN(x)], 1u);
        else XB_SPIN(xb_ld(&bar[XB_LGEN(x)]) == gen, bar);
        __builtin_amdgcn_fence(__ATOMIC_ACQUIRE, "agent");
        asm volatile("s_waitcnt vmcnt(0)" ::: "memory");
    }
    __syncthreads();
}
struct EpiSwiGLU {
    static constexpr bool PERM = true;
    bf16_t* H; int row_off;
    __device__ __forceinline__ void operator()(const f32x4 (&acc)[2][2][4][2], const pg8::Unit& u, int wr, int wc, int fr, int fq) const {
        const int row0 = row_off + u.pm * 256 + wr * 64 + fr, hc = u.pn * 128 + wc * 32 + 8 * fq;
#pragma unroll
        for (int ai = 0; ai < 2; ++ai)
#pragma unroll
            for (int m = 0; m < 4; ++m) {
                bf16_t* rowp = H + (size_t)(row0 + ai * 128 + m * 16) * DFF + hc;
                const f32x4 g0 = acc[ai][0][m][0], g1 = acc[ai][0][m][1], u0 = acc[ai][1][m][0], u1 = acc[ai][1][m][1];
                u32x4 w;
                w.x = cvt_pk_bf16(silu_f(g0[0]) * u0[0], silu_f(g0[1]) * u0[1]); w.y = cvt_pk_bf16(silu_f(g0[2]) * u0[2], silu_f(g0[3]) * u0[3]);
                w.z = cvt_pk_bf16(silu_f(g1[0]) * u1[0], silu_f(g1[1]) * u1[1]); w.w = cvt_pk_bf16(silu_f(g1[2]) * u1[2], silu_f(g1[3]) * u1[3]);
                *(u32x4*)rowp = w;
            }
    }
};
struct EpiPlain {
    static constexpr bool PERM = true;
    bf16_t* O; int ldc; int row_off; int split_cols; size_t split_stride; float scale0; int headmajor;
    __device__ __forceinline__ void operator()(const f32x4 (&acc)[2][2][4][2], const pg8::Unit& u, int wr, int wc, int fr, int fq) const {
        const int row0 = row_off + u.pm * 256 + wr * 64 + fr; int colt = u.pn * 256; bf16_t* base = O; float sc = scale0; int t = 0;
        if (split_cols) { t = colt / split_cols; base += (size_t)t * split_stride; colt -= t * split_cols; if (t) sc = 1.f; }
        const int col0 = colt + wc * 32 + 8 * fq; const bool hm = headmajor && t > 0;
        const size_t rstride = hm ? 64 : (size_t)ldc;
        const size_t cofs0 = hm ? (size_t)(col0 >> 6) * MTOT * 64 + (col0 & 63) : (size_t)col0, cofs1 = hm ? (size_t)((col0 + 128) >> 6) * MTOT * 64 + ((col0 + 128) & 63) : (size_t)col0 + 128;
#pragma unroll
        for (int ai = 0; ai < 2; ++ai)
#pragma unroll
            for (int m = 0; m < 4; ++m) { bf16_t* rowp = base + (size_t)(row0 + ai * 128 + m * 16) * rstride;
#pragma unroll
                for (int bj = 0; bj < 2; ++bj) { const f32x4 v0 = acc[ai][bj][m][0] * sc, v1 = acc[ai][bj][m][1] * sc;
                    u32x4 w; w.x = cvt_pk_bf16(v0[0], v0[1]); w.y = cvt_pk_bf16(v0[2], v0[3]); w.z = cvt_pk_bf16(v1[0], v1[1]); w.w = cvt_pk_bf16(v1[2], v1[3]);
                    *(u32x4*)(rowp + (bj ? cofs1 : cofs0)) = w; } }
    }
};
struct EpiRetIn {
    static constexpr bool PERM = true;
    bf16_t* Q; bf16_t* K; bf16_t* V; const float* rcos; const float* rsin;
    __device__ __forceinline__ void operator()(const f32x4 (&acc)[2][2][4][2], const pg8::Unit& u, int wr, int wc, int fr, int fq) const {
        const int row0 = u.pm * 256 + wr * 64 + fr, cin = wc * 32 + 8 * fq;
        if (u.pn >= 8) {
#pragma unroll
            for (int ai = 0; ai < 2; ++ai)
#pragma unroll
                for (int m = 0; m < 4; ++m) { bf16_t* rowp = V + (size_t)(row0 + ai * 128 + m * 16) * 2048 + (u.pn - 8) * 256 + cin;
#pragma unroll
                    for (int bj = 0; bj < 2; ++bj) { const f32x4 v0 = acc[ai][bj][m][0], v1 = acc[ai][bj][m][1];
                        u32x4 w; w.x = cvt_pk_bf16(v0[0], v0[1]); w.y = cvt_pk_bf16(v0[2], v0[3]); w.z = cvt_pk_bf16(v1[0], v1[1]); w.w = cvt_pk_bf16(v1[2], v1[3]);
                        *(u32x4*)(rowp + bj * 128) = w; } }
        } else {
            bf16_t* T = (u.pn < 4) ? Q : K; const float mul = (u.pn < 4) ? 1.f : 0.0625f; const int f0 = wc * 16 + 4 * fq;
#pragma unroll
            for (int ai = 0; ai < 2; ++ai)
#pragma unroll
                for (int m = 0; m < 4; ++m) { const int row = row0 + ai * 128 + m * 16; bf16_t* rowp = T + (size_t)row * 1024 + (u.pn & 3) * 256 + cin;
                    const bool lat = row >= MCTX; const int t = (row - MCTX) & 4095;
#pragma unroll
                    for (int bj = 0; bj < 2; ++bj) { f32x4 v0 = acc[ai][bj][m][0] * mul, v1 = acc[ai][bj][m][1] * mul;
                        if (lat) { const int pos = bj ? (t & 63) : (t >> 6); const f32x4 cs = *(const f32x4*)(rcos + pos * 64 + f0), sn = *(const f32x4*)(rsin + pos * 64 + f0);
                            const f32x4 a0 = v0, a1 = v1;
                            v0[0] = a0[0] * cs[0] - a0[1] * sn[0]; v0[1] = a0[0] * sn[0] + a0[1] * cs[0]; v0[2] = a0[2] * cs[1] - a0[3] * sn[1]; v0[3] = a0[2] * sn[1] + a0[3] * cs[1];
                            v1[0] = a1[0] * cs[2] - a1[1] * sn[2]; v1[1] = a1[0] * sn[2] + a1[1] * cs[2]; v1[2] = a1[2] * cs[3] - a1[3] * sn[3]; v1[3] = a1[2] * sn[3] + a1[3] * cs[3]; }
                        u32x4 w; w.x = cvt_pk_bf16(v0[0], v0[1]); w.y = cvt_pk_bf16(v0[2], v0[3]); w.z = cvt_pk_bf16(v1[0], v1[1]); w.w = cvt_pk_bf16(v1[2], v1[3]);
                        *(u32x4*)(rowp + bj * 128) = w; } }
        }
    }
};
struct EpiGates {
    static constexpr bool PERM = true;
    bf16_t* GP;
    __device__ __forceinline__ void operator()(const f32x4 (&acc)[2][2][4][2], const pg8::Unit& u, int wr, int wc, int fr, int fq) const {
        const int row0 = u.pm * 256 + wr * 64 + fr, col0 = (u.pn & 1) * 1024 + (u.pn >> 1) * 256 + wc * 32 + 8 * fq;
#pragma unroll
        for (int ai = 0; ai < 2; ++ai)
#pragma unroll
            for (int m = 0; m < 4; ++m) { bf16_t* rowp = GP + (size_t)(row0 + ai * 128 + m * 16) * 2048 + col0;
#pragma unroll
                for (int bj = 0; bj < 2; ++bj) { const f32x4 v0 = acc[ai][bj][m][0], v1 = acc[ai][bj][m][1];
                    u32x4 w; w.x = cvt_pk_bf16(v0[0], v0[1]); w.y = cvt_pk_bf16(v0[2], v0[3]); w.z = cvt_pk_bf16(v1[0], v1[1]); w.w = cvt_pk_bf16(v1[2], v1[3]);
                    *(u32x4*)(rowp + bj * 128) = w; } }
    }
};

struct CvtJob { const float* src; bf16_t* dst; int K, N, ld, perm; };
__device__ __forceinline__ CvtJob get_job(const Args& a, int j) {
    bf16_t* wt = (bf16_t*)(a.ws + WS_WT); CvtJob r;
    if (j < 8)       { r.src = a.ffn_w_in + (size_t)j * 1024 * 5632; r.dst = wt + E_FFN_IN + (size_t)j * 5632 * 1024; r.K = 1024; r.N = 5632; r.ld = 5632; r.perm = 1; }
    else if (j < 16) { const int i = j - 8; r.src = a.ffn_w_out + (size_t)i * 2816 * 1024; r.dst = wt + E_FFN_OUT + (size_t)i * 1024 * 2816; r.K = 2816; r.N = 1024; r.ld = 1024; r.perm = 0; }
    else if (j < 18) { const int i = j - 16; r.src = a.ret_w_in + (size_t)i * 1024 * 6144; r.dst = wt + E_RET_IN + (size_t)i * 6144 * 1024; r.K = 1024; r.N = 6144; r.ld = 6144; r.perm = 2; }
    else if (j < 20) { const int i = j - 18; r.src = a.ret_w_out + (size_t)i * 2048 * 1024; r.dst = wt + E_RET_OUT + (size_t)i * 1024 * 2048; r.K = 2048; r.N = 1024; r.ld = 1024; r.perm = 0; }
    else if (j == 20) { r.src = a.na_w_qkv; r.dst = wt + E_NA_QKV; r.K = 1024; r.N = 3072; r.ld = 3072; r.perm = 0; }
    else if (j == 21) { r.src = a.na_w_out; r.dst = wt + E_NA_OUT; r.K = 1024; r.N = 1024; r.ld = 1024; r.perm = 0; }
    else if (j == 22) { r.src = a.lru_w_in; r.dst = wt + E_LRU_IN; r.K = 1024; r.N = 2048; r.ld = 2048; r.perm = 0; }
    else if (j == 23) { r.src = a.lru_w_out; r.dst = wt + E_LRU_OUT; r.K = 1024; r.N = 1024; r.ld = 1024; r.perm = 0; }
    else { const int gI = j - 24, dir = gI >> 3, type = (gI >> 2) & 1, k = gI & 3;
        r.src = (type ? a.lru_w_x : a.lru_w_a) + (size_t)(dir * 4 + k) * 256 * 256; r.dst = wt + E_GATES + (size_t)dir * 2048 * 256 + (size_t)((k * 2 + type) * 256) * 256; r.K = 256; r.N = 256; r.ld = 256; r.perm = 0; }
    return r;
}
__device__ __forceinline__ int perm_col(int perm, int n) {
    if (perm == 1) return ((n & 255) >> 7) * 2816 + (n >> 8) * 128 + (n & 127);
    if (perm == 2) { if (n < 2048) { const int hb = n >> 8, dp = n & 255, p = dp >> 1, e = dp & 1; const int d = (p < 64) ? (p + 64 * e) : (128 + (p - 64) + 64 * e); return hb * 256 + d; } return n; }
    return n;
}
__device__ __forceinline__ void phase_prologue(const Args& a, LAS unsigned char* lds) {
    const int tid = otid(), G = gridDim.x;
    { LAS bf16_t* tile = (LAS bf16_t*)lds;
      int cum = 0;
      for (int j = 0; j < 40; ++j) {
          const CvtJob jb = get_job(a, j);
          const int tn = jb.N >> 6, ntile = tn * (jb.K >> 6);
          const int first = (int)((blockIdx.x + G - (cum % G)) % G);
          for (int t = first; t < ntile; t += G) {
              const int n0 = (t % tn) * 64, k0 = (t / tn) * 64, c = tid & 63, kr = tid >> 6;
              const float* sp = jb.src + (size_t)k0 * jb.ld + perm_col(jb.perm, n0 + c);
              float v[8];
#pragma unroll
              for (int i = 0; i < 8; ++i) v[i] = sp[(size_t)(kr + 8 * i) * jb.ld];
#pragma unroll
              for (int i = 0; i < 8; ++i) tile[c * 72 + kr + 8 * i] = f2bf(v[i]);
              __syncthreads();
              const int row = tid >> 3, ch = tid & 7;
              const u32x4 w = *(const LAS u32x4*)(tile + row * 72 + ch * 8);
              *(u32x4*)(jb.dst + (size_t)(n0 + row) * jb.K + k0 + ch * 8) = w;
              __syncthreads();
          }
          cum += ntile;
      } }
    { LAS float* sv = (LAS float*)lds; LAS float* red = sv + 9 * 1024; float* MOD = (float*)(a.ws + WS_MOD);
      for (int i = tid; i < 9 * 1024; i += 512) { const int r = i >> 10, k = i & 1023; const float cv = (r < 8) ? a.c[r * 1024 + k] : a.c_ctx[k]; sv[i] = cv / (1.f + expf(-cv)); }
      __syncthreads();
      for (int it = blockIdx.x; it < 288; it += G) {
          const int l = it / 72, cb = it % 72, cl = tid & 127, kq = tid >> 7;
          const float* W = a.ada_w + (size_t)l * 1024 * 9216 + cb * 128 + cl;
          float acc[9];
#pragma unroll
          for (int r = 0; r < 9; ++r) acc[r] = 0.f;
          for (int k = kq * 256; k < kq * 256 + 256; k += 4) {
              float w[4];
#pragma unroll
              for (int q = 0; q < 4; ++q) w[q] = W[(size_t)(k + q) * 9216];
#pragma unroll
              for (int q = 0; q < 4; ++q)
#pragma unroll
                  for (int r = 0; r < 9; ++r) acc[r] += sv[r * 1024 + k + q] * w[q];
          }
#pragma unroll
          for (int r = 0; r < 9; ++r) red[(kq * 9 + r) * 128 + cl] = acc[r];
          __syncthreads();
          for (int o = tid; o < 9 * 128; o += 512) { const int r = o >> 7, cc = o & 127, col = cb * 128 + cc;
              const float s = (red[(0 * 9 + r) * 128 + cc] + red[(1 * 9 + r) * 128 + cc]) + (red[(2 * 9 + r) * 128 + cc] + red[(3 * 9 + r) * 128 + cc]);
              MOD[(size_t)(l * 9 + r) * 9216 + col] = s + a.ada_b[l * 9216 + col]; }
          __syncthreads();
      } }
    { float* rc = (float*)(a.ws + WS_ROPE); float* rs = rc + 4096;
      for (int i = blockIdx.x * 512 + tid; i < 4096; i += G * 512) { const int pos = i >> 6, f = i & 63; const float fr = expf(-(float)(2 * f) * (1.f / 128.f) * 9.210340371976184f); const float ang = (float)pos * fr;
          rc[i] = cosf(ang); rs[i] = sinf(ang); } }
}

__device__ __forceinline__ void phase_u0(const Args& a, const Grp& gp) {
    const float* MOD = (const float*)(a.ws + WS_MOD); bf16_t* U = (bf16_t*)(a.ws + WS_U);
    for (int i = gp.rank * 512 + otid(); i < gp.nb * 4352 * 128; i += gp.gsize * 512) {
        const int row = grp_row(gp, i >> 7), c8 = (i & 127) * 8; const int r9 = row < MCTX ? 8 : (row - MCTX) >> 12;
        const float* hp = (row < MCTX ? a.ctx + (size_t)row * 1024 : a.x + (size_t)(row - MCTX) * 1024) + c8;
        const float* sh = MOD + (size_t)(r9 * 9 + 0) * 1024 + c8; const float* sc = sh + 1024;
        const f32x4 h0 = *(const f32x4*)hp, h1 = *(const f32x4*)(hp + 4), s0 = *(const f32x4*)sh, s1 = *(const f32x4*)(sh + 4), c0 = *(const f32x4*)sc, c1 = *(const f32x4*)(sc + 4);
        const f32x4 o0 = h0 * (c0 + 1.f) + s0, o1 = h1 * (c1 + 1.f) + s1;
        u32x4 w; w.x = cvt_pk_bf16(o0[0], o0[1]); w.y = cvt_pk_bf16(o0[2], o0[3]); w.z = cvt_pk_bf16(o1[0], o1[1]); w.w = cvt_pk_bf16(o1[2], o1[3]);
        *(u32x4*)(U + (size_t)row * 1024 + c8) = w;
    }
}

__device__ __forceinline__ void phase_postnorm(const Args& a, bool first, const bf16_t* Y, const float* modl, int gate_j, float ymul, const float* lng, const float* lnb,
                                               const float* modn, int sh_j, int row_begin, const Grp& gp) {
    const int tid = otid(), lane = tid & 63, gw = gp.rank * 8 + (tid >> 6), nw = gp.gsize * 8;
    const int nrows = gp.nb * (row_begin ? 4096 : 4352);
    float* HC = (float*)(a.ws + WS_HC); bf16_t* U = (bf16_t*)(a.ws + WS_U);
    f32x4 hr[2][4]; u32x2 yr[2][4];
#define PN_MAP(lr) (row_begin ? grp_row_lat(gp, (lr)) : grp_row(gp, (lr)))
#define PN_ROW(t, lA) PN_MAP((t) ? (((lA) + nw < nrows) ? (lA) + nw : (lA)) : (lA))
#define PN_LOAD(dstH, dstY, rA) do { _Pragma("unroll") for (int t = 0; t < 2; ++t) { const int row = PN_ROW(t, rA); const bool isc = row < MCTX; \
        const float* hin = first ? (isc ? a.ctx + (size_t)row * 1024 : a.x + (size_t)(row - MCTX) * 1024) : (isc ? HC + (size_t)row * 1024 : a.out + (size_t)(row - MCTX) * 1024); \
        const bf16_t* yp = Y + (size_t)row * 1024; \
        _Pragma("unroll") for (int c = 0; c < 4; ++c) { const int col = c * 256 + lane * 4; dstH[t][c] = *(const f32x4*)(hin + col); dstY[t][c] = *(const u32x2*)(yp + col); } } } while (0)
    f32x4 gv[4], bv[4];
#pragma unroll
    for (int c = 0; c < 4; ++c) { gv[c] = *(const f32x4*)(lng + c * 256 + lane * 4); bv[c] = *(const f32x4*)(lnb + c * 256 + lane * 4); }
    int rowA = gw;
    if (rowA < nrows) PN_LOAD(hr, yr, rowA);
    for (; rowA < nrows; rowA += 2 * nw) {
        const bool hasB = rowA + nw < nrows;
        f32x4 v[2][4]; float s[2] = {0.f, 0.f}, q[2] = {0.f, 0.f};
#pragma unroll
        for (int t = 0; t < 2; ++t) { const int row = PN_ROW(t, rowA); const int r9 = row < MCTX ? 8 : (row - MCTX) >> 12;
            const float* gate = modl + (size_t)(r9 * 9 + gate_j) * 1024;
#pragma unroll
            for (int c = 0; c < 4; ++c) { const int col = c * 256 + lane * 4; const f32x4 gt = *(const f32x4*)(gate + col);
                const f32x4 y = {bflo(yr[t][c].x), bfhi(yr[t][c].x), bflo(yr[t][c].y), bfhi(yr[t][c].y)};
                v[t][c] = hr[t][c] * DN_ALPHA + gt * y * ymul; s[t] += (v[t][c][0] + v[t][c][1]) + (v[t][c][2] + v[t][c][3]);
                q[t] += (v[t][c][0] * v[t][c][0] + v[t][c][1] * v[t][c][1]) + (v[t][c][2] * v[t][c][2] + v[t][c][3] * v[t][c][3]); } }
        const int rowN = rowA + 2 * nw;
        if (rowN < nrows) PN_LOAD(hr, yr, rowN);
#pragma unroll
        for (int o = 32; o >= 1; o >>= 1) { const float s0 = shx(s[0], lane, o), s1 = shx(s[1], lane, o), q0 = shx(q[0], lane, o), q1 = shx(q[1], lane, o); s[0] += s0; s[1] += s1; q[0] += q0; q[1] += q1; }
#pragma unroll
        for (int t = 0; t < 2; ++t) { if (t && !hasB) break; const int row = PN_MAP(t ? rowA + nw : rowA);
            const bool isc = row < MCTX; const int r9 = isc ? 8 : (row - MCTX) >> 12;
            float* hout = isc ? HC + (size_t)row * 1024 : a.out + (size_t)(row - MCTX) * 1024;
            const float mean = s[t] * (1.f / 1024.f); const float var = fmaxf(q[t] * (1.f / 1024.f) - mean * mean, 0.f);
            const float rstd = 1.0f / sqrtf(var + LN_EPS);
#pragma unroll
            for (int c = 0; c < 4; ++c) { const int col = c * 256 + lane * 4;
                const f32x4 hn = (v[t][c] - mean) * rstd * gv[c] + bv[c]; *(f32x4*)(hout + col) = hn;
                if (sh_j >= 0) { const f32x4 sh = *(const f32x4*)(modn + (size_t)(r9 * 9 + sh_j) * 1024 + col), sc = *(const f32x4*)(modn + (size_t)(r9 * 9 + sh_j + 1) * 1024 + col);
                    const f32x4 o = hn * (sc + 1.f) + sh; u32x2 w; w.x = cvt_pk_bf16(o[0], o[1]); w.y = cvt_pk_bf16(o[2], o[3]); *(u32x2*)(U + (size_t)row * 1024 + col) = w; } } }
    }
#undef PN_LOAD
#undef PN_ROW
#undef PN_MAP
}
template <int RABL>
__device__ __forceinline__ void phase_retention(const Args& a, LAS unsigned char* lds, const Grp& gp) {
    const bf16_t* Qg = (const bf16_t*)(a.ws + WS_BIG); const bf16_t* Kg = (const bf16_t*)(a.ws + WS_BIG + R1); const bf16_t* Vg = (const bf16_t*)(a.ws + WS_BIG + 2 * R1); bf16_t* Og = (bf16_t*)(a.ws + WS_BIG + 4 * R1);
    const int tid = otid(), w = __builtin_amdgcn_readfirstlane(tid >> 6), lane = tid & 63, c = lane & 15, g = lane >> 4;
    const int ib = w & 3, vh = w >> 2, vb2 = w & 3, dbase = (w >> 2) * 8;
    constexpr int QS = 0, KS = 32768, VS = 65536, ST = 73728;
    typedef short s16x4 __attribute__((ext_vector_type(4)));
    for (int item = gp.rank; item < gp.nb * 32; item += gp.gsize) {
        const int b = gp.b_lo + (item >> 5), h = (item >> 3) & 3, vs = item & 7;
        f32x4 accS[8]; u32x4 qreg[4], kreg[4], vreg; float lg = 0.f, g64 = 0.f;
        { const int row0 = b * 256;
#pragma unroll
          for (int i = 0; i < 4; ++i) { const int idx = tid + 512 * i, row = idx >> 5, ch = idx & 31; const size_t o = (size_t)(row0 + row) * 1024 + h * 256 + ch * 8; qreg[i] = *(const u32x4*)(Qg + o); kreg[i] = *(const u32x4*)(Kg + o); }
          vreg = *(const u32x4*)(Vg + (size_t)(row0 + (tid >> 3)) * 2048 + h * 512 + vs * 64 + (tid & 7) * 8); }
        for (int step = 0; step < 136; ++step) {
            const int dir = step >= 68 ? 1 : 0, s = step - 68 * dir;
            if (s == 0) {
#pragma unroll
                for (int x = 0; x < 8; ++x) accS[x] = (f32x4){0.f, 0.f, 0.f, 0.f};
                const int hh = dir ? 3 - h : h; lg = log2f(1.0f - exp2f(-5.0f - (float)hh)); g64 = exp2f(64.f * lg);
            }
            const int row0 = dir ? (s < 4 ? b * 256 + 64 * (3 - s) : MCTX + b * 4096 + 64 * (63 - (s - 4))) : (s < 4 ? b * 256 + 64 * s : MCTX + b * 4096 + 64 * (s - 4));
            __syncthreads();
            if (RABL != 1)
#pragma unroll
            for (int x = 0; x < 8; ++x) { const int d = 16 * (dbase + x) + c;
#pragma unroll
                for (int r = 0; r < 4; ++r) { const int v = 16 * vb2 + 4 * g + r; *(LAS bf16_t*)(lds + ST + v * 512 + (((d >> 3) ^ (v & 15)) << 4) + (d & 7) * 2) = f2bf(accS[x][r]); } }
#pragma unroll
            for (int i = 0; i < 4; ++i) { const int idx = tid + 512 * i, row = idx >> 5, ch = idx & 31; const int off = row * 512 + ((ch ^ (row & 15)) << 4);
                *(LAS u32x4*)(lds + QS + off) = qreg[i]; *(LAS u32x4*)(lds + KS + off) = kreg[i]; }
            { const int j = tid >> 3, ch = tid & 7; *(LAS u32x4*)(lds + VS + j * 128 + ((ch ^ ((j >> 1) & 7)) << 4)) = vreg; }
            __syncthreads();
            if (step + 1 < 136) { const int st2 = step + 1, dir2 = st2 >= 68 ? 1 : 0, s2 = st2 - 68 * dir2;
                const int nrow0 = dir2 ? (s2 < 4 ? b * 256 + 64 * (3 - s2) : MCTX + b * 4096 + 64 * (63 - (s2 - 4))) : (s2 < 4 ? b * 256 + 64 * s2 : MCTX + b * 4096 + 64 * (s2 - 4));
#pragma unroll
                for (int i = 0; i < 4; ++i) { const int idx = tid + 512 * i, row = idx >> 5, ch = idx & 31; const size_t o = (size_t)(nrow0 + row) * 1024 + h * 256 + ch * 8; qreg[i] = *(const u32x4*)(Qg + o); kreg[i] = *(const u32x4*)(Kg + o); }
                vreg = *(const u32x4*)(Vg + (size_t)(nrow0 + (tid >> 3)) * 2048 + h * 512 + vs * 64 + (tid & 7) * 8); }
            if (RABL == 2) continue;
            const int iq = 16 * ib + c;
            f32x4 accs[4], acco[2];
#pragma unroll
            for (int jb = 0; jb < 4; ++jb) accs[jb] = (f32x4){0.f, 0.f, 0.f, 0.f};
            acco[0] = (f32x4){0.f, 0.f, 0.f, 0.f}; acco[1] = (f32x4){0.f, 0.f, 0.f, 0.f};
#pragma unroll 1
            for (int ks = 0; ks < 8; ++ks) {
                const int sw = ((4 * ks + g) ^ c) << 4;
                const bf16x8 qf = *(const LAS bf16x8*)(lds + QS + iq * 512 + sw);
#pragma unroll
                for (int jb = 0; jb < 4; ++jb) { const bf16x8 kf = *(const LAS bf16x8*)(lds + KS + (16 * jb + c) * 512 + sw); accs[jb] = __builtin_amdgcn_mfma_f32_16x16x32_bf16(kf, qf, accs[jb], 0, 0, 0); }
#pragma unroll
                for (int vb = 0; vb < 2; ++vb) { const bf16x8 sf = *(const LAS bf16x8*)(lds + ST + (16 * (2 * vh + vb) + c) * 512 + sw); acco[vb] = __builtin_amdgcn_mfma_f32_16x16x32_bf16(sf, qf, acco[vb], 0, 0, 0); }
            }
            { const float qd = __builtin_amdgcn_exp2f(lg * (float)(dir ? 64 - iq : iq + 1)); acco[0] *= qd; acco[1] *= qd; }
#pragma unroll
            for (int jb = 0; jb < 4; ++jb)
#pragma unroll
                for (int r = 0; r < 4; ++r) { const int j = 16 * jb + 4 * g + r; const int df = dir ? j - iq : iq - j; const bool vis = dir ? (df > 0) : (df >= 0);
                    accs[jb][r] = vis ? accs[jb][r] * __builtin_amdgcn_exp2f(lg * (float)df) : 0.f; }
#pragma unroll
            for (int s2 = 0; s2 < 2; ++s2) {
                u32x4 pw; pw.x = cvt_pk_bf16(accs[2 * s2][0], accs[2 * s2][1]); pw.y = cvt_pk_bf16(accs[2 * s2][2], accs[2 * s2][3]); pw.z = cvt_pk_bf16(accs[2 * s2 + 1][0], accs[2 * s2 + 1][1]); pw.w = cvt_pk_bf16(accs[2 * s2 + 1][2], accs[2 * s2 + 1][3]);
                const bf16x8 pf = __builtin_bit_cast(bf16x8, pw);
#pragma unroll
                for (int vb = 0; vb < 2; ++vb) { const int vblk = 2 * vh + vb, ra = 32 * s2 + 4 * g + (c >> 2), rbb = ra + 16, cch = 2 * vblk + ((c & 3) >> 1);
                    const s16x4 lo = __builtin_amdgcn_ds_read_tr16_b64_v4i16((LAS s16x4*)(lds + VS + ra * 128 + ((cch ^ ((ra >> 1) & 7)) << 4) + 8 * (c & 1)));
                    const s16x4 hi = __builtin_amdgcn_ds_read_tr16_b64_v4i16((LAS s16x4*)(lds + VS + rbb * 128 + ((cch ^ ((rbb >> 1) & 7)) << 4) + 8 * (c & 1)));
                    const bf16x8 vf = {lo[0], lo[1], lo[2], lo[3], hi[0], hi[1], hi[2], hi[3]};
                    acco[vb] = __builtin_amdgcn_mfma_f32_16x16x32_bf16(vf, pf, acco[vb], 0, 0, 0); }
            }
#pragma unroll
            for (int vb = 0; vb < 2; ++vb) { bf16_t* op = Og + (size_t)(row0 + iq) * 2048 + h * 512 + vs * 64 + 16 * (2 * vh + vb) + 4 * g; f32x4 o = acco[vb];
                if (dir) { const u32x2 pv = *(const u32x2*)op; o[0] += bflo(pv.x); o[1] += bfhi(pv.x); o[2] += bflo(pv.y); o[3] += bfhi(pv.y); }
                u32x2 ow; ow.x = cvt_pk_bf16(o[0], o[1]); ow.y = cvt_pk_bf16(o[2], o[3]); *(u32x2*)op = ow; }
            { bf16x8 af[2];
              const int tq = c >> 2, tp = c & 3;
#pragma unroll
              for (int k2 = 0; k2 < 2; ++k2) { const int r0 = 32 * k2 + 8 * g + tq, r1 = r0 + 4, cch = 2 * vb2 + (tp >> 1);
                  const s16x4 t0 = __builtin_amdgcn_ds_read_tr16_b64_v4i16((LAS s16x4*)(lds + VS + r0 * 128 + ((cch ^ ((r0 >> 1) & 7)) << 4) + 8 * (tp & 1)));
                  const s16x4 t1 = __builtin_amdgcn_ds_read_tr16_b64_v4i16((LAS s16x4*)(lds + VS + r1 * 128 + ((cch ^ ((r1 >> 1) & 7)) << 4) + 8 * (tp & 1)));
                  const int j0 = 32 * k2 + 8 * g; float kd[8];
#pragma unroll
                  for (int e = 0; e < 8; ++e) kd[e] = __builtin_amdgcn_exp2f(lg * (float)(dir ? j0 + e : 63 - j0 - e));
                  u32x4 aw; aw.x = cvt_pk_bf16(bf2f((bf16_t)t0[0]) * kd[0], bf2f((bf16_t)t0[1]) * kd[1]); aw.y = cvt_pk_bf16(bf2f((bf16_t)t0[2]) * kd[2], bf2f((bf16_t)t0[3]) * kd[3]);
                  aw.z = cvt_pk_bf16(bf2f((bf16_t)t1[0]) * kd[4], bf2f((bf16_t)t1[1]) * kd[5]); aw.w = cvt_pk_bf16(bf2f((bf16_t)t1[2]) * kd[6], bf2f((bf16_t)t1[3]) * kd[7]);
                  af[k2] = __builtin_bit_cast(bf16x8, aw); }
#pragma unroll
              for (int x = 0; x < 8; ++x) { accS[x] *= g64; const int db = dbase + x;
#pragma unroll
                  for (int k2 = 0; k2 < 2; ++k2) { const int r0 = 32 * k2 + 8 * g + tq, r1 = r0 + 4;
                      const s16x4 t0 = __builtin_amdgcn_ds_read_tr16_b64_v4i16((LAS s16x4*)(lds + KS + r0 * 512 + (((2 * db + (tp >> 1)) ^ (r0 & 15)) << 4) + 8 * (tp & 1)));
                      const s16x4 t1 = __builtin_amdgcn_ds_read_tr16_b64_v4i16((LAS s16x4*)(lds + KS + r1 * 512 + (((2 * db + (tp >> 1)) ^ (r1 & 15)) << 4) + 8 * (tp & 1)));
                      const bf16x8 bfr = {t0[0], t0[1], t0[2], t0[3], t1[0], t1[1], t1[2], t1[3]};
                      accS[x] = __builtin_amdgcn_mfma_f32_16x16x32_bf16(af[k2], bfr, accS[x], 0, 0, 0); }
                  __builtin_amdgcn_sched_barrier(0); } }
        }
        __syncthreads();
    }
}

__device__ __forceinline__ void phase_ret_finish(const Args& a, int row_begin, const Grp& gp) {
    bf16_t* Og = (bf16_t*)(a.ws + WS_BIG + 4 * R1); const bf16_t* Gg = (const bf16_t*)(a.ws + WS_BIG);
    const int tid = otid(), lane = tid & 63, gw = gp.rank * 8 + (tid >> 6), nw = gp.gsize * 8, nrows = gp.nb * (row_begin ? 4096 : 4352);
    for (int lr = gw; lr < nrows; lr += nw) { const int row = row_begin ? grp_row_lat(gp, lr) : grp_row(gp, lr);
        const size_t base = (size_t)row * 2048 + (lane >> 4) * 512 + (lane & 15) * 32;
        float v[32]; float s = 0.f;
#pragma unroll
        for (int q = 0; q < 4; ++q) { const u32x4 w = *(const u32x4*)(Og + base + q * 8);
            v[q * 8 + 0] = bflo(w.x); v[q * 8 + 1] = bfhi(w.x); v[q * 8 + 2] = bflo(w.y); v[q * 8 + 3] = bfhi(w.y); v[q * 8 + 4] = bflo(w.z); v[q * 8 + 5] = bfhi(w.z); v[q * 8 + 6] = bflo(w.w); v[q * 8 + 7] = bfhi(w.w); }
#pragma unroll
        for (int i = 0; i < 32; ++i) s += v[i];
        s += shx(s, lane, 1); s += shx(s, lane, 2); s += shx(s, lane, 4); s += shx(s, lane, 8);
        const float mean = s * (1.f / 512.f); float qv = 0.f;
#pragma unroll
        for (int i = 0; i < 32; ++i) { const float d = v[i] - mean; qv += d * d; }
        qv += shx(qv, lane, 1); qv += shx(qv, lane, 2); qv += shx(qv, lane, 4); qv += shx(qv, lane, 8);
        const float rstd = 1.0f / sqrtf(qv * (1.f / 512.f) + LN_EPS);
#pragma unroll
        for (int q = 0; q < 4; ++q) { const u32x4 gwd = *(const u32x4*)(Gg + base + q * 8); const unsigned gw4[4] = {gwd.x, gwd.y, gwd.z, gwd.w}; unsigned ow[4];
#pragma unroll
            for (int p = 0; p < 4; ++p) { const float g0 = bflo(gw4[p]), g1 = bfhi(gw4[p]);
                ow[p] = cvt_pk_bf16(silu_f(g0) * (v[q * 8 + 2 * p] - mean) * rstd, silu_f(g1) * (v[q * 8 + 2 * p + 1] - mean) * rstd); }
            u32x4 o; o.x = ow[0]; o.y = ow[1]; o.z = ow[2]; o.w = ow[3]; *(u32x4*)(Og + base + q * 8) = o; }
    }
}

template <int ABL>
__device__ __forceinline__ void phase_na(const Args& a, LAS unsigned char* lds0, bf16_t* Odst, const Grp& gp) {
    const bf16_t* Qg = (const bf16_t*)(a.ws + WS_BIG); const bf16_t* Kg = (const bf16_t*)(a.ws + WS_BIG + R1); const bf16_t* Vg = (const bf16_t*)(a.ws + WS_BIG + 2 * R1);
    const int tid = otid(), w = __builtin_amdgcn_readfirstlane(tid >> 6), lane = tid & 63, c = lane & 15, g = lane >> 4, hb = w >> 2, w4 = w & 3, t2 = tid & 255;
    LAS unsigned char* lds = lds0 + hb * 65536;
    constexpr int QS = 0, KS = 32768, VT = 40960, RP = 49152;
    float mk[4][4]; int rco[4][4];
    { const int q0 = 16 * w4 + c, cs0 = min(max(q0 - 8, 0), 48);
#pragma unroll
      for (int kb = 0; kb < 4; ++kb)
#pragma unroll
          for (int e = 0; e < 4; ++e) { const int kc = 16 * kb + 4 * g + e; mk[kb][e] = (kc >= cs0 && kc < cs0 + 16) ? 0.f : -1e30f; rco[kb][e] = min(max(kc - q0 + 15, 0), 30) * 4; } }
    const int kb_lo = min(max(16 * w4 - 8, 0), 48) >> 4, kb_hi = (min(max(16 * w4 + 7, 0), 48) + 15) >> 4;
    for (int base_it = gp.rank * 2; base_it < gp.nb * 272; base_it += gp.gsize * 2) {
        const int it = base_it + hb, bb = it / 272, idx = it - bb * 272; const bool isl = (base_it % 272) < 256;
        const int b = gp.b_lo + bb; int h, r0 = 0, kr_lo = 0, kr_hi = 0;
        if (isl) { h = idx >> 4; r0 = (idx & 15) * 4; kr_lo = min(max(r0 - 4, 0), 56); kr_hi = min(max(r0 - 1, 0), 56) + 7; }
        else { h = idx - 256; }
        const int ntile = isl ? 15 : 4;
        __syncthreads();
#pragma unroll
        for (int i = 0; i < 8; ++i) { const int idx = t2 + 256 * i, row = idx >> 3, ch = idx & 7, rr = row >> 6, qi = row & 63;
            const int grow = isl ? MCTX + b * 4096 + (r0 + rr) * 64 + qi : b * 256 + rr * 64 + qi;
            *(LAS u32x4*)(lds + QS + row * 128 + ((ch ^ ((row >> 1) & 7)) << 4)) = *(const u32x4*)(Qg + (size_t)grow * 1024 + h * 64 + ch * 8); }
        for (int i = t2; i < 465; i += 256) *(LAS float*)(lds + RP + i * 4) = a.na_rpb[h * 465 + i];
        u32x4 kreg[2], vreg[2];
        { const int row0 = isl ? MCTX + b * 4096 + kr_lo * 64 : b * 256;
#pragma unroll
          for (int i = 0; i < 2; ++i) { const int idx = t2 + 256 * i, row = idx >> 3, ch = idx & 7; const size_t o = ((size_t)h * MTOT + row0 + row) * 64 + ch * 8; kreg[i] = *(const u32x4*)(Kg + o); vreg[i] = *(const u32x4*)(Vg + o); } }
        const int q = 16 * w4 + c;
        f32x4 oacc[4][4]; float mrun[4], lrun[4];
#pragma unroll
        for (int rr = 0; rr < 4; ++rr) { mrun[rr] = -1e30f; lrun[rr] = 0.f;
#pragma unroll
            for (int db = 0; db < 4; ++db) oacc[rr][db] = (f32x4){0.f, 0.f, 0.f, 0.f}; }
        for (int tl = 0; tl < ntile; ++tl) {
            if (ABL == 3) break;
            if (ABL == 4) { __syncthreads(); __syncthreads(); continue; }
            __syncthreads();
#pragma unroll
            for (int i = 0; i < 2; ++i) { const int idx = t2 + 256 * i, row = idx >> 3, ch = idx & 7;
                *(LAS u32x4*)(lds + KS + row * 128 + ((ch ^ ((row >> 1) & 7)) << 4)) = kreg[i];
                const unsigned vw[4] = {vreg[i].x, vreg[i].y, vreg[i].z, vreg[i].w};
#pragma unroll
                for (int e = 0; e < 8; ++e) { const int d = ch * 8 + e; const bf16_t val = (bf16_t)((e & 1) ? (vw[e >> 1] >> 16) : (vw[e >> 1] & 0xffffu));
                    *(LAS bf16_t*)(lds + VT + d * 128 + (((row >> 3) ^ ((d >> 1) & 7)) << 4) + (row & 7) * 2) = val; } }
            __syncthreads();
            if (tl + 1 < ntile) { const int t1 = tl + 1;
                const int row0 = isl ? (t1 < 11 ? MCTX + b * 4096 + min(kr_lo + t1, kr_hi) * 64 : b * 256 + (t1 - 11) * 64) : b * 256 + t1 * 64;
#pragma unroll
                for (int i = 0; i < 2; ++i) { const int idx = t2 + 256 * i, row = idx >> 3, ch = idx & 7; const size_t o = ((size_t)h * MTOT + row0 + row) * 64 + ch * 8; kreg[i] = *(const u32x4*)(Kg + o); vreg[i] = *(const u32x4*)(Vg + o); } }
            if (ABL == 2) continue;
            const bool local = isl && tl < 11; const int krow = kr_lo + tl;
            if (local && krow > kr_hi) continue;
#pragma unroll
            for (int rr = 0; rr < 4; ++rr) {
                const int r = r0 + rr, rs = min(max(r - 4, 0), 56);
                if (local && (krow < rs || krow >= rs + 8)) continue;
                bf16x8 qf[2];
#pragma unroll
                for (int ks = 0; ks < 2; ++ks) { const int qrow = rr * 64 + q; qf[ks] = *(const LAS bf16x8*)(lds + QS + qrow * 128 + (((4 * ks + g) ^ ((qrow >> 1) & 7)) << 4)); }
                f32x4 sT[4];
#pragma unroll
                for (int kb = 0; kb < 4; ++kb) { const bool skip = local && (kb < kb_lo || kb > kb_hi);
                    if (skip) { sT[kb] = (f32x4){-1e30f, -1e30f, -1e30f, -1e30f}; continue; }
                    sT[kb] = (f32x4){0.f, 0.f, 0.f, 0.f}; const int kr = 16 * kb + c;
#pragma unroll
                    for (int ks = 0; ks < 2; ++ks) { const bf16x8 kf = *(const LAS bf16x8*)(lds + KS + kr * 128 + (((4 * ks + g) ^ ((kr >> 1) & 7)) << 4)); sT[kb] = __builtin_amdgcn_mfma_f32_16x16x32_bf16(kf, qf[ks], sT[kb], 0, 0, 0); }
                    if (local) { const int rbase = RP + (krow - r + 7) * 124;
#pragma unroll
                        for (int e = 0; e < 4; ++e) sT[kb][e] = (sT[kb][e] + *(const LAS float*)(lds + rbase + rco[kb][e])) + mk[kb][e]; } }
                if (ABL == 1) { oacc[rr][0] += sT[0] + sT[1] + sT[2] + sT[3]; continue; }
                float mx = -1e30f;
#pragma unroll
                for (int kb = 0; kb < 4; ++kb) mx = fmaxf(mx, fmaxf(fmaxf(sT[kb][0], sT[kb][1]), fmaxf(sT[kb][2], sT[kb][3])));
                mx = fmaxf(mx, shx(mx, lane, 16)); mx = fmaxf(mx, shx(mx, lane, 32));
                const float mnew = fmaxf(mrun[rr], mx), alpha = __builtin_amdgcn_exp2f((mrun[rr] - mnew) * LOG2E); mrun[rr] = mnew;
                float ps = 0.f;
#pragma unroll
                for (int kb = 0; kb < 4; ++kb)
#pragma unroll
                    for (int e = 0; e < 4; ++e) { const float p = __builtin_amdgcn_exp2f((sT[kb][e] - mnew) * LOG2E); sT[kb][e] = p; ps += p; }
                ps += shx(ps, lane, 16); ps += shx(ps, lane, 32);
                lrun[rr] = lrun[rr] * alpha + ps;
#pragma unroll
                for (int db = 0; db < 4; ++db) oacc[rr][db] *= alpha;
#pragma unroll
                for (int s2 = 0; s2 < 2; ++s2) {
                    if (local && (2 * s2 + 1 < kb_lo || 2 * s2 > kb_hi)) continue;
                    u32x4 pw; pw.x = cvt_pk_bf16(sT[2 * s2][0], sT[2 * s2][1]); pw.y = cvt_pk_bf16(sT[2 * s2][2], sT[2 * s2][3]); pw.z = cvt_pk_bf16(sT[2 * s2 + 1][0], sT[2 * s2 + 1][1]); pw.w = cvt_pk_bf16(sT[2 * s2 + 1][2], sT[2 * s2 + 1][3]);
                    const bf16x8 pf = __builtin_bit_cast(bf16x8, pw);
#pragma unroll
                    for (int db = 0; db < 4; ++db) { const int vrow = 16 * db + c; const int sw = (vrow >> 1) & 7;
                        const u32x2 lo = *(const LAS u32x2*)(lds + VT + vrow * 128 + (((4 * s2 + (g >> 1)) ^ sw) << 4) + (g & 1) * 8);
                        const u32x2 hi = *(const LAS u32x2*)(lds + VT + vrow * 128 + (((4 * s2 + 2 + (g >> 1)) ^ sw) << 4) + (g & 1) * 8);
                        u32x4 vw; vw.x = lo.x; vw.y = lo.y; vw.z = hi.x; vw.w = hi.y;
                        oacc[rr][db] = __builtin_amdgcn_mfma_f32_16x16x32_bf16(__builtin_bit_cast(bf16x8, vw), pf, oacc[rr][db], 0, 0, 0); }
                }
            }
        }
        __syncthreads();
#pragma unroll
        for (int rr = 0; rr < 4; ++rr) { const float inv = 1.0f / lrun[rr]; const int orow = rr * 64 + q;
#pragma unroll
            for (int db = 0; db < 4; ++db) { const f32x4 o = oacc[rr][db] * inv; u32x2 ow; ow.x = cvt_pk_bf16(o[0], o[1]); ow.y = cvt_pk_bf16(o[2], o[3]);
                *(LAS u32x2*)(lds + QS + orow * 128 + (((2 * db + (g >> 1)) ^ ((orow >> 1) & 7)) << 4) + (g & 1) * 8) = ow; } }
        __syncthreads();
#pragma unroll
        for (int i = 0; i < 8; ++i) { const int idx = t2 + 256 * i, row = idx >> 3, ch = idx & 7, rr = row >> 6, qi = row & 63;
            const int grow = isl ? MCTX + b * 4096 + (r0 + rr) * 64 + qi : b * 256 + rr * 64 + qi;
            *(u32x4*)(Odst + (size_t)grow * 1024 + h * 64 + ch * 8) = *(const LAS u32x4*)(lds + QS + row * 128 + ((ch ^ ((row >> 1) & 7)) << 4)); }
    }
    __syncthreads();
}

__device__ __forceinline__ void phase_lru_conv(const Args& a, const Grp& gp) {
    const bf16_t* XR = (const bf16_t*)(a.ws + WS_BIG + R1); bf16_t* XC = (bf16_t*)(a.ws + WS_BIG + 2 * R1);
    for (int i = gp.rank * 512 + otid(); i < gp.nb * 4352 * 128; i += gp.gsize * 512) {
        const int row = grp_row(gp, i >> 7), c8 = (i & 127) * 8; const bool isc = row < MCTX; const int t = isc ? (row & 255) : ((row - MCTX) & 4095), len = isc ? 256 : 4096;
        float acc[8];
        { const f32x4 b0 = *(const f32x4*)(a.lru_conv_b + c8), b1 = *(const f32x4*)(a.lru_conv_b + c8 + 4); acc[0] = b0[0]; acc[1] = b0[1]; acc[2] = b0[2]; acc[3] = b0[3]; acc[4] = b1[0]; acc[5] = b1[1]; acc[6] = b1[2]; acc[7] = b1[3]; }
#pragma unroll
        for (int j = 0; j < 4; ++j) { const int tt = t - 2 + j;
            if (tt >= 0 && tt < len) { const u32x4 xw = *(const u32x4*)(XR + (size_t)(row - 2 + j) * 1024 + c8); const f32x4 w0 = *(const f32x4*)(a.lru_conv_w + j * 1024 + c8), w1 = *(const f32x4*)(a.lru_conv_w + j * 1024 + c8 + 4);
                acc[0] += w0[0] * bflo(xw.x); acc[1] += w0[1] * bfhi(xw.x); acc[2] += w0[2] * bflo(xw.y); acc[3] += w0[3] * bfhi(xw.y);
                acc[4] += w1[0] * bflo(xw.z); acc[5] += w1[1] * bfhi(xw.z); acc[6] += w1[2] * bflo(xw.w); acc[7] += w1[3] * bfhi(xw.w); } }
        u32x4 o; o.x = cvt_pk_bf16(acc[0], acc[1]); o.y = cvt_pk_bf16(acc[2], acc[3]); o.z = cvt_pk_bf16(acc[4], acc[5]); o.w = cvt_pk_bf16(acc[6], acc[7]);
        *(u32x4*)(XC + (size_t)row * 1024 + c8) = o;
    }
}
__device__ __forceinline__ void phase_lru_scan(const Args& a, int dir, int pass, const Grp& gp) {
    const bf16_t* GATE = (const bf16_t*)(a.ws + WS_BIG); bf16_t* HF = (bf16_t*)(a.ws + WS_BIG + R1); const bf16_t* XC = (const bf16_t*)(a.ws + WS_BIG + 2 * R1); const bf16_t* GP = (const bf16_t*)(a.ws + WS_BIG + 3 * R1);
    float* CARRY = (float*)(a.ws + WS_CARRY);
    for (int idx = gp.rank * 512 + otid(); idx < gp.nb * 64 * 256; idx += gp.gsize * 512) {
        const int cq = idx & 255, chunk = (idx >> 8) & 63, b = gp.b_lo + (idx >> 14), c0 = cq * 4;
        float ba[4], bx[4], sp[4], h[4], P[4];
        { const f32x4 t0 = *(const f32x4*)(a.lru_b_a + dir * 1024 + c0), t1 = *(const f32x4*)(a.lru_b_x + dir * 1024 + c0), t2 = *(const f32x4*)(a.lru_lam + dir * 1024 + c0);
#pragma unroll
          for (int k = 0; k < 4; ++k) { ba[k] = t0[k]; bx[k] = t1[k]; sp[k] = -8.f * log1pf(expf(-t2[k])); h[k] = 0.f; P[k] = 1.f; } }
        if (pass == 2) { for (int cc = 0; cc < chunk; ++cc) { const float* cp = CARRY + ((size_t)(b * 64 + cc) * 256 + cq) * 8; const f32x4 pp = *(const f32x4*)cp, ll = *(const f32x4*)(cp + 4);
#pragma unroll
            for (int k = 0; k < 4; ++k) h[k] = pp[k] * h[k] + ll[k]; } }
        for (int t4 = 0; t4 < 17; ++t4) {
            u32x2 rw[4], iw[4], xw[4], hw[4], gw[4]; int rows[4];
#pragma unroll
            for (int j = 0; j < 4; ++j) { const int p = chunk * 68 + t4 * 4 + j;
                const int row = dir ? (p < 256 ? b * 256 + (255 - p) : MCTX + b * 4096 + (4095 - (p - 256))) : (p < 256 ? b * 256 + p : MCTX + b * 4096 + (p - 256));
                rows[j] = row;
                rw[j] = *(const u32x2*)(GP + (size_t)row * 2048 + c0); iw[j] = *(const u32x2*)(GP + (size_t)row * 2048 + 1024 + c0); xw[j] = *(const u32x2*)(XC + (size_t)row * 1024 + c0);
                if (pass == 2 && dir == 1) { hw[j] = *(const u32x2*)(HF + (size_t)row * 1024 + c0); gw[j] = *(const u32x2*)(GATE + (size_t)row * 1024 + c0); } }
#pragma unroll
            for (int j = 0; j < 4; ++j) {
                const float rp[4] = {bflo(rw[j].x), bfhi(rw[j].x), bflo(rw[j].y), bfhi(rw[j].y)}, ip[4] = {bflo(iw[j].x), bfhi(iw[j].x), bflo(iw[j].y), bfhi(iw[j].y)}, xv[4] = {bflo(xw[j].x), bfhi(xw[j].x), bflo(xw[j].y), bfhi(xw[j].y)};
#pragma unroll
                for (int k = 0; k < 4; ++k) { const float la = sp[k] * sigmoid_f(rp[k] + ba[k]); const float av = __expf(la); const float m = sqrtf(fmaxf(-expm1f(2.f * la), 0.f));
                    h[k] = av * h[k] + m * sigmoid_f(ip[k] + bx[k]) * xv[k]; if (pass == 1) P[k] *= av; }
                if (pass == 2) { bf16_t* hp = HF + (size_t)rows[j] * 1024 + c0; u32x2 o;
                    if (dir == 0) { o.x = cvt_pk_bf16(h[0], h[1]); o.y = cvt_pk_bf16(h[2], h[3]); }
                    else { o.x = cvt_pk_bf16(gelu_tanh_f(bflo(gw[j].x)) * (bflo(hw[j].x) + h[0]), gelu_tanh_f(bfhi(gw[j].x)) * (bfhi(hw[j].x) + h[1]));
                           o.y = cvt_pk_bf16(gelu_tanh_f(bflo(gw[j].y)) * (bflo(hw[j].y) + h[2]), gelu_tanh_f(bfhi(gw[j].y)) * (bfhi(hw[j].y) + h[3])); }
                    *(u32x2*)hp = o; }
            }
        }
        if (pass == 1) { float* cp = CARRY + ((size_t)(b * 64 + chunk) * 256 + cq) * 8; *(f32x4*)cp = (f32x4){P[0], P[1], P[2], P[3]}; *(f32x4*)(cp + 4) = (f32x4){h[0], h[1], h[2], h[3]}; }
    }
}
constexpr int NPHASE = 52;
enum { OP_PROLOGUE, OP_U0, OP_GEMM_SWIGLU, OP_GEMM_PLAIN, OP_GEMM_RETIN, OP_GEMM_GATES, OP_POSTNORM, OP_RETSCAN, OP_RETFIN, OP_NAATT, OP_LRUCONV, OP_LRUSCAN };

typedef const Args __attribute__((address_space(4)))* KArgsPtr;
__global__ void __launch_bounds__(512) hybrid_fwd(Args a_in) {
    extern __shared__ __attribute__((aligned(16))) unsigned char lds_raw[];
    LAS unsigned char* lds = (LAS unsigned char*)lds_raw;
    const int ph_lo = a_in.ph_lo, ph_hi = a_in.ph_hi;
    volatile LAS unsigned* xb_st = (volatile LAS unsigned*)(lds + LDS_BYTES - 16);
    unsigned* xb_bar = (unsigned*)(a_in.ws + WS_BAR);
    if (threadIdx.x < 4) xb_st[threadIdx.x] = 0u;
    __syncthreads();
    if (threadIdx.x == 0) { const unsigned x = xb_xcc_id(); const unsigned r = xb_add(&xb_bar[XB_XCNT(x)], 1u); xb_st[2] = r | (x << 8); }
    int nexec = 0;
#ifdef PROBE_DBL
    for (int pp = 2 * ph_lo; pp < 2 * ph_hi; ++pp) { const int p = pp >> 1;
#else
    for (int p = ph_lo; p < ph_hi; ++p) {
#endif
#if defined(__HIP_DEVICE_COMPILE__)
        KArgsPtr ka = (KArgsPtr)__builtin_amdgcn_kernarg_segment_ptr(); asm volatile("" : "+s"(ka));
        Args a; __builtin_memcpy(&a, ka, sizeof(Args));
#else
        const Args a = a_in;
#endif
        bf16_t* WT = (bf16_t*)(a.ws + WS_WT); bf16_t* U = (bf16_t*)(a.ws + WS_U); unsigned char* BIG = a.ws + WS_BIG; const float* MOD = (const float*)(a.ws + WS_MOD);
        int op = OP_PROLOGUE, l = 0, s = 0, kind = 0, mi = 0, rb = 0, gsel = 0, sdir = 0, spass = 0; bool mixpn = false;
        if (p == 0) op = OP_PROLOGUE;
        else if (p == 1) op = OP_U0;
        else {
            const int q = p - 2; int li;
            if (q < 12) { l = 0; li = q; } else if (q < 22) { l = 1; li = q - 12; } else if (q < 38) { l = 2; li = q - 22; } else { l = 3; li = q - 38; }
            kind = l % 3; mi = l / 3; const int nmix = kind == 0 ? 6 : (kind == 1 ? 4 : 10);
            rb = (l == 3 && li >= 5) ? MCTX : 0;
            if (li < 3 || li >= 3 + nmix) {
                s = li < 3 ? 0 : 1; const int fs = li < 3 ? li : li - 3 - nmix;
                if (fs == 0) op = OP_GEMM_SWIGLU; else if (fs == 1) { op = OP_GEMM_PLAIN; gsel = 0; } else op = OP_POSTNORM;
            } else {
                const int ms = li - 3;
                if (ms == nmix - 1) { op = OP_POSTNORM; mixpn = true; }
                else if (kind == 0) { if (ms == 0) op = OP_GEMM_RETIN; else if (ms == 1) op = OP_RETSCAN; else if (ms == 2) { op = OP_GEMM_PLAIN; gsel = 1; } else if (ms == 3) op = OP_RETFIN; else { op = OP_GEMM_PLAIN; gsel = 2; } }
                else if (kind == 1) { if (ms == 0) { op = OP_GEMM_PLAIN; gsel = 3; } else if (ms == 1) op = OP_NAATT; else { op = OP_GEMM_PLAIN; gsel = 4; } }
                else { if (ms == 0) { op = OP_GEMM_PLAIN; gsel = 5; } else if (ms == 1) op = OP_LRUCONV; else if (ms == 2 || ms == 5) { op = OP_GEMM_GATES; sdir = ms == 5 ? 1 : 0; }
                       else if (ms == 3 || ms == 4) { op = OP_LRUSCAN; sdir = 0; spass = ms - 2; } else if (ms == 6 || ms == 7) { op = OP_LRUSCAN; sdir = 1; spass = ms - 5; } else { op = OP_GEMM_PLAIN; gsel = 6; } }
            }
        }
#ifdef PROBE_DBL
#if PROBE_DBL == 10
        if ((pp & 1) && p != 0) continue;
#else
        if (pp & 1) { const bool pdbl = (PROBE_DBL == 1) ? (op == OP_GEMM_SWIGLU || op == OP_GEMM_PLAIN || op == OP_GEMM_RETIN || op == OP_GEMM_GATES)
                        : (PROBE_DBL == 3) ? (op == OP_RETSCAN) : (PROBE_DBL == 10) ? (op == OP_PROLOGUE) : (PROBE_DBL == 8) ? (op == OP_GEMM_SWIGLU) : (PROBE_DBL == 5) ? (op == OP_NAATT) : (PROBE_DBL == 6) ? (op == OP_LRUCONV || (op == OP_LRUSCAN && !(sdir == 1 && spass == 2))) : (PROBE_DBL == 2) ? (op == OP_POSTNORM && l == 0 && s == 0 && !mixpn) : false;
            if (!pdbl) continue; }
#endif
#endif
        { const unsigned xm = (unsigned)__builtin_amdgcn_readfirstlane((int)xb_st[3]);
          const bool relayout = op == OP_GEMM_SWIGLU || op == OP_GEMM_RETIN || (op == OP_GEMM_PLAIN && (gsel == 1 || gsel == 3 || gsel == 5));
          if (nexec == 1) cg::this_grid().sync();
          else if (nexec > 1) { if (xm && !relayout) xcd_local_barrier((unsigned*)(a.ws + WS_BAR), ((unsigned)__builtin_amdgcn_readfirstlane((int)xb_st[2]) >> 8) & 0xffu, 32u);
                                else xcd_barrier((unsigned*)(a.ws + WS_BAR), xb_st); } }
        if (nexec == 1 && ph_lo == 0) {
            if (threadIdx.x == 0) { bool ok = gridDim.x == 256;
                for (unsigned j = 0; j < 16; ++j) { const unsigned cnt = xb_ld(&xb_bar[XB_XCNT(j)]); ok = ok && (j < 8 ? cnt == 32u : cnt == 0u); }
#ifdef PROBE_NO_XMODE
                ok = false;
#endif
                xb_st[3] = ok ? 1u : 0u; }
            __syncthreads(); }
        ++nexec;
        const unsigned gword = (unsigned)__builtin_amdgcn_readfirstlane((int)xb_st[2]), xmode = (unsigned)__builtin_amdgcn_readfirstlane((int)xb_st[3]);
        Grp grp; if (xmode) { grp.b_lo = (int)((gword >> 8) & 0xffu); grp.nb = 1; grp.rank = (int)(gword & 0xffu); grp.gsize = 32; } else { grp.b_lo = 0; grp.nb = 8; grp.rank = (int)blockIdx.x; grp.gsize = (int)gridDim.x; }
        switch (op) {
#ifndef NO_OP_PROLOGUE
            case OP_PROLOGUE: phase_prologue(a, lds); break;
#endif
#ifndef NO_OP_U0
            case OP_U0: phase_u0(a, grp); break;
#endif
#ifndef NO_OP_GEMM_SWIGLU
            case OP_GEMM_SWIGLU: { const pg8::Gemm gg{U, WT + E_FFN_IN + (size_t)(l * 2 + s) * 5632 * 1024, MTOT, 5632, 1024, 1024, 0, 0};
                pg8::GroupOrder S; S.init(grp.nb, grp.b_lo, rb != 0, gg.N, grp.gsize, grp.rank); EpiSwiGLU E{(bf16_t*)BIG, 0}; pg8::gemm_phase<EpiSwiGLU, pg8::GroupOrder>(lds, gg, S, E); } break;
#endif
#ifndef NO_OP_GEMM_PLAIN
            case OP_GEMM_PLAIN: { const bf16_t* gA; const bf16_t* gB; int gN, gK, glda; bf16_t* eO; int eldc = 1024, esplit = 0, ehm = 0; size_t estride = 0; float escale = 1.f;
                if (gsel == 0)      { gA = (const bf16_t*)BIG; gB = WT + E_FFN_OUT + (size_t)(l * 2 + s) * 1024 * 2816; gN = 1024; gK = 2816; glda = 2816; eO = (bf16_t*)(BIG + 3 * R1); }
                else if (gsel == 1) { gA = U; gB = WT + E_RET_IN + (size_t)mi * 6144 * 1024 + (size_t)4096 * 1024; gN = 2048; gK = 1024; glda = 1024; eO = (bf16_t*)BIG; eldc = 2048; }
                else if (gsel == 2) { gA = (const bf16_t*)(BIG + 4 * R1); gB = WT + E_RET_OUT + (size_t)mi * 1024 * 2048; gN = 1024; gK = 2048; glda = 2048; eO = (bf16_t*)(BIG + 2 * R1); }
                else if (gsel == 3) { gA = U; gB = WT + E_NA_QKV; gN = 3072; gK = 1024; glda = 1024; eO = (bf16_t*)BIG; esplit = 1024; estride = R1 / 2; escale = 0.125f; ehm = 1; }
                else if (gsel == 4) { gA = (const bf16_t*)BIG; gB = WT + E_NA_OUT; gN = 1024; gK = 1024; glda = 1024; eO = (bf16_t*)(BIG + 3 * R1); }
                else if (gsel == 5) { gA = U; gB = WT + E_LRU_IN; gN = 2048; gK = 1024; glda = 1024; eO = (bf16_t*)BIG; esplit = 1024; estride = R1 / 2; }
                else                { gA = (const bf16_t*)(BIG + R1); gB = WT + E_LRU_OUT; gN = 1024; gK = 1024; glda = 1024; eO = (bf16_t*)(BIG + 2 * R1); }
                const pg8::Gemm gg{gA, gB, MTOT, gN, gK, glda, 0, 0}; pg8::GroupOrder S; S.init(grp.nb, grp.b_lo, rb != 0, gg.N, grp.gsize, grp.rank);
                EpiPlain E{eO, eldc, 0, esplit, estride, escale, ehm}; pg8::gemm_phase<EpiPlain, pg8::GroupOrder>(lds, gg, S, E); } break;
#endif
#ifndef NO_OP_GEMM_RETIN
            case OP_GEMM_RETIN: { const pg8::Gemm gg{U, WT + E_RET_IN + (size_t)mi * 6144 * 1024, MTOT, 4096, 1024, 1024, 0, 0}; pg8::GroupOrder S; S.init(grp.nb, grp.b_lo, false, gg.N, grp.gsize, grp.rank);
                EpiRetIn E{(bf16_t*)BIG, (bf16_t*)(BIG + R1), (bf16_t*)(BIG + 2 * R1), (const float*)(a.ws + WS_ROPE), (const float*)(a.ws + WS_ROPE) + 4096}; pg8::gemm_phase<EpiRetIn, pg8::GroupOrder>(lds, gg, S, E); } break;
#endif
#ifndef NO_OP_GEMM_GATES
            case OP_GEMM_GATES: { const pg8::Gemm gg{(const bf16_t*)(BIG + 2 * R1), WT + E_GATES + (size_t)sdir * 2048 * 256, MTOT, 2048, 256, 1024, 1, 256}; pg8::GroupOrder S; S.init(grp.nb, grp.b_lo, false, gg.N, grp.gsize, grp.rank);
                EpiGates E{(bf16_t*)(BIG + 3 * R1)}; pg8::gemm_phase<EpiGates, pg8::GroupOrder>(lds, gg, S, E); } break;
#endif
#ifndef NO_OP_POSTNORM
            case OP_POSTNORM: { const float* modl = MOD + (size_t)l * 9 * 9216;
                if (mixpn) phase_postnorm(a, false, (const bf16_t*)(BIG + (kind == 1 ? 3 : 2) * R1), modl, 5, 1.f, a.ln_g + (size_t)(l * 3 + 1) * 1024, a.ln_b + (size_t)(l * 3 + 1) * 1024, modl, 6, rb, grp);
                else { const int li3 = l * 3 + (s == 0 ? 0 : 2); const float* modn = (s == 0) ? modl : MOD + (size_t)(l < 3 ? l + 1 : l) * 9 * 9216; const int psh = (s == 0) ? 3 : (l < 3 ? 0 : -1);
                    phase_postnorm(a, l == 0 && s == 0, (const bf16_t*)(BIG + 3 * R1), modl, s == 0 ? 2 : 8, 0.5f, a.ln_g + (size_t)li3 * 1024, a.ln_b + (size_t)li3 * 1024, modn, psh, rb, grp); } } break;
#endif
#ifndef NO_OP_RETSCAN
#if defined(PROBE_DBL) && PROBE_DBL == 3
#ifndef PROBE_RET_ABL
#define PROBE_RET_ABL 0
#endif
            case OP_RETSCAN: if (pp & 1) phase_retention<0>(a, lds, grp); else phase_retention<PROBE_RET_ABL>(a, lds, grp); break;
#else
            case OP_RETSCAN: phase_retention<0>(a, lds, grp); break;
#endif
#endif
#ifndef NO_OP_RETFIN
            case OP_RETFIN: phase_ret_finish(a, rb, grp); break;
#endif
#ifndef NO_OP_NAATT
#if defined(PROBE_DBL) && PROBE_DBL == 5
#ifndef PROBE_NA_ABL
#define PROBE_NA_ABL 0
#endif
            case OP_NAATT: if (pp & 1) phase_na<0>(a, lds, (bf16_t*)BIG, grp); else phase_na<PROBE_NA_ABL>(a, lds, (bf16_t*)(BIG + 3 * R1), grp); break;
#else
            case OP_NAATT: phase_na<0>(a, lds, (bf16_t*)BIG, grp); break;
#endif
#endif
#ifndef NO_OP_LRUCONV
            case OP_LRUCONV: phase_lru_conv(a, grp); break;
#endif
#ifndef NO_OP_LRUSCAN
            case OP_LRUSCAN: phase_lru_scan(a, sdir, spass, grp); break;
#endif
            default: break;
        }
    }
}

#ifndef MK_PER_PHASE
#define MK_PER_PHASE 0
#endif
extern "C" void kernel_launch(void* const* d_in, const int* in_sizes, int n_in, void* d_out, int out_size, void* d_ws, size_t ws_size, hipStream_t stream) {
    static int grid = 0;
    if (grid == 0) {
        if (n_in != 24 || out_size != MLAT * 1024 || ws_size < WS_END) { fprintf(stderr, "kernel_launch: unexpected shapes: n_in %d out %d ws %zu (need %zu)\n", n_in, out_size, ws_size, (size_t)WS_END); grid = -1; return; }
        int dev = 0, cus = 0, per_cu = 0;
        if (hipGetDevice(&dev) != hipSuccess || hipDeviceGetAttribute(&cus, hipDeviceAttributeMultiprocessorCount, dev) != hipSuccess) { grid = -1; return; }
        if (hipFuncSetAttribute((const void*)hybrid_fwd, hipFuncAttributeMaxDynamicSharedMemorySize, LDS_BYTES) != hipSuccess) { fprintf(stderr, "kernel_launch: hipFuncSetAttribute failed\n"); grid = -1; return; }
        if (hipOccupancyMaxActiveBlocksPerMultiprocessor(&per_cu, (const void*)hybrid_fwd, 512, LDS_BYTES) != hipSuccess || per_cu < 1) { fprintf(stderr, "kernel_launch: occupancy query says %d\n", per_cu); per_cu = 1; }
        (void)hipGetLastError();
        grid = cus * 1;
    }
    if (grid < 0) return;
    if (hipMemsetAsync((char*)d_ws + WS_BAR, 0, 16384, stream) != hipSuccess) { fprintf(stderr, "kernel_launch: barrier memset failed\n"); return; }
    Args a{};
    const float** pp = (const float**)&a;
    for (int i = 0; i < 24; ++i) pp[i] = (const float*)d_in[i];
    a.out = (float*)d_out; a.ws = (unsigned char*)d_ws;
#if MK_PER_PHASE
    for (int p = 0; p < NPHASE; ++p) { a.ph_lo = p; a.ph_hi = p + 1; hipLaunchKernelGGL(hybrid_fwd, dim3(grid), dim3(512), LDS_BYTES, stream, a); }
#else
    a.ph_lo = 0; a.ph_hi = NPHASE;
    void* args[] = {&a};
    hipError_t e = hipLaunchCooperativeKernel((const void*)hybrid_fwd, dim3(grid), dim3(512), args, LDS_BYTES, stream);
    if (e != hipSuccess) fprintf(stderr, "cooperative launch failed: %s (grid %d)\n", hipGetErrorString(e), grid);
#endif
}
```

```cpp
#include <hip/hip_runtime.h>
#include <hip/hip_cooperative_groups.h>
#include <cstdio>
namespace cg = cooperative_groups;

#define LAS __attribute__((address_space(3)))
typedef unsigned short bf16_t;
typedef short bf16x8 __attribute__((ext_vector_type(8)));
typedef float f32x4 __attribute__((ext_vector_type(4)));
typedef unsigned u32x4 __attribute__((ext_vector_type(4)));
typedef unsigned u32x2 __attribute__((ext_vector_type(2)));

constexpr int DM = 1024, NB = 8, SEQ = 4096, CTXL = 256, DFF = 2816;
constexpr int MCTX = NB * CTXL, MLAT = NB * SEQ, MTOT = MCTX + MLAT;
constexpr int NMOD = 9;
constexpr float DN_ALPHA = 1.681792830507429f;
constexpr float LN_EPS = 1e-5f;
constexpr float LOG2E = 1.4426950408889634f;
constexpr int LDS_BYTES = 147456;

constexpr size_t E_FFN_IN = 0;
constexpr size_t E_FFN_OUT = E_FFN_IN + (size_t)8 * 5632 * 1024;
constexpr size_t E_RET_IN = E_FFN_OUT + (size_t)8 * 1024 * 2816;
constexpr size_t E_RET_OUT = E_RET_IN + (size_t)2 * 6144 * 1024;
constexpr size_t E_NA_QKV = E_RET_OUT + (size_t)2 * 1024 * 2048;
constexpr size_t E_NA_OUT = E_NA_QKV + (size_t)3072 * 1024;
constexpr size_t E_LRU_IN = E_NA_OUT + (size_t)1024 * 1024;
constexpr size_t E_LRU_OUT = E_LRU_IN + (size_t)2048 * 1024;
constexpr size_t E_GATES = E_LRU_OUT + (size_t)1024 * 1024;
constexpr size_t E_WT_END = E_GATES + (size_t)2 * 2048 * 256;
constexpr size_t R1 = (size_t)MTOT * 1024 * 2;
constexpr size_t WS_WT = 0;
constexpr size_t WS_U = WS_WT + E_WT_END * 2;
constexpr size_t WS_HC = WS_U + R1;
constexpr size_t WS_MOD = WS_HC + (size_t)MCTX * 1024 * 4;
constexpr size_t WS_ROPE = WS_MOD + (size_t)4 * 9 * 9216 * 4;
constexpr size_t WS_CARRY = WS_ROPE + (size_t)2 * 4096 * 4;
constexpr size_t WS_BAR = WS_CARRY + (size_t)NB * 68 * 1024 * 2 * 4;
constexpr size_t WS_BIG = WS_BAR + 16384;
constexpr size_t WS_END = WS_BIG + 6 * R1;

struct Args {
    const float* x; const float* c; const float* ctx; const float* c_ctx; const float* ada_w; const float* ada_b; const float* ln_g; const float* ln_b;
    const float* ffn_w_in; const float* ffn_w_out; const float* ret_w_in; const float* ret_w_out; const float* na_w_qkv; const float* na_rpb; const float* na_w_out;
    const float* lru_w_in; const float* lru_conv_w; const float* lru_conv_b; const float* lru_w_a; const float* lru_b_a; const float* lru_w_x; const float* lru_b_x;
    const float* lru_lam; const float* lru_w_out;
    float* out; unsigned char* ws; int ph_lo, ph_hi;
};

struct Grp { int b_lo, nb, rank, gsize; };
__device__ __forceinline__ int grp_row(const Grp& g, int lr) { const int b = g.b_lo + lr / 4352, t = lr % 4352; return t < 256 ? b * 256 + t : MCTX + b * 4096 + (t - 256); }
__device__ __forceinline__ int grp_row_lat(const Grp& g, int lr) { return MCTX + (g.b_lo + (lr >> 12)) * 4096 + (lr & 4095); }
__device__ __forceinline__ int otid() { int t = threadIdx.x; asm volatile("" : "+v"(t)); return t; }
__device__ __forceinline__ float shx(float v, int lane, int m) { return __int_as_float(__builtin_amdgcn_ds_bpermute((lane ^ m) << 2, __float_as_int(v))); }
__device__ __forceinline__ unsigned cvt_pk_bf16(float lo, float hi) { unsigned r; asm volatile("v_cvt_pk_bf16_f32 %0, %1, %2" : "=v"(r) : "v"(lo), "v"(hi)); return r; }
__device__ __forceinline__ float bflo(unsigned w) { return __uint_as_float(w << 16); }
__device__ __forceinline__ float bfhi(unsigned w) { return __uint_as_float(w & 0xffff0000u); }
__device__ __forceinline__ float bf2f(bf16_t b) { return __uint_as_float(((unsigned)b) << 16); }
__device__ __forceinline__ bf16_t f2bf(float f) { return (bf16_t)(cvt_pk_bf16(f, 0.f) & 0xffffu); }
__device__ __forceinline__ float silu_f(float x) { return x * __builtin_amdgcn_rcpf(1.f + __expf(-x)); }
__device__ __forceinline__ float sigmoid_f(float x) { return __builtin_amdgcn_rcpf(1.f + __expf(-x)); }
__device__ __forceinline__ float gelu_tanh_f(float x) { const float z = 0.7978845608028654f * (x + 0.044715f * x * x * x); const float t = 1.f - 2.f * __builtin_amdgcn_rcpf(__expf(2.f * z) + 1.f); return 0.5f * x * (1.f + t); }

namespace pg8 {
constexpr int BM = 256, BK = 64, HALF = 128, HTB = HALF * BK * 2  , STAGE_BYTES = 8 * HTB, NXCD = 8, WGM = 8;
__host__ __device__ __forceinline__ int lds_byte(int r, int c) { const int st = (r >> 4) * 2 + (c >> 5), rr = r & 15, cc = c & 31, ob = rr * 64 + cc * 2; return st * 1024 + (ob ^ (((ob >> 9) & 1) << 5)); }
__host__ __device__ __forceinline__ void stage_rc(int b, int& R, int& C) { const int st = b / 1024, sb = b % 1024, swz = sb ^ (((sb >> 9) & 1) << 5); R = (st >> 1) * 16 + swz / 64; C = (st & 1) * 32 + (swz % 64) / 2; }
__host__ __device__ __forceinline__ int perm32(int rho) { const int n = rho >> 4, i = rho & 15; return 8 * (i >> 2) + 4 * n + (i & 3); }

struct Unit { int pm, pn; };
struct Gemm { const bf16_t* A; const bf16_t* Bt; int M, N, K, lda, a_sh, a_cols; };

struct StaticOrder {
    int nM, nN, nwg, G, c;
    __host__ __device__ void init(int M, int N, int G_, int c_) { nM = M / BM; nN = N / BM; nwg = nM * nN; G = G_; c = c_; }
    __host__ __device__ bool next(int i, Unit& u) const {
        const long L = (long)i * G + c; if (L >= nwg) return false;
        int wgid = (int)L; { const int q = nwg / NXCD, r = nwg % NXCD, xcd = wgid % NXCD, off = wgid / NXCD; wgid = (xcd < r ? xcd * (q + 1) : r * (q + 1) + (xcd - r) * q) + off; }
        const int nig = WGM * nN, gid = wgid / nig, fm = gid * WGM, gsz = (nM - fm) < WGM ? (nM - fm) : WGM;
        u.pm = fm + ((wgid % nig) % gsz); u.pn = (wgid % nig) / gsz; return true;
    }
    __device__ __forceinline__ void a_ready(const Unit&) const {}
    __device__ __forceinline__ void done(const Unit&) const {}
};

struct GroupOrder {
    int nP, nN, nwg, G, c, b_lo, per, W;
    __device__ void init(int nb, int b_lo_, bool skipctx, int N, int G_, int c_) { per = skipctx ? 16 : 17; nP = nb * per; nN = N / BM; nwg = nP * nN; G = G_; c = c_; b_lo = b_lo_;
        const int ng = (nP + WGM - 1) / WGM; W = (nP + ng - 1) / ng; }
    __device__ bool next(int i, Unit& u) const {
        const long L = (long)i * G + c; if (L >= nwg) return false;
        const int wgid = (int)L, nig = W * nN, gid = wgid / nig, fm = gid * W, gsz = (nP - fm) < W ? (nP - fm) : W;
        const int lp = fm + ((wgid % nig) % gsz); u.pn = (wgid % nig) / gsz;
        const int b = b_lo + lp / per, j = lp % per;
        u.pm = (per == 16) ? 8 + 16 * b + j : (j == 0 ? b : 8 + 16 * b + j - 1);
        return true;
    }
    __device__ __forceinline__ void a_ready(const Unit&) const {}
    __device__ __forceinline__ void done(const Unit&) const {}
};

template <class Epi, class Sched>
__device__ __forceinline__ void gemm_phase(LAS unsigned char* lds, const Gemm g, const Sched& S, const Epi& E) {
    const int tid = otid(), wid = __builtin_amdgcn_readfirstlane(tid >> 6), lane = tid & 63, wr = wid >> 2, wc = wid & 3, fr = lane & 15, fq = lane >> 4;
    const int K = g.K, nt = K / BK, lda = g.lda;
    unsigned voffA[2], voffB[2];
#pragma unroll
    for (int i = 0; i < 2; ++i) { int R, C; stage_rc(tid * 16 + i * 8192, R, C); const int Rb = Epi::PERM ? ((R & ~31) + perm32(R & 31)) : R;
        voffA[i] = (unsigned)(R * lda + C) * 2u; voffB[i] = (unsigned)(Rb * K + C) * 2u; }
    const size_t kstep = (size_t)(BK * 2);
    const size_t hstepA = (size_t)HALF * lda * 2, hstepB = (size_t)HALF * K * 2;
    const size_t tstepA = 2 * hstepA, tstepB = 2 * hstepB;
    const unsigned ldsw = (unsigned)wid * 1024u;
    const int aoff = lds_byte(wr * 64 + fr, fq * 8), boff = lds_byte(wc * 32 + fr, fq * 8);
#define PG8_SA(b, h) (((b) * 2 + (h)) * HTB)
#define PG8_SB(b, h) ((4 + (b) * 2 + (h)) * HTB)
#define PG8_STAGE(bufoff, gbase, voff) do { _Pragma("unroll") for (int _i = 0; _i < 2; ++_i) \
        __builtin_amdgcn_global_load_lds((const unsigned*)((const char*)(gbase) + (voff)[_i]), (LAS unsigned*)(lds + (bufoff) + ldsw + _i * 8192), 16, 0, 0); } while (0)
#define PG8_LDA(dst, b, h) do { _Pragma("unroll") for (int m = 0; m < 4; ++m) _Pragma("unroll") for (int k = 0; k < 2; ++k) dst[m][k] = *(const LAS bf16x8*)(lds + PG8_SA(b, h) + aoff + m * 2048 + k * 1024); } while (0)
#define PG8_LDB(dst, b, h) do { _Pragma("unroll") for (int n = 0; n < 2; ++n) _Pragma("unroll") for (int k = 0; k < 2; ++k) dst[n][k] = *(const LAS bf16x8*)(lds + PG8_SB(b, h) + boff + n * 2048 + k * 1024); } while (0)
#define PG8_MMA(ai, bj, At, Bt) do { __builtin_amdgcn_s_setprio(1); _Pragma("unroll") for (int m = 0; m < 4; ++m) _Pragma("unroll") for (int n = 0; n < 2; ++n) _Pragma("unroll") for (int k = 0; k < 2; ++k) \
        acc[ai][bj][m][n] = __builtin_amdgcn_mfma_f32_16x16x32_bf16(Bt[n][k], At[m][k], acc[ai][bj][m][n], 0, 0, 0); __builtin_amdgcn_s_setprio(0); } while (0)
#define PG8_WAIT_V(n) asm volatile("s_waitcnt vmcnt(" #n ")" ::: "memory")
#define PG8_WAIT_L(n) asm volatile("s_waitcnt lgkmcnt(" #n ")" ::: "memory")
#define PG8_BAR __builtin_amdgcn_s_barrier()
#define PG8_SCHED __builtin_amdgcn_sched_barrier(0)
#define PG8_AOFF(u) ((size_t)(u).pm * tstepA + (size_t)(((u).pn >> g.a_sh) * g.a_cols) * 2)
    Unit cur, nxt; int ui = 0;
    if (!S.next(0, cur)) return;
    f32x4 acc[2][2][4][2];
#pragma unroll
    for (int a = 0; a < 2; ++a)
#pragma unroll
        for (int b = 0; b < 2; ++b)
#pragma unroll
            for (int m = 0; m < 4; ++m)
#pragma unroll
                for (int n = 0; n < 2; ++n) acc[a][b][m][n] = (f32x4){0.f, 0.f, 0.f, 0.f};
    bf16x8 At[4][2], B0[2][2], B1[2][2];
    const char* cA = (const char*)g.A + PG8_AOFF(cur); const char* cB = (const char*)g.Bt + (size_t)cur.pn * tstepB;
    S.a_ready(cur);
    PG8_STAGE(PG8_SB(0, 0), cB, voffB); PG8_STAGE(PG8_SA(0, 0), cA, voffA); PG8_STAGE(PG8_SB(0, 1), cB + hstepB, voffB); PG8_STAGE(PG8_SA(0, 1), cA + hstepA, voffA);
    if (wr == 1) PG8_BAR;
    PG8_WAIT_V(4); PG8_BAR;
    PG8_STAGE(PG8_SB(1, 0), cB + kstep, voffB); PG8_STAGE(PG8_SA(1, 0), cA + kstep, voffA); PG8_STAGE(PG8_SB(1, 1), cB + hstepB + kstep, voffB);
    PG8_WAIT_V(6); PG8_BAR;
    for (;;) {
        const bool has_next = S.next(ui + 1, nxt);
        const char* nA = has_next ? (const char*)g.A + PG8_AOFF(nxt) : cA; const char* nB = has_next ? (const char*)g.Bt + (size_t)nxt.pn * tstepB : cB;
        for (int t = 0; t < nt; t += 2) {
            const bool last = (t == nt - 2);
            const char* a1 = cA + (size_t)(t + 1) * kstep;
            const char* a2 = last ? nA : cA + (size_t)(t + 2) * kstep; const char* b2 = last ? nB : cB + (size_t)(t + 2) * kstep;
            const char* a3 = a2 + kstep; const char* b3 = b2 + kstep;
            if (last && has_next) S.a_ready(nxt);
            PG8_LDB(B0, 0, 0); PG8_SCHED; PG8_LDA(At, 0, 0); PG8_STAGE(PG8_SA(1, 1), a1 + hstepA, voffA);
            PG8_WAIT_L(8); PG8_BAR; PG8_WAIT_L(0); PG8_MMA(0, 0, At, B0); PG8_BAR; PG8_SCHED;
            PG8_LDB(B1, 0, 1); PG8_STAGE(PG8_SB(0, 0), b2, voffB);
            PG8_BAR; PG8_WAIT_L(0); PG8_MMA(0, 1, At, B1); PG8_BAR;
            PG8_LDA(At, 0, 1); PG8_STAGE(PG8_SA(0, 0), a2, voffA);
            PG8_BAR; PG8_WAIT_L(0); PG8_MMA(1, 0, At, B0); PG8_BAR; PG8_SCHED;
            PG8_STAGE(PG8_SB(0, 1), b2 + hstepB, voffB);
            PG8_WAIT_V(6); PG8_BAR; PG8_MMA(1, 1, At, B1); PG8_BAR;
            PG8_LDB(B0, 1, 0); PG8_SCHED; PG8_LDA(At, 1, 0); PG8_STAGE(PG8_SA(0, 1), a2 + hstepA, voffA);
            PG8_WAIT_L(8); PG8_BAR; PG8_WAIT_L(0); PG8_MMA(0, 0, At, B0); PG8_BAR; PG8_SCHED;
            PG8_LDB(B1, 1, 1); PG8_STAGE(PG8_SB(1, 0), b3, voffB);
            PG8_BAR; PG8_WAIT_L(0); PG8_MMA(0, 1, At, B1); PG8_BAR;
            PG8_LDA(At, 1, 1); PG8_STAGE(PG8_SA(1, 0), a3, voffA);
            PG8_BAR; PG8_WAIT_L(0); PG8_MMA(1, 0, At, B0); PG8_BAR; PG8_SCHED;
            PG8_STAGE(PG8_SB(1, 1), b3 + hstepB, voffB);
            PG8_WAIT_V(6); PG8_BAR; PG8_MMA(1, 1, At, B1); PG8_BAR;
        }
        E(acc, cur, wr, wc, fr, fq); S.done(cur);
        if (!has_next) break;
#pragma unroll
        for (int a = 0; a < 2; ++a)
#pragma unroll
            for (int b = 0; b < 2; ++b)
#pragma unroll
                for (int m = 0; m < 4; ++m)
#pragma unroll
                    for (int n = 0; n < 2; ++n) acc[a][b][m][n] = (f32x4){0.f, 0.f, 0.f, 0.f};
        cur = nxt; cA = nA; cB = nB; ++ui;
    }
    PG8_WAIT_V(0);
    if (wr == 0) PG8_BAR;
    PG8_BAR;
#undef PG8_SA
#undef PG8_SB
#undef PG8_STAGE
#undef PG8_LDA
#undef PG8_LDB
#undef PG8_MMA
#undef PG8_WAIT_V
#undef PG8_WAIT_L
#undef PG8_BAR
#undef PG8_SCHED
#undef PG8_AOFF
}
}

#define XB_TMO      128
#define XB_XCNT(j)  (256  + 64 * (j))
#define XB_XSUB(j)  (1280 + 64 * (j))
#define XB_XGEN(j)  (2304 + 64 * (j))
#define XB_TOP      3328
#define XB_TOPGEN   3392
#define XCD_BAR_WORDS 3456
#define XB_LSUB(j)  (3456 + 64 * (j))
#define XB_LGEN(j)  (3488 + 64 * (j))
#define XB_SPIN_CAP (1u << 21)
__device__ __forceinline__ unsigned xb_ld(unsigned* p)              { return __hip_atomic_load(p, __ATOMIC_RELAXED, __HIP_MEMORY_SCOPE_AGENT); }
__device__ __forceinline__ unsigned xb_add(unsigned* p, unsigned v) { return __hip_atomic_fetch_add(p, v, __ATOMIC_RELAXED, __HIP_MEMORY_SCOPE_AGENT); }
__device__ __forceinline__ unsigned xb_xcc_id() { return (unsigned)__builtin_amdgcn_s_getreg((3 << 11) | 20) & 0xFu; }
#define XB_SPIN(cond, bar) do { unsigned _sp = 0; while (cond) { __builtin_amdgcn_s_sleep(1); \
    if ((++_sp & 255u) == 0u) { if (xb_ld(&(bar)[XB_TMO])) break; if (_sp > XB_SPIN_CAP) { atomicAdd(&(bar)[XB_TMO], 1u); break; } } } } while (0)
__device__ __forceinline__ void xcd_barrier_complete(unsigned* bar, unsigned x, unsigned& nloc, unsigned& nx) {
    const unsigned G = gridDim.x * gridDim.y * gridDim.z;
    unsigned sum, cnt, mine, sp = 0u;
    for (;;) {
        sum = 0u; cnt = 0u; mine = 0u;
#pragma unroll
        for (unsigned j = 0; j < 16; ++j) { const unsigned c = xb_ld(&bar[XB_XCNT(j)]); sum += c; cnt += (c > 0u) ? 1u : 0u; mine = (j == x) ? c : mine; }
        if (sum == G) break;
        __builtin_amdgcn_s_sleep(1);
        if ((++sp & 255u) == 0u) { if (xb_ld(&bar[XB_TMO])) break; if (sp > XB_SPIN_CAP) { atomicAdd(&bar[XB_TMO], 1u); break; } }
    }
    nloc = mine > 0u ? mine : 1u; nx = cnt > 0u ? cnt : 1u;
}
__device__ __forceinline__ void xcd_barrier(unsigned* bar, volatile LAS unsigned* st) {
    asm volatile("s_waitcnt vmcnt(0)" ::: "memory");
    __syncthreads();
    if (threadIdx.x == 0) {
        const unsigned x = xb_xcc_id();
        __builtin_amdgcn_s_waitcnt(0);
        unsigned nloc = st[0], nx = st[1];
        if (nloc == 0u) { xcd_barrier_complete(bar, x, nloc, nx); st[0] = nloc; st[1] = nx; }
        const unsigned old = xb_add(&bar[XB_XSUB(x)], 1u);
        const unsigned gen = old / nloc;
        if (old + 1u == (gen + 1u) * nloc) {
            __builtin_amdgcn_fence(__ATOMIC_RELEASE, "agent");
            asm volatile("s_waitcnt vmcnt(0)" ::: "memory");
            const unsigned og = xb_add(&bar[XB_TOP], 1u);
            const unsigned tg = og / nx;
            if (og + 1u == (tg + 1u) * nx) xb_add(&bar[XB_TOPGEN], 1u);
            else XB_SPIN(xb_ld(&bar[XB_TOPGEN]) == tg, bar);
            __builtin_amdgcn_fence(__ATOMIC_ACQUIRE, "agent");
            xb_add(&bar[XB_XGEN(x)], 1u);
            asm volatile("s_waitcnt vmcnt(0)" ::: "memory");
        } else {
            XB_SPIN(xb_ld(&bar[XB_XGEN(x)]) == gen, bar);
            __builtin_amdgcn_fence(__ATOMIC_ACQUIRE, "agent");
            asm volatile("s_waitcnt vmcnt(0)" ::: "memory");
        }
    }
    __syncthreads();
}

__device__ __forceinline__ void xcd_local_barrier(unsigned* bar, unsigned x, unsigned nloc) {
    asm volatile("s_waitcnt vmcnt(0)" ::: "memory");
    __syncthreads();
    if (threadIdx.x == 0) {
        __builtin_amdgcn_s_waitcnt(0);
        const unsigned old = xb_add(&bar[XB_LSUB(x)], 1u), gen = old / nloc;
        if (old + 1u == (gen + 1u) * nloc) xb_add(&bar[XB_LGEN(x)], 1u);
        else XB_SPIN(xb_ld(&bar[XB_LGEN(x)]) == gen, bar);
        __builtin_amdgcn_fence(__ATOMIC_ACQUIRE, "agent");
        asm volatile("s_waitcnt vmcnt(0)" ::: "memory");
    }
    __syncthreads();
}
struct EpiSwiGLU {
    static constexpr bool PERM = true;
    bf16_t* H; int row_off;
    __device__ __forceinline__ void operator()(const f32x4 (&acc)[2][2][4][2], const pg8::Unit& u, int wr, int wc, int fr, int fq) const {
        const int row0 = row_off + u.pm * 256 + wr * 64 + fr, hc = u.pn * 128 + wc * 32 + 8 * fq;
#pragma unroll
        for (int ai = 0; ai < 2; ++ai)
#pragma unroll
            for (int m = 0; m < 4; ++m) {
                bf16_t* rowp = H + (size_t)(row0 + ai * 128 + m * 16) * DFF + hc;
                const f32x4 g0 = acc[ai][0][m][0], g1 = acc[ai][0][m][1], u0 = acc[ai][1][m][0], u1 = acc[ai][1][m][1];
                u32x4 w;
                w.x = cvt_pk_bf16(silu_f(g0[0]) * u0[0], silu_f(g0[1]) * u0[1]); w.y = cvt_pk_bf16(silu_f(g0[2]) * u0[2], silu_f(g0[3]) * u0[3]);
                w.z = cvt_pk_bf16(silu_f(g1[0]) * u1[0], silu_f(g1[1]) * u1[1]); w.w = cvt_pk_bf16(silu_f(g1[2]) * u1[2], silu_f(g1[3]) * u1[3]);
                *(u32x4*)rowp = w;
            }
    }
};
struct EpiPlain {
    static constexpr bool PERM = true;
    bf16_t* O; int ldc; int row_off; int split_cols; size_t split_stride; float scale0; int headmajor;
    __device__ __forceinline__ void operator()(const f32x4 (&acc)[2][2][4][2], const pg8::Unit& u, int wr, int wc, int fr, int fq) const {
        const int row0 = row_off + u.pm * 256 + wr * 64 + fr; int colt = u.pn * 256; bf16_t* base = O; float sc = scale0; int t = 0;
        if (split_cols) { t = colt / split_cols; base += (size_t)t * split_stride; colt -= t * split_cols; if (t) sc = 1.f; }
        const int col0 = colt + wc * 32 + 8 * fq; const bool hm = headmajor && t > 0;
        const size_t rstride = hm ? 64 : (size_t)ldc;
        const size_t cofs0 = hm ? (size_t)(col0 >> 6) * MTOT * 64 + (col0 & 63) : (size_t)col0, cofs1 = hm ? (size_t)((col0 + 128) >> 6) * MTOT * 64 + ((col0 + 128) & 63) : (size_t)col0 + 128;
#pragma unroll
        for (int ai = 0; ai < 2; ++ai)
#pragma unroll
            for (int m = 0; m < 4; ++m) { bf16_t* rowp = base + (size_t)(row0 + ai * 128 + m * 16) * rstride;
#pragma unroll
                for (int bj = 0; bj < 2; ++bj) { const f32x4 v0 = acc[ai][bj][m][0] * sc, v1 = acc[ai][bj][m][1] * sc;
                    u32x4 w; w.x = cvt_pk_bf16(v0[0], v0[1]); w.y = cvt_pk_bf16(v0[2], v0[3]); w.z = cvt_pk_bf16(v1[0], v1[1]); w.w = cvt_pk_bf16(v1[2], v1[3]);
                    *(u32x4*)(rowp + (bj ? cofs1 : cofs0)) = w; } }
    }
};
struct EpiRetIn {
    static constexpr bool PERM = true;
    bf16_t* Q; bf16_t* K; bf16_t* V; const float* rcos; const float* rsin;
    __device__ __forceinline__ void operator()(const f32x4 (&acc)[2][2][4][2], const pg8::Unit& u, int wr, int wc, int fr, int fq) const {
        const int row0 = u.pm * 256 + wr * 64 + fr, cin = wc * 32 + 8 * fq;
        if (u.pn >= 8) {
#pragma unroll
            for (int ai = 0; ai < 2; ++ai)
#pragma unroll
                for (int m = 0; m < 4; ++m) { bf16_t* rowp = V + (size_t)(row0 + ai * 128 + m * 16) * 2048 + (u.pn - 8) * 256 + cin;
#pragma unroll
                    for (int bj = 0; bj < 2; ++bj) { const f32x4 v0 = acc[ai][bj][m][0], v1 = acc[ai][bj][m][1];
                        u32x4 w; w.x = cvt_pk_bf16(v0[0], v0[1]); w.y = cvt_pk_bf16(v0[2], v0[3]); w.z = cvt_pk_bf16(v1[0], v1[1]); w.w = cvt_pk_bf16(v1[2], v1[3]);
                        *(u32x4*)(rowp + bj * 128) = w; } }
        } else {
            bf16_t* T = (u.pn < 4) ? Q : K; const float mul = (u.pn < 4) ? 1.f : 0.0625f; const int f0 = wc * 16 + 4 * fq;
#pragma unroll
            for (int ai = 0; ai < 2; ++ai)
#pragma unroll
                for (int m = 0; m < 4; ++m) { const int row = row0 + ai * 128 + m * 16; bf16_t* rowp = T + (size_t)row * 1024 + (u.pn & 3) * 256 + cin;
                    const bool lat = row >= MCTX; const int t = (row - MCTX) & 4095;
#pragma unroll
                    for (int bj = 0; bj < 2; ++bj) { f32x4 v0 = acc[ai][bj][m][0] * mul, v1 = acc[ai][bj][m][1] * mul;
                        if (lat) { const int pos = bj ? (t & 63) : (t >> 6); const f32x4 cs = *(const f32x4*)(rcos + pos * 64 + f0), sn = *(const f32x4*)(rsin + pos * 64 + f0);
                            const f32x4 a0 = v0, a1 = v1;
                            v0[0] = a0[0] * cs[0] - a0[1] * sn[0]; v0[1] = a0[0] * sn[0] + a0[1] * cs[0]; v0[2] = a0[2] * cs[1] - a0[3] * sn[1]; v0[3] = a0[2] * sn[1] + a0[3] * cs[1];
                            v1[0] = a1[0] * cs[2] - a1[1] * sn[2]; v1[1] = a1[0] * sn[2] + a1[1] * cs[2]; v1[2] = a1[2] * cs[3] - a1[3] * sn[3]; v1[3] = a1[2] * sn[3] + a1[3] * cs[3]; }
                        u32x4 w; w.x = cvt_pk_bf16(v0[0], v0[1]); w.y = cvt_pk_bf16(v0[2], v0[3]); w.z = cvt_pk_bf16(v1[0], v1[1]); w.w = cvt_pk_bf16(v1[2], v1[3]);
                        *(u32x4*)(rowp + bj * 128) = w; } }
        }
    }
};
struct EpiGates {
    static constexpr bool PERM = true;
    bf16_t* GP;
    __device__ __forceinline__ void operator()(const f32x4 (&acc)[2][2][4][2], const pg8::Unit& u, int wr, int wc, int fr, int fq) const {
        const int row0 = u.pm * 256 + wr * 64 + fr, col0 = (u.pn & 1) * 1024 + (u.pn >> 1) * 256 + wc * 32 + 8 * fq;
#pragma unroll
        for (int ai = 0; ai < 2; ++ai)
#pragma unroll
            for (int m = 0; m < 4; ++m) { bf16_t* rowp = GP + (size_t)(row0 + ai * 128 + m * 16) * 2048 + col0;
#pragma unroll
                for (int bj = 0; bj < 2; ++bj) { const f32x4 v0 = acc[ai][bj][m][0], v1 = acc[ai][bj][m][1];
                    u32x4 w; w.x = cvt_pk_bf16(v0[0], v0[1]); w.y = cvt_pk_bf16(v0[2], v0[3]); w.z = cvt_pk_bf16(v1[0], v1[1]); w.w = cvt_pk_bf16(v1[2], v1[3]);
                    *(u32x4*)(rowp + bj * 128) = w; } }
    }
};

struct CvtJob { const float* src; bf16_t* dst; int K, N, ld, perm; };
__device__ __forceinline__ CvtJob get_job(const Args& a, int j) {
    bf16_t* wt = (bf16_t*)(a.ws + WS_WT); CvtJob r;
    if (j < 8)       { r.src = a.ffn_w_in + (size_t)j * 1024 * 5632; r.dst = wt + E_FFN_IN + (size_t)j * 5632 * 1024; r.K = 1024; r.N = 5632; r.ld = 5632; r.perm = 1; }
    else if (j < 16) { const int i = j - 8; r.src = a.ffn_w_out + (size_t)i * 2816 * 1024; r.dst = wt + E_FFN_OUT + (size_t)i * 1024 * 2816; r.K = 2816; r.N = 1024; r.ld = 1024; r.perm = 0; }
    else if (j < 18) { const int i = j - 16; r.src = a.ret_w_in + (size_t)i * 1024 * 6144; r.dst = wt + E_RET_IN + (size_t)i * 6144 * 1024; r.K = 1024; r.N = 6144; r.ld = 6144; r.perm = 2; }
    else if (j < 20) { const int i = j - 18; r.src = a.ret_w_out + (size_t)i * 2048 * 1024; r.dst = wt + E_RET_OUT + (size_t)i * 1024 * 2048; r.K = 2048; r.N = 1024; r.ld = 1024; r.perm = 0; }
    else if (j == 20) { r.src = a.na_w_qkv; r.dst = wt + E_NA_QKV; r.K = 1024; r.N = 3072; r.ld = 3072; r.perm = 0; }
    else if (j == 21) { r.src = a.na_w_out; r.dst = wt + E_NA_OUT; r.K = 1024; r.N = 1024; r.ld = 1024; r.perm = 0; }
    else if (j == 22) { r.src = a.lru_w_in; r.dst = wt + E_LRU_IN; r.K = 1024; r.N = 2048; r.ld = 2048; r.perm = 0; }
    else if (j == 23) { r.src = a.lru_w_out; r.dst = wt + E_LRU_OUT; r.K = 1024; r.N = 1024; r.ld = 1024; r.perm = 0; }
    else { const int gI = j - 24, dir = gI >> 3, type = (gI >> 2) & 1, k = gI & 3;
        r.src = (type ? a.lru_w_x : a.lru_w_a) + (size_t)(dir * 4 + k) * 256 * 256; r.dst = wt + E_GATES + (size_t)dir * 2048 * 256 + (size_t)((k * 2 + type) * 256) * 256; r.K = 256; r.N = 256; r.ld = 256; r.perm = 0; }
    return r;
}
__device__ __forceinline__ int perm_col(int perm, int n) {
    if (perm == 1) return ((n & 255) >> 7) * 2816 + (n >> 8) * 128 + (n & 127);
    if (perm == 2) { if (n < 2048) { const int hb = n >> 8, dp = n & 255, p = dp >> 1, e = dp & 1; const int d = (p < 64) ? (p + 64 * e) : (128 + (p - 64) + 64 * e); return hb * 256 + d; } return n; }
    return n;
}
__device__ __forceinline__ void phase_prologue(const Args& a, LAS unsigned char* lds) {
    const int tid = otid(), G = gridDim.x;
    { LAS bf16_t* tile = (LAS bf16_t*)lds;
      int cum = 0;
      for (int j = 0; j < 40; ++j) {
          const CvtJob jb = get_job(a, j);
          const int tn = jb.N >> 6, ntile = tn * (jb.K >> 6);
          const int first = (int)((blockIdx.x + G - (cum % G)) % G);
          for (int t = first; t < ntile; t += G) {
              const int n0 = (t % tn) * 64, k0 = (t / tn) * 64, c = tid & 63, kr = tid >> 6;
              const float* sp = jb.src + (size_t)k0 * jb.ld + perm_col(jb.perm, n0 + c);
              float v[8];
#pragma unroll
              for (int i = 0; i < 8; ++i) v[i] = sp[(size_t)(kr + 8 * i) * jb.ld];
#pragma unroll
              for (int i = 0; i < 8; ++i) tile[c * 72 + kr + 8 * i] = f2bf(v[i]);
              __syncthreads();
              const int row = tid >> 3, ch = tid & 7;
              const u32x4 w = *(const LAS u32x4*)(tile + row * 72 + ch * 8);
              *(u32x4*)(jb.dst + (size_t)(n0 + row) * jb.K + k0 + ch * 8) = w;
              __syncthreads();
          }
          cum += ntile;
      } }
    { LAS float* sv = (LAS float*)lds; LAS float* red = sv + 9 * 1024; float* MOD = (float*)(a.ws + WS_MOD);
      for (int i = tid; i < 9 * 1024; i += 512) { const int r = i >> 10, k = i & 1023; const float cv = (r < 8) ? a.c[r * 1024 + k] : a.c_ctx[k]; sv[i] = cv / (1.f + expf(-cv)); }
      __syncthreads();
      for (int it = blockIdx.x; it < 288; it += G) {
          const int l = it / 72, cb = it % 72, cl = tid & 127, kq = tid >> 7;
          const float* W = a.ada_w + (size_t)l * 1024 * 9216 + cb * 128 + cl;
          float acc[9];
#pragma unroll
          for (int r = 0; r < 9; ++r) acc[r] = 0.f;
          for (int k = kq * 256; k < kq * 256 + 256; k += 4) {
              float w[4];
#pragma unroll
              for (int q = 0; q < 4; ++q) w[q] = W[(size_t)(k + q) * 9216];
#pragma unroll
              for (int q = 0; q < 4; ++q)
#pragma unroll
                  for (int r = 0; r < 9; ++r) acc[r] += sv[r * 1024 + k + q] * w[q];
          }
#pragma unroll
          for (int r = 0; r < 9; ++r) red[(kq * 9 + r) * 128 + cl] = acc[r];
          __syncthreads();
          for (int o = tid; o < 9 * 128; o += 512) { const int r = o >> 7, cc = o & 127, col = cb * 128 + cc;
              const float s = (red[(0 * 9 + r) * 128 + cc] + red[(1 * 9 + r) * 128 + cc]) + (red[(2 * 9 + r) * 128 + cc] + red[(3 * 9 + r) * 128 + cc]);
              MOD[(size_t)(l * 9 + r) * 9216 + col] = s + a.ada_b[l * 9216 + col]; }
          __syncthreads();
      } }
    { float* rc = (float*)(a.ws + WS_ROPE); float* rs = rc + 4096;
      for (int i = blockIdx.x * 512 + tid; i < 4096; i += G * 512) { const int pos = i >> 6, f = i & 63; const float fr = expf(-(float)(2 * f) * (1.f / 128.f) * 9.210340371976184f); const float ang = (float)pos * fr;
          rc[i] = cosf(ang); rs[i] = sinf(ang); } }
}

__device__ __forceinline__ void phase_u0(const Args& a, const Grp& gp) {
    const float* MOD = (const float*)(a.ws + WS_MOD); bf16_t* U = (bf16_t*)(a.ws + WS_U);
    for (int i = gp.rank * 512 + otid(); i < gp.nb * 4352 * 128; i += gp.gsize * 512) {
        const int row = grp_row(gp, i >> 7), c8 = (i & 127) * 8; const int r9 = row < MCTX ? 8 : (row - MCTX) >> 12;
        const float* hp = (row < MCTX ? a.ctx + (size_t)row * 1024 : a.x + (size_t)(row - MCTX) * 1024) + c8;
        const float* sh = MOD + (size_t)(r9 * 9 + 0) * 1024 + c8; const float* sc = sh + 1024;
        const f32x4 h0 = *(const f32x4*)hp, h1 = *(const f32x4*)(hp + 4), s0 = *(const f32x4*)sh, s1 = *(const f32x4*)(sh + 4), c0 = *(const f32x4*)sc, c1 = *(const f32x4*)(sc + 4);
        const f32x4 o0 = h0 * (c0 + 1.f) + s0, o1 = h1 * (c1 + 1.f) + s1;
        u32x4 w; w.x = cvt_pk_bf16(o0[0], o0[1]); w.y = cvt_pk_bf16(o0[2], o0[3]); w.z = cvt_pk_bf16(o1[0], o1[1]); w.w = cvt_pk_bf16(o1[2], o1[3]);
        *(u32x4*)(U + (size_t)row * 1024 + c8) = w;
    }
}

__device__ __forceinline__ void phase_postnorm(const Args& a, bool first, const bf16_t* Y, const float* modl, int gate_j, float ymul, const float* lng, const float* lnb,
                                               const float* modn, int sh_j, int row_begin, const Grp& gp) {
    const int tid = otid(), lane = tid & 63, gw = gp.rank * 8 + (tid >> 6), nw = gp.gsize * 8;
    const int nrows = gp.nb * (row_begin ? 4096 : 4352);
    float* HC = (float*)(a.ws + WS_HC); bf16_t* U = (bf16_t*)(a.ws + WS_U);
    f32x4 hr[2][4]; u32x2 yr[2][4];
#define PN_MAP(lr) (row_begin ? grp_row_lat(gp, (lr)) : grp_row(gp, (lr)))
#define PN_ROW(t, lA) PN_MAP((t) ? (((lA) + nw < nrows) ? (lA) + nw : (lA)) : (lA))
#define PN_LOAD(dstH, dstY, rA) do { _Pragma("unroll") for (int t = 0; t < 2; ++t) { const int row = PN_ROW(t, rA); const bool isc = row < MCTX; \
        const float* hin = first ? (isc ? a.ctx + (size_t)row * 1024 : a.x + (size_t)(row - MCTX) * 1024) : (isc ? HC + (size_t)row * 1024 : a.out + (size_t)(row - MCTX) * 1024); \
        const bf16_t* yp = Y + (size_t)row * 1024; \
        _Pragma("unroll") for (int c = 0; c < 4; ++c) { const int col = c * 256 + lane * 4; dstH[t][c] = *(const f32x4*)(hin + col); dstY[t][c] = *(const u32x2*)(yp + col); } } } while (0)
    f32x4 gv[4], bv[4];
#pragma unroll
    for (int c = 0; c < 4; ++c) { gv[c] = *(const f32x4*)(lng + c * 256 + lane * 4); bv[c] = *(const f32x4*)(lnb + c * 256 + lane * 4); }
    int rowA = gw;
    if (rowA < nrows) PN_LOAD(hr, yr, rowA);
    for (; rowA < nrows; rowA += 2 * nw) {
        const bool hasB = rowA + nw < nrows;
        f32x4 v[2][4]; float s[2] = {0.f, 0.f}, q[2] = {0.f, 0.f};
#pragma unroll
        for (int t = 0; t < 2; ++t) { const int row = PN_ROW(t, rowA); const int r9 = row < MCTX ? 8 : (row - MCTX) >> 12;
            const float* gate = modl + (size_t)(r9 * 9 + gate_j) * 1024;
#pragma unroll
            for (int c = 0; c < 4; ++c) { const int col = c * 256 + lane * 4; const f32x4 gt = *(const f32x4*)(gate + col);
                const f32x4 y = {bflo(yr[t][c].x), bfhi(yr[t][c].x), bflo(yr[t][c].y), bfhi(yr[t][c].y)};
                v[t][c] = hr[t][c] * DN_ALPHA + gt * y * ymul; s[t] += (v[t][c][0] + v[t][c][1]) + (v[t][c][2] + v[t][c][3]);
                q[t] += (v[t][c][0] * v[t][c][0] + v[t][c][1] * v[t][c][1]) + (v[t][c][2] * v[t][c][2] + v[t][c][3] * v[t][c][3]); } }
        const int rowN = rowA + 2 * nw;
        if (rowN < nrows) PN_LOAD(hr, yr, rowN);
#pragma unroll
        for (int o = 32; o >= 1; o >>= 1) { const float s0 = shx(s[0], lane, o), s1 = shx(s[1], lane, o), q0 = shx(q[0], lane, o), q1 = shx(q[1], lane, o); s[0] += s0; s[1] += s1; q[0] += q0; q[1] += q1; }
#pragma unroll
        for (int t = 0; t < 2; ++t) { if (t && !hasB) break; const int row = PN_MAP(t ? rowA + nw : rowA);
            const bool isc = row < MCTX; const int r9 = isc ? 8 : (row - MCTX) >> 12;
            float* hout = isc ? HC + (size_t)row * 1024 : a.out + (size_t)(row - MCTX) * 1024;
            const float mean = s[t] * (1.f / 1024.f); const float var = fmaxf(q[t] * (1.f / 1024.f) - mean * mean, 0.f);
            const float rstd = 1.0f / sqrtf(var + LN_EPS);
#pragma unroll
            for (int c = 0; c < 4; ++c) { const int col = c * 256 + lane * 4;
                const f32x4 hn = (v[t][c] - mean) * rstd * gv[c] + bv[c]; *(f32x4*)(hout + col) = hn;
                if (sh_j >= 0) { const f32x4 sh = *(const f32x4*)(modn + (size_t)(r9 * 9 + sh_j) * 1024 + col), sc = *(const f32x4*)(modn + (size_t)(r9 * 9 + sh_j + 1) * 1024 + col);
                    const f32x4 o = hn * (sc + 1.f) + sh; u32x2 w; w.x = cvt_pk_bf16(o[0], o[1]); w.y = cvt_pk_bf16(o[2], o[3]); *(u32x2*)(U + (size_t)row * 1024 + col) = w; } } }
    }
#undef PN_LOAD
#undef PN_ROW
#undef PN_MAP
}
template <int RABL>
__device__ __forceinline__ void phase_retention(const Args& a, LAS unsigned char* lds, const Grp& gp) {
    const bf16_t* Qg = (const bf16_t*)(a.ws + WS_BIG); const bf16_t* Kg = (const bf16_t*)(a.ws + WS_BIG + R1); const bf16_t* Vg = (const bf16_t*)(a.ws + WS_BIG + 2 * R1); bf16_t* Og = (bf16_t*)(a.ws + WS_BIG + 4 * R1);
    const int tid = otid(), w = __builtin_amdgcn_readfirstlane(tid >> 6), lane = tid & 63, c = lane & 15, g = lane >> 4;
    const int ib = w & 3, vh = w >> 2, vb2 = w & 3, dbase = (w >> 2) * 8;
    constexpr int QS = 0, KS = 32768, VS = 65536, ST = 73728;
    typedef short s16x4 __attribute__((ext_vector_type(4)));
    for (int item = gp.rank; item < gp.nb * 32; item += gp.gsize) {
        const int b = gp.b_lo + (item >> 5), h = (item >> 3) & 3, vs = item & 7;
        f32x4 accS[8]; u32x4 qreg[4], kreg[4], vreg; float lg = 0.f, g64 = 0.f;
        { const int row0 = b * 256;
#pragma unroll
          for (int i = 0; i < 4; ++i) { const int idx = tid + 512 * i, row = idx >> 5, ch = idx & 31; const size_t o = (size_t)(row0 + row) * 1024 + h * 256 + ch * 8; qreg[i] = *(const u32x4*)(Qg + o); kreg[i] = *(const u32x4*)(Kg + o); }
          vreg = *(const u32x4*)(Vg + (size_t)(row0 + (tid >> 3)) * 2048 + h * 512 + vs * 64 + (tid & 7) * 8); }
        for (int step = 0; step < 136; ++step) {
            const int dir = step >= 68 ? 1 : 0, s = step - 68 * dir;
            if (s == 0) {
#pragma unroll
                for (int x = 0; x < 8; ++x) accS[x] = (f32x4){0.f, 0.f, 0.f, 0.f};
                const int hh = dir ? 3 - h : h; lg = log2f(1.0f - exp2f(-5.0f - (float)hh)); g64 = exp2f(64.f * lg);
            }
            const int row0 = dir ? (s < 4 ? b * 256 + 64 * (3 - s) : MCTX + b * 4096 + 64 * (63 - (s - 4))) : (s < 4 ? b * 256 + 64 * s : MCTX + b * 4096 + 64 * (s - 4));
            __syncthreads();
            if (RABL != 1)
#pragma unroll
            for (int x = 0; x < 8; ++x) { const int d = 16 * (dbase + x) + c;
#pragma unroll
                for (int r = 0; r < 4; ++r) { const int v = 16 * vb2 + 4 * g + r; *(LAS bf16_t*)(lds + ST + v * 512 + (((d >> 3) ^ (v & 15)) << 4) + (d & 7) * 2) = f2bf(accS[x][r]); } }
#pragma unroll
            for (int i = 0; i < 4; ++i) { const int idx = tid + 512 * i, row = idx >> 5, ch = idx & 31; const int off = row * 512 + ((ch ^ (row & 15)) << 4);
                *(LAS u32x4*)(lds + QS + off) = qreg[i]; *(LAS u32x4*)(lds + KS + off) = kreg[i]; }
            { const int j = tid >> 3, ch = tid & 7; *(LAS u32x4*)(lds + VS + j * 128 + ((ch ^ ((j >> 1) & 7)) << 4)) = vreg; }
            __syncthreads();
            if (step + 1 < 136) { const int st2 = step + 1, dir2 = st2 >= 68 ? 1 : 0, s2 = st2 - 68 * dir2;
                const int nrow0 = dir2 ? (s2 < 4 ? b * 256 + 64 * (3 - s2) : MCTX + b * 4096 + 64 * (63 - (s2 - 4))) : (s2 < 4 ? b * 256 + 64 * s2 : MCTX + b * 4096 + 64 * (s2 - 4));
#pragma unroll
                for (int i = 0; i < 4; ++i) { const int idx = tid + 512 * i, row = idx >> 5, ch = idx & 31; const size_t o = (size_t)(nrow0 + row) * 1024 + h * 256 + ch * 8; qreg[i] = *(const u32x4*)(Qg + o); kreg[i] = *(const u32x4*)(Kg + o); }
                vreg = *(const u32x4*)(Vg + (size_t)(nrow0 + (tid >> 3)) * 2048 + h * 512 + vs * 64 + (tid & 7) * 8); }
            if (RABL == 2) continue;
            const int iq = 16 * ib + c;
            f32x4 accs[4], acco[2];
#pragma unroll
            for (int jb = 0; jb < 4; ++jb) accs[jb] = (f32x4){0.f, 0.f, 0.f, 0.f};
            acco[0] = (f32x4){0.f, 0.f, 0.f, 0.f}; acco[1] = (f32x4){0.f, 0.f, 0.f, 0.f};
#pragma unroll 1
            for (int ks = 0; ks < 8; ++ks) {
                const int sw = ((4 * ks + g) ^ c) << 4;
                const bf16x8 qf = *(const LAS bf16x8*)(lds + QS + iq * 512 + sw);
#pragma unroll
                for (int jb = 0; jb < 4; ++jb) { const bf16x8 kf = *(const LAS bf16x8*)(lds + KS + (16 * jb + c) * 512 + sw); accs[jb] = __builtin_amdgcn_mfma_f32_16x16x32_bf16(kf, qf, accs[jb], 0, 0, 0); }
#pragma unroll
                for (int vb = 0; vb < 2; ++vb) { const bf16x8 sf = *(const LAS bf16x8*)(lds + ST + (16 * (2 * vh + vb) + c) * 512 + sw); acco[vb] = __builtin_amdgcn_mfma_f32_16x16x32_bf16(sf, qf, acco[vb], 0, 0, 0); }
            }
            { const float qd = __builtin_amdgcn_exp2f(lg * (float)(dir ? 64 - iq : iq + 1)); acco[0] *= qd; acco[1] *= qd; }
#pragma unroll
            for (int jb = 0; jb < 4; ++jb)
#pragma unroll
                for (int r = 0; r < 4; ++r) { const int j = 16 * jb + 4 * g + r; const int df = dir ? j - iq : iq - j; const bool vis = dir ? (df > 0) : (df >= 0);
                    accs[jb][r] = vis ? accs[jb][r] * __builtin_amdgcn_exp2f(lg * (float)df) : 0.f; }
#pragma unroll
            for (int s2 = 0; s2 < 2; ++s2) {
                u32x4 pw; pw.x = cvt_pk_bf16(accs[2 * s2][0], accs[2 * s2][1]); pw.y = cvt_pk_bf16(accs[2 * s2][2], accs[2 * s2][3]); pw.z = cvt_pk_bf16(accs[2 * s2 + 1][0], accs[2 * s2 + 1][1]); pw.w = cvt_pk_bf16(accs[2 * s2 + 1][2], accs[2 * s2 + 1][3]);
                const bf16x8 pf = __builtin_bit_cast(bf16x8, pw);
#pragma unroll
                for (int vb = 0; vb < 2; ++vb) { const int vblk = 2 * vh + vb, ra = 32 * s2 + 4 * g + (c >> 2), rbb = ra + 16, cch = 2 * vblk + ((c & 3) >> 1);
                    const s16x4 lo = __builtin_amdgcn_ds_read_tr16_b64_v4i16((LAS s16x4*)(lds + VS + ra * 128 + ((cch ^ ((ra >> 1) & 7)) << 4) + 8 * (c & 1)));
                    const s16x4 hi = __builtin_amdgcn_ds_read_tr16_b64_v4i16((LAS s16x4*)(lds + VS + rbb * 128 + ((cch ^ ((rbb >> 1) & 7)) << 4) + 8 * (c & 1)));
                    const bf16x8 vf = {lo[0], lo[1], lo[2], lo[3], hi[0], hi[1], hi[2], hi[3]};
                    acco[vb] = __builtin_amdgcn_mfma_f32_16x16x32_bf16(vf, pf, acco[vb], 0, 0, 0); }
            }
#pragma unroll
            for (int vb = 0; vb < 2; ++vb) { bf16_t* op = Og + (size_t)(row0 + iq) * 2048 + h * 512 + vs * 64 + 16 * (2 * vh + vb) + 4 * g; f32x4 o = acco[vb];
                if (dir) { const u32x2 pv = *(const u32x2*)op; o[0] += bflo(pv.x); o[1] += bfhi(pv.x); o[2] += bflo(pv.y); o[3] += bfhi(pv.y); }
                u32x2 ow; ow.x = cvt_pk_bf16(o[0], o[1]); ow.y = cvt_pk_bf16(o[2], o[3]); *(u32x2*)op = ow; }
            { bf16x8 af[2];
              const int tq = c >> 2, tp = c & 3;
#pragma unroll
              for (int k2 = 0; k2 < 2; ++k2) { const int r0 = 32 * k2 + 8 * g + tq, r1 = r0 + 4, cch = 2 * vb2 + (tp >> 1);
                  const s16x4 t0 = __builtin_amdgcn_ds_read_tr16_b64_v4i16((LAS s16x4*)(lds + VS + r0 * 128 + ((cch ^ ((r0 >> 1) & 7)) << 4) + 8 * (tp & 1)));
                  const s16x4 t1 = __builtin_amdgcn_ds_read_tr16_b64_v4i16((LAS s16x4*)(lds + VS + r1 * 128 + ((cch ^ ((r1 >> 1) & 7)) << 4) + 8 * (tp & 1)));
                  const int j0 = 32 * k2 + 8 * g; float kd[8];
#pragma unroll
                  for (int e = 0; e < 8; ++e) kd[e] = __builtin_amdgcn_exp2f(lg * (float)(dir ? j0 + e : 63 - j0 - e));
                  u32x4 aw; aw.x = cvt_pk_bf16(bf2f((bf16_t)t0[0]) * kd[0], bf2f((bf16_t)t0[1]) * kd[1]); aw.y = cvt_pk_bf16(bf2f((bf16_t)t0[2]) * kd[2], bf2f((bf16_t)t0[3]) * kd[3]);
                  aw.z = cvt_pk_bf16(bf2f((bf16_t)t1[0]) * kd[4], bf2f((bf16_t)t1[1]) * kd[5]); aw.w = cvt_pk_bf16(bf2f((bf16_t)t1[2]) * kd[6], bf2f((bf16_t)t1[3]) * kd[7]);
                  af[k2] = __builtin_bit_cast(bf16x8, aw); }
#pragma unroll
              for (int x = 0; x < 8; ++x) { accS[x] *= g64; const int db = dbase + x;
#pragma unroll
                  for (int k2 = 0; k2 < 2; ++k2) { const int r0 = 32 * k2 + 8 * g + tq, r1 = r0 + 4;
                      const s16x4 t0 = __builtin_amdgcn_ds_read_tr16_b64_v4i16((LAS s16x4*)(lds + KS + r0 * 512 + (((2 * db + (tp >> 1)) ^ (r0 & 15)) << 4) + 8 * (tp & 1)));
                      const s16x4 t1 = __builtin_amdgcn_ds_read_tr16_b64_v4i16((LAS s16x4*)(lds + KS + r1 * 512 + (((2 * db + (tp >> 1)) ^ (r1 & 15)) << 4) + 8 * (tp & 1)));
                      const bf16x8 bfr = {t0[0], t0[1], t0[2], t0[3], t1[0], t1[1], t1[2], t1[3]};
                      accS[x] = __builtin_amdgcn_mfma_f32_16x16x32_bf16(af[k2], bfr, accS[x], 0, 0, 0); }
                  __builtin_amdgcn_sched_barrier(0); } }
        }
        __syncthreads();
    }
}

__device__ __forceinline__ void phase_ret_finish(const Args& a, int row_begin, const Grp& gp) {
    bf16_t* Og = (bf16_t*)(a.ws + WS_BIG + 4 * R1); const bf16_t* Gg = (const bf16_t*)(a.ws + WS_BIG);
    const int tid = otid(), lane = tid & 63, gw = gp.rank * 8 + (tid >> 6), nw = gp.gsize * 8, nrows = gp.nb * (row_begin ? 4096 : 4352);
    for (int lr = gw; lr < nrows; lr += nw) { const int row = row_begin ? grp_row_lat(gp, lr) : grp_row(gp, lr);
        const size_t base = (size_t)row * 2048 + (lane >> 4) * 512 + (lane & 15) * 32;
        float v[32]; float s = 0.f;
#pragma unroll
        for (int q = 0; q < 4; ++q) { const u32x4 w = *(const u32x4*)(Og + base + q * 8);
            v[q * 8 + 0] = bflo(w.x); v[q * 8 + 1] = bfhi(w.x); v[q * 8 + 2] = bflo(w.y); v[q * 8 + 3] = bfhi(w.y); v[q * 8 + 4] = bflo(w.z); v[q * 8 + 5] = bfhi(w.z); v[q * 8 + 6] = bflo(w.w); v[q * 8 + 7] = bfhi(w.w); }
#pragma unroll
        for (int i = 0; i < 32; ++i) s += v[i];
        s += shx(s, lane, 1); s += shx(s, lane, 2); s += shx(s, lane, 4); s += shx(s, lane, 8);
        const float mean = s * (1.f / 512.f); float qv = 0.f;
#pragma unroll
        for (int i = 0; i < 32; ++i) { const float d = v[i] - mean; qv += d * d; }
        qv += shx(qv, lane, 1); qv += shx(qv, lane, 2); qv += shx(qv, lane, 4); qv += shx(qv, lane, 8);
        const float rstd = 1.0f / sqrtf(qv * (1.f / 512.f) + LN_EPS);
#pragma unroll
        for (int q = 0; q < 4; ++q) { const u32x4 gwd = *(const u32x4*)(Gg + base + q * 8); const unsigned gw4[4] = {gwd.x, gwd.y, gwd.z, gwd.w}; unsigned ow[4];
#pragma unroll
            for (int p = 0; p < 4; ++p) { const float g0 = bflo(gw4[p]), g1 = bfhi(gw4[p]);
                ow[p] = cvt_pk_bf16(silu_f(g0) * (v[q * 8 + 2 * p] - mean) * rstd, silu_f(g1) * (v[q * 8 + 2 * p + 1] - mean) * rstd); }
            u32x4 o; o.x = ow[0]; o.y = ow[1]; o.z = ow[2]; o.w = ow[3]; *(u32x4*)(Og + base + q * 8) = o; }
    }
}

template <int ABL>
__device__ __forceinline__ void phase_na(const Args& a, LAS unsigned char* lds0, bf16_t* Odst, const Grp& gp) {
    const bf16_t* Qg = (const bf16_t*)(a.ws + WS_BIG); const bf16_t* Kg = (const bf16_t*)(a.ws + WS_BIG + R1); const bf16_t* Vg = (const bf16_t*)(a.ws + WS_BIG + 2 * R1);
    const int tid = otid(), w = __builtin_amdgcn_readfirstlane(tid >> 6), lane = tid & 63, c = lane & 15, g = lane >> 4, hb = w >> 2, w4 = w & 3, t2 = tid & 255;
    LAS unsigned char* lds = lds0 + hb * 65536;
    constexpr int QS = 0, KS = 32768, VT = 40960, RP = 49152;
    float mk[4][4]; int rco[4][4];
    { const int q0 = 16 * w4 + c, cs0 = min(max(q0 - 8, 0), 48);
#pragma unroll
      for (int kb = 0; kb < 4; ++kb)
#pragma unroll
          for (int e = 0; e < 4; ++e) { const int kc = 16 * kb + 4 * g + e; mk[kb][e] = (kc >= cs0 && kc < cs0 + 16) ? 0.f : -1e30f; rco[kb][e] = min(max(kc - q0 + 15, 0), 30) * 4; } }
    const int kb_lo = min(max(16 * w4 - 8, 0), 48) >> 4, kb_hi = (min(max(16 * w4 + 7, 0), 48) + 15) >> 4;
    for (int base_it = gp.rank * 2; base_it < gp.nb * 272; base_it += gp.gsize * 2) {
        const int it = base_it + hb, bb = it / 272, idx = it - bb * 272; const bool isl = (base_it % 272) < 256;
        const int b = gp.b_lo + bb; int h, r0 = 0, kr_lo = 0, kr_hi = 0;
        if (isl) { h = idx >> 4; r0 = (idx & 15) * 4; kr_lo = min(max(r0 - 4, 0), 56); kr_hi = min(max(r0 - 1, 0), 56) + 7; }
        else { h = idx - 256; }
        const int ntile = isl ? 15 : 4;
        __syncthreads();
#pragma unroll
        for (int i = 0; i < 8; ++i) { const int idx = t2 + 256 * i, row = idx >> 3, ch = idx & 7, rr = row >> 6, qi = row & 63;
            const int grow = isl ? MCTX + b * 4096 + (r0 + rr) * 64 + qi : b * 256 + rr * 64 + qi;
            *(LAS u32x4*)(lds + QS + row * 128 + ((ch ^ ((row >> 1) & 7)) << 4)) = *(const u32x4*)(Qg + (size_t)grow * 1024 + h * 64 + ch * 8); }
        for (int i = t2; i < 465; i += 256) *(LAS float*)(lds + RP + i * 4) = a.na_rpb[h * 465 + i];
        u32x4 kreg[2], vreg[2];
        { const int row0 = isl ? MCTX + b * 4096 + kr_lo * 64 : b * 256;
#pragma unroll
          for (int i = 0; i < 2; ++i) { const int idx = t2 + 256 * i, row = idx >> 3, ch = idx & 7; const size_t o = ((size_t)h * MTOT + row0 + row) * 64 + ch * 8; kreg[i] = *(const u32x4*)(Kg + o); vreg[i] = *(const u32x4*)(Vg + o); } }
        const int q = 16 * w4 + c;
        f32x4 oacc[4][4]; float mrun[4], lrun[4];
#pragma unroll
        for (int rr = 0; rr < 4; ++rr) { mrun[rr] = -1e30f; lrun[rr] = 0.f;
#pragma unroll
            for (int db = 0; db < 4; ++db) oacc[rr][db] = (f32x4){0.f, 0.f, 0.f, 0.f}; }
        for (int tl = 0; tl < ntile; ++tl) {
            if (ABL == 3) break;
            if (ABL == 4) { __syncthreads(); __syncthreads(); continue; }
            __syncthreads();
#pragma unroll
            for (int i = 0; i < 2; ++i) { const int idx = t2 + 256 * i, row = idx >> 3, ch = idx & 7;
                *(LAS u32x4*)(lds + KS + row * 128 + ((ch ^ ((row >> 1) & 7)) << 4)) = kreg[i];
                const unsigned vw[4] = {vreg[i].x, vreg[i].y, vreg[i].z, vreg[i].w};
#pragma unroll
                for (int e = 0; e < 8; ++e) { const int d = ch * 8 + e; const bf16_t val = (bf16_t)((e & 1) ? (vw[e >> 1] >> 16) : (vw[e >> 1] & 0xffffu));
                    *(LAS bf16_t*)(lds + VT + d * 128 + (((row >> 3) ^ ((d >> 1) & 7)) << 4) + (row & 7) * 2) = val; } }
            __syncthreads();
            if (tl + 1 < ntile) { const int t1 = tl + 1;
                const int row0 = isl ? (t1 < 11 ? MCTX + b * 4096 + min(kr_lo + t1, kr_hi) * 64 : b * 256 + (t1 - 11) * 64) : b * 256 + t1 * 64;
#pragma unroll
                for (int i = 0; i < 2; ++i) { const int idx = t2 + 256 * i, row = idx >> 3, ch = idx & 7; const size_t o = ((size_t)h * MTOT + row0 + row) * 64 + ch * 8; kreg[i] = *(const u32x4*)(Kg + o); vreg[i] = *(const u32x4*)(Vg + o); } }
            if (ABL == 2) continue;
            const bool local = isl && tl < 11; const int krow = kr_lo + tl;
            if (local && krow > kr_hi) continue;
#pragma unroll
            for (int rr = 0; rr < 4; ++rr) {
                const int r = r0 + rr, rs = min(max(r - 4, 0), 56);
                if (local && (krow < rs || krow >= rs + 8)) continue;
                bf16x8 qf[2];
#pragma unroll
                for (int ks = 0; ks < 2; ++ks) { const int qrow = rr * 64 + q; qf[ks] = *(const LAS bf16x8*)(lds + QS + qrow * 128 + (((4 * ks + g) ^ ((qrow >> 1) & 7)) << 4)); }
                f32x4 sT[4];
#pragma unroll
                for (int kb = 0; kb < 4; ++kb) { const bool skip = local && (kb < kb_lo || kb > kb_hi);
                    if (skip) { sT[kb] = (f32x4){-1e30f, -1e30f, -1e30f, -1e30f}; continue; }
                    sT[kb] = (f32x4){0.f, 0.f, 0.f, 0.f}; const int kr = 16 * kb + c;
#pragma unroll
                    for (int ks = 0; ks < 2; ++ks) { const bf16x8 kf = *(const LAS bf16x8*)(lds + KS + kr * 128 + (((4 * ks + g) ^ ((kr >> 1) & 7)) << 4)); sT[kb] = __builtin_amdgcn_mfma_f32_16x16x32_bf16(kf, qf[ks], sT[kb], 0, 0, 0); }
                    if (local) { const int rbase = RP + (krow - r + 7) * 124;
#pragma unroll
                        for (int e = 0; e < 4; ++e) sT[kb][e] = (sT[kb][e] + *(const LAS float*)(lds + rbase + rco[kb][e])) + mk[kb][e]; } }
                if (ABL == 1) { oacc[rr][0] += sT[0] + sT[1] + sT[2] + sT[3]; continue; }
                float mx = -1e30f;
#pragma unroll
                for (int kb = 0; kb < 4; ++kb) mx = fmaxf(mx, fmaxf(fmaxf(sT[kb][0], sT[kb][1]), fmaxf(sT[kb][2], sT[kb][3])));
                mx = fmaxf(mx, shx(mx, lane, 16)); mx = fmaxf(mx, shx(mx, lane, 32));
                const float mnew = fmaxf(mrun[rr], mx), alpha = __builtin_amdgcn_exp2f((mrun[rr] - mnew) * LOG2E); mrun[rr] = mnew;
                float ps = 0.f;
#pragma unroll
                for (int kb = 0; kb < 4; ++kb)
#pragma unroll
                    for (int e = 0; e < 4; ++e) { const float p = __builtin_amdgcn_exp2f((sT[kb][e] - mnew) * LOG2E); sT[kb][e] = p; ps += p; }
                ps += shx(ps, lane, 16); ps += shx(ps, lane, 32);
                lrun[rr] = lrun[rr] * alpha + ps;
#pragma unroll
                for (int db = 0; db < 4; ++db) oacc[rr][db] *= alpha;
#pragma unroll
                for (int s2 = 0; s2 < 2; ++s2) {
                    if (local && (2 * s2 + 1 < kb_lo || 2 * s2 > kb_hi)) continue;
                    u32x4 pw; pw.x = cvt_pk_bf16(sT[2 * s2][0], sT[2 * s2][1]); pw.y = cvt_pk_bf16(sT[2 * s2][2], sT[2 * s2][3]); pw.z = cvt_pk_bf16(sT[2 * s2 + 1][0], sT[2 * s2 + 1][1]); pw.w = cvt_pk_bf16(sT[2 * s2 + 1][2], sT[2 * s2 + 1][3]);
                    const bf16x8 pf = __builtin_bit_cast(bf16x8, pw);
#pragma unroll
                    for (int db = 0; db < 4; ++db) { const int vrow = 16 * db + c; const int sw = (vrow >> 1) & 7;
                        const u32x2 lo = *(const LAS u32x2*)(lds + VT + vrow * 128 + (((4 * s2 + (g >> 1)) ^ sw) << 4) + (g & 1) * 8);
                        const u32x2 hi = *(const LAS u32x2*)(lds + VT + vrow * 128 + (((4 * s2 + 2 + (g >> 1)) ^ sw) << 4) + (g & 1) * 8);
                        u32x4 vw; vw.x = lo.x; vw.y = lo.y; vw.z = hi.x; vw.w = hi.y;
                        oacc[rr][db] = __builtin_amdgcn_mfma_f32_16x16x32_bf16(__builtin_bit_cast(bf16x8, vw), pf, oacc[rr][db], 0, 0, 0); }
                }
            }
        }
        __syncthreads();
#pragma unroll
        for (int rr = 0; rr < 4; ++rr) { const float inv = 1.0f / lrun[rr]; const int orow = rr * 64 + q;
#pragma unroll
            for (int db = 0; db < 4; ++db) { const f32x4 o = oacc[rr][db] * inv; u32x2 ow; ow.x = cvt_pk_bf16(o[0], o[1]); ow.y = cvt_pk_bf16(o[2], o[3]);
                *(LAS u32x2*)(lds + QS + orow * 128 + (((2 * db + (g >> 1)) ^ ((orow >> 1) & 7)) << 4) + (g & 1) * 8) = ow; } }
        __syncthreads();
#pragma unroll
        for (int i = 0; i < 8; ++i) { const int idx = t2 + 256 * i, row = idx >> 3, ch = idx & 7, rr = row >> 6, qi = row & 63;
            const int grow = isl ? MCTX + b * 4096 + (r0 + rr) * 64 + qi : b * 256 + rr * 64 + qi;
            *(u32x4*)(Odst + (size_t)grow * 1024 + h * 64 + ch * 8) = *(const LAS u32x4*)(lds + QS + row * 128 + ((ch ^ ((row >> 1) & 7)) << 4)); }
    }
    __syncthreads();
}

__device__ __forceinline__ void phase_lru_conv(const Args& a, const Grp& gp) {
    const bf16_t* XR = (const bf16_t*)(a.ws + WS_BIG + R1); bf16_t* XC = (bf16_t*)(a.ws + WS_BIG + 2 * R1);
    for (int i = gp.rank * 512 + otid(); i < gp.nb * 4352 * 128; i += gp.gsize * 512) {
        const int row = grp_row(gp, i >> 7), c8 = (i & 127) * 8; const bool isc = row < MCTX; const int t = isc ? (row & 255) : ((row - MCTX) & 4095), len = isc ? 256 : 4096;
        float acc[8];
        { const f32x4 b0 = *(const f32x4*)(a.lru_conv_b + c8), b1 = *(const f32x4*)(a.lru_conv_b + c8 + 4); acc[0] = b0[0]; acc[1] = b0[1]; acc[2] = b0[2]; acc[3] = b0[3]; acc[4] = b1[0]; acc[5] = b1[1]; acc[6] = b1[2]; acc[7] = b1[3]; }
#pragma unroll
        for (int j = 0; j < 4; ++j) { const int tt = t - 2 + j;
            if (tt >= 0 && tt < len) { const u32x4 xw = *(const u32x4*)(XR + (size_t)(row - 2 + j) * 1024 + c8); const f32x4 w0 = *(const f32x4*)(a.lru_conv_w + j * 1024 + c8), w1 = *(const f32x4*)(a.lru_conv_w + j * 1024 + c8 + 4);
                acc[0] += w0[0] * bflo(xw.x); acc[1] += w0[1] * bfhi(xw.x); acc[2] += w0[2] * bflo(xw.y); acc[3] += w0[3] * bfhi(xw.y);
                acc[4] += w1[0] * bflo(xw.z); acc[5] += w1[1] * bfhi(xw.z); acc[6] += w1[2] * bflo(xw.w); acc[7] += w1[3] * bfhi(xw.w); } }
        u32x4 o; o.x = cvt_pk_bf16(acc[0], acc[1]); o.y = cvt_pk_bf16(acc[2], acc[3]); o.z = cvt_pk_bf16(acc[4], acc[5]); o.w = cvt_pk_bf16(acc[6], acc[7]);
        *(u32x4*)(XC + (size_t)row * 1024 + c8) = o;
    }
}
__device__ __forceinline__ void phase_lru_scan(const Args& a, int dir, int pass, const Grp& gp) {
    const bf16_t* GATE = (const bf16_t*)(a.ws + WS_BIG); bf16_t* HF = (bf16_t*)(a.ws + WS_BIG + R1); const bf16_t* XC = (const bf16_t*)(a.ws + WS_BIG + 2 * R1); const bf16_t* GP = (const bf16_t*)(a.ws + WS_BIG + 3 * R1);
    float* CARRY = (float*)(a.ws + WS_CARRY);
    for (int idx = gp.rank * 512 + otid(); idx < gp.nb * 64 * 256; idx += gp.gsize * 512) {
        const int cq = idx & 255, chunk = (idx >> 8) & 63, b = gp.b_lo + (idx >> 14), c0 = cq * 4;
        float ba[4], bx[4], sp[4], h[4], P[4];
        { const f32x4 t0 = *(const f32x4*)(a.lru_b_a + dir * 1024 + c0), t1 = *(const f32x4*)(a.lru_b_x + dir * 1024 + c0), t2 = *(const f32x4*)(a.lru_lam + dir * 1024 + c0);
#pragma unroll
          for (int k = 0; k < 4; ++k) { ba[k] = t0[k]; bx[k] = t1[k]; sp[k] = -8.f * log1pf(expf(-t2[k])); h[k] = 0.f; P[k] = 1.f; } }
        if (pass == 2) { for (int cc = 0; cc < chunk; ++cc) { const float* cp = CARRY + ((size_t)(b * 64 + cc) * 256 + cq) * 8; const f32x4 pp = *(const f32x4*)cp, ll = *(const f32x4*)(cp + 4);
#pragma unroll
            for (int k = 0; k < 4; ++k) h[k] = pp[k] * h[k] + ll[k]; } }
        for (int t4 = 0; t4 < 17; ++t4) {
            u32x2 rw[4], iw[4], xw[4], hw[4], gw[4]; int rows[4];
#pragma unroll
            for (int j = 0; j < 4; ++j) { const int p = chunk * 68 + t4 * 4 + j;
                const int row = dir ? (p < 256 ? b * 256 + (255 - p) : MCTX + b * 4096 + (4095 - (p - 256))) : (p < 256 ? b * 256 + p : MCTX + b * 4096 + (p - 256));
                rows[j] = row;
                rw[j] = *(const u32x2*)(GP + (size_t)row * 2048 + c0); iw[j] = *(const u32x2*)(GP + (size_t)row * 2048 + 1024 + c0); xw[j] = *(const u32x2*)(XC + (size_t)row * 1024 + c0);
                if (pass == 2 && dir == 1) { hw[j] = *(const u32x2*)(HF + (size_t)row * 1024 + c0); gw[j] = *(const u32x2*)(GATE + (size_t)row * 1024 + c0); } }
#pragma unroll
            for (int j = 0; j < 4; ++j) {
                const float rp[4] = {bflo(rw[j].x), bfhi(rw[j].x), bflo(rw[j].y), bfhi(rw[j].y)}, ip[4] = {bflo(iw[j].x), bfhi(iw[j].x), bflo(iw[j].y), bfhi(iw[j].y)}, xv[4] = {bflo(xw[j].x), bfhi(xw[j].x), bflo(xw[j].y), bfhi(xw[j].y)};
#pragma unroll
                for (int k = 0; k < 4; ++k) { const float la = sp[k] * sigmoid_f(rp[k] + ba[k]); const float av = __expf(la); const float m = sqrtf(fmaxf(-expm1f(2.f * la), 0.f));
                    h[k] = av * h[k] + m * sigmoid_f(ip[k] + bx[k]) * xv[k]; if (pass == 1) P[k] *= av; }
                if (pass == 2) { bf16_t* hp = HF + (size_t)rows[j] * 1024 + c0; u32x2 o;
                    if (dir == 0) { o.x = cvt_pk_bf16(h[0], h[1]); o.y = cvt_pk_bf16(h[2], h[3]); }
                    else { o.x = cvt_pk_bf16(gelu_tanh_f(bflo(gw[j].x)) * (bflo(hw[j].x) + h[0]), gelu_tanh_f(bfhi(gw[j].x)) * (bfhi(hw[j].x) + h[1]));
                           o.y = cvt_pk_bf16(gelu_tanh_f(bflo(gw[j].y)) * (bflo(hw[j].y) + h[2]), gelu_tanh_f(bfhi(gw[j].y)) * (bfhi(hw[j].y) + h[3])); }
                    *(u32x2*)hp = o; }
            }
        }
        if (pass == 1) { float* cp = CARRY + ((size_t)(b * 64 + chunk) * 256 + cq) * 8; *(f32x4*)cp = (f32x4){P[0], P[1], P[2], P[3]}; *(f32x4*)(cp + 4) = (f32x4){h[0], h[1], h[2], h[3]}; }
    }
}
constexpr int NPHASE = 52;
enum { OP_PROLOGUE, OP_U0, OP_GEMM_SWIGLU, OP_GEMM_PLAIN, OP_GEMM_RETIN, OP_GEMM_GATES, OP_POSTNORM, OP_RETSCAN, OP_RETFIN, OP_NAATT, OP_LRUCONV, OP_LRUSCAN };

typedef const Args __attribute__((address_space(4)))* KArgsPtr;
__global__ void __launch_bounds__(512) hybrid_fwd(Args a_in) {
    extern __shared__ __attribute__((aligned(16))) unsigned char lds_raw[];
    LAS unsigned char* lds = (LAS unsigned char*)lds_raw;
    const int ph_lo = a_in.ph_lo, ph_hi = a_in.ph_hi;
    volatile LAS unsigned* xb_st = (volatile LAS unsigned*)(lds + LDS_BYTES - 16);
    unsigned* xb_bar = (unsigned*)(a_in.ws + WS_BAR);
    if (threadIdx.x < 4) xb_st[threadIdx.x] = 0u;
    __syncthreads();
    if (threadIdx.x == 0) { const unsigned x = xb_xcc_id(); const unsigned r = xb_add(&xb_bar[XB_XCNT(x)], 1u); xb_st[2] = r | (x << 8); }
    int nexec = 0;
#ifdef PROBE_DBL
    for (int pp = 2 * ph_lo; pp < 2 * ph_hi; ++pp) { const int p = pp >> 1;
#else
    for (int p = ph_lo; p < ph_hi; ++p) {
#endif
#if defined(__HIP_DEVICE_COMPILE__)
        KArgsPtr ka = (KArgsPtr)__builtin_amdgcn_kernarg_segment_ptr(); asm volatile("" : "+s"(ka));
        Args a; __builtin_memcpy(&a, ka, sizeof(Args));
#else
        const Args a = a_in;
#endif
        bf16_t* WT = (bf16_t*)(a.ws + WS_WT); bf16_t* U = (bf16_t*)(a.ws + WS_U); unsigned char* BIG = a.ws + WS_BIG; const float* MOD = (const float*)(a.ws + WS_MOD);
        int op = OP_PROLOGUE, l = 0, s = 0, kind = 0, mi = 0, rb = 0, gsel = 0, sdir = 0, spass = 0; bool mixpn = false;
        if (p == 0) op = OP_PROLOGUE;
        else if (p == 1) op = OP_U0;
        else {
            const int q = p - 2; int li;
            if (q < 12) { l = 0; li = q; } else if (q < 22) { l = 1; li = q - 12; } else if (q < 38) { l = 2; li = q - 22; } else { l = 3; li = q - 38; }
            kind = l % 3; mi = l / 3; const int nmix = kind == 0 ? 6 : (kind == 1 ? 4 : 10);
            rb = (l == 3 && li >= 5) ? MCTX : 0;
            if (li < 3 || li >= 3 + nmix) {
                s = li < 3 ? 0 : 1; const int fs = li < 3 ? li : li - 3 - nmix;
                if (fs == 0) op = OP_GEMM_SWIGLU; else if (fs == 1) { op = OP_GEMM_PLAIN; gsel = 0; } else op = OP_POSTNORM;
            } else {
                const int ms = li - 3;
                if (ms == nmix - 1) { op = OP_POSTNORM; mixpn = true; }
                else if (kind == 0) { if (ms == 0) op = OP_GEMM_RETIN; else if (ms == 1) op = OP_RETSCAN; else if (ms == 2) { op = OP_GEMM_PLAIN; gsel = 1; } else if (ms == 3) op = OP_RETFIN; else { op = OP_GEMM_PLAIN; gsel = 2; } }
                else if (kind == 1) { if (ms == 0) { op = OP_GEMM_PLAIN; gsel = 3; } else if (ms == 1) op = OP_NAATT; else { op = OP_GEMM_PLAIN; gsel = 4; } }
                else { if (ms == 0) { op = OP_GEMM_PLAIN; gsel = 5; } else if (ms == 1) op = OP_LRUCONV; else if (ms == 2 || ms == 5) { op = OP_GEMM_GATES; sdir = ms == 5 ? 1 : 0; }
                       else if (ms == 3 || ms == 4) { op = OP_LRUSCAN; sdir = 0; spass = ms - 2; } else if (ms == 6 || ms == 7) { op = OP_LRUSCAN; sdir = 1; spass = ms - 5; } else { op = OP_GEMM_PLAIN; gsel = 6; } }
            }
        }
#ifdef PROBE_DBL
#if PROBE_DBL == 10
        if ((pp & 1) && p != 0) continue;
#else
        if (pp & 1) { const bool pdbl = (PROBE_DBL == 1) ? (op == OP_GEMM_SWIGLU || op == OP_GEMM_PLAIN || op == OP_GEMM_RETIN || op == OP_GEMM_GATES)
                        : (PROBE_DBL == 3) ? (op == OP_RETSCAN) : (PROBE_DBL == 10) ? (op == OP_PROLOGUE) : (PROBE_DBL == 8) ? (op == OP_GEMM_SWIGLU) : (PROBE_DBL == 5) ? (op == OP_NAATT) : (PROBE_DBL == 6) ? (op == OP_LRUCONV || (op == OP_LRUSCAN && !(sdir == 1 && spass == 2))) : (PROBE_DBL == 2) ? (op == OP_POSTNORM && l == 0 && s == 0 && !mixpn) : false;
            if (!pdbl) continue; }
#endif
#endif
        { const unsigned xm = (unsigned)__builtin_amdgcn_readfirstlane((int)xb_st[3]);
          const bool relayout = op == OP_GEMM_SWIGLU || op == OP_GEMM_RETIN || (op == OP_GEMM_PLAIN && (gsel == 1 || gsel == 3 || gsel == 5));
          if (nexec == 1) cg::this_grid().sync();
          else if (nexec > 1) { if (xm && !relayout) xcd_local_barrier((unsigned*)(a.ws + WS_BAR), ((unsigned)__builtin_amdgcn_readfirstlane((int)xb_st[2]) >> 8) & 0xffu, 32u);
                                else xcd_barrier((unsigned*)(a.ws + WS_BAR), xb_st); } }
        if (nexec == 1 && ph_lo == 0) {
            if (threadIdx.x == 0) { bool ok = gridDim.x == 256;
                for (unsigned j = 0; j < 16; ++j) { const unsigned cnt = xb_ld(&xb_bar[XB_XCNT(j)]); ok = ok && (j < 8 ? cnt == 32u : cnt == 0u); }
#ifdef PROBE_NO_XMODE
                ok = false;
#endif
                xb_st[3] = ok ? 1u : 0u; }
            __syncthreads(); }
        ++nexec;
        const unsigned gword = (unsigned)__builtin_amdgcn_readfirstlane((int)xb_st[2]), xmode = (unsigned)__builtin_amdgcn_readfirstlane((int)xb_st[3]);
        Grp grp; if (xmode) { grp.b_lo = (int)((gword >> 8) & 0xffu); grp.nb = 1; grp.rank = (int)(gword & 0xffu); grp.gsize = 32; } else { grp.b_lo = 0; grp.nb = 8; grp.rank = (int)blockIdx.x; grp.gsize = (int)gridDim.x; }
        switch (op) {
#ifndef NO_OP_PROLOGUE
            case OP_PROLOGUE: phase_prologue(a, lds); break;
#endif
#ifndef NO_OP_U0
            case OP_U0: phase_u0(a, grp); break;
#endif
#ifndef NO_OP_GEMM_SWIGLU
            case OP_GEMM_SWIGLU: { const pg8::Gemm gg{U, WT + E_FFN_IN + (size_t)(l * 2 + s) * 5632 * 1024, MTOT, 5632, 1024, 1024, 0, 0};
                pg8::GroupOrder S; S.init(grp.nb, grp.b_lo, rb != 0, gg.N, grp.gsize, grp.rank); EpiSwiGLU E{(bf16_t*)BIG, 0}; pg8::gemm_phase<EpiSwiGLU, pg8::GroupOrder>(lds, gg, S, E); } break;
#endif
#ifndef NO_OP_GEMM_PLAIN
            case OP_GEMM_PLAIN: { const bf16_t* gA; const bf16_t* gB; int gN, gK, glda; bf16_t* eO; int eldc = 1024, esplit = 0, ehm = 0; size_t estride = 0; float escale = 1.f;
                if (gsel == 0)      { gA = (const bf16_t*)BIG; gB = WT + E_FFN_OUT + (size_t)(l * 2 + s) * 1024 * 2816; gN = 1024; gK = 2816; glda = 2816; eO = (bf16_t*)(BIG + 3 * R1); }
                else if (gsel == 1) { gA = U; gB = WT + E_RET_IN + (size_t)mi * 6144 * 1024 + (size_t)4096 * 1024; gN = 2048; gK = 1024; glda = 1024; eO = (bf16_t*)BIG; eldc = 2048; }
                else if (gsel == 2) { gA = (const bf16_t*)(BIG + 4 * R1); gB = WT + E_RET_OUT + (size_t)mi * 1024 * 2048; gN = 1024; gK = 2048; glda = 2048; eO = (bf16_t*)(BIG + 2 * R1); }
                else if (gsel == 3) { gA = U; gB = WT + E_NA_QKV; gN = 3072; gK = 1024; glda = 1024; eO = (bf16_t*)BIG; esplit = 1024; estride = R1 / 2; escale = 0.125f; ehm = 1; }
                else if (gsel == 4) { gA = (const bf16_t*)BIG; gB = WT + E_NA_OUT; gN = 1024; gK = 1024; glda = 1024; eO = (bf16_t*)(BIG + 3 * R1); }
                else if (gsel == 5) { gA = U; gB = WT + E_LRU_IN; gN = 2048; gK = 1024; glda = 1024; eO = (bf16_t*)BIG; esplit = 1024; estride = R1 / 2; }
                else                { gA = (const bf16_t*)(BIG + R1); gB = WT + E_LRU_OUT; gN = 1024; gK = 1024; glda = 1024; eO = (bf16_t*)(BIG + 2 * R1); }
                const pg8::Gemm gg{gA, gB, MTOT, gN, gK, glda, 0, 0}; pg8::GroupOrder S; S.init(grp.nb, grp.b_lo, rb != 0, gg.N, grp.gsize, grp.rank);
                EpiPlain E{eO, eldc, 0, esplit, estride, escale, ehm}; pg8::gemm_phase<EpiPlain, pg8::GroupOrder>(lds, gg, S, E); } break;
#endif
#ifndef NO_OP_GEMM_RETIN
            case OP_GEMM_RETIN: { const pg8::Gemm gg{U, WT + E_RET_IN + (size_t)mi * 6144 * 1024, MTOT, 4096, 1024, 1024, 0, 0}; pg8::GroupOrder S; S.init(grp.nb, grp.b_lo, false, gg.N, grp.gsize, grp.rank);
                EpiRetIn E{(bf16_t*)BIG, (bf16_t*)(BIG + R1), (bf16_t*)(BIG + 2 * R1), (const float*)(a.ws + WS_ROPE), (const float*)(a.ws + WS_ROPE) + 4096}; pg8::gemm_phase<EpiRetIn, pg8::GroupOrder>(lds, gg, S, E); } break;
#endif
#ifndef NO_OP_GEMM_GATES
            case OP_GEMM_GATES: { const pg8::Gemm gg{(const bf16_t*)(BIG + 2 * R1), WT + E_GATES + (size_t)sdir * 2048 * 256, MTOT, 2048, 256, 1024, 1, 256}; pg8::GroupOrder S; S.init(grp.nb, grp.b_lo, false, gg.N, grp.gsize, grp.rank);
                EpiGates E{(bf16_t*)(BIG + 3 * R1)}; pg8::gemm_phase<EpiGates, pg8::GroupOrder>(lds, gg, S, E); } break;
#endif
#ifndef NO_OP_POSTNORM
            case OP_POSTNORM: { const float* modl = MOD + (size_t)l * 9 * 9216;
                if (mixpn) phase_postnorm(a, false, (const bf16_t*)(BIG + (kind == 1 ? 3 : 2) * R1), modl, 5, 1.f, a.ln_g + (size_t)(l * 3 + 1) * 1024, a.ln_b + (size_t)(l * 3 + 1) * 1024, modl, 6, rb, grp);
                else { const int li3 = l * 3 + (s == 0 ? 0 : 2); const float* modn = (s == 0) ? modl : MOD + (size_t)(l < 3 ? l + 1 : l) * 9 * 9216; const int psh = (s == 0) ? 3 : (l < 3 ? 0 : -1);
                    phase_postnorm(a, l == 0 && s == 0, (const bf16_t*)(BIG + 3 * R1), modl, s == 0 ? 2 : 8, 0.5f, a.ln_g + (size_t)li3 * 1024, a.ln_b + (size_t)li3 * 1024, modn, psh, rb, grp); } } break;
#endif
#ifndef NO_OP_RETSCAN
#if defined(PROBE_DBL) && PROBE_DBL == 3
#ifndef PROBE_RET_ABL
#define PROBE_RET_ABL 0
#endif
            case OP_RETSCAN: if (pp & 1) phase_retention<0>(a, lds, grp); else phase_retention<PROBE_RET_ABL>(a, lds, grp); break;
#else
            case OP_RETSCAN: phase_retention<0>(a, lds, grp); break;
#endif
#endif
#ifndef NO_OP_RETFIN
            case OP_RETFIN: phase_ret_finish(a, rb, grp); break;
#endif
#ifndef NO_OP_NAATT
#if defined(PROBE_DBL) && PROBE_DBL == 5
#ifndef PROBE_NA_ABL
#define PROBE_NA_ABL 0
#endif
            case OP_NAATT: if (pp & 1) phase_na<0>(a, lds, (bf16_t*)BIG, grp); else phase_na<PROBE_NA_ABL>(a, lds, (bf16_t*)(BIG + 3 * R1), grp); break;
#else
            case OP_NAATT: phase_na<0>(a, lds, (bf16_t*)BIG, grp); break;
#endif
#endif
#ifndef NO_OP_LRUCONV
            case OP_LRUCONV: phase_lru_conv(a, grp); break;
#endif
#ifndef NO_OP_LRUSCAN
            case OP_LRUSCAN: phase_lru_scan(a, sdir, spass, grp); break;
#endif
            default: break;
        }
    }
}

#ifndef MK_PER_PHASE
#define MK_PER_PHASE 0
#endif
extern "C" void kernel_launch(void* const* d_in, const int* in_sizes, int n_in, void* d_out, int out_size, void* d_ws, size_t ws_size, hipStream_t stream) {
    static int grid = 0;
    if (grid == 0) {
        if (n_in != 24 || out_size != MLAT * 1024 || ws_size < WS_END) { fprintf(stderr, "kernel_launch: unexpected shapes: n_in %d out %d ws %zu (need %zu)\n", n_in, out_size, ws_size, (size_t)WS_END); grid = -1; return; }
        int dev = 0, cus = 0, per_cu = 0;
        if (hipGetDevice(&dev) != hipSuccess || hipDeviceGetAttribute(&cus, hipDeviceAttributeMultiprocessorCount, dev) != hipSuccess) { grid = -1; return; }
        if (hipFuncSetAttribute((const void*)hybrid_fwd, hipFuncAttributeMaxDynamicSharedMemorySize, LDS_BYTES) != hipSuccess) { fprintf(stderr, "kernel_launch: hipFuncSetAttribute failed\n"); grid = -1; return; }
        if (hipOccupancyMaxActiveBlocksPerMultiprocessor(&per_cu, (const void*)hybrid_fwd, 512, LDS_BYTES) != hipSuccess || per_cu < 1) { fprintf(stderr, "kernel_launch: occupancy query says %d\n", per_cu); per_cu = 1; }
        (void)hipGetLastError();
        grid = cus * 1;
    }
    if (grid < 0) return;
    if (hipMemsetAsync((char*)d_ws + WS_BAR, 0, 16384, stream) != hipSuccess) { fprintf(stderr, "kernel_launch: barrier memset failed\n"); return; }
    Args a{};
    const float** pp = (const float**)&a;
    for (int i = 0; i < 24; ++i) pp[i] = (const float*)d_in[i];
    a.out = (float*)d_out; a.ws = (unsigned char*)d_ws;
#if MK_PER_PHASE
    for (int p = 0; p < NPHASE; ++p) { a.ph_lo = p; a.ph_hi = p + 1; hipLaunchKernelGGL(hybrid_fwd, dim3(grid), dim3(512), LDS_BYTES, stream, a); }
#else
    a.ph_lo = 0; a.ph_hi = NPHASE;
    void* args[] = {&a};
    hipError_t e = hipLaunchCooperativeKernel((const void*)hybrid_fwd, dim3(grid), dim3(512), args, LDS_BYTES, stream);
    if (e != hipSuccess) fprintf(stderr, "cooperative launch failed: %s (grid %d)\n", hipGetErrorString(e), grid);
#endif
}
```

```cpp
#include <hip/hip_runtime.h>
#include <hip/hip_cooperative_groups.h>
#include <cstdio>
namespace cg = cooperative_groups;

#define LAS __attribute__((address_space(3)))
typedef unsigned short bf16_t;
typedef short bf16x8 __attribute__((ext_vector_type(8)));
typedef float f32x4 __attribute__((ext_vector_type(4)));
typedef unsigned u32x4 __attribute__((ext_vector_type(4)));
typedef unsigned u32x2 __attribute__((ext_vector_type(2)));

constexpr int DM = 1024, NB = 8, SEQ = 4096, CTXL = 256, DFF = 2816;
constexpr int MCTX = NB * CTXL, MLAT = NB * SEQ, MTOT = MCTX + MLAT;
constexpr int NMOD = 9;
constexpr float DN_ALPHA = 1.681792830507429f;
constexpr float LN_EPS = 1e-5f;
constexpr float LOG2E = 1.4426950408889634f;
constexpr int LDS_BYTES = 147456;

constexpr size_t E_FFN_IN = 0;
constexpr size_t E_FFN_OUT = E_FFN_IN + (size_t)8 * 5632 * 1024;
constexpr size_t E_RET_IN = E_FFN_OUT + (size_t)8 * 1024 * 2816;
constexpr size_t E_RET_OUT = E_RET_IN + (size_t)2 * 6144 * 1024;
constexpr size_t E_NA_QKV = E_RET_OUT + (size_t)2 * 1024 * 2048;
constexpr size_t E_NA_OUT = E_NA_QKV + (size_t)3072 * 1024;
constexpr size_t E_LRU_IN = E_NA_OUT + (size_t)1024 * 1024;
constexpr size_t E_LRU_OUT = E_LRU_IN + (size_t)2048 * 1024;
constexpr size_t E_GATES = E_LRU_OUT + (size_t)1024 * 1024;
constexpr size_t E_WT_END = E_GATES + (size_t)2 * 2048 * 256;
constexpr size_t R1 = (size_t)MTOT * 1024 * 2;
constexpr size_t WS_WT = 0;
constexpr size_t WS_U = WS_WT + E_WT_END * 2;
constexpr size_t WS_HC = WS_U + R1;
constexpr size_t WS_MOD = WS_HC + (size_t)MCTX * 1024 * 4;
constexpr size_t WS_ROPE = WS_MOD + (size_t)4 * 9 * 9216 * 4;
constexpr size_t WS_CARRY = WS_ROPE + (size_t)2 * 4096 * 4;
constexpr size_t WS_BAR = WS_CARRY + (size_t)NB * 68 * 1024 * 2 * 4;
constexpr size_t WS_BIG = WS_BAR + 16384;
constexpr size_t WS_END = WS_BIG + 6 * R1;

struct Args {
    const float* x; const float* c; const float* ctx; const float* c_ctx; const float* ada_w; const float* ada_b; const float* ln_g; const float* ln_b;
    const float* ffn_w_in; const float* ffn_w_out; const float* ret_w_in; const float* ret_w_out; const float* na_w_qkv; const float* na_rpb; const float* na_w_out;
    const float* lru_w_in; const float* lru_conv_w; const float* lru_conv_b; const float* lru_w_a; const float* lru_b_a; const float* lru_w_x; const float* lru_b_x;
    const float* lru_lam; const float* lru_w_out;
    float* out; unsigned char* ws; int ph_lo, ph_hi;
};

struct Grp { int b_lo, nb, rank, gsize; };
__device__ __forceinline__ int grp_row(const Grp& g, int lr) { const int b = g.b_lo + lr / 4352, t = lr % 4352; return t < 256 ? b * 256 + t : MCTX + b * 4096 + (t - 256); }
__device__ __forceinline__ int grp_row_lat(const Grp& g, int lr) { return MCTX + (g.b_lo + (lr >> 12)) * 4096 + (lr & 4095); }
__device__ __forceinline__ int otid() { int t = threadIdx.x; asm volatile("" : "+v"(t)); return t; }
__device__ __forceinline__ float shx(float v, int lane, int m) { return __int_as_float(__builtin_amdgcn_ds_bpermute((lane ^ m) << 2, __float_as_int(v))); }
__device__ __forceinline__ unsigned cvt_pk_bf16(float lo, float hi) { unsigned r; asm volatile("v_cvt_pk_bf16_f32 %0, %1, %2" : "=v"(r) : "v"(lo), "v"(hi)); return r; }
__device__ __forceinline__ float bflo(unsigned w) { return __uint_as_float(w << 16); }
__device__ __forceinline__ float bfhi(unsigned w) { return __uint_as_float(w & 0xffff0000u); }
__device__ __forceinline__ float bf2f(bf16_t b) { return __uint_as_float(((unsigned)b) << 16); }
__device__ __forceinline__ bf16_t f2bf(float f) { return (bf16_t)(cvt_pk_bf16(f, 0.f) & 0xffffu); }
__device__ __forceinline__ float silu_f(float x) { return x * __builtin_amdgcn_rcpf(1.f + __expf(-x)); }
__device__ __forceinline__ float sigmoid_f(float x) { return __builtin_amdgcn_rcpf(1.f + __expf(-x)); }
__device__ __forceinline__ float gelu_tanh_f(float x) { const float z = 0.7978845608028654f * (x + 0.044715f * x * x * x); const float t = 1.f - 2.f * __builtin_amdgcn_rcpf(__expf(2.f * z) + 1.f); return 0.5f * x * (1.f + t); }

namespace pg8 {
constexpr int BM = 256, BK = 64, HALF = 128, HTB = HALF * BK * 2  , STAGE_BYTES = 8 * HTB, NXCD = 8, WGM = 8;
__host__ __device__ __forceinline__ int lds_byte(int r, int c) { const int st = (r >> 4) * 2 + (c >> 5), rr = r & 15, cc = c & 31, ob = rr * 64 + cc * 2; return st * 1024 + (ob ^ (((ob >> 9) & 1) << 5)); }
__host__ __device__ __forceinline__ void stage_rc(int b, int& R, int& C) { const int st = b / 1024, sb = b % 1024, swz = sb ^ (((sb >> 9) & 1) << 5); R = (st >> 1) * 16 + swz / 64; C = (st & 1) * 32 + (swz % 64) / 2; }
__host__ __device__ __forceinline__ int perm32(int rho) { const int n = rho >> 4, i = rho & 15; return 8 * (i >> 2) + 4 * n + (i & 3); }

struct Unit { int pm, pn; };
struct Gemm { const bf16_t* A; const bf16_t* Bt; int M, N, K, lda, a_sh, a_cols; };

struct StaticOrder {
    int nM, nN, nwg, G, c;
    __host__ __device__ void init(int M, int N, int G_, int c_) { nM = M / BM; nN = N / BM; nwg = nM * nN; G = G_; c = c_; }
    __host__ __device__ bool next(int i, Unit& u) const {
        const long L = (long)i * G + c; if (L >= nwg) return false;
        int wgid = (int)L; { const int q = nwg / NXCD, r = nwg % NXCD, xcd = wgid % NXCD, off = wgid / NXCD; wgid = (xcd < r ? xcd * (q + 1) : r * (q + 1) + (xcd - r) * q) + off; }
        const int nig = WGM * nN, gid = wgid / nig, fm = gid * WGM, gsz = (nM - fm) < WGM ? (nM - fm) : WGM;
        u.pm = fm + ((wgid % nig) % gsz); u.pn = (wgid % nig) / gsz; return true;
    }
    __device__ __forceinline__ void a_ready(const Unit&) const {}
    __device__ __forceinline__ void done(const Unit&) const {}
};

struct GroupOrder {
    int nP, nN, nwg, G, c, b_lo, per, W;
    __device__ void init(int nb, int b_lo_, bool skipctx, int N, int G_, int c_) { per = skipctx ? 16 : 17; nP = nb * per; nN = N / BM; nwg = nP * nN; G = G_; c = c_; b_lo = b_lo_;
        const int ng = (nP + WGM - 1) / WGM; W = (nP + ng - 1) / ng; }
    __device__ bool next(int i, Unit& u) const {
        const long L = (long)i * G + c; if (L >= nwg) return false;
        const int wgid = (int)L, nig = W * nN, gid = wgid / nig, fm = gid * W, gsz = (nP - fm) < W ? (nP - fm) : W;
        const int lp = fm + ((wgid % nig) % gsz); u.pn = (wgid % nig) / gsz;
        const int b = b_lo + lp / per, j = lp % per;
        u.pm = (per == 16) ? 8 + 16 * b + j : (j == 0 ? b : 8 + 16 * b + j - 1);
        return true;
    }
    __device__ __forceinline__ void a_ready(const Unit&) const {}
    __device__ __forceinline__ void done(const Unit&) const {}
};

template <class Epi, class Sched>
__device__ __forceinline__ void gemm_phase(LAS unsigned char* lds, const Gemm g, const Sched& S, const Epi& E) {
    const int tid = otid(), wid = __builtin_amdgcn_readfirstlane(tid >> 6), lane = tid & 63, wr = wid >> 2, wc = wid & 3, fr = lane & 15, fq = lane >> 4;
    const int K = g.K, nt = K / BK, lda = g.lda;
    unsigned voffA[2], voffB[2];
#pragma unroll
    for (int i = 0; i < 2; ++i) { int R, C; stage_rc(tid * 16 + i * 8192, R, C); const int Rb = Epi::PERM ? ((R & ~31) + perm32(R & 31)) : R;
        voffA[i] = (unsigned)(R * lda + C) * 2u; voffB[i] = (unsigned)(Rb * K + C) * 2u; }
    const size_t kstep = (size_t)(BK * 2);
    const size_t hstepA = (size_t)HALF * lda * 2, hstepB = (size_t)HALF * K * 2;
    const size_t tstepA = 2 * hstepA, tstepB = 2 * hstepB;
    const unsigned ldsw = (unsigned)wid * 1024u;
    const int aoff = lds_byte(wr * 64 + fr, fq * 8), boff = lds_byte(wc * 32 + fr, fq * 8);
#define PG8_SA(b, h) (((b) * 2 + (h)) * HTB)
#define PG8_SB(b, h) ((4 + (b) * 2 + (h)) * HTB)
#define PG8_STAGE(bufoff, gbase, voff) do { _Pragma("unroll") for (int _i = 0; _i < 2; ++_i) \
        __builtin_amdgcn_global_load_lds((const unsigned*)((const char*)(gbase) + (voff)[_i]), (LAS unsigned*)(lds + (bufoff) + ldsw + _i * 8192), 16, 0, 0); } while (0)
#define PG8_LDA(dst, b, h) do { _Pragma("unroll") for (int m = 0; m < 4; ++m) _Pragma("unroll") for (int k = 0; k < 2; ++k) dst[m][k] = *(const LAS bf16x8*)(lds + PG8_SA(b, h) + aoff + m * 2048 + k * 1024); } while (0)
#define PG8_LDB(dst, b, h) do { _Pragma("unroll") for (int n = 0; n < 2; ++n) _Pragma("unroll") for (int k = 0; k < 2; ++k) dst[n][k] = *(const LAS bf16x8*)(lds + PG8_SB(b, h) + boff + n * 2048 + k * 1024); } while (0)
#define PG8_MMA(ai, bj, At, Bt) do { __builtin_amdgcn_s_setprio(1); _Pragma("unroll") for (int m = 0; m < 4; ++m) _Pragma("unroll") for (int n = 0; n < 2; ++n) _Pragma("unroll") for (int k = 0; k < 2; ++k) \
        acc[ai][bj][m][n] = __builtin_amdgcn_mfma_f32_16x16x32_bf16(Bt[n][k], At[m][k], acc[ai][bj][m][n], 0, 0, 0); __builtin_amdgcn_s_setprio(0); } while (0)
#define PG8_WAIT_V(n) asm volatile("s_waitcnt vmcnt(" #n ")" ::: "memory")
#define PG8_WAIT_L(n) asm volatile("s_waitcnt lgkmcnt(" #n ")" ::: "memory")
#define PG8_BAR __builtin_amdgcn_s_barrier()
#define PG8_SCHED __builtin_amdgcn_sched_barrier(0)
#define PG8_AOFF(u) ((size_t)(u).pm * tstepA + (size_t)(((u).pn >> g.a_sh) * g.a_cols) * 2)
    Unit cur, nxt; int ui = 0;
    if (!S.next(0, cur)) return;
    f32x4 acc[2][2][4][2];
#pragma unroll
    for (int a = 0; a < 2; ++a)
#pragma unroll
        for (int b = 0; b < 2; ++b)
#pragma unroll
            for (int m = 0; m < 4; ++m)
#pragma unroll
                for (int n = 0; n < 2; ++n) acc[a][b][m][n] = (f32x4){0.f, 0.f, 0.f, 0.f};
    bf16x8 At[4][2], B0[2][2], B1[2][2];
    const char* cA = (const char*)g.A + PG8_AOFF(cur); const char* cB = (const char*)g.Bt + (size_t)cur.pn * tstepB;
    S.a_ready(cur);
    PG8_STAGE(PG8_SB(0, 0), cB, voffB); PG8_STAGE(PG8_SA(0, 0), cA, voffA); PG8_STAGE(PG8_SB(0, 1), cB + hstepB, voffB); PG8_STAGE(PG8_SA(0, 1), cA + hstepA, voffA);
    if (wr == 1) PG8_BAR;
    PG8_WAIT_V(4); PG8_BAR;
    PG8_STAGE(PG8_SB(1, 0), cB + kstep, voffB); PG8_STAGE(PG8_SA(1, 0), cA + kstep, voffA); PG8_STAGE(PG8_SB(1, 1), cB + hstepB + kstep, voffB);
    PG8_WAIT_V(6); PG8_BAR;
    for (;;) {
        const bool has_next = S.next(ui + 1, nxt);
        const char* nA = has_next ? (const char*)g.A + PG8_AOFF(nxt) : cA; const char* nB = has_next ? (const char*)g.Bt + (size_t)nxt.pn * tstepB : cB;
        for (int t = 0; t < nt; t += 2) {
            const bool last = (t == nt - 2);
            const char* a1 = cA + (size_t)(t + 1) * kstep;
            const char* a2 = last ? nA : cA + (size_t)(t + 2) * kstep; const char* b2 = last ? nB : cB + (size_t)(t + 2) * kstep;
            const char* a3 = a2 + kstep; const char* b3 = b2 + kstep;
            if (last && has_next) S.a_ready(nxt);
            PG8_LDB(B0, 0, 0); PG8_SCHED; PG8_LDA(At, 0, 0); PG8_STAGE(PG8_SA(1, 1), a1 + hstepA, voffA);
            PG8_WAIT_L(8); PG8_BAR; PG8_WAIT_L(0); PG8_MMA(0, 0, At, B0); PG8_BAR; PG8_SCHED;
            PG8_LDB(B1, 0, 1); PG8_STAGE(PG8_SB(0, 0), b2, voffB);
            PG8_BAR; PG8_WAIT_L(0); PG8_MMA(0, 1, At, B1); PG8_BAR;
            PG8_LDA(At, 0, 1); PG8_STAGE(PG8_SA(0, 0), a2, voffA);
            PG8_BAR; PG8_WAIT_L(0); PG8_MMA(1, 0, At, B0); PG8_BAR; PG8_SCHED;
            PG8_STAGE(PG8_SB(0, 1), b2 + hstepB, voffB);
            PG8_WAIT_V(6); PG8_BAR; PG8_MMA(1, 1, At, B1); PG8_BAR;
            PG8_LDB(B0, 1, 0); PG8_SCHED; PG8_LDA(At, 1, 0); PG8_STAGE(PG8_SA(0, 1), a2 + hstepA, voffA);
            PG8_WAIT_L(8); PG8_BAR; PG8_WAIT_L(0); PG8_MMA(0, 0, At, B0); PG8_BAR; PG8_SCHED;
            PG8_LDB(B1, 1, 1); PG8_STAGE(PG8_SB(1, 0), b3, voffB);
            PG8_BAR; PG8_WAIT_L(0); PG8_MMA(0, 1, At, B1); PG8_BAR;
            PG8_LDA(At, 1, 1); PG8_STAGE(PG8_SA(1, 0), a3, voffA);
            PG8_BAR; PG8_WAIT_L(0); PG8_MMA(1, 0, At, B0); PG8_BAR; PG8_SCHED;
            PG8_STAGE(PG8_SB(1, 1), b3 + hstepB, voffB);
            PG8_WAIT_V(6); PG8_BAR; PG8_MMA(1, 1, At, B1); PG8_BAR;
        }
        E(acc, cur, wr, wc, fr, fq); S.done(cur);
        if (!has_next) break;
#pragma unroll
        for (int a = 0; a < 2; ++a)
#pragma unroll
            for (int b = 0; b < 2; ++b)
#pragma unroll
                for (int m = 0; m < 4; ++m)
#pragma unroll
                    for (int n = 0; n < 2; ++n) acc[a][b][m][n] = (f32x4){0.f, 0.f, 0.f, 0.f};
        cur = nxt; cA = nA; cB = nB; ++ui;
    }
    PG8_WAIT_V(0);
    if (wr == 0) PG8_BAR;
    PG8_BAR;
#undef PG8_SA
#undef PG8_SB
#undef PG8_STAGE
#undef PG8_LDA
#undef PG8_LDB
#undef PG8_MMA
#undef PG8_WAIT_V
#undef PG8_WAIT_L
#undef PG8_BAR
#undef PG8_SCHED
#undef PG8_AOFF
}
}

#define XB_TMO      128
#define XB_XCNT(j)  (256  + 64 * (j))
#define XB_XSUB(j)  (1280 + 64 * (j))
#define XB_XGEN(j)  (2304 + 64 * (j))
#define XB_TOP      3328
#define XB_TOPGEN   3392
#define XCD_BAR_WORDS 3456
#define XB_LSUB(j)  (3456 + 64 * (j))
#define XB_LGEN(j)  (3488 + 64 * (j))
#define XB_SPIN_CAP (1u << 21)
__device__ __forceinline__ unsigned xb_ld(unsigned* p)              { return __hip_atomic_load(p, __ATOMIC_RELAXED, __HIP_MEMORY_SCOPE_AGENT); }
__device__ __forceinline__ unsigned xb_add(unsigned* p, unsigned v) { return __hip_atomic_fetch_add(p, v, __ATOMIC_RELAXED, __HIP_MEMORY_SCOPE_AGENT); }
__device__ __forceinline__ unsigned xb_xcc_id() { return (unsigned)__builtin_amdgcn_s_getreg((3 << 11) | 20) & 0xFu; }
#define XB_SPIN(cond, bar) do { unsigned _sp = 0; while (cond) { __builtin_amdgcn_s_sleep(1); \
    if ((++_sp & 255u) == 0u) { if (xb_ld(&(bar)[XB_TMO])) break; if (_sp > XB_SPIN_CAP) { atomicAdd(&(bar)[XB_TMO], 1u); break; } } } } while (0)
__device__ __forceinline__ void xcd_barrier_complete(unsigned* bar, unsigned x, unsigned& nloc, unsigned& nx) {
    const unsigned G = gridDim.x * gridDim.y * gridDim.z;
    unsigned sum, cnt, mine, sp = 0u;
    for (;;) {
        sum = 0u; cnt = 0u; mine = 0u;
#pragma unroll
        for (unsigned j = 0; j < 16; ++j) { const unsigned c = xb_ld(&bar[XB_XCNT(j)]); sum += c; cnt += (c > 0u) ? 1u : 0u; mine = (j == x) ? c : mine; }
        if (sum == G) break;
        __builtin_amdgcn_s_sleep(1);
        if ((++sp & 255u) == 0u) { if (xb_ld(&bar[XB_TMO])) break; if (sp > XB_SPIN_CAP) { atomicAdd(&bar[XB_TMO], 1u); break; } }
    }
    nloc = mine > 0u ? mine : 1u; nx = cnt > 0u ? cnt : 1u;
}
__device__ __forceinline__ void xcd_barrier(unsigned* bar, volatile LAS unsigned* st) {
    asm volatile("s_waitcnt vmcnt(0)" ::: "memory");
    __syncthreads();
    if (threadIdx.x == 0) {
        const unsigned x = xb_xcc_id();
        __builtin_amdgcn_s_waitcnt(0);
        unsigned nloc = st[0], nx = st[1];
        if (nloc == 0u) { xcd_barrier_complete(bar, x, nloc, nx); st[0] = nloc; st[1] = nx; }
        const unsigned old = xb_add(&bar[XB_XSUB(x)], 1u);
        const unsigned gen = old / nloc;
        if (old + 1u == (gen + 1u) * nloc) {
            __builtin_amdgcn_fence(__ATOMIC_RELEASE, "agent");
            asm volatile("s_waitcnt vmcnt(0)" ::: "memory");
            const unsigned og = xb_add(&bar[XB_TOP], 1u);
            const unsigned tg = og / nx;
            if (og + 1u == (tg + 1u) * nx) xb_add(&bar[XB_TOPGEN], 1u);
            else XB_SPIN(xb_ld(&bar[XB_TOPGEN]) == tg, bar);
            __builtin_amdgcn_fence(__ATOMIC_ACQUIRE, "agent");
            xb_add(&bar[XB_XGEN(x)], 1u);
            asm volatile("s_waitcnt vmcnt(0)" ::: "memory");
        } else {
            XB_SPIN(xb_ld(&bar[XB_XGEN(x)]) == gen, bar);
            __builtin_amdgcn_fence(__ATOMIC_ACQUIRE, "agent");
            asm volatile("s_waitcnt vmcnt(0)" ::: "memory");
        }
    }
    __syncthreads();
}

__device__ __forceinline__ void xcd_local_barrier(unsigned* bar, unsigned x, unsigned nloc) {
    asm volatile("s_waitcnt vmcnt(0)" ::: "memory");
    __syncthreads();
    if (threadIdx.x == 0) {
        __builtin_amdgcn_s_waitcnt(0);
        const unsigned old = xb_add(&bar[XB_LSUB(x)], 1u), gen = old / nloc;
        if (old + 1u == (gen + 1u) * nloc) xb_add(&bar[XB_LGEN(x)], 1u);
        else XB_SPIN(xb_ld(&bar[XB_LGEN(x)]) == gen, bar);
        __builtin_amdgcn_fence(__ATOMIC_ACQUIRE, "agent");
        asm volatile("s_waitcnt vmcnt(0)" ::: "memory");
    }
    __syncthreads();
}
struct EpiSwiGLU {
    static constexpr bool PERM = true;
    bf16_t* H; int row_off;
    __device__ __forceinline__ void operator()(const f32x4 (&acc)[2][2][4][2], const pg8::Unit& u, int wr, int wc, int fr, int fq) const {
        const int row0 = row_off + u.pm * 256 + wr * 64 + fr, hc = u.pn * 128 + wc * 32 + 8 * fq;
#pragma unroll
        for (int ai = 0; ai < 2; ++ai)
#pragma unroll
            for (int m = 0; m < 4; ++m) {
                bf16_t* rowp = H + (size_t)(row0 + ai * 128 + m * 16) * DFF + hc;
                const f32x4 g0 = acc[ai][0][m][0], g1 = acc[ai][0][m][1], u0 = acc[ai][1][m][0], u1 = acc[ai][1][m][1];
                u32x4 w;
                w.x = cvt_pk_bf16(silu_f(g0[0]) * u0[0], silu_f(g0[1]) * u0[1]); w.y = cvt_pk_bf16(silu_f(g0[2]) * u0[2], silu_f(g0[3]) * u0[3]);
                w.z = cvt_pk_bf16(silu_f(g1[0]) * u1[0], silu_f(g1[1]) * u1[1]); w.w = cvt_pk_bf16(silu_f(g1[2]) * u1[2], silu_f(g1[3]) * u1[3]);
                *(u32x4*)rowp = w;
            }
    }
};
struct EpiPlain {
    static constexpr bool PERM = true;
    bf16_t* O; int ldc; int row_off; int split_cols; size_t split_stride; float scale0; int headmajor;
    __device__ __forceinline__ void operator()(const f32x4 (&acc)[2][2][4][2], const pg8::Unit& u, int wr, int wc, int fr, int fq) const {
        const int row0 = row_off + u.pm * 256 + wr * 64 + fr; int colt = u.pn * 256; bf16_t* base = O; float sc = scale0; int t = 0;
        if (split_cols) { t = colt / split_cols; base += (size_t)t * split_stride; colt -= t * split_cols; if (t) sc = 1.f; }
        const int col0 = colt + wc * 32 + 8 * fq; const bool hm = headmajor && t > 0;
        const size_t rstride = hm ? 64 : (size_t)ldc;
        const size_t cofs0 = hm ? (size_t)(col0 >> 6) * MTOT * 64 + (col0 & 63) : (size_t)col0, cofs1 = hm ? (size_t)((col0 + 128) >> 6) * MTOT * 64 + ((col0 + 128) & 63) : (size_t)col0 + 128;
#pragma unroll
        for (int ai = 0; ai < 2; ++ai)
#pragma unroll
            for (int m = 0; m < 4; ++m) { bf16_t* rowp = base + (size_t)(row0 + ai * 128 + m * 16) * rstride;
#pragma unroll
                for (int bj = 0; bj < 2; ++bj) { const f32x4 v0 = acc[ai][bj][m][0] * sc, v1 = acc[ai][bj][m][1] * sc;
                    u32x4 w; w.x = cvt_pk_bf16(v0[0], v0[1]); w.y = cvt_pk_bf16(v0[2], v0[3]); w.z = cvt_pk_bf16(v1[0], v1[1]); w.w = cvt_pk_bf16(v1[2], v1[3]);
                    *(u32x4*)(rowp + (bj ? cofs1 : cofs0)) = w; } }
    }
};
struct EpiRetIn {
    static constexpr bool PERM = true;
    bf16_t* Q; bf16_t* K; bf16_t* V; const float* rcos; const float* rsin;
    __device__ __forceinline__ void operator()(const f32x4 (&acc)[2][2][4][2], const pg8::Unit& u, int wr, int wc, int fr, int fq) const {
        const int row0 = u.pm * 256 + wr * 64 + fr, cin = wc * 32 + 8 * fq;
        if (u.pn >= 8) {
#pragma unroll
            for (int ai = 0; ai < 2; ++ai)
#pragma unroll
                for (int m = 0; m < 4; ++m) { bf16_t* rowp = V + (size_t)(row0 + ai * 128 + m * 16) * 2048 + (u.pn - 8) * 256 + cin;
#pragma unroll
                    for (int bj = 0; bj < 2; ++bj) { const f32x4 v0 = acc[ai][bj][m][0], v1 = acc[ai][bj][m][1];
                        u32x4 w; w.x = cvt_pk_bf16(v0[0], v0[1]); w.y = cvt_pk_bf16(v0[2], v0[3]); w.z = cvt_pk_bf16(v1[0], v1[1]); w.w = cvt_pk_bf16(v1[2], v1[3]);
                        *(u32x4*)(rowp + bj * 128) = w; } }
        } else {
            bf16_t* T = (u.pn < 4) ? Q : K; const float mul = (u.pn < 4) ? 1.f : 0.0625f; const int f0 = wc * 16 + 4 * fq;
#pragma unroll
            for (int ai = 0; ai < 2; ++ai)
#pragma unroll
                for (int m = 0; m < 4; ++m) { const int row = row0 + ai * 128 + m * 16; bf16_t* rowp = T + (size_t)row * 1024 + (u.pn & 3) * 256 + cin;
                    const bool lat = row >= MCTX; const int t = (row - MCTX) & 4095;
#pragma unroll
                    for (int bj = 0; bj < 2; ++bj) { f32x4 v0 = acc[ai][bj][m][0] * mul, v1 = acc[ai][bj][m][1] * mul;
                        if (lat) { const int pos = bj ? (t & 63) : (t >> 6); const f32x4 cs = *(const f32x4*)(rcos + pos * 64 + f0), sn = *(const f32x4*)(rsin + pos * 64 + f0);
                            const f32x4 a0 = v0, a1 = v1;
                            v0[0] = a0[0] * cs[0] - a0[1] * sn[0]; v0[1] = a0[0] * sn[0] + a0[1] * cs[0]; v0[2] = a0[2] * cs[1] - a0[3] * sn[1]; v0[3] = a0[2] * sn[1] + a0[3] * cs[1];
                            v1[0] = a1[0] * cs[2] - a1[1] * sn[2]; v1[1] = a1[0] * sn[2] + a1[1] * cs[2]; v1[2] = a1[2] * cs[3] - a1[3] * sn[3]; v1[3] = a1[2] * sn[3] + a1[3] * cs[3]; }
                        u32x4 w; w.x = cvt_pk_bf16(v0[0], v0[1]); w.y = cvt_pk_bf16(v0[2], v0[3]); w.z = cvt_pk_bf16(v1[0], v1[1]); w.w = cvt_pk_bf16(v1[2], v1[3]);
                        *(u32x4*)(rowp + bj * 128) = w; } }
        }
    }
};
struct EpiGates {
    static constexpr bool PERM = true;
    bf16_t* GP;
    __device__ __forceinline__ void operator()(const f32x4 (&acc)[2][2][4][2], const pg8::Unit& u, int wr, int wc, int fr, int fq) const {
        const int row0 = u.pm * 256 + wr * 64 + fr, col0 = (u.pn & 1) * 1024 + (u.pn >> 1) * 256 + wc * 32 + 8 * fq;
#pragma unroll
        for (int ai = 0; ai < 2; ++ai)
#pragma unroll
            for (int m = 0; m < 4; ++m) { bf16_t* rowp = GP + (size_t)(row0 + ai * 128 + m * 16) * 2048 + col0;
#pragma unroll
                for (int bj = 0; bj < 2; ++bj) { const f32x4 v0 = acc[ai][bj][m][0], v1 = acc[ai][bj][m][1];
                    u32x4 w; w.x = cvt_pk_bf16(v0[0], v0[1]); w.y = cvt_pk_bf16(v0[2], v0[3]); w.z = cvt_pk_bf16(v1[0], v1[1]); w.w = cvt_pk_bf16(v1[2], v1[3]);
                    *(u32x4*)(rowp + bj * 128) = w; } }
    }
};

struct CvtJob { const float* src; bf16_t* dst; int K, N, ld, perm; };
__device__ __forceinline__ CvtJob get_job(const Args& a, int j) {
    bf16_t* wt = (bf16_t*)(a.ws + WS_WT); CvtJob r;
    if (j < 8)       { r.src = a.ffn_w_in + (size_t)j * 1024 * 5632; r.dst = wt + E_FFN_IN + (size_t)j * 5632 * 1024; r.K = 1024; r.N = 5632; r.ld = 5632; r.perm = 1; }
    else if (j < 16) { const int i = j - 8; r.src = a.ffn_w_out + (size_t)i * 2816 * 1024; r.dst = wt + E_FFN_OUT + (size_t)i * 1024 * 2816; r.K = 2816; r.N = 1024; r.ld = 1024; r.perm = 0; }
    else if (j < 18) { const int i = j - 16; r.src = a.ret_w_in + (size_t)i * 1024 * 6144; r.dst = wt + E_RET_IN + (size_t)i * 6144 * 1024; r.K = 1024; r.N = 6144; r.ld = 6144; r.perm = 2; }
    else if (j < 20) { const int i = j - 18; r.src = a.ret_w_out + (size_t)i * 2048 * 1024; r.dst = wt + E_RET_OUT + (size_t)i * 1024 * 2048; r.K = 2048; r.N = 1024; r.ld = 1024; r.perm = 0; }
    else if (j == 20) { r.src = a.na_w_qkv; r.dst = wt + E_NA_QKV; r.K = 1024; r.N = 3072; r.ld = 3072; r.perm = 0; }
    else if (j == 21) { r.src = a.na_w_out; r.dst = wt + E_NA_OUT; r.K = 1024; r.N = 1024; r.ld = 1024; r.perm = 0; }
    else if (j == 22) { r.src = a.lru_w_in; r.dst = wt + E_LRU_IN; r.K = 1024; r.N = 2048; r.ld = 2048; r.perm = 0; }
    else if (j == 23) { r.src = a.lru_w_out; r.dst = wt + E_LRU_OUT; r.K = 1024; r.N = 1024; r.ld = 1024; r.perm = 0; }
    else { const int gI = j - 24, dir = gI >> 3, type = (gI >> 2) & 1, k = gI & 3;
        r.src = (type ? a.lru_w_x : a.lru_w_a) + (size_t)(dir * 4 + k) * 256 * 256; r.dst = wt + E_GATES + (size_t)dir * 2048 * 256 + (size_t)((k * 2 + type) * 256) * 256; r.K = 256; r.N = 256; r.ld = 256; r.perm = 0; }
    return r;
}
__device__ __forceinline__ int perm_col(int perm, int n) {
    if (perm == 1) return ((n & 255) >> 7) * 2816 + (n >> 8) * 128 + (n & 127);
    if (perm == 2) { if (n < 2048) { const int hb = n >> 8, dp = n & 255, p = dp >> 1, e = dp & 1; const int d = (p < 64) ? (p + 64 * e) : (128 + (p - 64) + 64 * e); return hb * 256 + d; } return n; }
    return n;
}
__device__ __forceinline__ void phase_prologue(const Args& a, LAS unsigned char* lds) {
    const int tid = otid(), G = gridDim.x;
    { LAS bf16_t* tile = (LAS bf16_t*)lds;
      int cum = 0;
      for (int j = 0; j < 40; ++j) {
          const CvtJob jb = get_job(a, j);
          const int tn = jb.N >> 6, ntile = tn * (jb.K >> 6);
          const int first = (int)((blockIdx.x + G - (cum % G)) % G);
          for (int t = first; t < ntile; t += G) {
              const int n0 = (t % tn) * 64, k0 = (t / tn) * 64, c = tid & 63, kr = tid >> 6;
              const float* sp = jb.src + (size_t)k0 * jb.ld + perm_col(jb.perm, n0 + c);
              float v[8];
#pragma unroll
              for (int i = 0; i < 8; ++i) v[i] = sp[(size_t)(kr + 8 * i) * jb.ld];
#pragma unroll
              for (int i = 0; i < 8; ++i) tile[c * 72 + kr + 8 * i] = f2bf(v[i]);
              __syncthreads();
              const int row = tid >> 3, ch = tid & 7;
              const u32x4 w = *(const LAS u32x4*)(tile + row * 72 + ch * 8);
              *(u32x4*)(jb.dst + (size_t)(n0 + row) * jb.K + k0 + ch * 8) = w;
              __syncthreads();
          }
          cum += ntile;
      } }
    { LAS float* sv = (LAS float*)lds; LAS float* red = sv + 9 * 1024; float* MOD = (float*)(a.ws + WS_MOD);
      for (int i = tid; i < 9 * 1024; i += 512) { const int r = i >> 10, k = i & 1023; const float cv = (r < 8) ? a.c[r * 1024 + k] : a.c_ctx[k]; sv[i] = cv / (1.f + expf(-cv)); }
      __syncthreads();
      for (int it = blockIdx.x; it < 288; it += G) {
          const int l = it / 72, cb = it % 72, cl = tid & 127, kq = tid >> 7;
          const float* W = a.ada_w + (size_t)l * 1024 * 9216 + cb * 128 + cl;
          float acc[9];
#pragma unroll
          for (int r = 0; r < 9; ++r) acc[r] = 0.f;
          for (int k = kq * 256; k < kq * 256 + 256; k += 4) {
              float w[4];
#pragma unroll
              for (int q = 0; q < 4; ++q) w[q] = W[(size_t)(k + q) * 9216];
#pragma unroll
              for (int q = 0; q < 4; ++q)
#pragma unroll
                  for (int r = 0; r < 9; ++r) acc[r] += sv[r * 1024 + k + q] * w[q];
          }
#pragma unroll
          for (int r = 0; r < 9; ++r) red[(kq * 9 + r) * 128 + cl] = acc[r];
          __syncthreads();
          for (int o = tid; o < 9 * 128; o += 512) { const int r = o >> 7, cc = o & 127, col = cb * 128 + cc;
              const float s = (red[(0 * 9 + r) * 128 + cc] + red[(1 * 9 + r) * 128 + cc]) + (red[(2 * 9 + r) * 128 + cc] + red[(3 * 9 + r) * 128 + cc]);
              MOD[(size_t)(l * 9 + r) * 9216 + col] = s + a.ada_b[l * 9216 + col]; }
          __syncthreads();
      } }
    { float* rc = (float*)(a.ws + WS_ROPE); float* rs = rc + 4096;
      for (int i = blockIdx.x * 512 + tid; i < 4096; i += G * 512) { const int pos = i >> 6, f = i & 63; const float fr = expf(-(float)(2 * f) * (1.f / 128.f) * 9.210340371976184f); const float ang = (float)pos * fr;
          rc[i] = cosf(ang); rs[i] = sinf(ang); } }
}

__device__ __forceinline__ void phase_u0(const Args& a, const Grp& gp) {
    const float* MOD = (const float*)(a.ws + WS_MOD); bf16_t* U = (bf16_t*)(a.ws + WS_U);
    for (int i = gp.rank * 512 + otid(); i < gp.nb * 4352 * 128; i += gp.gsize * 512) {
        const int row = grp_row(gp, i >> 7), c8 = (i & 127) * 8; const int r9 = row < MCTX ? 8 : (row - MCTX) >> 12;
        const float* hp = (row < MCTX ? a.ctx + (size_t)row * 1024 : a.x + (size_t)(row - MCTX) * 1024) + c8;
        const float* sh = MOD + (size_t)(r9 * 9 + 0) * 1024 + c8; const float* sc = sh + 1024;
        const f32x4 h0 = *(const f32x4*)hp, h1 = *(const f32x4*)(hp + 4), s0 = *(const f32x4*)sh, s1 = *(const f32x4*)(sh + 4), c0 = *(const f32x4*)sc, c1 = *(const f32x4*)(sc + 4);
        const f32x4 o0 = h0 * (c0 + 1.f) + s0, o1 = h1 * (c1 + 1.f) + s1;
        u32x4 w; w.x = cvt_pk_bf16(o0[0], o0[1]); w.y = cvt_pk_bf16(o0[2], o0[3]); w.z = cvt_pk_bf16(o1[0], o1[1]); w.w = cvt_pk_bf16(o1[2], o1[3]);
        *(u32x4*)(U + (size_t)row * 1024 + c8) = w;
    }
}

__device__ __forceinline__ void phase_postnorm(const Args& a, bool first, const bf16_t* Y, const float* modl, int gate_j, float ymul, const float* lng, const float* lnb,
                                               const float* modn, int sh_j, int row_begin, const Grp& gp) {
    const int tid = otid(), lane = tid & 63, gw = gp.rank * 8 + (tid >> 6), nw = gp.gsize * 8;
    const int nrows = gp.nb * (row_begin ? 4096 : 4352);
    float* HC = (float*)(a.ws + WS_HC); bf16_t* U = (bf16_t*)(a.ws + WS_U);
    f32x4 hr[2][4]; u32x2 yr[2][4];
#define PN_MAP(lr) (row_begin ? grp_row_lat(gp, (lr)) : grp_row(gp, (lr)))
#define PN_ROW(t, lA) PN_MAP((t) ? (((lA) + nw < nrows) ? (lA) + nw : (lA)) : (lA))
#define PN_LOAD(dstH, dstY, rA) do { _Pragma("unroll") for (int t = 0; t < 2; ++t) { const int row = PN_ROW(t, rA); const bool isc = row < MCTX; \
        const float* hin = first ? (isc ? a.ctx + (size_t)row * 1024 : a.x + (size_t)(row - MCTX) * 1024) : (isc ? HC + (size_t)row * 1024 : a.out + (size_t)(row - MCTX) * 1024); \
        const bf16_t* yp = Y + (size_t)row * 1024; \
        _Pragma("unroll") for (int c = 0; c < 4; ++c) { const int col = c * 256 + lane * 4; dstH[t][c] = *(const f32x4*)(hin + col); dstY[t][c] = *(const u32x2*)(yp + col); } } } while (0)
    f32x4 gv[4], bv[4];
#pragma unroll
    for (int c = 0; c < 4; ++c) { gv[c] = *(const f32x4*)(lng + c * 256 + lane * 4); bv[c] = *(const f32x4*)(lnb + c * 256 + lane * 4); }
    int rowA = gw;
    if (rowA < nrows) PN_LOAD(hr, yr, rowA);
    for (; rowA < nrows; rowA += 2 * nw) {
        const bool hasB = rowA + nw < nrows;
        f32x4 v[2][4]; float s[2] = {0.f, 0.f}, q[2] = {0.f, 0.f};
#pragma unroll
        for (int t = 0; t < 2; ++t) { const int row = PN_ROW(t, rowA); const int r9 = row < MCTX ? 8 : (row - MCTX) >> 12;
            const float* gate = modl + (size_t)(r9 * 9 + gate_j) * 1024;
#pragma unroll
            for (int c = 0; c < 4; ++c) { const int col = c * 256 + lane * 4; const f32x4 gt = *(const f32x4*)(gate + col);
                const f32x4 y = {bflo(yr[t][c].x), bfhi(yr[t][c].x), bflo(yr[t][c].y), bfhi(yr[t][c].y)};
                v[t][c] = hr[t][c] * DN_ALPHA + gt * y * ymul; s[t] += (v[t][c][0] + v[t][c][1]) + (v[t][c][2] + v[t][c][3]);
                q[t] += (v[t][c][0] * v[t][c][0] + v[t][c][1] * v[t][c][1]) + (v[t][c][2] * v[t][c][2] + v[t][c][3] * v[t][c][3]); } }
        const int rowN = rowA + 2 * nw;
        if (rowN < nrows) PN_LOAD(hr, yr, rowN);
#pragma unroll
        for (int o = 32; o >= 1; o >>= 1) { const float s0 = shx(s[0], lane, o), s1 = shx(s[1], lane, o), q0 = shx(q[0], lane, o), q1 = shx(q[1], lane, o); s[0] += s0; s[1] += s1; q[0] += q0; q[1] += q1; }
#pragma unroll
        for (int t = 0; t < 2; ++t) { if (t && !hasB) break; const int row = PN_MAP(t ? rowA + nw : rowA);
            const bool isc = row < MCTX; const int r9 = isc ? 8 : (row - MCTX) >> 12;
            float* hout = isc ? HC + (size_t)row * 1024 : a.out + (size_t)(row - MCTX) * 1024;
            const float mean = s[t] * (1.f / 1024.f); const float var = fmaxf(q[t] * (1.f / 1024.f) - mean * mean, 0.f);
            const float rstd = 1.0f / sqrtf(var + LN_EPS);
#pragma unroll
            for (int c = 0; c < 4; ++c) { const int col = c * 256 + lane * 4;
                const f32x4 hn = (v[t][c] - mean) * rstd * gv[c] + bv[c]; *(f32x4*)(hout + col) = hn;
                if (sh_j >= 0) { const f32x4 sh = *(const f32x4*)(modn + (size_t)(r9 * 9 + sh_j) * 1024 + col), sc = *(const f32x4*)(modn + (size_t)(r9 * 9 + sh_j + 1) * 1024 + col);
                    const f32x4 o = hn * (sc + 1.f) + sh; u32x2 w; w.x = cvt_pk_bf16(o[0], o[1]); w.y = cvt_pk_bf16(o[2], o[3]); *(u32x2*)(U + (size_t)row * 1024 + col) = w; } } }
    }
#undef PN_LOAD
#undef PN_ROW
#undef PN_MAP
}
template <int RABL>
__device__ __forceinline__ void phase_retention(const Args& a, LAS unsigned char* lds, const Grp& gp) {
    const bf16_t* Qg = (const bf16_t*)(a.ws + WS_BIG); const bf16_t* Kg = (const bf16_t*)(a.ws + WS_BIG + R1); const bf16_t* Vg = (const bf16_t*)(a.ws + WS_BIG + 2 * R1); bf16_t* Og = (bf16_t*)(a.ws + WS_BIG + 4 * R1);
    const int tid = otid(), w = __builtin_amdgcn_readfirstlane(tid >> 6), lane = tid & 63, c = lane & 15, g = lane >> 4;
    const int ib = w & 3, vh = w >> 2, vb2 = w & 3, dbase = (w >> 2) * 8;
    constexpr int QS = 0, KS = 32768, VS = 65536, ST = 73728;
    typedef short s16x4 __attribute__((ext_vector_type(4)));
    for (int item = gp.rank; item < gp.nb * 32; item += gp.gsize) {
        const int b = gp.b_lo + (item >> 5), h = (item >> 3) & 3, vs = item & 7;
        f32x4 accS[8]; u32x4 qreg[4], kreg[4], vreg; float lg = 0.f, g64 = 0.f;
        { const int row0 = b * 256;
#pragma unroll
          for (int i = 0; i < 4; ++i) { const int idx = tid + 512 * i, row = idx >> 5, ch = idx & 31; const size_t o = (size_t)(row0 + row) * 1024 + h * 256 + ch * 8; qreg[i] = *(const u32x4*)(Qg + o); kreg[i] = *(const u32x4*)(Kg + o); }
          vreg = *(const u32x4*)(Vg + (size_t)(row0 + (tid >> 3)) * 2048 + h * 512 + vs * 64 + (tid & 7) * 8); }
        for (int step = 0; step < 136; ++step) {
            const int dir = step >= 68 ? 1 : 0, s = step - 68 * dir;
            if (s == 0) {
#pragma unroll
                for (int x = 0; x < 8; ++x) accS[x] = (f32x4){0.f, 0.f, 0.f, 0.f};
                const int hh = dir ? 3 - h : h; lg = log2f(1.0f - exp2f(-5.0f - (float)hh)); g64 = exp2f(64.f * lg);
            }
            const int row0 = dir ? (s < 4 ? b * 256 + 64 * (3 - s) : MCTX + b * 4096 + 64 * (63 - (s - 4))) : (s < 4 ? b * 256 + 64 * s : MCTX + b * 4096 + 64 * (s - 4));
            __syncthreads();
            if (RABL != 1)
#pragma unroll
            for (int x = 0; x < 8; ++x) { const int d = 16 * (dbase + x) + c;
#pragma unroll
                for (int r = 0; r < 4; ++r) { const int v = 16 * vb2 + 4 * g + r; *(LAS bf16_t*)(lds + ST + v * 512 + (((d >> 3) ^ (v & 15)) << 4) + (d & 7) * 2) = f2bf(accS[x][r]); } }
#pragma unroll
            for (int i = 0; i < 4; ++i) { const int idx = tid + 512 * i, row = idx >> 5, ch = idx & 31; const int off = row * 512 + ((ch ^ (row & 15)) << 4);
                *(LAS u32x4*)(lds + QS + off) = qreg[i]; *(LAS u32x4*)(lds + KS + off) = kreg[i]; }
            { const int j = tid >> 3, ch = tid & 7; *(LAS u32x4*)(lds + VS + j * 128 + ((ch ^ ((j >> 1) & 7)) << 4)) = vreg; }
            __syncthreads();
            if (step + 1 < 136) { const int st2 = step + 1, dir2 = st2 >= 68 ? 1 : 0, s2 = st2 - 68 * dir2;
                const int nrow0 = dir2 ? (s2 < 4 ? b * 256 + 64 * (3 - s2) : MCTX + b * 4096 + 64 * (63 - (s2 - 4))) : (s2 < 4 ? b * 256 + 64 * s2 : MCTX + b * 4096 + 64 * (s2 - 4));
#pragma unroll
                for (int i = 0; i < 4; ++i) { const int idx = tid + 512 * i, row = idx >> 5, ch = idx & 31; const size_t o = (size_t)(nrow0 + row) * 1024 + h * 256 + ch * 8; qreg[i] = *(const u32x4*)(Qg + o); kreg[i] = *(const u32x4*)(Kg + o); }
                vreg = *(const u32x4*)(Vg + (size_t)(nrow0 + (tid >> 3)) * 2048 + h * 512 + vs * 64 + (tid & 7) * 8); }
            if (RABL == 2) continue;
            const int iq = 16 * ib + c;
            f32x4 accs[4], acco[2];
#pragma unroll
            for (int jb = 0; jb < 4; ++jb) accs[jb] = (f32x4){0.f, 0.f, 0.f, 0.f};
            acco[0] = (f32x4){0.f, 0.f, 0.f, 0.f}; acco[1] = (f32x4){0.f, 0.f, 0.f, 0.f};
#pragma unroll 1
            for (int ks = 0; ks < 8; ++ks) {
                const int sw = ((4 * ks + g) ^ c) << 4;
                const bf16x8 qf = *(const LAS bf16x8*)(lds + QS + iq * 512 + sw);
#pragma unroll
                for (int jb = 0; jb < 4; ++jb) { const bf16x8 kf = *(const LAS bf16x8*)(lds + KS + (16 * jb + c) * 512 + sw); accs[jb] = __builtin_amdgcn_mfma_f32_16x16x32_bf16(kf, qf, accs[jb], 0, 0, 0); }
#pragma unroll
                for (int vb = 0; vb < 2; ++vb) { const bf16x8 sf = *(const LAS bf16x8*)(lds + ST + (16 * (2 * vh + vb) + c) * 512 + sw); acco[vb] = __builtin_amdgcn_mfma_f32_16x16x32_bf16(sf, qf, acco[vb], 0, 0, 0); }
            }
            { const float qd = __builtin_amdgcn_exp2f(lg * (float)(dir ? 64 - iq : iq + 1)); acco[0] *= qd; acco[1] *= qd; }
#pragma unroll
            for (int jb = 0; jb < 4; ++jb)
#pragma unroll
                for (int r = 0; r < 4; ++r) { const int j = 16 * jb + 4 * g + r; const int df = dir ? j - iq : iq - j; const bool vis = dir ? (df > 0) : (df >= 0);
                    accs[jb][r] = vis ? accs[jb][r] * __builtin_amdgcn_exp2f(lg * (float)df) : 0.f; }
#pragma unroll
            for (int s2 = 0; s2 < 2; ++s2) {
                u32x4 pw; pw.x = cvt_pk_bf16(accs[2 * s2][0], accs[2 * s2][1]); pw.y = cvt_pk_bf16(accs[2 * s2][2], accs[2 * s2][3]); pw.z = cvt_pk_bf16(accs[2 * s2 + 1][0], accs[2 * s2 + 1][1]); pw.w = cvt_pk_bf16(accs[2 * s2 + 1][2], accs[2 * s2 + 1][3]);
                const bf16x8 pf = __builtin_bit_cast(bf16x8, pw);
#pragma unroll
                for (int vb = 0; vb < 2; ++vb) { const int vblk = 2 * vh + vb, ra = 32 * s2 + 4 * g + (c >> 2), rbb = ra + 16, cch = 2 * vblk + ((c & 3) >> 1);
                    const s16x4 lo = __builtin_amdgcn_ds_read_tr16_b64_v4i16((LAS s16x4*)(lds + VS + ra * 128 + ((cch ^ ((ra >> 1) & 7)) << 4) + 8 * (c & 1)));
                    const s16x4 hi = __builtin_amdgcn_ds_read_tr16_b64_v4i16((LAS s16x4*)(lds + VS + rbb * 128 + ((cch ^ ((rbb >> 1) & 7)) << 4) + 8 * (c & 1)));
                    const bf16x8 vf = {lo[0], lo[1], lo[2], lo[3], hi[0], hi[1], hi[2], hi[3]};
                    acco[vb] = __builtin_amdgcn_mfma_f32_16x16x32_bf16(vf, pf, acco[vb], 0, 0, 0); }
            }
#pragma unroll
            for (int vb = 0; vb < 2; ++vb) { bf16_t* op = Og + (size_t)(row0 + iq) * 2048 + h * 512 + vs * 64 + 16 * (2 * vh + vb) + 4 * g; f32x4 o = acco[vb];
                if (dir) { const u32x2 pv = *(const u32x2*)op; o[0] += bflo(pv.x); o[1] += bfhi(pv.x); o[2] += bflo(pv.y); o[3] += bfhi(pv.y); }
                u32x2 ow; ow.x = cvt_pk_bf16(o[0], o[1]); ow.y = cvt_pk_bf16(o[2], o[3]); *(u32x2*)op = ow; }
            { bf16x8 af[2];
              const int tq = c >> 2, tp = c & 3;
#pragma unroll
              for (int k2 = 0; k2 < 2; ++k2) { const int r0 = 32 * k2 + 8 * g + tq, r1 = r0 + 4, cch = 2 * vb2 + (tp >> 1);
                  const s16x4 t0 = __builtin_amdgcn_ds_read_tr16_b64_v4i16((LAS s16x4*)(lds + VS + r0 * 128 + ((cch ^ ((r0 >> 1) & 7)) << 4) + 8 * (tp & 1)));
                  const s16x4 t1 = __builtin_amdgcn_ds_read_tr16_b64_v4i16((LAS s16x4*)(lds + VS + r1 * 128 + ((cch ^ ((r1 >> 1) & 7)) << 4) + 8 * (tp & 1)));
                  const int j0 = 32 * k2 + 8 * g; float kd[8];
#pragma unroll
                  for (int e = 0; e < 8; ++e) kd[e] = __builtin_amdgcn_exp2f(lg * (float)(dir ? j0 + e : 63 - j0 - e));
                  u32x4 aw; aw.x = cvt_pk_bf16(bf2f((bf16_t)t0[0]) * kd[0], bf2f((bf16_t)t0[1]) * kd[1]); aw.y = cvt_pk_bf16(bf2f((bf16_t)t0[2]) * kd[2], bf2f((bf16_t)t0[3]) * kd[3]);
                  aw.z = cvt_pk_bf16(bf2f((bf16_t)t1[0]) * kd[4], bf2f((bf16_t)t1[1]) * kd[5]); aw.w = cvt_pk_bf16(bf2f((bf16_t)t1[2]) * kd[6], bf2f((bf16_t)t1[3]) * kd[7]);
                  af[k2] = __builtin_bit_cast(bf16x8, aw); }
#pragma unroll
              for (int x = 0; x < 8; ++x) { accS[x] *= g64; const int db = dbase + x;
#pragma unroll
                  for (int k2 = 0; k2 < 2; ++k2) { const int r0 = 32 * k2 + 8 * g + tq, r1 = r0 + 4;
                      const s16x4 t0 = __builtin_amdgcn_ds_read_tr16_b64_v4i16((LAS s16x4*)(lds + KS + r0 * 512 + (((2 * db + (tp >> 1)) ^ (r0 & 15)) << 4) + 8 * (tp & 1)));
                      const s16x4 t1 = __builtin_amdgcn_ds_read_tr16_b64_v4i16((LAS s16x4*)(lds + KS + r1 * 512 + (((2 * db + (tp >> 1)) ^ (r1 & 15)) << 4) + 8 * (tp & 1)));
                      const bf16x8 bfr = {t0[0], t0[1], t0[2], t0[3], t1[0], t1[1], t1[2], t1[3]};
                      accS[x] = __builtin_amdgcn_mfma_f32_16x16x32_bf16(af[k2], bfr, accS[x], 0, 0, 0); }
                  __builtin_amdgcn_sched_barrier(0); } }
        }
        __syncthreads();
    }
}

__device__ __forceinline__ void phase_ret_finish(const Args& a, int row_begin, const Grp& gp) {
    bf16_t* Og = (bf16_t*)(a.ws + WS_BIG + 4 * R1); const bf16_t* Gg = (const bf16_t*)(a.ws + WS_BIG);
    const int tid = otid(), lane = tid & 63, gw = gp.rank * 8 + (tid >> 6), nw = gp.gsize * 8, nrows = gp.nb * (row_begin ? 4096 : 4352);
    for (int lr = gw; lr < nrows; lr += nw) { const int row = row_begin ? grp_row_lat(gp, lr) : grp_row(gp, lr);
        const size_t base = (size_t)row * 2048 + (lane >> 4) * 512 + (lane & 15) * 32;
        float v[32]; float s = 0.f;
#pragma unroll
        for (int q = 0; q < 4; ++q) { const u32x4 w = *(const u32x4*)(Og + base + q * 8);
            v[q * 8 + 0] = bflo(w.x); v[q * 8 + 1] = bfhi(w.x); v[q * 8 + 2] = bflo(w.y); v[q * 8 + 3] = bfhi(w.y); v[q * 8 + 4] = bflo(w.z); v[q * 8 + 5] = bfhi(w.z); v[q * 8 + 6] = bflo(w.w); v[q * 8 + 7] = bfhi(w.w); }
#pragma unroll
        for (int i = 0; i < 32; ++i) s += v[i];
        s += shx(s, lane, 1); s += shx(s, lane, 2); s += shx(s, lane, 4); s += shx(s, lane, 8);
        const float mean = s * (1.f / 512.f); float qv = 0.f;
#pragma unroll
        for (int i = 0; i < 32; ++i) { const float d = v[i] - mean; qv += d * d; }
        qv += shx(qv, lane, 1); qv += shx(qv, lane, 2); qv += shx(qv, lane, 4); qv += shx(qv, lane, 8);
        const float rstd = 1.0f / sqrtf(qv * (1.f / 512.f) + LN_EPS);
#pragma unroll
        for (int q = 0; q < 4; ++q) { const u32x4 gwd = *(const u32x4*)(Gg + base + q * 8); const unsigned gw4[4] = {gwd.x, gwd.y, gwd.z, gwd.w}; unsigned ow[4];
#pragma unroll
            for (int p = 0; p < 4; ++p) { const float g0 = bflo(gw4[p]), g1 = bfhi(gw4[p]);
                ow[p] = cvt_pk_bf16(silu_f(g0) * (v[q * 8 + 2 * p] - mean) * rstd, silu_f(g1) * (v[q * 8 + 2 * p + 1] - mean) * rstd); }
            u32x4 o; o.x = ow[0]; o.y = ow[1]; o.z = ow[2]; o.w = ow[3]; *(u32x4*)(Og + base + q * 8) = o; }
    }
}

template <int ABL>
__device__ __forceinline__ void phase_na(const Args& a, LAS unsigned char* lds0, bf16_t* Odst, const Grp& gp) {
    const bf16_t* Qg = (const bf16_t*)(a.ws + WS_BIG); const bf16_t* Kg = (const bf16_t*)(a.ws + WS_BIG + R1); const bf16_t* Vg = (const bf16_t*)(a.ws + WS_BIG + 2 * R1);
    const int tid = otid(), w = __builtin_amdgcn_readfirstlane(tid >> 6), lane = tid & 63, c = lane & 15, g = lane >> 4, hb = w >> 2, w4 = w & 3, t2 = tid & 255;
    LAS unsigned char* lds = lds0 + hb * 65536;
    constexpr int QS = 0, KS = 32768, VT = 40960, RP = 49152;
    float mk[4][4]; int rco[4][4];
    { const int q0 = 16 * w4 + c, cs0 = min(max(q0 - 8, 0), 48);
#pragma unroll
      for (int kb = 0; kb < 4; ++kb)
#pragma unroll
          for (int e = 0; e < 4; ++e) { const int kc = 16 * kb + 4 * g + e; mk[kb][e] = (kc >= cs0 && kc < cs0 + 16) ? 0.f : -1e30f; rco[kb][e] = min(max(kc - q0 + 15, 0), 30) * 4; } }
    const int kb_lo = min(max(16 * w4 - 8, 0), 48) >> 4, kb_hi = (min(max(16 * w4 + 7, 0), 48) + 15) >> 4;
    for (int base_it = gp.rank * 2; base_it < gp.nb * 272; base_it += gp.gsize * 2) {
        const int it = base_it + hb, bb = it / 272, idx = it - bb * 272; const bool isl = (base_it % 272) < 256;
        const int b = gp.b_lo + bb; int h, r0 = 0, kr_lo = 0, kr_hi = 0;
        if (isl) { h = idx >> 4; r0 = (idx & 15) * 4; kr_lo = min(max(r0 - 4, 0), 56); kr_hi = min(max(r0 - 1, 0), 56) + 7; }
        else { h = idx - 256; }
        const int ntile = isl ? 15 : 4;
        __syncthreads();
#pragma unroll
        for (int i = 0; i < 8; ++i) { const int idx = t2 + 256 * i, row = idx >> 3, ch = idx & 7, rr = row >> 6, qi = row & 63;
            const int grow = isl ? MCTX + b * 4096 + (r0 + rr) * 64 + qi : b * 256 + rr * 64 + qi;
            *(LAS u32x4*)(lds + QS + row * 128 + ((ch ^ ((row >> 1) & 7)) << 4)) = *(const u32x4*)(Qg + (size_t)grow * 1024 + h * 64 + ch * 8); }
        for (int i = t2; i < 465; i += 256) *(LAS float*)(lds + RP + i * 4) = a.na_rpb[h * 465 + i];
        u32x4 kreg[2], vreg[2];
        { const int row0 = isl ? MCTX + b * 4096 + kr_lo * 64 : b * 256;
#pragma unroll
          for (int i = 0; i < 2; ++i) { const int idx = t2 + 256 * i, row = idx >> 3, ch = idx & 7; const size_t o = ((size_t)h * MTOT + row0 + row) * 64 + ch * 8; kreg[i] = *(const u32x4*)(Kg + o); vreg[i] = *(const u32x4*)(Vg + o); } }
        const int q = 16 * w4 + c;
        f32x4 oacc[4][4]; float mrun[4], lrun[4];
#pragma unroll
        for (int rr = 0; rr < 4; ++rr) { mrun[rr] = -1e30f; lrun[rr] = 0.f;
#pragma unroll
            for (int db = 0; db < 4; ++db) oacc[rr][db] = (f32x4){0.f, 0.f, 0.f, 0.f}; }
        for (int tl = 0; tl < ntile; ++tl) {
            if (ABL == 3) break;
            if (ABL == 4) { __syncthreads(); __syncthreads(); continue; }
            __syncthreads();
#pragma unroll
            for (int i = 0; i < 2; ++i) { const int idx = t2 + 256 * i, row = idx >> 3, ch = idx & 7;
                *(LAS u32x4*)(lds + KS + row * 128 + ((ch ^ ((row >> 1) & 7)) << 4)) = kreg[i];
                const unsigned vw[4] = {vreg[i].x, vreg[i].y, vreg[i].z, vreg[i].w};
#pragma unroll
                for (int e = 0; e < 8; ++e) { const int d = ch * 8 + e; const bf16_t val = (bf16_t)((e & 1) ? (vw[e >> 1] >> 16) : (vw[e >> 1] & 0xffffu));
                    *(LAS bf16_t*)(lds + VT + d * 128 + (((row >> 3) ^ ((d >> 1) & 7)) << 4) + (row & 7) * 2) = val; } }
            __syncthreads();
            if (tl + 1 < ntile) { const int t1 = tl + 1;
                const int row0 = isl ? (t1 < 11 ? MCTX + b * 4096 + min(kr_lo + t1, kr_hi) * 64 : b * 256 + (t1 - 11) * 64) : b * 256 + t1 * 64;
#pragma unroll
                for (int i = 0; i < 2; ++i) { const int idx = t2 + 256 * i, row = idx >> 3, ch = idx & 7; const size_t o = ((size_t)h * MTOT + row0 + row) * 64 + ch * 8; kreg[i] = *(const u32x4*)(Kg + o); vreg[i] = *(const u32x4*)(Vg + o); } }
            if (ABL == 2) continue;
            const bool local = isl && tl < 11; const int krow = kr_lo + tl;
            if (local && krow > kr_hi) continue;
#pragma unroll
            for (int rr = 0; rr < 4; ++rr) {
                const int r = r0 + rr, rs = min(max(r - 4, 0), 56);
                if (local && (krow < rs || krow >= rs + 8)) continue;
                bf16x8 qf[2];
#pragma unroll
                for (int ks = 0; ks < 2; ++ks) { const int qrow = rr * 64 + q; qf[ks] = *(const LAS bf16x8*)(lds + QS + qrow * 128 + (((4 * ks + g) ^ ((qrow >> 1) & 7)) << 4)); }
                f32x4 sT[4];
#pragma unroll
                for (int kb = 0; kb < 4; ++kb) { const bool skip = local && (kb < kb_lo || kb > kb_hi);
                    if (skip) { sT[kb] = (f32x4){-1e30f, -1e30f, -1e30f, -1e30f}; continue; }
                    sT[kb] = (f32x4){0.f, 0.f, 0.f, 0.f}; const int kr = 16 * kb + c;
#pragma unroll
                    for (int ks = 0; ks < 2; ++ks) { const bf16x8 kf = *(const LAS bf16x8*)(lds + KS + kr * 128 + (((4 * ks + g) ^ ((kr >> 1) & 7)) << 4)); sT[kb] = __builtin_amdgcn_mfma_f32_16x16x32_bf16(kf, qf[ks], sT[kb], 0, 0, 0); }
                    if (local) { const int rbase = RP + (krow - r + 7) * 124;
#pragma unroll
                        for (int e = 0; e < 4; ++e) sT[kb][e] = (sT[kb][e] + *(const LAS float*)(lds + rbase + rco[kb][e])) + mk[kb][e]; } }
                if (ABL == 1) { oacc[rr][0] += sT[0] + sT[1] + sT[2] + sT[3]; continue; }
                float mx = -1e30f;
#pragma unroll
                for (int kb = 0; kb < 4; ++kb) mx = fmaxf(mx, fmaxf(fmaxf(sT[kb][0], sT[kb][1]), fmaxf(sT[kb][2], sT[kb][3])));
                mx = fmaxf(mx, shx(mx, lane, 16)); mx = fmaxf(mx, shx(mx, lane, 32));
                const float mnew = fmaxf(mrun[rr], mx), alpha = __builtin_amdgcn_exp2f((mrun[rr] - mnew) * LOG2E); mrun[rr] = mnew;
                float ps = 0.f;
#pragma unroll
                for (int kb = 0; kb < 4; ++kb)
#pragma unroll
                    for (int e = 0; e < 4; ++e) { const float p = __builtin_amdgcn_exp2f((sT[kb][e] - mnew) * LOG2E); sT[kb][e] = p; ps += p; }
                ps += shx(ps, lane, 16); ps += shx(ps, lane, 32);
                lrun[rr] = lrun[rr] * alpha + ps;
#pragma unroll
                for (int db = 0; db < 4; ++db) oacc[rr][db] *= alpha;
#pragma unroll
                for (int s2 = 0; s2 < 2; ++s2) {
                    if (local && (2 * s2 + 1 < kb_lo || 2 * s2 > kb_hi)) continue;
                    u32x4 pw; pw.x = cvt_pk_bf16(sT[2 * s2][0], sT[2 * s2][1]); pw.y = cvt_pk_bf16(sT[2 * s2][2], sT[2 * s2][3]); pw.z = cvt_pk_bf16(sT[2 * s2 + 1][0], sT[2 * s2 + 1][1]); pw.w = cvt_pk_bf16(sT[2 * s2 + 1][2], sT[2 * s2 + 1][3]);
                    const bf16x8 pf = __builtin_bit_cast(bf16x8, pw);
#pragma unroll
                    for (int db = 0; db < 4; ++db) { const int vrow = 16 * db + c; const int sw = (vrow >> 1) & 7;
                        const u32x2 lo = *(const LAS u32x2*)(lds + VT + vrow * 128 + (((4 * s2 + (g >> 1)) ^ sw) << 4) + (g & 1) * 8);
                        const u32x2 hi = *(const LAS u32x2*)(lds + VT + vrow * 128 + (((4 * s2 + 2 + (g >> 1)) ^ sw) << 4) + (g & 1) * 8);
                        u32x4 vw; vw.x = lo.x; vw.y = lo.y; vw.z = hi.x; vw.w = hi.y;
                        oacc[rr][db] = __builtin_amdgcn_mfma_f32_16x16x32_bf16(__builtin_bit_cast(bf16x8, vw), pf, oacc[rr][db], 0, 0, 0); }
                }
            }
        }
        __syncthreads();
#pragma unroll
        for (int rr = 0; rr < 4; ++rr) { const float inv = 1.0f / lrun[rr]; const int orow = rr * 64 + q;
#pragma unroll
            for (int db = 0; db < 4; ++db) { const f32x4 o = oacc[rr][db] * inv; u32x2 ow; ow.x = cvt_pk_bf16(o[0], o[1]); ow.y = cvt_pk_bf16(o[2], o[3]);
                *(LAS u32x2*)(lds + QS + orow * 128 + (((2 * db + (g >> 1)) ^ ((orow >> 1) & 7)) << 4) + (g & 1) * 8) = ow; } }
        __syncthreads();
#pragma unroll
        for (int i = 0; i < 8; ++i) { const int idx = t2 + 256 * i, row = idx >> 3, ch = idx & 7, rr = row >> 6, qi = row & 63;
            const int grow = isl ? MCTX + b * 4096 + (r0 + rr) * 64 + qi : b * 256 + rr * 64 + qi;
            *(u32x4*)(Odst + (size_t)grow * 1024 + h * 64 + ch * 8) = *(const LAS u32x4*)(lds + QS + row * 128 + ((ch ^ ((row >> 1) & 7)) << 4)); }
    }
    __syncthreads();
}

__device__ __forceinline__ void phase_lru_conv(const Args& a, const Grp& gp) {
    const bf16_t* XR = (const bf16_t*)(a.ws + WS_BIG + R1); bf16_t* XC = (bf16_t*)(a.ws + WS_BIG + 2 * R1);
    for (int i = gp.rank * 512 + otid(); i < gp.nb * 4352 * 128; i += gp.gsize * 512) {
        const int row = grp_row(gp, i >> 7), c8 = (i & 127) * 8; const bool isc = row < MCTX; const int t = isc ? (row & 255) : ((row - MCTX) & 4095), len = isc ? 256 : 4096;
        float acc[8];
        { const f32x4 b0 = *(const f32x4*)(a.lru_conv_b + c8), b1 = *(const f32x4*)(a.lru_conv_b + c8 + 4); acc[0] = b0[0]; acc[1] = b0[1]; acc[2] = b0[2]; acc[3] = b0[3]; acc[4] = b1[0]; acc[5] = b1[1]; acc[6] = b1[2]; acc[7] = b1[3]; }
#pragma unroll
        for (int j = 0; j < 4; ++j) { const int tt = t - 2 + j;
            if (tt >= 0 && tt < len) { const u32x4 xw = *(const u32x4*)(XR + (size_t)(row - 2 + j) * 1024 + c8); const f32x4 w0 = *(const f32x4*)(a.lru_conv_w + j * 1024 + c8), w1 = *(const f32x4*)(a.lru_conv_w + j * 1024 + c8 + 4);
                acc[0] += w0[0] * bflo(xw.x); acc[1] += w0[1] * bfhi(xw.x); acc[2] += w0[2] * bflo(xw.y); acc[3] += w0[3] * bfhi(xw.y);
                acc[4] += w1[0] * bflo(xw.z); acc[5] += w1[1] * bfhi(xw.z); acc[6] += w1[2] * bflo(xw.w); acc[7] += w1[3] * bfhi(xw.w); } }
        u32x4 o; o.x = cvt_pk_bf16(acc[0], acc[1]); o.y = cvt_pk_bf16(acc[2], acc[3]); o.z = cvt_pk_bf16(acc[4], acc[5]); o.w = cvt_pk_bf16(acc[6], acc[7]);
        *(u32x4*)(XC + (size_t)row * 1024 + c8) = o;
    }
}
__device__ __forceinline__ void phase_lru_scan(const Args& a, int dir, int pass, const Grp& gp) {
    const bf16_t* GATE = (const bf16_t*)(a.ws + WS_BIG); bf16_t* HF = (bf16_t*)(a.ws + WS_BIG + R1); const bf16_t* XC = (const bf16_t*)(a.ws + WS_BIG + 2 * R1); const bf16_t* GP = (const bf16_t*)(a.ws + WS_BIG + 3 * R1);
    float* CARRY = (float*)(a.ws + WS_CARRY);
    for (int idx = gp.rank * 512 + otid(); idx < gp.nb * 64 * 256; idx += gp.gsize * 512) {
        const int cq = idx & 255, chunk = (idx >> 8) & 63, b = gp.b_lo + (idx >> 14), c0 = cq * 4;
        float ba[4], bx[4], sp[4], h[4], P[4];
        { const f32x4 t0 = *(const f32x4*)(a.lru_b_a + dir * 1024 + c0), t1 = *(const f32x4*)(a.lru_b_x + dir * 1024 + c0), t2 = *(const f32x4*)(a.lru_lam + dir * 1024 + c0);
#pragma unroll
          for (int k = 0; k < 4; ++k) { ba[k] = t0[k]; bx[k] = t1[k]; sp[k] = -8.f * log1pf(expf(-t2[k])); h[k] = 0.f; P[k] = 1.f; } }
        if (pass == 2) { for (int cc = 0; cc < chunk; ++cc) { const float* cp = CARRY + ((size_t)(b * 64 + cc) * 256 + cq) * 8; const f32x4 pp = *(const f32x4*)cp, ll = *(const f32x4*)(cp + 4);
#pragma unroll
            for (int k = 0; k < 4; ++k) h[k] = pp[k] * h[k] + ll[k]; } }
        for (int t4 = 0; t4 < 17; ++t4) {
            u32x2 rw[4], iw[4], xw[4], hw[4], gw[4]; int rows[4];
#pragma unroll
            for (int j = 0; j < 4; ++j) { const int p = chunk * 68 + t4 * 4 + j;
                const int row = dir ? (p < 256 ? b * 256 + (255 - p) : MCTX + b * 4096 + (4095 - (p - 256))) : (p < 256 ? b * 256 + p : MCTX + b * 4096 + (p - 256));
                rows[j] = row;
                rw[j] = *(const u32x2*)(GP + (size_t)row * 2048 + c0); iw[j] = *(const u32x2*)(GP + (size_t)row * 2048 + 1024 + c0); xw[j] = *(const u32x2*)(XC + (size_t)row * 1024 + c0);
                if (pass == 2 && dir == 1) { hw[j] = *(const u32x2*)(HF + (size_t)row * 1024 + c0); gw[j] = *(const u32x2*)(GATE + (size_t)row * 1024 + c0); } }
#pragma unroll
            for (int j = 0; j < 4; ++j) {
                const float rp[4] = {bflo(rw[j].x), bfhi(rw[j].x), bflo(rw[j].y), bfhi(rw[j].y)}, ip[4] = {bflo(iw[j].x), bfhi(iw[j].x), bflo(iw[j].y), bfhi(iw[j].y)}, xv[4] = {bflo(xw[j].x), bfhi(xw[j].x), bflo(xw[j].y), bfhi(xw[j].y)};
#pragma unroll
                for (int k = 0; k < 4; ++k) { const float la = sp[k] * sigmoid_f(rp[k] + ba[k]); const float av = __expf(la); const float m = sqrtf(fmaxf(-expm1f(2.f * la), 0.f));
                    h[k] = av * h[k] + m * sigmoid_f(ip[k] + bx[k]) * xv[k]; if (pass == 1) P[k] *= av; }
                if (pass == 2) { bf16_t* hp = HF + (size_t)rows[j] * 1024 + c0; u32x2 o;
                    if (dir == 0) { o.x = cvt_pk_bf16(h[0], h[1]); o.y = cvt_pk_bf16(h[2], h[3]); }
                    else { o.x = cvt_pk_bf16(gelu_tanh_f(bflo(gw[j].x)) * (bflo(hw[j].x) + h[0]), gelu_tanh_f(bfhi(gw[j].x)) * (bfhi(hw[j].x) + h[1]));
                           o.y = cvt_pk_bf16(gelu_tanh_f(bflo(gw[j].y)) * (bflo(hw[j].y) + h[2]), gelu_tanh_f(bfhi(gw[j].y)) * (bfhi(hw[j].y) + h[3])); }
                    *(u32x2*)hp = o; }
            }
        }
        if (pass == 1) { float* cp = CARRY + ((size_t)(b * 64 + chunk) * 256 + cq) * 8; *(f32x4*)cp = (f32x4){P[0], P[1], P[2], P[3]}; *(f32x4*)(cp + 4) = (f32x4){h[0], h[1], h[2], h[3]}; }
    }
}
constexpr int NPHASE = 52;
enum { OP_PROLOGUE, OP_U0, OP_GEMM_SWIGLU, OP_GEMM_PLAIN, OP_GEMM_RETIN, OP_GEMM_GATES, OP_POSTNORM, OP_RETSCAN, OP_RETFIN, OP_NAATT, OP_LRUCONV, OP_LRUSCAN };

typedef const Args __attribute__((address_space(4)))* KArgsPtr;
__global__ void __launch_bounds__(512) hybrid_fwd(Args a_in) {
    extern __shared__ __attribute__((aligned(16))) unsigned char lds_raw[];
    LAS unsigned char* lds = (LAS unsigned char*)lds_raw;
    const int ph_lo = a_in.ph_lo, ph_hi = a_in.ph_hi;
    volatile LAS unsigned* xb_st = (volatile LAS unsigned*)(lds + LDS_BYTES - 16);
    unsigned* xb_bar = (unsigned*)(a_in.ws + WS_BAR);
    if (threadIdx.x < 4) xb_st[threadIdx.x] = 0u;
    __syncthreads();
    if (threadIdx.x == 0) { const unsigned x = xb_xcc_id(); const unsigned r = xb_add(&xb_bar[XB_XCNT(x)], 1u); xb_st[2] = r | (x << 8); }
    int nexec = 0;
#ifdef PROBE_DBL
    for (int pp = 2 * ph_lo; pp < 2 * ph_hi; ++pp) { const int p = pp >> 1;
#else
    for (int p = ph_lo; p < ph_hi; ++p) {
#endif
#if defined(__HIP_DEVICE_COMPILE__)
        KArgsPtr ka = (KArgsPtr)__builtin_amdgcn_kernarg_segment_ptr(); asm volatile("" : "+s"(ka));
        Args a; __builtin_memcpy(&a, ka, sizeof(Args));
#else
        const Args a = a_in;
#endif
        bf16_t* WT = (bf16_t*)(a.ws + WS_WT); bf16_t* U = (bf16_t*)(a.ws + WS_U); unsigned char* BIG = a.ws + WS_BIG; const float* MOD = (const float*)(a.ws + WS_MOD);
        int op = OP_PROLOGUE, l = 0, s = 0, kind = 0, mi = 0, rb = 0, gsel = 0, sdir = 0, spass = 0; bool mixpn = false;
        if (p == 0) op = OP_PROLOGUE;
        else if (p == 1) op = OP_U0;
        else {
            const int q = p - 2; int li;
            if (q < 12) { l = 0; li = q; } else if (q < 22) { l = 1; li = q - 12; } else if (q < 38) { l = 2; li = q - 22; } else { l = 3; li = q - 38; }
            kind = l % 3; mi = l / 3; const int nmix = kind == 0 ? 6 : (kind == 1 ? 4 : 10);
            rb = (l == 3 && li >= 5) ? MCTX : 0;
            if (li < 3 || li >= 3 + nmix) {
                s = li < 3 ? 0 : 1; const int fs = li < 3 ? li : li - 3 - nmix;
                if (fs == 0) op = OP_GEMM_SWIGLU; else if (fs == 1) { op = OP_GEMM_PLAIN; gsel = 0; } else op = OP_POSTNORM;
            } else {
                const int ms = li - 3;
                if (ms == nmix - 1) { op = OP_POSTNORM; mixpn = true; }
                else if (kind == 0) { if (ms == 0) op = OP_GEMM_RETIN; else if (ms == 1) op = OP_RETSCAN; else if (ms == 2) { op = OP_GEMM_PLAIN; gsel = 1; } else if (ms == 3) op = OP_RETFIN; else { op = OP_GEMM_PLAIN; gsel = 2; } }
                else if (kind == 1) { if (ms == 0) { op = OP_GEMM_PLAIN; gsel = 3; } else if (ms == 1) op = OP_NAATT; else { op = OP_GEMM_PLAIN; gsel = 4; } }
                else { if (ms == 0) { op = OP_GEMM_PLAIN; gsel = 5; } else if (ms == 1) op = OP_LRUCONV; else if (ms == 2 || ms == 5) { op = OP_GEMM_GATES; sdir = ms == 5 ? 1 : 0; }
                       else if (ms == 3 || ms == 4) { op = OP_LRUSCAN; sdir = 0; spass = ms - 2; } else if (ms == 6 || ms == 7) { op = OP_LRUSCAN; sdir = 1; spass = ms - 5; } else { op = OP_GEMM_PLAIN; gsel = 6; } }
            }
        }
#ifdef PROBE_DBL
#if PROBE_DBL == 10
        if ((pp & 1) && p != 0) continue;
#else
        if (pp & 1) { const bool pdbl = (PROBE_DBL == 1) ? (op == OP_GEMM_SWIGLU || op == OP_GEMM_PLAIN || op == OP_GEMM_RETIN || op == OP_GEMM_GATES)
                        : (PROBE_DBL == 3) ? (op == OP_RETSCAN) : (PROBE_DBL == 10) ? (op == OP_PROLOGUE) : (PROBE_DBL == 8) ? (op == OP_GEMM_SWIGLU) : (PROBE_DBL == 5) ? (op == OP_NAATT) : (PROBE_DBL == 6) ? (op == OP_LRUCONV || (op == OP_LRUSCAN && !(sdir == 1 && spass == 2))) : (PROBE_DBL == 2) ? (op == OP_POSTNORM && l == 0 && s == 0 && !mixpn) : false;
            if (!pdbl) continue; }
#endif
#endif
        { const unsigned xm = (unsigned)__builtin_amdgcn_readfirstlane((int)xb_st[3]);
          const bool relayout = (op == OP_GEMM_SWIGLU && s == 1) || op == OP_GEMM_RETIN || (op == OP_GEMM_PLAIN && (gsel == 1 || gsel == 3 || gsel == 5));
          if (nexec == 1) cg::this_grid().sync();
          else if (nexec > 1) { if (xm && !relayout) xcd_local_barrier((unsigned*)(a.ws + WS_BAR), ((unsigned)__builtin_amdgcn_readfirstlane((int)xb_st[2]) >> 8) & 0xffu, 32u);
                                else xcd_barrier((unsigned*)(a.ws + WS_BAR), xb_st); } }
        if (nexec == 1 && ph_lo == 0) {
            if (threadIdx.x == 0) { bool ok = gridDim.x == 256;
                for (unsigned j = 0; j < 16; ++j) { const unsigned cnt = xb_ld(&xb_bar[XB_XCNT(j)]); ok = ok && (j < 8 ? cnt == 32u : cnt == 0u); }
#ifdef PROBE_NO_XMODE
                ok = false;
#endif
                xb_st[3] = ok ? 1u : 0u; }
            __syncthreads(); }
        ++nexec;
        const unsigned gword = (unsigned)__builtin_amdgcn_readfirstlane((int)xb_st[2]), xmode = (unsigned)__builtin_amdgcn_readfirstlane((int)xb_st[3]);
        Grp grp; if (xmode) { grp.b_lo = (int)((gword >> 8) & 0xffu); grp.nb = 1; grp.rank = (int)(gword & 0xffu); grp.gsize = 32; } else { grp.b_lo = 0; grp.nb = 8; grp.rank = (int)blockIdx.x; grp.gsize = (int)gridDim.x; }
        switch (op) {
#ifndef NO_OP_PROLOGUE
            case OP_PROLOGUE: phase_prologue(a, lds); break;
#endif
#ifndef NO_OP_U0
            case OP_U0: phase_u0(a, grp); break;
#endif
#ifndef NO_OP_GEMM_SWIGLU
            case OP_GEMM_SWIGLU: { const pg8::Gemm gg{U, WT + E_FFN_IN + (size_t)(l * 2 + s) * 5632 * 1024, MTOT, 5632, 1024, 1024, 0, 0};
                pg8::GroupOrder S; S.init(grp.nb, grp.b_lo, rb != 0, gg.N, grp.gsize, grp.rank); EpiSwiGLU E{(bf16_t*)BIG, 0}; pg8::gemm_phase<EpiSwiGLU, pg8::GroupOrder>(lds, gg, S, E); } break;
#endif
#ifndef NO_OP_GEMM_PLAIN
            case OP_GEMM_PLAIN: { const bf16_t* gA; const bf16_t* gB; int gN, gK, glda; bf16_t* eO; int eldc = 1024, esplit = 0, ehm = 0; size_t estride = 0; float escale = 1.f;
                if (gsel == 0)      { gA = (const bf16_t*)BIG; gB = WT + E_FFN_OUT + (size_t)(l * 2 + s) * 1024 * 2816; gN = 1024; gK = 2816; glda = 2816; eO = (bf16_t*)(BIG + 3 * R1); }
                else if (gsel == 1) { gA = U; gB = WT + E_RET_IN + (size_t)mi * 6144 * 1024 + (size_t)4096 * 1024; gN = 2048; gK = 1024; glda = 1024; eO = (bf16_t*)BIG; eldc = 2048; }
                else if (gsel == 2) { gA = (const bf16_t*)(BIG + 4 * R1); gB = WT + E_RET_OUT + (size_t)mi * 1024 * 2048; gN = 1024; gK = 2048; glda = 2048; eO = (bf16_t*)(BIG + 2 * R1); }
                else if (gsel == 3) { gA = U; gB = WT + E_NA_QKV; gN = 3072; gK = 1024; glda = 1024; eO = (bf16_t*)BIG; esplit = 1024; estride = R1 / 2; escale = 0.125f; ehm = 1; }
                else if (gsel == 4) { gA = (const bf16_t*)BIG; gB = WT + E_NA_OUT; gN = 1024; gK = 1024; glda = 1024; eO = (bf16_t*)(BIG + 3 * R1); }
                else if (gsel == 5) { gA = U; gB = WT + E_LRU_IN; gN = 2048; gK = 1024; glda = 1024; eO = (bf16_t*)BIG; esplit = 1024; estride = R1 / 2; }
                else                { gA = (const bf16_t*)(BIG + R1); gB = WT + E_LRU_OUT; gN = 1024; gK = 1024; glda = 1024; eO = (bf16_t*)(BIG + 2 * R1); }
                const pg8::Gemm gg{gA, gB, MTOT, gN, gK, glda, 0, 0}; pg8::GroupOrder S; S.init(grp.nb, grp.b_lo, rb != 0, gg.N, grp.gsize, grp.rank);
                EpiPlain E{eO, eldc, 0, esplit, estride, escale, ehm}; pg8::gemm_phase<EpiPlain, pg8::GroupOrder>(lds, gg, S, E); } break;
#endif
#ifndef NO_OP_GEMM_RETIN
            case OP_GEMM_RETIN: { const pg8::Gemm gg{U, WT + E_RET_IN + (size_t)mi * 6144 * 1024, MTOT, 4096, 1024, 1024, 0, 0}; pg8::GroupOrder S; S.init(grp.nb, grp.b_lo, false, gg.N, grp.gsize, grp.rank);
                EpiRetIn E{(bf16_t*)BIG, (bf16_t*)(BIG + R1), (bf16_t*)(BIG + 2 * R1), (const float*)(a.ws + WS_ROPE), (const float*)(a.ws + WS_ROPE) + 4096}; pg8::gemm_phase<EpiRetIn, pg8::GroupOrder>(lds, gg, S, E); } break;
#endif
#ifndef NO_OP_GEMM_GATES
            case OP_GEMM_GATES: { const pg8::Gemm gg{(const bf16_t*)(BIG + 2 * R1), WT + E_GATES + (size_t)sdir * 2048 * 256, MTOT, 2048, 256, 1024, 1, 256}; pg8::GroupOrder S; S.init(grp.nb, grp.b_lo, false, gg.N, grp.gsize, grp.rank);
                EpiGates E{(bf16_t*)(BIG + 3 * R1)}; pg8::gemm_phase<EpiGates, pg8::GroupOrder>(lds, gg, S, E); } break;
#endif
#ifndef NO_OP_POSTNORM
            case OP_POSTNORM: { const float* modl = MOD + (size_t)l * 9 * 9216;
                if (mixpn) phase_postnorm(a, false, (const bf16_t*)(BIG + (kind == 1 ? 3 : 2) * R1), modl, 5, 1.f, a.ln_g + (size_t)(l * 3 + 1) * 1024, a.ln_b + (size_t)(l * 3 + 1) * 1024, modl, 6, rb, grp);
                else { const int li3 = l * 3 + (s == 0 ? 0 : 2); const float* modn = (s == 0) ? modl : MOD + (size_t)(l < 3 ? l + 1 : l) * 9 * 9216; const int psh = (s == 0) ? 3 : (l < 3 ? 0 : -1);
                    phase_postnorm(a, l == 0 && s == 0, (const bf16_t*)(BIG + 3 * R1), modl, s == 0 ? 2 : 8, 0.5f, a.ln_g + (size_t)li3 * 1024, a.ln_b + (size_t)li3 * 1024, modn, psh, rb, grp); } } break;
#endif
#ifndef NO_OP_RETSCAN
#if defined(PROBE_DBL) && PROBE_DBL == 3
#ifndef PROBE_RET_ABL
#define PROBE_RET_ABL 0
#endif
            case OP_RETSCAN: if (pp & 1) phase_retention<0>(a, lds, grp); else phase_retention<PROBE_RET_ABL>(a, lds, grp); break;
#else
            case OP_RETSCAN: phase_retention<0>(a, lds, grp); break;
#endif
#endif
#ifndef NO_OP_RETFIN
            case OP_RETFIN: phase_ret_finish(a, rb, grp); break;
#endif
#ifndef NO_OP_NAATT
#if defined(PROBE_DBL) && PROBE_DBL == 5
#ifndef PROBE_NA_ABL
#define PROBE_NA_ABL 0
#endif
            case OP_NAATT: if (pp & 1) phase_na<0>(a, lds, (bf16_t*)BIG, grp); else phase_na<PROBE_NA_ABL>(a, lds, (bf16_t*)(BIG + 3 * R1), grp); break;
#else
            case OP_NAATT: phase_na<0>(a, lds, (bf16_t*)BIG, grp); break;
#endif
#endif
#ifndef NO_OP_LRUCONV
            case OP_LRUCONV: phase_lru_conv(a, grp); break;
#endif
#ifndef NO_OP_LRUSCAN
            case OP_LRUSCAN: phase_lru_scan(a, sdir, spass, grp); break;
#endif
            default: break;
        }
    }
}

#ifndef MK_PER_PHASE
#define MK_PER_PHASE 0
#endif
extern "C" void kernel_launch(void* const* d_in, const int* in_sizes, int n_in, void* d_out, int out_size, void* d_ws, size_t ws_size, hipStream_t stream) {
    static int grid = 0;
    if (grid == 0) {
        if (n_in != 24 || out_size != MLAT * 1024 || ws_size < WS_END) { fprintf(stderr, "kernel_launch: unexpected shapes: n_in %d out %d ws %zu (need %zu)\n", n_in, out_size, ws_size, (size_t)WS_END); grid = -1; return; }
        int dev = 0, cus = 0, per_cu = 0;
        if (hipGetDevice(&dev) != hipSuccess || hipDeviceGetAttribute(&cus, hipDeviceAttributeMultiprocessorCount, dev) != hipSuccess) { grid = -1; return; }
        if (hipFuncSetAttribute((const void*)hybrid_fwd, hipFuncAttributeMaxDynamicSharedMemorySize, LDS_BYTES) != hipSuccess) { fprintf(stderr, "kernel_launch: hipFuncSetAttribute failed\n"); grid = -1; return; }
        if (hipOccupancyMaxActiveBlocksPerMultiprocessor(&per_cu, (const void*)hybrid_fwd, 512, LDS_BYTES) != hipSuccess || per_cu < 1) { fprintf(stderr, "kernel_launch: occupancy query says %d\n", per_cu); per_cu = 1; }
        (void)hipGetLastError();
        grid = cus * 1;
    }
    if (grid < 0) return;
    if (hipMemsetAsync((char*)d_ws + WS_BAR, 0, 16384, stream) != hipSuccess) { fprintf(stderr, "kernel_launch: barrier memset failed\n"); return; }
    Args a{};
    const float** pp = (const float**)&a;
    for (int i = 0; i < 24; ++i) pp[i] = (const float*)d_in[i];
    a.out = (float*)d_out; a.ws = (unsigned char*)d_ws;
#if MK_PER_PHASE
    for (int p = 0; p < NPHASE; ++p) { a.ph_lo = p; a.ph_hi = p + 1; hipLaunchKernelGGL(hybrid_fwd, dim3(grid), dim3(512), LDS_BYTES, stream, a); }
#else
    a.ph_lo = 0; a.ph_hi = NPHASE;
    void* args[] = {&a};
    hipError_t e = hipLaunchCooperativeKernel((const void*)hybrid_fwd, dim3(grid), dim3(512), args, LDS_BYTES, stream);
    if (e != hipSuccess) fprintf(stderr, "cooperative launch failed: %s (grid %d)\n", hipGetErrorString(e), grid);
#endif
}
```

```cpp
#include <hip/hip_runtime.h>
#include <hip/hip_cooperative_groups.h>
#include <cstdio>
namespace cg = cooperative_groups;

#define LAS __attribute__((address_space(3)))
typedef unsigned short bf16_t;
typedef short bf16x8 __attribute__((ext_vector_type(8)));
typedef float f32x4 __attribute__((ext_vector_type(4)));
typedef unsigned u32x4 __attribute__((ext_vector_type(4)));
typedef unsigned u32x2 __attribute__((ext_vector_type(2)));

constexpr int DM = 1024, NB = 8, SEQ = 4096, CTXL = 256, DFF = 2816;
constexpr int MCTX = NB * CTXL, MLAT = NB * SEQ, MTOT = MCTX + MLAT;
constexpr int NMOD = 9;
constexpr float DN_ALPHA = 1.681792830507429f;
constexpr float LN_EPS = 1e-5f;
constexpr float LOG2E = 1.4426950408889634f;
constexpr int LDS_BYTES = 147456;

constexpr size_t E_FFN_IN = 0;
constexpr size_t E_FFN_OUT = E_FFN_IN + (size_t)8 * 5632 * 1024;
constexpr size_t E_RET_IN = E_FFN_OUT + (size_t)8 * 1024 * 2816;
constexpr size_t E_RET_OUT = E_RET_IN + (size_t)2 * 6144 * 1024;
constexpr size_t E_NA_QKV = E_RET_OUT + (size_t)2 * 1024 * 2048;
constexpr size_t E_NA_OUT = E_NA_QKV + (size_t)3072 * 1024;
constexpr size_t E_LRU_IN = E_NA_OUT + (size_t)1024 * 1024;
constexpr size_t E_LRU_OUT = E_LRU_IN + (size_t)2048 * 1024;
constexpr size_t E_GATES = E_LRU_OUT + (size_t)1024 * 1024;
constexpr size_t E_WT_END = E_GATES + (size_t)2 * 2048 * 256;
constexpr size_t R1 = (size_t)MTOT * 1024 * 2;
constexpr size_t WS_WT = 0;
constexpr size_t WS_U = WS_WT + E_WT_END * 2;
constexpr size_t WS_HC = WS_U + R1;
constexpr size_t WS_MOD = WS_HC + (size_t)MCTX * 1024 * 4;
constexpr size_t WS_ROPE = WS_MOD + (size_t)4 * 9 * 9216 * 4;
constexpr size_t WS_CARRY = WS_ROPE + (size_t)2 * 4096 * 4;
constexpr size_t WS_BAR = WS_CARRY + (size_t)NB * 68 * 1024 * 2 * 4;
constexpr size_t WS_BIG = WS_BAR + 16384;
constexpr size_t WS_END = WS_BIG + 6 * R1;

struct Args {
    const float* x; const float* c; const float* ctx; const float* c_ctx; const float* ada_w; const float* ada_b; const float* ln_g; const float* ln_b;
    const float* ffn_w_in; const float* ffn_w_out; const float* ret_w_in; const float* ret_w_out; const float* na_w_qkv; const float* na_rpb; const float* na_w_out;
    const float* lru_w_in; const float* lru_conv_w; const float* lru_conv_b; const float* lru_w_a; const float* lru_b_a; const float* lru_w_x; const float* lru_b_x;
    const float* lru_lam; const float* lru_w_out;
    float* out; unsigned char* ws; int ph_lo, ph_hi;
};

struct Grp { int b_lo, nb, rank, gsize; };
__device__ __forceinline__ int grp_row(const Grp& g, int lr) { const int b = g.b_lo + lr / 4352, t = lr % 4352; return t < 256 ? b * 256 + t : MCTX + b * 4096 + (t - 256); }
__device__ __forceinline__ int grp_row_lat(const Grp& g, int lr) { return MCTX + (g.b_lo + (lr >> 12)) * 4096 + (lr & 4095); }
__device__ __forceinline__ int otid() { int t = threadIdx.x; asm volatile("" : "+v"(t)); return t; }
__device__ __forceinline__ float shx(float v, int lane, int m) { return __int_as_float(__builtin_amdgcn_ds_bpermute((lane ^ m) << 2, __float_as_int(v))); }
__device__ __forceinline__ unsigned cvt_pk_bf16(float lo, float hi) { unsigned r; asm volatile("v_cvt_pk_bf16_f32 %0, %1, %2" : "=v"(r) : "v"(lo), "v"(hi)); return r; }
__device__ __forceinline__ float bflo(unsigned w) { return __uint_as_float(w << 16); }
__device__ __forceinline__ float bfhi(unsigned w) { return __uint_as_float(w & 0xffff0000u); }
__device__ __forceinline__ float bf2f(bf16_t b) { return __uint_as_float(((unsigned)b) << 16); }
__device__ __forceinline__ bf16_t f2bf(float f) { return (bf16_t)(cvt_pk_bf16(f, 0.f) & 0xffffu); }
__device__ __forceinline__ float silu_f(float x) { return x * __builtin_amdgcn_rcpf(1.f + __expf(-x)); }
__device__ __forceinline__ float sigmoid_f(float x) { return __builtin_amdgcn_rcpf(1.f + __expf(-x)); }
__device__ __forceinline__ float gelu_tanh_f(float x) { const float z = 0.7978845608028654f * (x + 0.044715f * x * x * x); const float t = 1.f - 2.f * __builtin_amdgcn_rcpf(__expf(2.f * z) + 1.f); return 0.5f * x * (1.f + t); }

namespace pg8 {
constexpr int BM = 256, BK = 64, HALF = 128, HTB = HALF * BK * 2  , STAGE_BYTES = 8 * HTB, NXCD = 8, WGM = 8;
__host__ __device__ __forceinline__ int lds_byte(int r, int c) { const int st = (r >> 4) * 2 + (c >> 5), rr = r & 15, cc = c & 31, ob = rr * 64 + cc * 2; return st * 1024 + (ob ^ (((ob >> 9) & 1) << 5)); }
__host__ __device__ __forceinline__ void stage_rc(int b, int& R, int& C) { const int st = b / 1024, sb = b % 1024, swz = sb ^ (((sb >> 9) & 1) << 5); R = (st >> 1) * 16 + swz / 64; C = (st & 1) * 32 + (swz % 64) / 2; }
__host__ __device__ __forceinline__ int perm32(int rho) { const int n = rho >> 4, i = rho & 15; return 8 * (i >> 2) + 4 * n + (i & 3); }

struct Unit { int pm, pn; };
struct Gemm { const bf16_t* A; const bf16_t* Bt; int M, N, K, lda, a_sh, a_cols; };

struct StaticOrder {
    int nM, nN, nwg, G, c;
    __host__ __device__ void init(int M, int N, int G_, int c_) { nM = M / BM; nN = N / BM; nwg = nM * nN; G = G_; c = c_; }
    __host__ __device__ bool next(int i, Unit& u) const {
        const long L = (long)i * G + c; if (L >= nwg) return false;
        int wgid = (int)L; { const int q = nwg / NXCD, r = nwg % NXCD, xcd = wgid % NXCD, off = wgid / NXCD; wgid = (xcd < r ? xcd * (q + 1) : r * (q + 1) + (xcd - r) * q) + off; }
        const int nig = WGM * nN, gid = wgid / nig, fm = gid * WGM, gsz = (nM - fm) < WGM ? (nM - fm) : WGM;
        u.pm = fm + ((wgid % nig) % gsz); u.pn = (wgid % nig) / gsz; return true;
    }
    __device__ __forceinline__ void a_ready(const Unit&) const {}
    __device__ __forceinline__ void done(const Unit&) const {}
};

struct GroupOrder {
    int nP, nN, nwg, G, c, b_lo, per, W;
    __device__ void init(int nb, int b_lo_, bool skipctx, int N, int G_, int c_) { per = skipctx ? 16 : 17; nP = nb * per; nN = N / BM; nwg = nP * nN; G = G_; c = c_; b_lo = b_lo_;
        const int ng = (nP + WGM - 1) / WGM; W = (nP + ng - 1) / ng; }
    __device__ bool next(int i, Unit& u) const {
        const long L = (long)i * G + c; if (L >= nwg) return false;
        const int wgid = (int)L, nig = W * nN, gid = wgid / nig, fm = gid * W, gsz = (nP - fm) < W ? (nP - fm) : W;
        const int lp = fm + ((wgid % nig) % gsz); u.pn = (wgid % nig) / gsz;
        const int b = b_lo + lp / per, j = lp % per;
        u.pm = (per == 16) ? 8 + 16 * b + j : (j == 0 ? b : 8 + 16 * b + j - 1);
        return true;
    }
    __device__ __forceinline__ void a_ready(const Unit&) const {}
    __device__ __forceinline__ void done(const Unit&) const {}
};

template <class Epi, class Sched>
__device__ __forceinline__ void gemm_phase(LAS unsigned char* lds, const Gemm g, const Sched& S, const Epi& E) {
    const int tid = otid(), wid = __builtin_amdgcn_readfirstlane(tid >> 6), lane = tid & 63, wr = wid >> 2, wc = wid & 3, fr = lane & 15, fq = lane >> 4;
    const int K = g.K, nt = K / BK, lda = g.lda;
    unsigned voffA[2], voffB[2];
#pragma unroll
    for (int i = 0; i < 2; ++i) { int R, C; stage_rc(tid * 16 + i * 8192, R, C); const int Rb = Epi::PERM ? ((R & ~31) + perm32(R & 31)) : R;
        voffA[i] = (unsigned)(R * lda + C) * 2u; voffB[i] = (unsigned)(Rb * K + C) * 2u; }
    const size_t kstep = (size_t)(BK * 2);
    const size_t hstepA = (size_t)HALF * lda * 2, hstepB = (size_t)HALF * K * 2;
    const size_t tstepA = 2 * hstepA, tstepB = 2 * hstepB;
    const unsigned ldsw = (unsigned)wid * 1024u;
    const int aoff = lds_byte(wr * 64 + fr, fq * 8), boff = lds_byte(wc * 32 + fr, fq * 8);
#define PG8_SA(b, h) (((b) * 2 + (h)) * HTB)
#define PG8_SB(b, h) ((4 + (b) * 2 + (h)) * HTB)
#define PG8_STAGE(bufoff, gbase, voff) do { _Pragma("unroll") for (int _i = 0; _i < 2; ++_i) \
        __builtin_amdgcn_global_load_lds((const unsigned*)((const char*)(gbase) + (voff)[_i]), (LAS unsigned*)(lds + (bufoff) + ldsw + _i * 8192), 16, 0, 0); } while (0)
#define PG8_LDA(dst, b, h) do { _Pragma("unroll") for (int m = 0; m < 4; ++m) _Pragma("unroll") for (int k = 0; k < 2; ++k) dst[m][k] = *(const LAS bf16x8*)(lds + PG8_SA(b, h) + aoff + m * 2048 + k * 1024); } while (0)
#define PG8_LDB(dst, b, h) do { _Pragma("unroll") for (int n = 0; n < 2; ++n) _Pragma("unroll") for (int k = 0; k < 2; ++k) dst[n][k] = *(const LAS bf16x8*)(lds + PG8_SB(b, h) + boff + n * 2048 + k * 1024); } while (0)
#define PG8_MMA(ai, bj, At, Bt) do { __builtin_amdgcn_s_setprio(1); _Pragma("unroll") for (int m = 0; m < 4; ++m) _Pragma("unroll") for (int n = 0; n < 2; ++n) _Pragma("unroll") for (int k = 0; k < 2; ++k) \
        acc[ai][bj][m][n] = __builtin_amdgcn_mfma_f32_16x16x32_bf16(Bt[n][k], At[m][k], acc[ai][bj][m][n], 0, 0, 0); __builtin_amdgcn_s_setprio(0); } while (0)
#define PG8_WAIT_V(n) asm volatile("s_waitcnt vmcnt(" #n ")" ::: "memory")
#define PG8_WAIT_L(n) asm volatile("s_waitcnt lgkmcnt(" #n ")" ::: "memory")
#define PG8_BAR __builtin_amdgcn_s_barrier()
#define PG8_SCHED __builtin_amdgcn_sched_barrier(0)
#define PG8_AOFF(u) ((size_t)(u).pm * tstepA + (size_t)(((u).pn >> g.a_sh) * g.a_cols) * 2)
    Unit cur, nxt; int ui = 0;
    if (!S.next(0, cur)) return;
    f32x4 acc[2][2][4][2];
#pragma unroll
    for (int a = 0; a < 2; ++a)
#pragma unroll
        for (int b = 0; b < 2; ++b)
#pragma unroll
            for (int m = 0; m < 4; ++m)
#pragma unroll
                for (int n = 0; n < 2; ++n) acc[a][b][m][n] = (f32x4){0.f, 0.f, 0.f, 0.f};
    bf16x8 At[4][2], B0[2][2], B1[2][2];
    const char* cA = (const char*)g.A + PG8_AOFF(cur); const char* cB = (const char*)g.Bt + (size_t)cur.pn * tstepB;
    S.a_ready(cur);
    PG8_STAGE(PG8_SB(0, 0), cB, voffB); PG8_STAGE(PG8_SA(0, 0), cA, voffA); PG8_STAGE(PG8_SB(0, 1), cB + hstepB, voffB); PG8_STAGE(PG8_SA(0, 1), cA + hstepA, voffA);
    if (wr == 1) PG8_BAR;
    PG8_WAIT_V(4); PG8_BAR;
    PG8_STAGE(PG8_SB(1, 0), cB + kstep, voffB); PG8_STAGE(PG8_SA(1, 0), cA + kstep, voffA); PG8_STAGE(PG8_SB(1, 1), cB + hstepB + kstep, voffB);
    PG8_WAIT_V(6); PG8_BAR;
    for (;;) {
        const bool has_next = S.next(ui + 1, nxt);
        const char* nA = has_next ? (const char*)g.A + PG8_AOFF(nxt) : cA; const char* nB = has_next ? (const char*)g.Bt + (size_t)nxt.pn * tstepB : cB;
        for (int t = 0; t < nt; t += 2) {
            const bool last = (t == nt - 2);
            const char* a1 = cA + (size_t)(t + 1) * kstep;
            const char* a2 = last ? nA : cA + (size_t)(t + 2) * kstep; const char* b2 = last ? nB : cB + (size_t)(t + 2) * kstep;
            const char* a3 = a2 + kstep; const char* b3 = b2 + kstep;
            if (last && has_next) S.a_ready(nxt);
            PG8_LDB(B0, 0, 0); PG8_SCHED; PG8_LDA(At, 0, 0); PG8_STAGE(PG8_SA(1, 1), a1 + hstepA, voffA);
            PG8_WAIT_L(8); PG8_BAR; PG8_WAIT_L(0); PG8_MMA(0, 0, At, B0); PG8_BAR; PG8_SCHED;
            PG8_LDB(B1, 0, 1); PG8_STAGE(PG8_SB(0, 0), b2, voffB);
            PG8_BAR; PG8_WAIT_L(0); PG8_MMA(0, 1, At, B1); PG8_BAR;
            PG8_LDA(At, 0, 1); PG8_STAGE(PG8_SA(0, 0), a2, voffA);
            PG8_BAR; PG8_WAIT_L(0); PG8_MMA(1, 0, At, B0); PG8_BAR; PG8_SCHED;
            PG8_STAGE(PG8_SB(0, 1), b2 + hstepB, voffB);
            PG8_WAIT_V(6); PG8_BAR; PG8_MMA(1, 1, At, B1); PG8_BAR;
            PG8_LDB(B0, 1, 0); PG8_SCHED; PG8_LDA(At, 1, 0); PG8_STAGE(PG8_SA(0, 1), a2 + hstepA, voffA);
            PG8_WAIT_L(8); PG8_BAR; PG8_WAIT_L(0); PG8_MMA(0, 0, At, B0); PG8_BAR; PG8_SCHED;
            PG8_LDB(B1, 1, 1); PG8_STAGE(PG8_SB(1, 0), b3, voffB);
            PG8_BAR; PG8_WAIT_L(0); PG8_MMA(0, 1, At, B1); PG8_BAR;
            PG8_LDA(At, 1, 1); PG8_STAGE(PG8_SA(1, 0), a3, voffA);
            PG8_BAR; PG8_WAIT_L(0); PG8_MMA(1, 0, At, B0); PG8_BAR; PG8_SCHED;
            PG8_STAGE(PG8_SB(1, 1), b3 + hstepB, voffB);
            PG8_WAIT_V(6); PG8_BAR; PG8_MMA(1, 1, At, B1); PG8_BAR;
        }
        E(acc, cur, wr, wc, fr, fq); S.done(cur);
        if (!has_next) break;
#pragma unroll
        for (int a = 0; a < 2; ++a)
#pragma unroll
            for (int b = 0; b < 2; ++b)
#pragma unroll
                for (int m = 0; m < 4; ++m)
#pragma unroll
                    for (int n = 0; n < 2; ++n) acc[a][b][m][n] = (f32x4){0.f, 0.f, 0.f, 0.f};
        cur = nxt; cA = nA; cB = nB; ++ui;
    }
    PG8_WAIT_V(0);
    if (wr == 0) PG8_BAR;
    PG8_BAR;
#undef PG8_SA
#undef PG8_SB
#undef PG8_STAGE
#undef PG8_LDA
#undef PG8_LDB
#undef PG8_MMA
#undef PG8_WAIT_V
#undef PG8_WAIT_L
#undef PG8_BAR
#undef PG8_SCHED
#undef PG8_AOFF
}
}

#define XB_TMO      128
#define XB_XCNT(j)  (256  + 64 * (j))
#define XB_XSUB(j)  (1280 + 64 * (j))
#define XB_XGEN(j)  (2304 + 64 * (j))
#define XB_TOP      3328
#define XB_TOPGEN   3392
#define XCD_BAR_WORDS 3456
#define XB_LSUB(j)  (3456 + 64 * (j))
#define XB_LGEN(j)  (3488 + 64 * (j))
#define XB_SPIN_CAP (1u << 21)
__device__ __forceinline__ unsigned xb_ld(unsigned* p)              { return __hip_atomic_load(p, __ATOMIC_RELAXED, __HIP_MEMORY_SCOPE_AGENT); }
__device__ __forceinline__ unsigned xb_add(unsigned* p, unsigned v) { return __hip_atomic_fetch_add(p, v, __ATOMIC_RELAXED, __HIP_MEMORY_SCOPE_AGENT); }
__device__ __forceinline__ unsigned xb_xcc_id() { return (unsigned)__builtin_amdgcn_s_getreg((3 << 11) | 20) & 0xFu; }
#define XB_SPIN(cond, bar) do { unsigned _sp = 0; while (cond) { __builtin_amdgcn_s_sleep(1); \
    if ((++_sp & 255u) == 0u) { if (xb_ld(&(bar)[XB_TMO])) break; if (_sp > XB_SPIN_CAP) { atomicAdd(&(bar)[XB_TMO], 1u); break; } } } } while (0)
__device__ __forceinline__ void xcd_barrier_complete(unsigned* bar, unsigned x, unsigned& nloc, unsigned& nx) {
    const unsigned G = gridDim.x * gridDim.y * gridDim.z;
    unsigned sum, cnt, mine, sp = 0u;
    for (;;) {
        sum = 0u; cnt = 0u; mine = 0u;
#pragma unroll
        for (unsigned j = 0; j < 16; ++j) { const unsigned c = xb_ld(&bar[XB_XCNT(j)]); sum += c; cnt += (c > 0u) ? 1u : 0u; mine = (j == x) ? c : mine; }
        if (sum == G) break;
        __builtin_amdgcn_s_sleep(1);
        if ((++sp & 255u) == 0u) { if (xb_ld(&bar[XB_TMO])) break; if (sp > XB_SPIN_CAP) { atomicAdd(&bar[XB_TMO], 1u); break; } }
    }
    nloc = mine > 0u ? mine : 1u; nx = cnt > 0u ? cnt : 1u;
}
__device__ __forceinline__ void xcd_barrier(unsigned* bar, volatile LAS unsigned* st) {
    asm volatile("s_waitcnt vmcnt(0)" ::: "memory");
    __syncthreads();
    if (threadIdx.x == 0) {
        const unsigned x = xb_xcc_id();
        __builtin_amdgcn_s_waitcnt(0);
        unsigned nloc = st[0], nx = st[1];
        if (nloc == 0u) { xcd_barrier_complete(bar, x, nloc, nx); st[0] = nloc; st[1] = nx; }
        const unsigned old = xb_add(&bar[XB_XSUB(x)], 1u);
        const unsigned gen = old / nloc;
        if (old + 1u == (gen + 1u) * nloc) {
            __builtin_amdgcn_fence(__ATOMIC_RELEASE, "agent");
            asm volatile("s_waitcnt vmcnt(0)" ::: "memory");
            const unsigned og = xb_add(&bar[XB_TOP], 1u);
            const unsigned tg = og / nx;
            if (og + 1u == (tg + 1u) * nx) xb_add(&bar[XB_TOPGEN], 1u);
            else XB_SPIN(xb_ld(&bar[XB_TOPGEN]) == tg, bar);
            __builtin_amdgcn_fence(__ATOMIC_ACQUIRE, "agent");
            xb_add(&bar[XB_XGEN(x)], 1u);
            asm volatile("s_waitcnt vmcnt(0)" ::: "memory");
        } else {
            XB_SPIN(xb_ld(&bar[XB_XGEN(x)]) == gen, bar);
            __builtin_amdgcn_fence(__ATOMIC_ACQUIRE, "agent");
            asm volatile("s_waitcnt vmcnt(0)" ::: "memory");
        }
    }
    __syncthreads();
}

__device__ __forceinline__ void xcd_local_barrier(unsigned* bar, unsigned x, unsigned nloc) {
    asm volatile("s_waitcnt vmcnt(0)" ::: "memory");
    __syncthreads();
    if (threadIdx.x == 0) {
        __builtin_amdgcn_s_waitcnt(0);
        const unsigned old = xb_add(&bar[XB_LSUB(x)], 1u), gen = old / nloc;
        if (old + 1u == (gen + 1u) * nloc) xb_add(&bar[XB_LGEN(x)], 1u);
        else XB_SPIN(xb_ld(&bar[XB_LGEN(x)]) == gen, bar);
        __builtin_amdgcn_fence(__ATOMIC_ACQUIRE, "agent");
        asm volatile("s_waitcnt vmcnt(0)" ::: "memory");
    }
    __syncthreads();
}
struct EpiSwiGLU {
    static constexpr bool PERM = true;
    bf16_t* H; int row_off;
    __device__ __forceinline__ void operator()(const f32x4 (&acc)[2][2][4][2], const pg8::Unit& u, int wr, int wc, int fr, int fq) const {
        const int row0 = row_off + u.pm * 256 + wr * 64 + fr, hc = u.pn * 128 + wc * 32 + 8 * fq;
#pragma unroll
        for (int ai = 0; ai < 2; ++ai)
#pragma unroll
            for (int m = 0; m < 4; ++m) {
                bf16_t* rowp = H + (size_t)(row0 + ai * 128 + m * 16) * DFF + hc;
                const f32x4 g0 = acc[ai][0][m][0], g1 = acc[ai][0][m][1], u0 = acc[ai][1][m][0], u1 = acc[ai][1][m][1];
                u32x4 w;
                w.x = cvt_pk_bf16(silu_f(g0[0]) * u0[0], silu_f(g0[1]) * u0[1]); w.y = cvt_pk_bf16(silu_f(g0[2]) * u0[2], silu_f(g0[3]) * u0[3]);
                w.z = cvt_pk_bf16(silu_f(g1[0]) * u1[0], silu_f(g1[1]) * u1[1]); w.w = cvt_pk_bf16(silu_f(g1[2]) * u1[2], silu_f(g1[3]) * u1[3]);
                *(u32x4*)rowp = w;
            }
    }
};
struct EpiPlain {
    static constexpr bool PERM = true;
    bf16_t* O; int ldc; int row_off; int split_cols; size_t split_stride; float scale0; int headmajor;
    __device__ __forceinline__ void operator()(const f32x4 (&acc)[2][2][4][2], const pg8::Unit& u, int wr, int wc, int fr, int fq) const {
        const int row0 = row_off + u.pm * 256 + wr * 64 + fr; int colt = u.pn * 256; bf16_t* base = O; float sc = scale0; int t = 0;
        if (split_cols) { t = colt / split_cols; base += (size_t)t * split_stride; colt -= t * split_cols; if (t) sc = 1.f; }
        const int col0 = colt + wc * 32 + 8 * fq; const bool hm = headmajor && t > 0;
        const size_t rstride = hm ? 64 : (size_t)ldc;
        const size_t cofs0 = hm ? (size_t)(col0 >> 6) * MTOT * 64 + (col0 & 63) : (size_t)col0, cofs1 = hm ? (size_t)((col0 + 128) >> 6) * MTOT * 64 + ((col0 + 128) & 63) : (size_t)col0 + 128;
#pragma unroll
        for (int ai = 0; ai < 2; ++ai)
#pragma unroll
            for (int m = 0; m < 4; ++m) { bf16_t* rowp = base + (size_t)(row0 + ai * 128 + m * 16) * rstride;
#pragma unroll
                for (int bj = 0; bj < 2; ++bj) { const f32x4 v0 = acc[ai][bj][m][0] * sc, v1 = acc[ai][bj][m][1] * sc;
                    u32x4 w; w.x = cvt_pk_bf16(v0[0], v0[1]); w.y = cvt_pk_bf16(v0[2], v0[3]); w.z = cvt_pk_bf16(v1[0], v1[1]); w.w = cvt_pk_bf16(v1[2], v1[3]);
                    *(u32x4*)(rowp + (bj ? cofs1 : cofs0)) = w; } }
    }
};
struct EpiRetIn {
    static constexpr bool PERM = true;
    bf16_t* Q; bf16_t* K; bf16_t* V; const float* rcos; const float* rsin;
    __device__ __forceinline__ void operator()(const f32x4 (&acc)[2][2][4][2], const pg8::Unit& u, int wr, int wc, int fr, int fq) const {
        const int row0 = u.pm * 256 + wr * 64 + fr, cin = wc * 32 + 8 * fq;
        if (u.pn >= 8) {
#pragma unroll
            for (int ai = 0; ai < 2; ++ai)
#pragma unroll
                for (int m = 0; m < 4; ++m) { bf16_t* rowp = V + (size_t)(row0 + ai * 128 + m * 16) * 2048 + (u.pn - 8) * 256 + cin;
#pragma unroll
                    for (int bj = 0; bj < 2; ++bj) { const f32x4 v0 = acc[ai][bj][m][0], v1 = acc[ai][bj][m][1];
                        u32x4 w; w.x = cvt_pk_bf16(v0[0], v0[1]); w.y = cvt_pk_bf16(v0[2], v0[3]); w.z = cvt_pk_bf16(v1[0], v1[1]); w.w = cvt_pk_bf16(v1[2], v1[3]);
                        *(u32x4*)(rowp + bj * 128) = w; } }
        } else {
            bf16_t* T = (u.pn < 4) ? Q : K; const float mul = (u.pn < 4) ? 1.f : 0.0625f; const int f0 = wc * 16 + 4 * fq;
#pragma unroll
            for (int ai = 0; ai < 2; ++ai)
#pragma unroll
                for (int m = 0; m < 4; ++m) { const int row = row0 + ai * 128 + m * 16; bf16_t* rowp = T + (size_t)row * 1024 + (u.pn & 3) * 256 + cin;
                    const bool lat = row >= MCTX; const int t = (row - MCTX) & 4095;
#pragma unroll
                    for (int bj = 0; bj < 2; ++bj) { f32x4 v0 = acc[ai][bj][m][0] * mul, v1 = acc[ai][bj][m][1] * mul;
                        if (lat) { const int pos = bj ? (t & 63) : (t >> 6); const f32x4 cs = *(const f32x4*)(rcos + pos * 64 + f0), sn = *(const f32x4*)(rsin + pos * 64 + f0);
                            const f32x4 a0 = v0, a1 = v1;
                            v0[0] = a0[0] * cs[0] - a0[1] * sn[0]; v0[1] = a0[0] * sn[0] + a0[1] * cs[0]; v0[2] = a0[2] * cs[1] - a0[3] * sn[1]; v0[3] = a0[2] * sn[1] + a0[3] * cs[1];
                            v1[0] = a1[0] * cs[2] - a1[1] * sn[2]; v1[1] = a1[0] * sn[2] + a1[1] * cs[2]; v1[2] = a1[2] * cs[3] - a1[3] * sn[3]; v1[3] = a1[2] * sn[3] + a1[3] * cs[3]; }
                        u32x4 w; w.x = cvt_pk_bf16(v0[0], v0[1]); w.y = cvt_pk_bf16(v0[2], v0[3]); w.z = cvt_pk_bf16(v1[0], v1[1]); w.w = cvt_pk_bf16(v1[2], v1[3]);
                        *(u32x4*)(rowp + bj * 128) = w; } }
        }
    }
};
struct EpiGates {
    static constexpr bool PERM = true;
    bf16_t* GP;
    __device__ __forceinline__ void operator()(const f32x4 (&acc)[2][2][4][2], const pg8::Unit& u, int wr, int wc, int fr, int fq) const {
        const int row0 = u.pm * 256 + wr * 64 + fr, col0 = (u.pn & 1) * 1024 + (u.pn >> 1) * 256 + wc * 32 + 8 * fq;
#pragma unroll
        for (int ai = 0; ai < 2; ++ai)
#pragma unroll
            for (int m = 0; m < 4; ++m) { bf16_t* rowp = GP + (size_t)(row0 + ai * 128 + m * 16) * 2048 + col0;
#pragma unroll
                for (int bj = 0; bj < 2; ++bj) { const f32x4 v0 = acc[ai][bj][m][0], v1 = acc[ai][bj][m][1];
                    u32x4 w; w.x = cvt_pk_bf16(v0[0], v0[1]); w.y = cvt_pk_bf16(v0[2], v0[3]); w.z = cvt_pk_bf16(v1[0], v1[1]); w.w = cvt_pk_bf16(v1[2], v1[3]);
                    *(u32x4*)(rowp + bj * 128) = w; } }
    }
};

struct CvtJob { const float* src; bf16_t* dst; int K, N, ld, perm; };
__device__ __forceinline__ CvtJob get_job(const Args& a, int j) {
    bf16_t* wt = (bf16_t*)(a.ws + WS_WT); CvtJob r;
    if (j < 8)       { r.src = a.ffn_w_in + (size_t)j * 1024 * 5632; r.dst = wt + E_FFN_IN + (size_t)j * 5632 * 1024; r.K = 1024; r.N = 5632; r.ld = 5632; r.perm = 1; }
    else if (j < 16) { const int i = j - 8; r.src = a.ffn_w_out + (size_t)i * 2816 * 1024; r.dst = wt + E_FFN_OUT + (size_t)i * 1024 * 2816; r.K = 2816; r.N = 1024; r.ld = 1024; r.perm = 0; }
    else if (j < 18) { const int i = j - 16; r.src = a.ret_w_in + (size_t)i * 1024 * 6144; r.dst = wt + E_RET_IN + (size_t)i * 6144 * 1024; r.K = 1024; r.N = 6144; r.ld = 6144; r.perm = 2; }
    else if (j < 20) { const int i = j - 18; r.src = a.ret_w_out + (size_t)i * 2048 * 1024; r.dst = wt + E_RET_OUT + (size_t)i * 1024 * 2048; r.K = 2048; r.N = 1024; r.ld = 1024; r.perm = 0; }
    else if (j == 20) { r.src = a.na_w_qkv; r.dst = wt + E_NA_QKV; r.K = 1024; r.N = 3072; r.ld = 3072; r.perm = 0; }
    else if (j == 21) { r.src = a.na_w_out; r.dst = wt + E_NA_OUT; r.K = 1024; r.N = 1024; r.ld = 1024; r.perm = 0; }
    else if (j == 22) { r.src = a.lru_w_in; r.dst = wt + E_LRU_IN; r.K = 1024; r.N = 2048; r.ld = 2048; r.perm = 0; }
    else if (j == 23) { r.src = a.lru_w_out; r.dst = wt + E_LRU_OUT; r.K = 1024; r.N = 1024; r.ld = 1024; r.perm = 0; }
    else { const int gI = j - 24, dir = gI >> 3, type = (gI >> 2) & 1, k = gI & 3;
        r.src = (type ? a.lru_w_x : a.lru_w_a) + (size_t)(dir * 4 + k) * 256 * 256; r.dst = wt + E_GATES + (size_t)dir * 2048 * 256 + (size_t)((k * 2 + type) * 256) * 256; r.K = 256; r.N = 256; r.ld = 256; r.perm = 0; }
    return r;
}
__device__ __forceinline__ int perm_col(int perm, int n) {
    if (perm == 1) return ((n & 255) >> 7) * 2816 + (n >> 8) * 128 + (n & 127);
    if (perm == 2) { if (n < 2048) { const int hb = n >> 8, dp = n & 255, p = dp >> 1, e = dp & 1; const int d = (p < 64) ? (p + 64 * e) : (128 + (p - 64) + 64 * e); return hb * 256 + d; } return n; }
    return n;
}
__device__ __forceinline__ void phase_prologue(const Args& a, LAS unsigned char* lds) {
    const int tid = otid(), G = gridDim.x;
    { LAS bf16_t* tile = (LAS bf16_t*)lds;
      int cum = 0;
      for (int j = 0; j < 40; ++j) {
          const CvtJob jb = get_job(a, j);
          const int tn = jb.N >> 6, ntile = tn * (jb.K >> 6);
          const int first = (int)((blockIdx.x + G - (cum % G)) % G);
          for (int t = first; t < ntile; t += G) {
              const int n0 = (t % tn) * 64, k0 = (t / tn) * 64, c = tid & 63, kr = tid >> 6;
              const float* sp = jb.src + (size_t)k0 * jb.ld + perm_col(jb.perm, n0 + c);
              float v[8];
#pragma unroll
              for (int i = 0; i < 8; ++i) v[i] = sp[(size_t)(kr + 8 * i) * jb.ld];
#pragma unroll
              for (int i = 0; i < 8; ++i) tile[c * 72 + kr + 8 * i] = f2bf(v[i]);
              __syncthreads();
              const int row = tid >> 3, ch = tid & 7;
              const u32x4 w = *(const LAS u32x4*)(tile + row * 72 + ch * 8);
              *(u32x4*)(jb.dst + (size_t)(n0 + row) * jb.K + k0 + ch * 8) = w;
              __syncthreads();
          }
          cum += ntile;
      } }
    { LAS float* sv = (LAS float*)lds; LAS float* red = sv + 9 * 1024; float* MOD = (float*)(a.ws + WS_MOD);
      for (int i = tid; i < 9 * 1024; i += 512) { const int r = i >> 10, k = i & 1023; const float cv = (r < 8) ? a.c[r * 1024 + k] : a.c_ctx[k]; sv[i] = cv / (1.f + expf(-cv)); }
      __syncthreads();
      for (int it = blockIdx.x; it < 288; it += G) {
          const int l = it / 72, cb = it % 72, cl = tid & 127, kq = tid >> 7;
          const float* W = a.ada_w + (size_t)l * 1024 * 9216 + cb * 128 + cl;
          float acc[9];
#pragma unroll
          for (int r = 0; r < 9; ++r) acc[r] = 0.f;
          for (int k = kq * 256; k < kq * 256 + 256; k += 4) {
              float w[4];
#pragma unroll
              for (int q = 0; q < 4; ++q) w[q] = W[(size_t)(k + q) * 9216];
#pragma unroll
              for (int q = 0; q < 4; ++q)
#pragma unroll
                  for (int r = 0; r < 9; ++r) acc[r] += sv[r * 1024 + k + q] * w[q];
          }
#pragma unroll
          for (int r = 0; r < 9; ++r) red[(kq * 9 + r) * 128 + cl] = acc[r];
          __syncthreads();
          for (int o = tid; o < 9 * 128; o += 512) { const int r = o >> 7, cc = o & 127, col = cb * 128 + cc;
              const float s = (red[(0 * 9 + r) * 128 + cc] + red[(1 * 9 + r) * 128 + cc]) + (red[(2 * 9 + r) * 128 + cc] + red[(3 * 9 + r) * 128 + cc]);
              MOD[(size_t)(l * 9 + r) * 9216 + col] = s + a.ada_b[l * 9216 + col]; }
          __syncthreads();
      } }
    { float* rc = (float*)(a.ws + WS_ROPE); float* rs = rc + 4096;
      for (int i = blockIdx.x * 512 + tid; i < 4096; i += G * 512) { const int pos = i >> 6, f = i & 63; const float fr = expf(-(float)(2 * f) * (1.f / 128.f) * 9.210340371976184f); const float ang = (float)pos * fr;
          rc[i] = cosf(ang); rs[i] = sinf(ang); } }
}

__device__ __forceinline__ void phase_u0(const Args& a, const Grp& gp) {
    const float* MOD = (const float*)(a.ws + WS_MOD); bf16_t* U = (bf16_t*)(a.ws + WS_U);
    for (int i = gp.rank * 512 + otid(); i < gp.nb * 4352 * 128; i += gp.gsize * 512) {
        const int row = grp_row(gp, i >> 7), c8 = (i & 127) * 8; const int r9 = row < MCTX ? 8 : (row - MCTX) >> 12;
        const float* hp = (row < MCTX ? a.ctx + (size_t)row * 1024 : a.x + (size_t)(row - MCTX) * 1024) + c8;
        const float* sh = MOD + (size_t)(r9 * 9 + 0) * 1024 + c8; const float* sc = sh + 1024;
        const f32x4 h0 = *(const f32x4*)hp, h1 = *(const f32x4*)(hp + 4), s0 = *(const f32x4*)sh, s1 = *(const f32x4*)(sh + 4), c0 = *(const f32x4*)sc, c1 = *(const f32x4*)(sc + 4);
        const f32x4 o0 = h0 * (c0 + 1.f) + s0, o1 = h1 * (c1 + 1.f) + s1;
        u32x4 w; w.x = cvt_pk_bf16(o0[0], o0[1]); w.y = cvt_pk_bf16(o0[2], o0[3]); w.z = cvt_pk_bf16(o1[0], o1[1]); w.w = cvt_pk_bf16(o1[2], o1[3]);
        *(u32x4*)(U + (size_t)row * 1024 + c8) = w;
    }
}

__device__ __forceinline__ void phase_postnorm(const Args& a, bool first, const bf16_t* Y, const float* modl, int gate_j, float ymul, const float* lng, const float* lnb,
                                               const float* modn, int sh_j, int row_begin, const Grp& gp) {
    const int tid = otid(), lane = tid & 63, gw = gp.rank * 8 + (tid >> 6), nw = gp.gsize * 8;
    const int nrows = gp.nb * (row_begin ? 4096 : 4352);
    float* HC = (float*)(a.ws + WS_HC); bf16_t* U = (bf16_t*)(a.ws + WS_U);
    f32x4 hr[2][4]; u32x2 yr[2][4];
#define PN_MAP(lr) (row_begin ? grp_row_lat(gp, (lr)) : grp_row(gp, (lr)))
#define PN_ROW(t, lA) PN_MAP((t) ? (((lA) + nw < nrows) ? (lA) + nw : (lA)) : (lA))
#define PN_LOAD(dstH, dstY, rA) do { _Pragma("unroll") for (int t = 0; t < 2; ++t) { const int row = PN_ROW(t, rA); const bool isc = row < MCTX; \
        const float* hin = first ? (isc ? a.ctx + (size_t)row * 1024 : a.x + (size_t)(row - MCTX) * 1024) : (isc ? HC + (size_t)row * 1024 : a.out + (size_t)(row - MCTX) * 1024); \
        const bf16_t* yp = Y + (size_t)row * 1024; \
        _Pragma("unroll") for (int c = 0; c < 4; ++c) { const int col = c * 256 + lane * 4; dstH[t][c] = *(const f32x4*)(hin + col); dstY[t][c] = *(const u32x2*)(yp + col); } } } while (0)
    f32x4 gv[4], bv[4];
#pragma unroll
    for (int c = 0; c < 4; ++c) { gv[c] = *(const f32x4*)(lng + c * 256 + lane * 4); bv[c] = *(const f32x4*)(lnb + c * 256 + lane * 4); }
    const bool uni = gp.nb == 1;
    f32x4 gl[4], shl[4], scl[4];
#pragma unroll
    for (int c = 0; c < 4; ++c) { const int col = c * 256 + lane * 4; const int rl = uni ? gp.b_lo : 0;
        gl[c] = *(const f32x4*)(modl + (size_t)(rl * 9 + gate_j) * 1024 + col);
        shl[c] = *(const f32x4*)(modn + (size_t)(rl * 9 + (sh_j >= 0 ? sh_j : 0)) * 1024 + col); scl[c] = *(const f32x4*)(modn + (size_t)(rl * 9 + (sh_j >= 0 ? sh_j : 0) + 1) * 1024 + col); }
    int rowA = gw;
    if (rowA < nrows) PN_LOAD(hr, yr, rowA);
    for (; rowA < nrows; rowA += 2 * nw) {
        const bool hasB = rowA + nw < nrows;
        f32x4 v[2][4]; float s[2] = {0.f, 0.f}, q[2] = {0.f, 0.f};
#pragma unroll
        for (int t = 0; t < 2; ++t) { const int row = PN_ROW(t, rowA); const int r9 = row < MCTX ? 8 : (row - MCTX) >> 12;
            const float* gate = modl + (size_t)(r9 * 9 + gate_j) * 1024;
#pragma unroll
            for (int c = 0; c < 4; ++c) { const int col = c * 256 + lane * 4; const f32x4 gt = (uni && row >= MCTX) ? gl[c] : *(const f32x4*)(gate + col);
                const f32x4 y = {bflo(yr[t][c].x), bfhi(yr[t][c].x), bflo(yr[t][c].y), bfhi(yr[t][c].y)};
                v[t][c] = hr[t][c] * DN_ALPHA + gt * y * ymul; s[t] += (v[t][c][0] + v[t][c][1]) + (v[t][c][2] + v[t][c][3]);
                q[t] += (v[t][c][0] * v[t][c][0] + v[t][c][1] * v[t][c][1]) + (v[t][c][2] * v[t][c][2] + v[t][c][3] * v[t][c][3]); } }
        const int rowN = rowA + 2 * nw;
        if (rowN < nrows) PN_LOAD(hr, yr, rowN);
#pragma unroll
        for (int o = 32; o >= 1; o >>= 1) { const float s0 = shx(s[0], lane, o), s1 = shx(s[1], lane, o), q0 = shx(q[0], lane, o), q1 = shx(q[1], lane, o); s[0] += s0; s[1] += s1; q[0] += q0; q[1] += q1; }
#pragma unroll
        for (int t = 0; t < 2; ++t) { if (t && !hasB) break; const int row = PN_MAP(t ? rowA + nw : rowA);
            const bool isc = row < MCTX; const int r9 = isc ? 8 : (row - MCTX) >> 12;
            float* hout = isc ? HC + (size_t)row * 1024 : a.out + (size_t)(row - MCTX) * 1024;
            const float mean = s[t] * (1.f / 1024.f); const float var = fmaxf(q[t] * (1.f / 1024.f) - mean * mean, 0.f);
            const float rstd = 1.0f / sqrtf(var + LN_EPS);
#pragma unroll
            for (int c = 0; c < 4; ++c) { const int col = c * 256 + lane * 4;
                const f32x4 hn = (v[t][c] - mean) * rstd * gv[c] + bv[c]; *(f32x4*)(hout + col) = hn;
                if (sh_j >= 0) { f32x4 sh, sc; if (uni && !isc) { sh = shl[c]; sc = scl[c]; } else { sh = *(const f32x4*)(modn + (size_t)(r9 * 9 + sh_j) * 1024 + col); sc = *(const f32x4*)(modn + (size_t)(r9 * 9 + sh_j + 1) * 1024 + col); }
                    const f32x4 o = hn * (sc + 1.f) + sh; u32x2 w; w.x = cvt_pk_bf16(o[0], o[1]); w.y = cvt_pk_bf16(o[2], o[3]); *(u32x2*)(U + (size_t)row * 1024 + col) = w; } } }
    }
#undef PN_LOAD
#undef PN_ROW
#undef PN_MAP
}
template <int RABL>
__device__ __forceinline__ void phase_retention(const Args& a, LAS unsigned char* lds, const Grp& gp) {
    const bf16_t* Qg = (const bf16_t*)(a.ws + WS_BIG); const bf16_t* Kg = (const bf16_t*)(a.ws + WS_BIG + R1); const bf16_t* Vg = (const bf16_t*)(a.ws + WS_BIG + 2 * R1); bf16_t* Og = (bf16_t*)(a.ws + WS_BIG + 4 * R1);
    const int tid = otid(), w = __builtin_amdgcn_readfirstlane(tid >> 6), lane = tid & 63, c = lane & 15, g = lane >> 4;
    const int ib = w & 3, vh = w >> 2, vb2 = w & 3, dbase = (w >> 2) * 8;
    constexpr int QS = 0, KS = 32768, VS = 65536, ST = 73728;
    typedef short s16x4 __attribute__((ext_vector_type(4)));
    for (int item = gp.rank; item < gp.nb * 32; item += gp.gsize) {
        const int b = gp.b_lo + (item >> 5), h = (item >> 3) & 3, vs = item & 7;
        f32x4 accS[8]; u32x4 qreg[4], kreg[4], vreg; float lg = 0.f, g64 = 0.f;
        { const int row0 = b * 256;
#pragma unroll
          for (int i = 0; i < 4; ++i) { const int idx = tid + 512 * i, row = idx >> 5, ch = idx & 31; const size_t o = (size_t)(row0 + row) * 1024 + h * 256 + ch * 8; qreg[i] = *(const u32x4*)(Qg + o); kreg[i] = *(const u32x4*)(Kg + o); }
          vreg = *(const u32x4*)(Vg + (size_t)(row0 + (tid >> 3)) * 2048 + h * 512 + vs * 64 + (tid & 7) * 8); }
        for (int step = 0; step < 136; ++step) {
            const int dir = step >= 68 ? 1 : 0, s = step - 68 * dir;
            if (s == 0) {
#pragma unroll
                for (int x = 0; x < 8; ++x) accS[x] = (f32x4){0.f, 0.f, 0.f, 0.f};
                const int hh = dir ? 3 - h : h; lg = log2f(1.0f - exp2f(-5.0f - (float)hh)); g64 = exp2f(64.f * lg);
            }
            const int row0 = dir ? (s < 4 ? b * 256 + 64 * (3 - s) : MCTX + b * 4096 + 64 * (63 - (s - 4))) : (s < 4 ? b * 256 + 64 * s : MCTX + b * 4096 + 64 * (s - 4));
            __syncthreads();
            if (RABL != 1)
#pragma unroll
            for (int x = 0; x < 8; ++x) { const int d = 16 * (dbase + x) + c;
#pragma unroll
                for (int r = 0; r < 4; ++r) { const int v = 16 * vb2 + 4 * g + r; *(LAS bf16_t*)(lds + ST + v * 512 + (((d >> 3) ^ (v & 15)) << 4) + (d & 7) * 2) = f2bf(accS[x][r]); } }
#pragma unroll
            for (int i = 0; i < 4; ++i) { const int idx = tid + 512 * i, row = idx >> 5, ch = idx & 31; const int off = row * 512 + ((ch ^ (row & 15)) << 4);
                *(LAS u32x4*)(lds + QS + off) = qreg[i]; *(LAS u32x4*)(lds + KS + off) = kreg[i]; }
            { const int j = tid >> 3, ch = tid & 7; *(LAS u32x4*)(lds + VS + j * 128 + ((ch ^ ((j >> 1) & 7)) << 4)) = vreg; }
            __syncthreads();
            if (step + 1 < 136) { const int st2 = step + 1, dir2 = st2 >= 68 ? 1 : 0, s2 = st2 - 68 * dir2;
                const int nrow0 = dir2 ? (s2 < 4 ? b * 256 + 64 * (3 - s2) : MCTX + b * 4096 + 64 * (63 - (s2 - 4))) : (s2 < 4 ? b * 256 + 64 * s2 : MCTX + b * 4096 + 64 * (s2 - 4));
#pragma unroll
                for (int i = 0; i < 4; ++i) { const int idx = tid + 512 * i, row = idx >> 5, ch = idx & 31; const size_t o = (size_t)(nrow0 + row) * 1024 + h * 256 + ch * 8; qreg[i] = *(const u32x4*)(Qg + o); kreg[i] = *(const u32x4*)(Kg + o); }
                vreg = *(const u32x4*)(Vg + (size_t)(nrow0 + (tid >> 3)) * 2048 + h * 512 + vs * 64 + (tid & 7) * 8); }
            if (RABL == 2) continue;
            const int iq = 16 * ib + c;
            f32x4 accs[4], acco[2];
#pragma unroll
            for (int jb = 0; jb < 4; ++jb) accs[jb] = (f32x4){0.f, 0.f, 0.f, 0.f};
            acco[0] = (f32x4){0.f, 0.f, 0.f, 0.f}; acco[1] = (f32x4){0.f, 0.f, 0.f, 0.f};
#pragma unroll 1
            for (int ks = 0; ks < 8; ++ks) {
                const int sw = ((4 * ks + g) ^ c) << 4;
                const bf16x8 qf = *(const LAS bf16x8*)(lds + QS + iq * 512 + sw);
#pragma unroll
                for (int jb = 0; jb < 4; ++jb) { const bf16x8 kf = *(const LAS bf16x8*)(lds + KS + (16 * jb + c) * 512 + sw); accs[jb] = __builtin_amdgcn_mfma_f32_16x16x32_bf16(kf, qf, accs[jb], 0, 0, 0); }
#pragma unroll
                for (int vb = 0; vb < 2; ++vb) { const bf16x8 sf = *(const LAS bf16x8*)(lds + ST + (16 * (2 * vh + vb) + c) * 512 + sw); acco[vb] = __builtin_amdgcn_mfma_f32_16x16x32_bf16(sf, qf, acco[vb], 0, 0, 0); }
            }
            { const float qd = __builtin_amdgcn_exp2f(lg * (float)(dir ? 64 - iq : iq + 1)); acco[0] *= qd; acco[1] *= qd; }
#pragma unroll
            for (int jb = 0; jb < 4; ++jb)
#pragma unroll
                for (int r = 0; r < 4; ++r) { const int j = 16 * jb + 4 * g + r; const int df = dir ? j - iq : iq - j; const bool vis = dir ? (df > 0) : (df >= 0);
                    accs[jb][r] = vis ? accs[jb][r] * __builtin_amdgcn_exp2f(lg * (float)df) : 0.f; }
#pragma unroll
            for (int s2 = 0; s2 < 2; ++s2) {
                u32x4 pw; pw.x = cvt_pk_bf16(accs[2 * s2][0], accs[2 * s2][1]); pw.y = cvt_pk_bf16(accs[2 * s2][2], accs[2 * s2][3]); pw.z = cvt_pk_bf16(accs[2 * s2 + 1][0], accs[2 * s2 + 1][1]); pw.w = cvt_pk_bf16(accs[2 * s2 + 1][2], accs[2 * s2 + 1][3]);
                const bf16x8 pf = __builtin_bit_cast(bf16x8, pw);
#pragma unroll
                for (int vb = 0; vb < 2; ++vb) { const int vblk = 2 * vh + vb, ra = 32 * s2 + 4 * g + (c >> 2), rbb = ra + 16, cch = 2 * vblk + ((c & 3) >> 1);
                    const s16x4 lo = __builtin_amdgcn_ds_read_tr16_b64_v4i16((LAS s16x4*)(lds + VS + ra * 128 + ((cch ^ ((ra >> 1) & 7)) << 4) + 8 * (c & 1)));
                    const s16x4 hi = __builtin_amdgcn_ds_read_tr16_b64_v4i16((LAS s16x4*)(lds + VS + rbb * 128 + ((cch ^ ((rbb >> 1) & 7)) << 4) + 8 * (c & 1)));
                    const bf16x8 vf = {lo[0], lo[1], lo[2], lo[3], hi[0], hi[1], hi[2], hi[3]};
                    acco[vb] = __builtin_amdgcn_mfma_f32_16x16x32_bf16(vf, pf, acco[vb], 0, 0, 0); }
            }
#pragma unroll
            for (int vb = 0; vb < 2; ++vb) { bf16_t* op = Og + (size_t)(row0 + iq) * 2048 + h * 512 + vs * 64 + 16 * (2 * vh + vb) + 4 * g; f32x4 o = acco[vb];
                if (dir) { const u32x2 pv = *(const u32x2*)op; o[0] += bflo(pv.x); o[1] += bfhi(pv.x); o[2] += bflo(pv.y); o[3] += bfhi(pv.y); }
                u32x2 ow; ow.x = cvt_pk_bf16(o[0], o[1]); ow.y = cvt_pk_bf16(o[2], o[3]); *(u32x2*)op = ow; }
            { bf16x8 af[2];
              const int tq = c >> 2, tp = c & 3;
#pragma unroll
              for (int k2 = 0; k2 < 2; ++k2) { const int r0 = 32 * k2 + 8 * g + tq, r1 = r0 + 4, cch = 2 * vb2 + (tp >> 1);
                  const s16x4 t0 = __builtin_amdgcn_ds_read_tr16_b64_v4i16((LAS s16x4*)(lds + VS + r0 * 128 + ((cch ^ ((r0 >> 1) & 7)) << 4) + 8 * (tp & 1)));
                  const s16x4 t1 = __builtin_amdgcn_ds_read_tr16_b64_v4i16((LAS s16x4*)(lds + VS + r1 * 128 + ((cch ^ ((r1 >> 1) & 7)) << 4) + 8 * (tp & 1)));
                  const int j0 = 32 * k2 + 8 * g; float kd[8];
#pragma unroll
                  for (int e = 0; e < 8; ++e) kd[e] = __builtin_amdgcn_exp2f(lg * (float)(dir ? j0 + e : 63 - j0 - e));
                  u32x4 aw; aw.x = cvt_pk_bf16(bf2f((bf16_t)t0[0]) * kd[0], bf2f((bf16_t)t0[1]) * kd[1]); aw.y = cvt_pk_bf16(bf2f((bf16_t)t0[2]) * kd[2], bf2f((bf16_t)t0[3]) * kd[3]);
                  aw.z = cvt_pk_bf16(bf2f((bf16_t)t1[0]) * kd[4], bf2f((bf16_t)t1[1]) * kd[5]); aw.w = cvt_pk_bf16(bf2f((bf16_t)t1[2]) * kd[6], bf2f((bf16_t)t1[3]) * kd[7]);
                  af[k2] = __builtin_bit_cast(bf16x8, aw); }
#pragma unroll
              for (int x = 0; x < 8; ++x) { accS[x] *= g64; const int db = dbase + x;
#pragma unroll
                  for (int k2 = 0; k2 < 2; ++k2) { const int r0 = 32 * k2 + 8 * g + tq, r1 = r0 + 4;
                      const s16x4 t0 = __builtin_amdgcn_ds_read_tr16_b64_v4i16((LAS s16x4*)(lds + KS + r0 * 512 + (((2 * db + (tp >> 1)) ^ (r0 & 15)) << 4) + 8 * (tp & 1)));
                      const s16x4 t1 = __builtin_amdgcn_ds_read_tr16_b64_v4i16((LAS s16x4*)(lds + KS + r1 * 512 + (((2 * db + (tp >> 1)) ^ (r1 & 15)) << 4) + 8 * (tp & 1)));
                      const bf16x8 bfr = {t0[0], t0[1], t0[2], t0[3], t1[0], t1[1], t1[2], t1[3]};
                      accS[x] = __builtin_amdgcn_mfma_f32_16x16x32_bf16(af[k2], bfr, accS[x], 0, 0, 0); }
                  __builtin_amdgcn_sched_barrier(0); } }
        }
        __syncthreads();
    }
}

__device__ __forceinline__ void phase_ret_finish(const Args& a, int row_begin, const Grp& gp) {
    bf16_t* Og = (bf16_t*)(a.ws + WS_BIG + 4 * R1); const bf16_t* Gg = (const bf16_t*)(a.ws + WS_BIG);
    const int tid = otid(), lane = tid & 63, gw = gp.rank * 8 + (tid >> 6), nw = gp.gsize * 8, nrows = gp.nb * (row_begin ? 4096 : 4352);
    for (int lr = gw; lr < nrows; lr += nw) { const int row = row_begin ? grp_row_lat(gp, lr) : grp_row(gp, lr);
        const size_t base = (size_t)row * 2048 + (lane >> 4) * 512 + (lane & 15) * 32;
        float v[32]; float s = 0.f;
#pragma unroll
        for (int q = 0; q < 4; ++q) { const u32x4 w = *(const u32x4*)(Og + base + q * 8);
            v[q * 8 + 0] = bflo(w.x); v[q * 8 + 1] = bfhi(w.x); v[q * 8 + 2] = bflo(w.y); v[q * 8 + 3] = bfhi(w.y); v[q * 8 + 4] = bflo(w.z); v[q * 8 + 5] = bfhi(w.z); v[q * 8 + 6] = bflo(w.w); v[q * 8 + 7] = bfhi(w.w); }
#pragma unroll
        for (int i = 0; i < 32; ++i) s += v[i];
        s += shx(s, lane, 1); s += shx(s, lane, 2); s += shx(s, lane, 4); s += shx(s, lane, 8);
        const float mean = s * (1.f / 512.f); float qv = 0.f;
#pragma unroll
        for (int i = 0; i < 32; ++i) { const float d = v[i] - mean; qv += d * d; }
        qv += shx(qv, lane, 1); qv += shx(qv, lane, 2); qv += shx(qv, lane, 4); qv += shx(qv, lane, 8);
        const float rstd = 1.0f / sqrtf(qv * (1.f / 512.f) + LN_EPS);
#pragma unroll
        for (int q = 0; q < 4; ++q) { const u32x4 gwd = *(const u32x4*)(Gg + base + q * 8); const unsigned gw4[4] = {gwd.x, gwd.y, gwd.z, gwd.w}; unsigned ow[4];
#pragma unroll
            for (int p = 0; p < 4; ++p) { const float g0 = bflo(gw4[p]), g1 = bfhi(gw4[p]);
                ow[p] = cvt_pk_bf16(silu_f(g0) * (v[q * 8 + 2 * p] - mean) * rstd, silu_f(g1) * (v[q * 8 + 2 * p + 1] - mean) * rstd); }
            u32x4 o; o.x = ow[0]; o.y = ow[1]; o.z = ow[2]; o.w = ow[3]; *(u32x4*)(Og + base + q * 8) = o; }
    }
}

template <int ABL>
__device__ __forceinline__ void phase_na(const Args& a, LAS unsigned char* lds0, bf16_t* Odst, const Grp& gp) {
    const bf16_t* Qg = (const bf16_t*)(a.ws + WS_BIG); const bf16_t* Kg = (const bf16_t*)(a.ws + WS_BIG + R1); const bf16_t* Vg = (const bf16_t*)(a.ws + WS_BIG + 2 * R1);
    const int tid = otid(), w = __builtin_amdgcn_readfirstlane(tid >> 6), lane = tid & 63, c = lane & 15, g = lane >> 4, hb = w >> 2, w4 = w & 3, t2 = tid & 255;
    LAS unsigned char* lds = lds0 + hb * 65536;
    constexpr int QS = 0, KS = 32768, VT = 40960, RP = 49152;
    float mk[4][4]; int rco[4][4];
    { const int q0 = 16 * w4 + c, cs0 = min(max(q0 - 8, 0), 48);
#pragma unroll
      for (int kb = 0; kb < 4; ++kb)
#pragma unroll
          for (int e = 0; e < 4; ++e) { const int kc = 16 * kb + 4 * g + e; mk[kb][e] = (kc >= cs0 && kc < cs0 + 16) ? 0.f : -1e30f; rco[kb][e] = min(max(kc - q0 + 15, 0), 30) * 4; } }
    const int kb_lo = min(max(16 * w4 - 8, 0), 48) >> 4, kb_hi = (min(max(16 * w4 + 7, 0), 48) + 15) >> 4;
    for (int base_it = gp.rank * 2; base_it < gp.nb * 272; base_it += gp.gsize * 2) {
        const int it = base_it + hb, bb = it / 272, idx = it - bb * 272; const bool isl = (base_it % 272) < 256;
        const int b = gp.b_lo + bb; int h, r0 = 0, kr_lo = 0, kr_hi = 0;
        if (isl) { h = idx >> 4; r0 = (idx & 15) * 4; kr_lo = min(max(r0 - 4, 0), 56); kr_hi = min(max(r0 - 1, 0), 56) + 7; }
        else { h = idx - 256; }
        const int ntile = isl ? 15 : 4;
        __syncthreads();
#pragma unroll
        for (int i = 0; i < 8; ++i) { const int idx = t2 + 256 * i, row = idx >> 3, ch = idx & 7, rr = row >> 6, qi = row & 63;
            const int grow = isl ? MCTX + b * 4096 + (r0 + rr) * 64 + qi : b * 256 + rr * 64 + qi;
            *(LAS u32x4*)(lds + QS + row * 128 + ((ch ^ ((row >> 1) & 7)) << 4)) = *(const u32x4*)(Qg + (size_t)grow * 1024 + h * 64 + ch * 8); }
        for (int i = t2; i < 465; i += 256) *(LAS float*)(lds + RP + i * 4) = a.na_rpb[h * 465 + i];
        u32x4 kreg[2], vreg[2];
        { const int row0 = isl ? MCTX + b * 4096 + kr_lo * 64 : b * 256;
#pragma unroll
          for (int i = 0; i < 2; ++i) { const int idx = t2 + 256 * i, row = idx >> 3, ch = idx & 7; const size_t o = ((size_t)h * MTOT + row0 + row) * 64 + ch * 8; kreg[i] = *(const u32x4*)(Kg + o); vreg[i] = *(const u32x4*)(Vg + o); } }
        const int q = 16 * w4 + c;
        f32x4 oacc[4][4]; float mrun[4], lrun[4];
#pragma unroll
        for (int rr = 0; rr < 4; ++rr) { mrun[rr] = -1e30f; lrun[rr] = 0.f;
#pragma unroll
            for (int db = 0; db < 4; ++db) oacc[rr][db] = (f32x4){0.f, 0.f, 0.f, 0.f}; }
        for (int tl = 0; tl < ntile; ++tl) {
            if (ABL == 3) break;
            if (ABL == 4) { __syncthreads(); __syncthreads(); continue; }
            __syncthreads();
#pragma unroll
            for (int i = 0; i < 2; ++i) { const int idx = t2 + 256 * i, row = idx >> 3, ch = idx & 7;
                *(LAS u32x4*)(lds + KS + row * 128 + ((ch ^ ((row >> 1) & 7)) << 4)) = kreg[i];
                const unsigned vw[4] = {vreg[i].x, vreg[i].y, vreg[i].z, vreg[i].w};
#pragma unroll
                for (int e = 0; e < 8; ++e) { const int d = ch * 8 + e; const bf16_t val = (bf16_t)((e & 1) ? (vw[e >> 1] >> 16) : (vw[e >> 1] & 0xffffu));
                    *(LAS bf16_t*)(lds + VT + d * 128 + (((row >> 3) ^ ((d >> 1) & 7)) << 4) + (row & 7) * 2) = val; } }
            __syncthreads();
            if (tl + 1 < ntile) { const int t1 = tl + 1;
                const int row0 = isl ? (t1 < 11 ? MCTX + b * 4096 + min(kr_lo + t1, kr_hi) * 64 : b * 256 + (t1 - 11) * 64) : b * 256 + t1 * 64;
#pragma unroll
                for (int i = 0; i < 2; ++i) { const int idx = t2 + 256 * i, row = idx >> 3, ch = idx & 7; const size_t o = ((size_t)h * MTOT + row0 + row) * 64 + ch * 8; kreg[i] = *(const u32x4*)(Kg + o); vreg[i] = *(const u32x4*)(Vg + o); } }
            if (ABL == 2) continue;
            const bool local = isl && tl < 11; const int krow = kr_lo + tl;
            if (local && krow > kr_hi) continue;
#pragma unroll
            for (int rr = 0; rr < 4; ++rr) {
                const int r = r0 + rr, rs = min(max(r - 4, 0), 56);
                if (local && (krow < rs || krow >= rs + 8)) continue;
                bf16x8 qf[2];
#pragma unroll
                for (int ks = 0; ks < 2; ++ks) { const int qrow = rr * 64 + q; qf[ks] = *(const LAS bf16x8*)(lds + QS + qrow * 128 + (((4 * ks + g) ^ ((qrow >> 1) & 7)) << 4)); }
                f32x4 sT[4];
#pragma unroll
                for (int kb = 0; kb < 4; ++kb) { const bool skip = local && (kb < kb_lo || kb > kb_hi);
                    if (skip) { sT[kb] = (f32x4){-1e30f, -1e30f, -1e30f, -1e30f}; continue; }
                    sT[kb] = (f32x4){0.f, 0.f, 0.f, 0.f}; const int kr = 16 * kb + c;
#pragma unroll
                    for (int ks = 0; ks < 2; ++ks) { const bf16x8 kf = *(const LAS bf16x8*)(lds + KS + kr * 128 + (((4 * ks + g) ^ ((kr >> 1) & 7)) << 4)); sT[kb] = __builtin_amdgcn_mfma_f32_16x16x32_bf16(kf, qf[ks], sT[kb], 0, 0, 0); }
                    if (local) { const int rbase = RP + (krow - r + 7) * 124;
#pragma unroll
                        for (int e = 0; e < 4; ++e) sT[kb][e] = (sT[kb][e] + *(const LAS float*)(lds + rbase + rco[kb][e])) + mk[kb][e]; } }
                if (ABL == 1) { oacc[rr][0] += sT[0] + sT[1] + sT[2] + sT[3]; continue; }
                float mx = -1e30f;
#pragma unroll
                for (int kb = 0; kb < 4; ++kb) mx = fmaxf(mx, fmaxf(fmaxf(sT[kb][0], sT[kb][1]), fmaxf(sT[kb][2], sT[kb][3])));
                mx = fmaxf(mx, shx(mx, lane, 16)); mx = fmaxf(mx, shx(mx, lane, 32));
                const float mnew = fmaxf(mrun[rr], mx), alpha = __builtin_amdgcn_exp2f((mrun[rr] - mnew) * LOG2E); mrun[rr] = mnew;
                float ps = 0.f;
#pragma unroll
                for (int kb = 0; kb < 4; ++kb)
#pragma unroll
                    for (int e = 0; e < 4; ++e) { const float p = __builtin_amdgcn_exp2f((sT[kb][e] - mnew) * LOG2E); sT[kb][e] = p; ps += p; }
                ps += shx(ps, lane, 16); ps += shx(ps, lane, 32);
                lrun[rr] = lrun[rr] * alpha + ps;
#pragma unroll
                for (int db = 0; db < 4; ++db) oacc[rr][db] *= alpha;
#pragma unroll
                for (int s2 = 0; s2 < 2; ++s2) {
                    if (local && (2 * s2 + 1 < kb_lo || 2 * s2 > kb_hi)) continue;
                    u32x4 pw; pw.x = cvt_pk_bf16(sT[2 * s2][0], sT[2 * s2][1]); pw.y = cvt_pk_bf16(sT[2 * s2][2], sT[2 * s2][3]); pw.z = cvt_pk_bf16(sT[2 * s2 + 1][0], sT[2 * s2 + 1][1]); pw.w = cvt_pk_bf16(sT[2 * s2 + 1][2], sT[2 * s2 + 1][3]);
                    const bf16x8 pf = __builtin_bit_cast(bf16x8, pw);
#pragma unroll
                    for (int db = 0; db < 4; ++db) { const int vrow = 16 * db + c; const int sw = (vrow >> 1) & 7;
                        const u32x2 lo = *(const LAS u32x2*)(lds + VT + vrow * 128 + (((4 * s2 + (g >> 1)) ^ sw) << 4) + (g & 1) * 8);
                        const u32x2 hi = *(const LAS u32x2*)(lds + VT + vrow * 128 + (((4 * s2 + 2 + (g >> 1)) ^ sw) << 4) + (g & 1) * 8);
                        u32x4 vw; vw.x = lo.x; vw.y = lo.y; vw.z = hi.x; vw.w = hi.y;
                        oacc[rr][db] = __builtin_amdgcn_mfma_f32_16x16x32_bf16(__builtin_bit_cast(bf16x8, vw), pf, oacc[rr][db], 0, 0, 0); }
                }
            }
        }
        __syncthreads();
#pragma unroll
        for (int rr = 0; rr < 4; ++rr) { const float inv = 1.0f / lrun[rr]; const int orow = rr * 64 + q;
#pragma unroll
            for (int db = 0; db < 4; ++db) { const f32x4 o = oacc[rr][db] * inv; u32x2 ow; ow.x = cvt_pk_bf16(o[0], o[1]); ow.y = cvt_pk_bf16(o[2], o[3]);
                *(LAS u32x2*)(lds + QS + orow * 128 + (((2 * db + (g >> 1)) ^ ((orow >> 1) & 7)) << 4) + (g & 1) * 8) = ow; } }
        __syncthreads();
#pragma unroll
        for (int i = 0; i < 8; ++i) { const int idx = t2 + 256 * i, row = idx >> 3, ch = idx & 7, rr = row >> 6, qi = row & 63;
            const int grow = isl ? MCTX + b * 4096 + (r0 + rr) * 64 + qi : b * 256 + rr * 64 + qi;
            *(u32x4*)(Odst + (size_t)grow * 1024 + h * 64 + ch * 8) = *(const LAS u32x4*)(lds + QS + row * 128 + ((ch ^ ((row >> 1) & 7)) << 4)); }
    }
    __syncthreads();
}

__device__ __forceinline__ void phase_lru_conv(const Args& a, const Grp& gp) {
    const bf16_t* XR = (const bf16_t*)(a.ws + WS_BIG + R1); bf16_t* XC = (bf16_t*)(a.ws + WS_BIG + 2 * R1);
    for (int i = gp.rank * 512 + otid(); i < gp.nb * 4352 * 128; i += gp.gsize * 512) {
        const int row = grp_row(gp, i >> 7), c8 = (i & 127) * 8; const bool isc = row < MCTX; const int t = isc ? (row & 255) : ((row - MCTX) & 4095), len = isc ? 256 : 4096;
        float acc[8];
        { const f32x4 b0 = *(const f32x4*)(a.lru_conv_b + c8), b1 = *(const f32x4*)(a.lru_conv_b + c8 + 4); acc[0] = b0[0]; acc[1] = b0[1]; acc[2] = b0[2]; acc[3] = b0[3]; acc[4] = b1[0]; acc[5] = b1[1]; acc[6] = b1[2]; acc[7] = b1[3]; }
#pragma unroll
        for (int j = 0; j < 4; ++j) { const int tt = t - 2 + j;
            if (tt >= 0 && tt < len) { const u32x4 xw = *(const u32x4*)(XR + (size_t)(row - 2 + j) * 1024 + c8); const f32x4 w0 = *(const f32x4*)(a.lru_conv_w + j * 1024 + c8), w1 = *(const f32x4*)(a.lru_conv_w + j * 1024 + c8 + 4);
                acc[0] += w0[0] * bflo(xw.x); acc[1] += w0[1] * bfhi(xw.x); acc[2] += w0[2] * bflo(xw.y); acc[3] += w0[3] * bfhi(xw.y);
                acc[4] += w1[0] * bflo(xw.z); acc[5] += w1[1] * bfhi(xw.z); acc[6] += w1[2] * bflo(xw.w); acc[7] += w1[3] * bfhi(xw.w); } }
        u32x4 o; o.x = cvt_pk_bf16(acc[0], acc[1]); o.y = cvt_pk_bf16(acc[2], acc[3]); o.z = cvt_pk_bf16(acc[4], acc[5]); o.w = cvt_pk_bf16(acc[6], acc[7]);
        *(u32x4*)(XC + (size_t)row * 1024 + c8) = o;
    }
}
__device__ __forceinline__ void phase_lru_scan(const Args& a, int dir, int pass, const Grp& gp) {
    const bf16_t* GATE = (const bf16_t*)(a.ws + WS_BIG); bf16_t* HF = (bf16_t*)(a.ws + WS_BIG + R1); const bf16_t* XC = (const bf16_t*)(a.ws + WS_BIG + 2 * R1); const bf16_t* GP = (const bf16_t*)(a.ws + WS_BIG + 3 * R1);
    float* CARRY = (float*)(a.ws + WS_CARRY);
    for (int idx = gp.rank * 512 + otid(); idx < gp.nb * 64 * 256; idx += gp.gsize * 512) {
        const int cq = idx & 255, chunk = (idx >> 8) & 63, b = gp.b_lo + (idx >> 14), c0 = cq * 4;
        float ba[4], bx[4], sp[4], h[4], P[4];
        { const f32x4 t0 = *(const f32x4*)(a.lru_b_a + dir * 1024 + c0), t1 = *(const f32x4*)(a.lru_b_x + dir * 1024 + c0), t2 = *(const f32x4*)(a.lru_lam + dir * 1024 + c0);
#pragma unroll
          for (int k = 0; k < 4; ++k) { ba[k] = t0[k]; bx[k] = t1[k]; sp[k] = -8.f * log1pf(expf(-t2[k])); h[k] = 0.f; P[k] = 1.f; } }
        if (pass == 2) { for (int cc = 0; cc < chunk; ++cc) { const float* cp = CARRY + ((size_t)(b * 64 + cc) * 256 + cq) * 8; const f32x4 pp = *(const f32x4*)cp, ll = *(const f32x4*)(cp + 4);
#pragma unroll
            for (int k = 0; k < 4; ++k) h[k] = pp[k] * h[k] + ll[k]; } }
        for (int t4 = 0; t4 < 17; ++t4) {
            u32x2 rw[4], iw[4], xw[4], hw[4], gw[4]; int rows[4];
#pragma unroll
            for (int j = 0; j < 4; ++j) { const int p = chunk * 68 + t4 * 4 + j;
                const int row = dir ? (p < 256 ? b * 256 + (255 - p) : MCTX + b * 4096 + (4095 - (p - 256))) : (p < 256 ? b * 256 + p : MCTX + b * 4096 + (p - 256));
                rows[j] = row;
                rw[j] = *(const u32x2*)(GP + (size_t)row * 2048 + c0); iw[j] = *(const u32x2*)(GP + (size_t)row * 2048 + 1024 + c0); xw[j] = *(const u32x2*)(XC + (size_t)row * 1024 + c0);
                if (pass == 2 && dir == 1) { hw[j] = *(const u32x2*)(HF + (size_t)row * 1024 + c0); gw[j] = *(const u32x2*)(GATE + (size_t)row * 1024 + c0); } }
#pragma unroll
            for (int j = 0; j < 4; ++j) {
                const float rp[4] = {bflo(rw[j].x), bfhi(rw[j].x), bflo(rw[j].y), bfhi(rw[j].y)}, ip[4] = {bflo(iw[j].x), bfhi(iw[j].x), bflo(iw[j].y), bfhi(iw[j].y)}, xv[4] = {bflo(xw[j].x), bfhi(xw[j].x), bflo(xw[j].y), bfhi(xw[j].y)};
#pragma unroll
                for (int k = 0; k < 4; ++k) { const float la = sp[k] * sigmoid_f(rp[k] + ba[k]); const float av = __expf(la); const float m = sqrtf(fmaxf(-expm1f(2.f * la), 0.f));
                    h[k] = av * h[k] + m * sigmoid_f(ip[k] + bx[k]) * xv[k]; if (pass == 1) P[k] *= av; }
                if (pass == 2) { bf16_t* hp = HF + (size_t)rows[j] * 1024 + c0; u32x2 o;
                    if (dir == 0) { o.x = cvt_pk_bf16(h[0], h[1]); o.y = cvt_pk_bf16(h[2], h[3]); }
                    else { o.x = cvt_pk_bf16(gelu_tanh_f(bflo(gw[j].x)) * (bflo(hw[j].x) + h[0]), gelu_tanh_f(bfhi(gw[j].x)) * (bfhi(hw[j].x) + h[1]));
                           o.y = cvt_pk_bf16(gelu_tanh_f(bflo(gw[j].y)) * (bflo(hw[j].y) + h[2]), gelu_tanh_f(bfhi(gw[j].y)) * (bfhi(hw[j].y) + h[3])); }
                    *(u32x2*)hp = o; }
            }
        }
        if (pass == 1) { float* cp = CARRY + ((size_t)(b * 64 + chunk) * 256 + cq) * 8; *(f32x4*)cp = (f32x4){P[0], P[1], P[2], P[3]}; *(f32x4*)(cp + 4) = (f32x4){h[0], h[1], h[2], h[3]}; }
    }
}
constexpr int NPHASE = 52;
enum { OP_PROLOGUE, OP_U0, OP_GEMM_SWIGLU, OP_GEMM_PLAIN, OP_GEMM_RETIN, OP_GEMM_GATES, OP_POSTNORM, OP_RETSCAN, OP_RETFIN, OP_NAATT, OP_LRUCONV, OP_LRUSCAN };

typedef const Args __attribute__((address_space(4)))* KArgsPtr;
__global__ void __launch_bounds__(512) hybrid_fwd(Args a_in) {
    extern __shared__ __attribute__((aligned(16))) unsigned char lds_raw[];
    LAS unsigned char* lds = (LAS unsigned char*)lds_raw;
    const int ph_lo = a_in.ph_lo, ph_hi = a_in.ph_hi;
    volatile LAS unsigned* xb_st = (volatile LAS unsigned*)(lds + LDS_BYTES - 16);
    unsigned* xb_bar = (unsigned*)(a_in.ws + WS_BAR);
    if (threadIdx.x < 4) xb_st[threadIdx.x] = 0u;
    __syncthreads();
    if (threadIdx.x == 0) { const unsigned x = xb_xcc_id(); const unsigned r = xb_add(&xb_bar[XB_XCNT(x)], 1u); xb_st[2] = r | (x << 8); }
    int nexec = 0;
#ifdef PROBE_DBL
    for (int pp = 2 * ph_lo; pp < 2 * ph_hi; ++pp) { const int p = pp >> 1;
#else
    for (int p = ph_lo; p < ph_hi; ++p) {
#endif
#if defined(__HIP_DEVICE_COMPILE__)
        KArgsPtr ka = (KArgsPtr)__builtin_amdgcn_kernarg_segment_ptr(); asm volatile("" : "+s"(ka));
        Args a; __builtin_memcpy(&a, ka, sizeof(Args));
#else
        const Args a = a_in;
#endif
        bf16_t* WT = (bf16_t*)(a.ws + WS_WT); bf16_t* U = (bf16_t*)(a.ws + WS_U); unsigned char* BIG = a.ws + WS_BIG; const float* MOD = (const float*)(a.ws + WS_MOD);
        int op = OP_PROLOGUE, l = 0, s = 0, kind = 0, mi = 0, rb = 0, gsel = 0, sdir = 0, spass = 0; bool mixpn = false;
        if (p == 0) op = OP_PROLOGUE;
        else if (p == 1) op = OP_U0;
        else {
            const int q = p - 2; int li;
            if (q < 12) { l = 0; li = q; } else if (q < 22) { l = 1; li = q - 12; } else if (q < 38) { l = 2; li = q - 22; } else { l = 3; li = q - 38; }
            kind = l % 3; mi = l / 3; const int nmix = kind == 0 ? 6 : (kind == 1 ? 4 : 10);
            rb = (l == 3 && li >= 5) ? MCTX : 0;
            if (li < 3 || li >= 3 + nmix) {
                s = li < 3 ? 0 : 1; const int fs = li < 3 ? li : li - 3 - nmix;
                if (fs == 0) op = OP_GEMM_SWIGLU; else if (fs == 1) { op = OP_GEMM_PLAIN; gsel = 0; } else op = OP_POSTNORM;
            } else {
                const int ms = li - 3;
                if (ms == nmix - 1) { op = OP_POSTNORM; mixpn = true; }
                else if (kind == 0) { if (ms == 0) op = OP_GEMM_RETIN; else if (ms == 1) op = OP_RETSCAN; else if (ms == 2) { op = OP_GEMM_PLAIN; gsel = 1; } else if (ms == 3) op = OP_RETFIN; else { op = OP_GEMM_PLAIN; gsel = 2; } }
                else if (kind == 1) { if (ms == 0) { op = OP_GEMM_PLAIN; gsel = 3; } else if (ms == 1) op = OP_NAATT; else { op = OP_GEMM_PLAIN; gsel = 4; } }
                else { if (ms == 0) { op = OP_GEMM_PLAIN; gsel = 5; } else if (ms == 1) op = OP_LRUCONV; else if (ms == 2 || ms == 5) { op = OP_GEMM_GATES; sdir = ms == 5 ? 1 : 0; }
                       else if (ms == 3 || ms == 4) { op = OP_LRUSCAN; sdir = 0; spass = ms - 2; } else if (ms == 6 || ms == 7) { op = OP_LRUSCAN; sdir = 1; spass = ms - 5; } else { op = OP_GEMM_PLAIN; gsel = 6; } }
            }
        }
#ifdef PROBE_DBL
#if PROBE_DBL == 10
        if ((pp & 1) && p != 0) continue;
#else
        if (pp & 1) { const bool pdbl = (PROBE_DBL == 1) ? (op == OP_GEMM_SWIGLU || op == OP_GEMM_PLAIN || op == OP_GEMM_RETIN || op == OP_GEMM_GATES)
                        : (PROBE_DBL == 3) ? (op == OP_RETSCAN) : (PROBE_DBL == 10) ? (op == OP_PROLOGUE) : (PROBE_DBL == 8) ? (op == OP_GEMM_SWIGLU) : (PROBE_DBL == 5) ? (op == OP_NAATT) : (PROBE_DBL == 6) ? (op == OP_LRUCONV || (op == OP_LRUSCAN && !(sdir == 1 && spass == 2))) : (PROBE_DBL == 2) ? (op == OP_POSTNORM && l == 0 && s == 0 && !mixpn) : false;
            if (!pdbl) continue; }
#endif
#endif
        { const unsigned xm = (unsigned)__builtin_amdgcn_readfirstlane((int)xb_st[3]);
          const bool relayout = (op == OP_GEMM_SWIGLU && s == 1) || op == OP_GEMM_RETIN || (op == OP_GEMM_PLAIN && (gsel == 1 || gsel == 3 || gsel == 5));
          if (nexec == 1) cg::this_grid().sync();
          else if (nexec > 1) { if (xm && !relayout) xcd_local_barrier((unsigned*)(a.ws + WS_BAR), ((unsigned)__builtin_amdgcn_readfirstlane((int)xb_st[2]) >> 8) & 0xffu, 32u);
                                else xcd_barrier((unsigned*)(a.ws + WS_BAR), xb_st); } }
        if (nexec == 1 && ph_lo == 0) {
            if (threadIdx.x == 0) { bool ok = gridDim.x == 256;
                for (unsigned j = 0; j < 16; ++j) { const unsigned cnt = xb_ld(&xb_bar[XB_XCNT(j)]); ok = ok && (j < 8 ? cnt == 32u : cnt == 0u); }
#ifdef PROBE_NO_XMODE
                ok = false;
#endif
                xb_st[3] = ok ? 1u : 0u; }
            __syncthreads(); }
        ++nexec;
        const unsigned gword = (unsigned)__builtin_amdgcn_readfirstlane((int)xb_st[2]), xmode = (unsigned)__builtin_amdgcn_readfirstlane((int)xb_st[3]);
        Grp grp; if (xmode) { grp.b_lo = (int)((gword >> 8) & 0xffu); grp.nb = 1; grp.rank = (int)(gword & 0xffu); grp.gsize = 32; } else { grp.b_lo = 0; grp.nb = 8; grp.rank = (int)blockIdx.x; grp.gsize = (int)gridDim.x; }
        switch (op) {
#ifndef NO_OP_PROLOGUE
            case OP_PROLOGUE: phase_prologue(a, lds); break;
#endif
#ifndef NO_OP_U0
            case OP_U0: phase_u0(a, grp); break;
#endif
#ifndef NO_OP_GEMM_SWIGLU
            case OP_GEMM_SWIGLU: { const pg8::Gemm gg{U, WT + E_FFN_IN + (size_t)(l * 2 + s) * 5632 * 1024, MTOT, 5632, 1024, 1024, 0, 0};
                pg8::GroupOrder S; S.init(grp.nb, grp.b_lo, rb != 0, gg.N, grp.gsize, grp.rank); EpiSwiGLU E{(bf16_t*)BIG, 0}; pg8::gemm_phase<EpiSwiGLU, pg8::GroupOrder>(lds, gg, S, E); } break;
#endif
#ifndef NO_OP_GEMM_PLAIN
            case OP_GEMM_PLAIN: { const bf16_t* gA; const bf16_t* gB; int gN, gK, glda; bf16_t* eO; int eldc = 1024, esplit = 0, ehm = 0; size_t estride = 0; float escale = 1.f;
                if (gsel == 0)      { gA = (const bf16_t*)BIG; gB = WT + E_FFN_OUT + (size_t)(l * 2 + s) * 1024 * 2816; gN = 1024; gK = 2816; glda = 2816; eO = (bf16_t*)(BIG + 3 * R1); }
                else if (gsel == 1) { gA = U; gB = WT + E_RET_IN + (size_t)mi * 6144 * 1024 + (size_t)4096 * 1024; gN = 2048; gK = 1024; glda = 1024; eO = (bf16_t*)BIG; eldc = 2048; }
                else if (gsel == 2) { gA = (const bf16_t*)(BIG + 4 * R1); gB = WT + E_RET_OUT + (size_t)mi * 1024 * 2048; gN = 1024; gK = 2048; glda = 2048; eO = (bf16_t*)(BIG + 2 * R1); }
                else if (gsel == 3) { gA = U; gB = WT + E_NA_QKV; gN = 3072; gK = 1024; glda = 1024; eO = (bf16_t*)BIG; esplit = 1024; estride = R1 / 2; escale = 0.125f; ehm = 1; }
                else if (gsel == 4) { gA = (const bf16_t*)BIG; gB = WT + E_NA_OUT; gN = 1024; gK = 1024; glda = 1024; eO = (bf16_t*)(BIG + 3 * R1); }
                else if (gsel == 5) { gA = U; gB = WT + E_LRU_IN; gN = 2048; gK = 1024; glda = 1024; eO = (bf16_t*)BIG; esplit = 1024; estride = R1 / 2; }
                else                { gA = (const bf16_t*)(BIG + R1); gB = WT + E_LRU_OUT; gN = 1024; gK = 1024; glda = 1024; eO = (bf16_t*)(BIG + 2 * R1); }
                const pg8::Gemm gg{gA, gB, MTOT, gN, gK, glda, 0, 0}; pg8::GroupOrder S; S.init(grp.nb, grp.b_lo, rb != 0, gg.N, grp.gsize, grp.rank);
                EpiPlain E{eO, eldc, 0, esplit, estride, escale, ehm}; pg8::gemm_phase<EpiPlain, pg8::GroupOrder>(lds, gg, S, E); } break;
#endif
#ifndef NO_OP_GEMM_RETIN
            case OP_GEMM_RETIN: { const pg8::Gemm gg{U, WT + E_RET_IN + (size_t)mi * 6144 * 1024, MTOT, 4096, 1024, 1024, 0, 0}; pg8::GroupOrder S; S.init(grp.nb, grp.b_lo, false, gg.N, grp.gsize, grp.rank);
                EpiRetIn E{(bf16_t*)BIG, (bf16_t*)(BIG + R1), (bf16_t*)(BIG + 2 * R1), (const float*)(a.ws + WS_ROPE), (const float*)(a.ws + WS_ROPE) + 4096}; pg8::gemm_phase<EpiRetIn, pg8::GroupOrder>(lds, gg, S, E); } break;
#endif
#ifndef NO_OP_GEMM_GATES
            case OP_GEMM_GATES: { const pg8::Gemm gg{(const bf16_t*)(BIG + 2 * R1), WT + E_GATES + (size_t)sdir * 2048 * 256, MTOT, 2048, 256, 1024, 1, 256}; pg8::GroupOrder S; S.init(grp.nb, grp.b_lo, false, gg.N, grp.gsize, grp.rank);
                EpiGates E{(bf16_t*)(BIG + 3 * R1)}; pg8::gemm_phase<EpiGates, pg8::GroupOrder>(lds, gg, S, E); } break;
#endif
#ifndef NO_OP_POSTNORM
            case OP_POSTNORM: { const float* modl = MOD + (size_t)l * 9 * 9216;
                if (mixpn) phase_postnorm(a, false, (const bf16_t*)(BIG + (kind == 1 ? 3 : 2) * R1), modl, 5, 1.f, a.ln_g + (size_t)(l * 3 + 1) * 1024, a.ln_b + (size_t)(l * 3 + 1) * 1024, modl, 6, rb, grp);
                else { const int li3 = l * 3 + (s == 0 ? 0 : 2); const float* modn = (s == 0) ? modl : MOD + (size_t)(l < 3 ? l + 1 : l) * 9 * 9216; const int psh = (s == 0) ? 3 : (l < 3 ? 0 : -1);
                    phase_postnorm(a, l == 0 && s == 0, (const bf16_t*)(BIG + 3 * R1), modl, s == 0 ? 2 : 8, 0.5f, a.ln_g + (size_t)li3 * 1024, a.ln_b + (size_t)li3 * 1024, modn, psh, rb, grp); } } break;
#endif
#ifndef NO_OP_RETSCAN
#if defined(PROBE_DBL) && PROBE_DBL == 3
#ifndef PROBE_RET_ABL
#define PROBE_RET_ABL 0
#endif
            case OP_RETSCAN: if (pp & 1) phase_retention<0>(a, lds, grp); else phase_retention<PROBE_RET_ABL>(a, lds, grp); break;
#else
            case OP_RETSCAN: phase_retention<0>(a, lds, grp); break;
#endif
#endif
#ifndef NO_OP_RETFIN
            case OP_RETFIN: phase_ret_finish(a, rb, grp); break;
#endif
#ifndef NO_OP_NAATT
#if defined(PROBE_DBL) && PROBE_DBL == 5
#ifndef PROBE_NA_ABL
#define PROBE_NA_ABL 0
#endif
            case OP_NAATT: if (pp & 1) phase_na<0>(a, lds, (bf16_t*)BIG, grp); else phase_na<PROBE_NA_ABL>(a, lds, (bf16_t*)(BIG + 3 * R1), grp); break;
#else
            case OP_NAATT: phase_na<0>(a, lds, (bf16_t*)BIG, grp); break;
#endif
#endif
#ifndef NO_OP_LRUCONV
            case OP_LRUCONV: phase_lru_conv(a, grp); break;
#endif
#ifndef NO_OP_LRUSCAN
            case OP_LRUSCAN: phase_lru_scan(a, sdir, spass, grp); break;
#endif
            default: break;
        }
    }
}

#ifndef MK_PER_PHASE
#define MK_PER_PHASE 0
#endif
extern "C" void kernel_launch(void* const* d_in, const int* in_sizes, int n_in, void* d_out, int out_size, void* d_ws, size_t ws_size, hipStream_t stream) {
    static int grid = 0;
    if (grid == 0) {
        if (n_in != 24 || out_size != MLAT * 1024 || ws_size < WS_END) { fprintf(stderr, "kernel_launch: unexpected shapes: n_in %d out %d ws %zu (need %zu)\n", n_in, out_size, ws_size, (size_t)WS_END); grid = -1; return; }
        int dev = 0, cus = 0, per_cu = 0;
        if (hipGetDevice(&dev) != hipSuccess || hipDeviceGetAttribute(&cus, hipDeviceAttributeMultiprocessorCount, dev) != hipSuccess) { grid = -1; return; }
        if (hipFuncSetAttribute((const void*)hybrid_fwd, hipFuncAttributeMaxDynamicSharedMemorySize, LDS_BYTES) != hipSuccess) { fprintf(stderr, "kernel_launch: hipFuncSetAttribute failed\n"); grid = -1; return; }
        if (hipOccupancyMaxActiveBlocksPerMultiprocessor(&per_cu, (const void*)hybrid_fwd, 512, LDS_BYTES) != hipSuccess || per_cu < 1) { fprintf(stderr, "kernel_launch: occupancy query says %d\n", per_cu); per_cu = 1; }
        (void)hipGetLastError();
        grid = cus * 1;
    }
    if (grid < 0) return;
    if (hipMemsetAsync((char*)d_ws + WS_BAR, 0, 16384, stream) != hipSuccess) { fprintf(stderr, "kernel_launch: barrier memset failed\n"); return; }
    Args a{};
    const float** pp = (const float**)&a;
    for (int i = 0; i < 24; ++i) pp[i] = (const float*)d_in[i];
    a.out = (float*)d_out; a.ws = (unsigned char*)d_ws;
#if MK_PER_PHASE
    for (int p = 0; p < NPHASE; ++p) { a.ph_lo = p; a.ph_hi = p + 1; hipLaunchKernelGGL(hybrid_fwd, dim3(grid), dim3(512), LDS_BYTES, stream, a); }
#else
    a.ph_lo = 0; a.ph_hi = NPHASE;
    void* args[] = {&a};
    hipError_t e = hipLaunchCooperativeKernel((const void*)hybrid_fwd, dim3(grid), dim3(512), args, LDS_BYTES, stream);
    if (e != hipSuccess) fprintf(stderr, "cooperative launch failed: %s (grid %d)\n", hipGetErrorString(e), grid);
#endif
}
```

```cpp
#include <hip/hip_runtime.h>
#include <hip/hip_cooperative_groups.h>
#include <cstdio>
namespace cg = cooperative_groups;

#define LAS __attribute__((address_space(3)))
typedef unsigned short bf16_t;
typedef short bf16x8 __attribute__((ext_vector_type(8)));
typedef float f32x4 __attribute__((ext_vector_type(4)));
typedef unsigned u32x4 __attribute__((ext_vector_type(4)));
typedef unsigned u32x2 __attribute__((ext_vector_type(2)));

constexpr int DM = 1024, NB = 8, SEQ = 4096, CTXL = 256, DFF = 2816;
constexpr int MCTX = NB * CTXL, MLAT = NB * SEQ, MTOT = MCTX + MLAT;
constexpr int NMOD = 9;
constexpr float DN_ALPHA = 1.681792830507429f;
constexpr float LN_EPS = 1e-5f;
constexpr float LOG2E = 1.4426950408889634f;
constexpr int LDS_BYTES = 147456;

constexpr size_t E_FFN_IN = 0;
constexpr size_t E_FFN_OUT = E_FFN_IN + (size_t)8 * 5632 * 1024;
constexpr size_t E_RET_IN = E_FFN_OUT + (size_t)8 * 1024 * 2816;
constexpr size_t E_RET_OUT = E_RET_IN + (size_t)2 * 6144 * 1024;
constexpr size_t E_NA_QKV = E_RET_OUT + (size_t)2 * 1024 * 2048;
constexpr size_t E_NA_OUT = E_NA_QKV + (size_t)3072 * 1024;
constexpr size_t E_LRU_IN = E_NA_OUT + (size_t)1024 * 1024;
constexpr size_t E_LRU_OUT = E_LRU_IN + (size_t)2048 * 1024;
constexpr size_t E_GATES = E_LRU_OUT + (size_t)1024 * 1024;
constexpr size_t E_WT_END = E_GATES + (size_t)2 * 2048 * 256;
constexpr size_t R1 = (size_t)MTOT * 1024 * 2;
constexpr size_t WS_WT = 0;
constexpr size_t WS_U = WS_WT + E_WT_END * 2;
constexpr size_t WS_HC = WS_U + R1;
constexpr size_t WS_MOD = WS_HC + (size_t)MCTX * 1024 * 4;
constexpr size_t WS_ROPE = WS_MOD + (size_t)4 * 9 * 9216 * 4;
constexpr size_t WS_CARRY = WS_ROPE + (size_t)2 * 4096 * 4;
constexpr size_t WS_BAR = WS_CARRY + (size_t)NB * 68 * 1024 * 2 * 4;
constexpr size_t WS_BIG = WS_BAR + 16384;
constexpr size_t WS_END = WS_BIG + 6 * R1;

struct Args {
    const float* x; const float* c; const float* ctx; const float* c_ctx; const float* ada_w; const float* ada_b; const float* ln_g; const float* ln_b;
    const float* ffn_w_in; const float* ffn_w_out; const float* ret_w_in; const float* ret_w_out; const float* na_w_qkv; const float* na_rpb; const float* na_w_out;
    const float* lru_w_in; const float* lru_conv_w; const float* lru_conv_b; const float* lru_w_a; const float* lru_b_a; const float* lru_w_x; const float* lru_b_x;
    const float* lru_lam; const float* lru_w_out;
    float* out; unsigned char* ws; int ph_lo, ph_hi;
};

struct Grp { int b_lo, nb, rank, gsize; };
__device__ __forceinline__ int grp_row(const Grp& g, int lr) { const int b = g.b_lo + lr / 4352, t = lr % 4352; return t < 256 ? b * 256 + t : MCTX + b * 4096 + (t - 256); }
__device__ __forceinline__ int grp_row_lat(const Grp& g, int lr) { return MCTX + (g.b_lo + (lr >> 12)) * 4096 + (lr & 4095); }
__device__ __forceinline__ int otid() { int t = threadIdx.x; asm volatile("" : "+v"(t)); return t; }
__device__ __forceinline__ float shx(float v, int lane, int m) { return __int_as_float(__builtin_amdgcn_ds_bpermute((lane ^ m) << 2, __float_as_int(v))); }
__device__ __forceinline__ unsigned cvt_pk_bf16(float lo, float hi) { unsigned r; asm volatile("v_cvt_pk_bf16_f32 %0, %1, %2" : "=v"(r) : "v"(lo), "v"(hi)); return r; }
__device__ __forceinline__ float bflo(unsigned w) { return __uint_as_float(w << 16); }
__device__ __forceinline__ float bfhi(unsigned w) { return __uint_as_float(w & 0xffff0000u); }
__device__ __forceinline__ float bf2f(bf16_t b) { return __uint_as_float(((unsigned)b) << 16); }
__device__ __forceinline__ bf16_t f2bf(float f) { return (bf16_t)(cvt_pk_bf16(f, 0.f) & 0xffffu); }
__device__ __forceinline__ float silu_f(float x) { return x * __builtin_amdgcn_rcpf(1.f + __expf(-x)); }
__device__ __forceinline__ float sigmoid_f(float x) { return __builtin_amdgcn_rcpf(1.f + __expf(-x)); }
__device__ __forceinline__ float gelu_tanh_f(float x) { const float z = 0.7978845608028654f * (x + 0.044715f * x * x * x); const float t = 1.f - 2.f * __builtin_amdgcn_rcpf(__expf(2.f * z) + 1.f); return 0.5f * x * (1.f + t); }

namespace pg8 {
constexpr int BM = 256, BK = 64, HALF = 128, HTB = HALF * BK * 2  , STAGE_BYTES = 8 * HTB, NXCD = 8, WGM = 8;
__host__ __device__ __forceinline__ int lds_byte(int r, int c) { const int st = (r >> 4) * 2 + (c >> 5), rr = r & 15, cc = c & 31, ob = rr * 64 + cc * 2; return st * 1024 + (ob ^ (((ob >> 9) & 1) << 5)); }
__host__ __device__ __forceinline__ void stage_rc(int b, int& R, int& C) { const int st = b / 1024, sb = b % 1024, swz = sb ^ (((sb >> 9) & 1) << 5); R = (st >> 1) * 16 + swz / 64; C = (st & 1) * 32 + (swz % 64) / 2; }
__host__ __device__ __forceinline__ int perm32(int rho) { const int n = rho >> 4, i = rho & 15; return 8 * (i >> 2) + 4 * n + (i & 3); }

struct Unit { int pm, pn; };
struct Gemm { const bf16_t* A; const bf16_t* Bt; int M, N, K, lda, a_sh, a_cols; };

struct StaticOrder {
    int nM, nN, nwg, G, c;
    __host__ __device__ void init(int M, int N, int G_, int c_) { nM = M / BM; nN = N / BM; nwg = nM * nN; G = G_; c = c_; }
    __host__ __device__ bool next(int i, Unit& u) const {
        const long L = (long)i * G + c; if (L >= nwg) return false;
        int wgid = (int)L; { const int q = nwg / NXCD, r = nwg % NXCD, xcd = wgid % NXCD, off = wgid / NXCD; wgid = (xcd < r ? xcd * (q + 1) : r * (q + 1) + (xcd - r) * q) + off; }
        const int nig = WGM * nN, gid = wgid / nig, fm = gid * WGM, gsz = (nM - fm) < WGM ? (nM - fm) : WGM;
        u.pm = fm + ((wgid % nig) % gsz); u.pn = (wgid % nig) / gsz; return true;
    }
    __device__ __forceinline__ void a_ready(const Unit&) const {}
    __device__ __forceinline__ void done(const Unit&) const {}
};

struct GroupOrder {
    int nP, nN, nwg, G, c, b_lo, per, W;
    __device__ void init(int nb, int b_lo_, bool skipctx, int N, int G_, int c_) { per = skipctx ? 16 : 17; nP = nb * per; nN = N / BM; nwg = nP * nN; G = G_; c = c_; b_lo = b_lo_;
        const int ng = (nP + WGM - 1) / WGM; W = (nP + ng - 1) / ng; }
    __device__ bool next(int i, Unit& u) const {
        const long L = (long)i * G + c; if (L >= nwg) return false;
        const int wgid = (int)L, nig = W * nN, gid = wgid / nig, fm = gid * W, gsz = (nP - fm) < W ? (nP - fm) : W;
        const int lp = fm + ((wgid % nig) % gsz); u.pn = (wgid % nig) / gsz;
        const int b = b_lo + lp / per, j = lp % per;
        u.pm = (per == 16) ? 8 + 16 * b + j : (j == 0 ? b : 8 + 16 * b + j - 1);
        return true;
    }
    __device__ __forceinline__ void a_ready(const Unit&) const {}
    __device__ __forceinline__ void done(const Unit&) const {}
};

template <class Epi, class Sched>
__device__ __forceinline__ void gemm_phase(LAS unsigned char* lds, const Gemm g, const Sched& S, const Epi& E) {
    const int tid = otid(), wid = __builtin_amdgcn_readfirstlane(tid >> 6), lane = tid & 63, wr = wid >> 2, wc = wid & 3, fr = lane & 15, fq = lane >> 4;
    const int K = g.K, nt = K / BK, lda = g.lda;
    unsigned voffA[2], voffB[2];
#pragma unroll
    for (int i = 0; i < 2; ++i) { int R, C; stage_rc(tid * 16 + i * 8192, R, C); const int Rb = Epi::PERM ? ((R & ~31) + perm32(R & 31)) : R;
        voffA[i] = (unsigned)(R * lda + C) * 2u; voffB[i] = (unsigned)(Rb * K + C) * 2u; }
    const size_t kstep = (size_t)(BK * 2);
    const size_t hstepA = (size_t)HALF * lda * 2, hstepB = (size_t)HALF * K * 2;
    const size_t tstepA = 2 * hstepA, tstepB = 2 * hstepB;
    const unsigned ldsw = (unsigned)wid * 1024u;
    const int aoff = lds_byte(wr * 64 + fr, fq * 8), boff = lds_byte(wc * 32 + fr, fq * 8);
#define PG8_SA(b, h) (((b) * 2 + (h)) * HTB)
#define PG8_SB(b, h) ((4 + (b) * 2 + (h)) * HTB)
#define PG8_STAGE(bufoff, gbase, voff) do { _Pragma("unroll") for (int _i = 0; _i < 2; ++_i) \
        __builtin_amdgcn_global_load_lds((const unsigned*)((const char*)(gbase) + (voff)[_i]), (LAS unsigned*)(lds + (bufoff) + ldsw + _i * 8192), 16, 0, 0); } while (0)
#define PG8_LDA(dst, b, h) do { _Pragma("unroll") for (int m = 0; m < 4; ++m) _Pragma("unroll") for (int k = 0; k < 2; ++k) dst[m][k] = *(const LAS bf16x8*)(lds + PG8_SA(b, h) + aoff + m * 2048 + k * 1024); } while (0)
#define PG8_LDB(dst, b, h) do { _Pragma("unroll") for (int n = 0; n < 2; ++n) _Pragma("unroll") for (int k = 0; k < 2; ++k) dst[n][k] = *(const LAS bf16x8*)(lds + PG8_SB(b, h) + boff + n * 2048 + k * 1024); } while (0)
#define PG8_MMA(ai, bj, At, Bt) do { __builtin_amdgcn_s_setprio(1); _Pragma("unroll") for (int m = 0; m < 4; ++m) _Pragma("unroll") for (int n = 0; n < 2; ++n) _Pragma("unroll") for (int k = 0; k < 2; ++k) \
        acc[ai][bj][m][n] = __builtin_amdgcn_mfma_f32_16x16x32_bf16(Bt[n][k], At[m][k], acc[ai][bj][m][n], 0, 0, 0); __builtin_amdgcn_s_setprio(0); } while (0)
#define PG8_WAIT_V(n) asm volatile("s_waitcnt vmcnt(" #n ")" ::: "memory")
#define PG8_WAIT_L(n) asm volatile("s_waitcnt lgkmcnt(" #n ")" ::: "memory")
#define PG8_BAR __builtin_amdgcn_s_barrier()
#define PG8_SCHED __builtin_amdgcn_sched_barrier(0)
#define PG8_AOFF(u) ((size_t)(u).pm * tstepA + (size_t)(((u).pn >> g.a_sh) * g.a_cols) * 2)
    Unit cur, nxt; int ui = 0;
    if (!S.next(0, cur)) return;
    f32x4 acc[2][2][4][2];
#pragma unroll
    for (int a = 0; a < 2; ++a)
#pragma unroll
        for (int b = 0; b < 2; ++b)
#pragma unroll
            for (int m = 0; m < 4; ++m)
#pragma unroll
                for (int n = 0; n < 2; ++n) acc[a][b][m][n] = (f32x4){0.f, 0.f, 0.f, 0.f};
    bf16x8 At[4][2], B0[2][2], B1[2][2];
    const char* cA = (const char*)g.A + PG8_AOFF(cur); const char* cB = (const char*)g.Bt + (size_t)cur.pn * tstepB;
    S.a_ready(cur);
    PG8_STAGE(PG8_SB(0, 0), cB, voffB); PG8_STAGE(PG8_SA(0, 0), cA, voffA); PG8_STAGE(PG8_SB(0, 1), cB + hstepB, voffB); PG8_STAGE(PG8_SA(0, 1), cA + hstepA, voffA);
    if (wr == 1) PG8_BAR;
    PG8_WAIT_V(4); PG8_BAR;
    PG8_STAGE(PG8_SB(1, 0), cB + kstep, voffB); PG8_STAGE(PG8_SA(1, 0), cA + kstep, voffA); PG8_STAGE(PG8_SB(1, 1), cB + hstepB + kstep, voffB);
    PG8_WAIT_V(6); PG8_BAR;
    for (;;) {
        const bool has_next = S.next(ui + 1, nxt);
        const char* nA = has_next ? (const char*)g.A + PG8_AOFF(nxt) : cA; const char* nB = has_next ? (const char*)g.Bt + (size_t)nxt.pn * tstepB : cB;
        for (int t = 0; t < nt; t += 2) {
            const bool last = (t == nt - 2);
            const char* a1 = cA + (size_t)(t + 1) * kstep;
            const char* a2 = last ? nA : cA + (size_t)(t + 2) * kstep; const char* b2 = last ? nB : cB + (size_t)(t + 2) * kstep;
            const char* a3 = a2 + kstep; const char* b3 = b2 + kstep;
            if (last && has_next) S.a_ready(nxt);
            PG8_LDB(B0, 0, 0); PG8_SCHED; PG8_LDA(At, 0, 0); PG8_STAGE(PG8_SA(1, 1), a1 + hstepA, voffA);
            PG8_WAIT_L(8); PG8_BAR; PG8_WAIT_L(0); PG8_MMA(0, 0, At, B0); PG8_BAR; PG8_SCHED;
            PG8_LDB(B1, 0, 1); PG8_STAGE(PG8_SB(0, 0), b2, voffB);
            PG8_BAR; PG8_WAIT_L(0); PG8_MMA(0, 1, At, B1); PG8_BAR;
            PG8_LDA(At, 0, 1); PG8_STAGE(PG8_SA(0, 0), a2, voffA);
            PG8_BAR; PG8_WAIT_L(0); PG8_MMA(1, 0, At, B0); PG8_BAR; PG8_SCHED;
            PG8_STAGE(PG8_SB(0, 1), b2 + hstepB, voffB);
            PG8_WAIT_V(6); PG8_BAR; PG8_MMA(1, 1, At, B1); PG8_BAR;
            PG8_LDB(B0, 1, 0); PG8_SCHED; PG8_LDA(At, 1, 0); PG8_STAGE(PG8_SA(0, 1), a2 + hstepA, voffA);
            PG8_WAIT_L(8); PG8_BAR; PG8_WAIT_L(0); PG8_MMA(0, 0, At, B0); PG8_BAR; PG8_SCHED;
            PG8_LDB(B1, 1, 1); PG8_STAGE(PG8_SB(1, 0), b3, voffB);
            PG8_BAR; PG8_WAIT_L(0); PG8_MMA(0, 1, At, B1); PG8_BAR;
            PG8_LDA(At, 1, 1); PG8_STAGE(PG8_SA(1, 0), a3, voffA);
            PG8_BAR; PG8_WAIT_L(0); PG8_MMA(1, 0, At, B0); PG8_BAR; PG8_SCHED;
            PG8_STAGE(PG8_SB(1, 1), b3 + hstepB, voffB);
            PG8_WAIT_V(6); PG8_BAR; PG8_MMA(1, 1, At, B1); PG8_BAR;
        }
        E(acc, cur, wr, wc, fr, fq); S.done(cur);
        if (!has_next) break;
#pragma unroll
        for (int a = 0; a < 2; ++a)
#pragma unroll
            for (int b = 0; b < 2; ++b)
#pragma unroll
                for (int m = 0; m < 4; ++m)
#pragma unroll
                    for (int n = 0; n < 2; ++n) acc[a][b][m][n] = (f32x4){0.f, 0.f, 0.f, 0.f};
        cur = nxt; cA = nA; cB = nB; ++ui;
    }
    PG8_WAIT_V(0);
    if (wr == 0) PG8_BAR;
    PG8_BAR;
#undef PG8_SA
#undef PG8_SB
#undef PG8_STAGE
#undef PG8_LDA
#undef PG8_LDB
#undef PG8_MMA
#undef PG8_WAIT_V
#undef PG8_WAIT_L
#undef PG8_BAR
#undef PG8_SCHED
#undef PG8_AOFF
}
}

#define XB_TMO      128
#define XB_XCNT(j)  (256  + 64 * (j))
#define XB_XSUB(j)  (1280 + 64 * (j))
#define XB_XGEN(j)  (2304 + 64 * (j))
#define XB_TOP      3328
#define XB_TOPGEN   3392
#define XCD_BAR_WORDS 3456
#define XB_LSUB(j)  (3456 + 64 * (j))
#define XB_LGEN(j)  (3488 + 64 * (j))
#define XB_SPIN_CAP (1u << 21)
__device__ __forceinline__ unsigned xb_ld(unsigned* p)              { return __hip_atomic_load(p, __ATOMIC_RELAXED, __HIP_MEMORY_SCOPE_AGENT); }
__device__ __forceinline__ unsigned xb_add(unsigned* p, unsigned v) { return __hip_atomic_fetch_add(p, v, __ATOMIC_RELAXED, __HIP_MEMORY_SCOPE_AGENT); }
__device__ __forceinline__ unsigned xb_xcc_id() { return (unsigned)__builtin_amdgcn_s_getreg((3 << 11) | 20) & 0xFu; }
#define XB_SPIN(cond, bar) do { unsigned _sp = 0; while (cond) { __builtin_amdgcn_s_sleep(1); \
    if ((++_sp & 255u) == 0u) { if (xb_ld(&(bar)[XB_TMO])) break; if (_sp > XB_SPIN_CAP) { atomicAdd(&(bar)[XB_TMO], 1u); break; } } } } while (0)
__device__ __forceinline__ void xcd_barrier_complete(unsigned* bar, unsigned x, unsigned& nloc, unsigned& nx) {
    const unsigned G = gridDim.x * gridDim.y * gridDim.z;
    unsigned sum, cnt, mine, sp = 0u;
    for (;;) {
        sum = 0u; cnt = 0u; mine = 0u;
#pragma unroll
        for (unsigned j = 0; j < 16; ++j) { const unsigned c = xb_ld(&bar[XB_XCNT(j)]); sum += c; cnt += (c > 0u) ? 1u : 0u; mine = (j == x) ? c : mine; }
        if (sum == G) break;
        __builtin_amdgcn_s_sleep(1);
        if ((++sp & 255u) == 0u) { if (xb_ld(&bar[XB_TMO])) break; if (sp > XB_SPIN_CAP) { atomicAdd(&bar[XB_TMO], 1u); break; } }
    }
    nloc = mine > 0u ? mine : 1u; nx = cnt > 0u ? cnt : 1u;
}
__device__ __forceinline__ void xcd_barrier(unsigned* bar, volatile LAS unsigned* st) {
    asm volatile("s_waitcnt vmcnt(0)" ::: "memory");
    __syncthreads();
    if (threadIdx.x == 0) {
        const unsigned x = xb_xcc_id();
        __builtin_amdgcn_s_waitcnt(0);
        unsigned nloc = st[0], nx = st[1];
        if (nloc == 0u) { xcd_barrier_complete(bar, x, nloc, nx); st[0] = nloc; st[1] = nx; }
        const unsigned old = xb_add(&bar[XB_XSUB(x)], 1u);
        const unsigned gen = old / nloc;
        if (old + 1u == (gen + 1u) * nloc) {
            __builtin_amdgcn_fence(__ATOMIC_RELEASE, "agent");
            asm volatile("s_waitcnt vmcnt(0)" ::: "memory");
            const unsigned og = xb_add(&bar[XB_TOP], 1u);
            const unsigned tg = og / nx;
            if (og + 1u == (tg + 1u) * nx) xb_add(&bar[XB_TOPGEN], 1u);
            else XB_SPIN(xb_ld(&bar[XB_TOPGEN]) == tg, bar);
            __builtin_amdgcn_fence(__ATOMIC_ACQUIRE, "agent");
            xb_add(&bar[XB_XGEN(x)], 1u);
            asm volatile("s_waitcnt vmcnt(0)" ::: "memory");
        } else {
            XB_SPIN(xb_ld(&bar[XB_XGEN(x)]) == gen, bar);
            __builtin_amdgcn_fence(__ATOMIC_ACQUIRE, "agent");
            asm volatile("s_waitcnt vmcnt(0)" ::: "memory");
        }
    }
    __syncthreads();
}

__device__ __forceinline__ void xcd_local_barrier(unsigned* bar, unsigned x, unsigned nloc) {
    asm volatile("s_waitcnt vmcnt(0)" ::: "memory");
    __syncthreads();
    if (threadIdx.x == 0) {
        __builtin_amdgcn_s_waitcnt(0);
        const unsigned old = xb_add(&bar[XB_LSUB(x)], 1u), gen = old / nloc;
        if (old + 1u == (gen + 1u) * nloc) xb_add(&bar[XB_LGEN(x)], 1u);
        else XB_SPIN(xb_ld(&bar[XB_LGEN(x)]) == gen, bar);
        __builtin_amdgcn_fence(__ATOMIC_ACQUIRE, "agent");
        asm volatile("s_waitcnt vmcnt(0)" ::: "memory");
    }
    __syncthreads();
}
struct EpiSwiGLU {
    static constexpr bool PERM = true;
    bf16_t* H; int row_off;
    __device__ __forceinline__ void operator()(const f32x4 (&acc)[2][2][4][2], const pg8::Unit& u, int wr, int wc, int fr, int fq) const {
        const int row0 = row_off + u.pm * 256 + wr * 64 + fr, hc = u.pn * 128 + wc * 32 + 8 * fq;
#pragma unroll
        for (int ai = 0; ai < 2; ++ai)
#pragma unroll
            for (int m = 0; m < 4; ++m) {
                bf16_t* rowp = H + (size_t)(row0 + ai * 128 + m * 16) * DFF + hc;
                const f32x4 g0 = acc[ai][0][m][0], g1 = acc[ai][0][m][1], u0 = acc[ai][1][m][0], u1 = acc[ai][1][m][1];
                u32x4 w;
                w.x = cvt_pk_bf16(silu_f(g0[0]) * u0[0], silu_f(g0[1]) * u0[1]); w.y = cvt_pk_bf16(silu_f(g0[2]) * u0[2], silu_f(g0[3]) * u0[3]);
                w.z = cvt_pk_bf16(silu_f(g1[0]) * u1[0], silu_f(g1[1]) * u1[1]); w.w = cvt_pk_bf16(silu_f(g1[2]) * u1[2], silu_f(g1[3]) * u1[3]);
                *(u32x4*)rowp = w;
            }
    }
};
struct EpiPlain {
    static constexpr bool PERM = true;
    bf16_t* O; int ldc; int row_off; int split_cols; size_t split_stride; float scale0; int headmajor;
    __device__ __forceinline__ void operator()(const f32x4 (&acc)[2][2][4][2], const pg8::Unit& u, int wr, int wc, int fr, int fq) const {
        const int row0 = row_off + u.pm * 256 + wr * 64 + fr; int colt = u.pn * 256; bf16_t* base = O; float sc = scale0; int t = 0;
        if (split_cols) { t = colt / split_cols; base += (size_t)t * split_stride; colt -= t * split_cols; if (t) sc = 1.f; }
        const int col0 = colt + wc * 32 + 8 * fq; const bool hm = headmajor && t > 0;
        const size_t rstride = hm ? 64 : (size_t)ldc;
        const size_t cofs0 = hm ? (size_t)(col0 >> 6) * MTOT * 64 + (col0 & 63) : (size_t)col0, cofs1 = hm ? (size_t)((col0 + 128) >> 6) * MTOT * 64 + ((col0 + 128) & 63) : (size_t)col0 + 128;
#pragma unroll
        for (int ai = 0; ai < 2; ++ai)
#pragma unroll
            for (int m = 0; m < 4; ++m) { bf16_t* rowp = base + (size_t)(row0 + ai * 128 + m * 16) * rstride;
#pragma unroll
                for (int bj = 0; bj < 2; ++bj) { const f32x4 v0 = acc[ai][bj][m][0] * sc, v1 = acc[ai][bj][m][1] * sc;
                    u32x4 w; w.x = cvt_pk_bf16(v0[0], v0[1]); w.y = cvt_pk_bf16(v0[2], v0[3]); w.z = cvt_pk_bf16(v1[0], v1[1]); w.w = cvt_pk_bf16(v1[2], v1[3]);
                    *(u32x4*)(rowp + (bj ? cofs1 : cofs0)) = w; } }
    }
};
struct EpiRetIn {
    static constexpr bool PERM = true;
    bf16_t* Q; bf16_t* K; bf16_t* V; const float* rcos; const float* rsin;
    __device__ __forceinline__ void operator()(const f32x4 (&acc)[2][2][4][2], const pg8::Unit& u, int wr, int wc, int fr, int fq) const {
        const int row0 = u.pm * 256 + wr * 64 + fr, cin = wc * 32 + 8 * fq;
        if (u.pn >= 8) {
#pragma unroll
            for (int ai = 0; ai < 2; ++ai)
#pragma unroll
                for (int m = 0; m < 4; ++m) { bf16_t* rowp = V + (size_t)(row0 + ai * 128 + m * 16) * 2048 + (u.pn - 8) * 256 + cin;
#pragma unroll
                    for (int bj = 0; bj < 2; ++bj) { const f32x4 v0 = acc[ai][bj][m][0], v1 = acc[ai][bj][m][1];
                        u32x4 w; w.x = cvt_pk_bf16(v0[0], v0[1]); w.y = cvt_pk_bf16(v0[2], v0[3]); w.z = cvt_pk_bf16(v1[0], v1[1]); w.w = cvt_pk_bf16(v1[2], v1[3]);
                        *(u32x4*)(rowp + bj * 128) = w; } }
        } else {
            bf16_t* T = (u.pn < 4) ? Q : K; const float mul = (u.pn < 4) ? 1.f : 0.0625f; const int f0 = wc * 16 + 4 * fq;
#pragma unroll
            for (int ai = 0; ai < 2; ++ai)
#pragma unroll
                for (int m = 0; m < 4; ++m) { const int row = row0 + ai * 128 + m * 16; bf16_t* rowp = T + (size_t)row * 1024 + (u.pn & 3) * 256 + cin;
                    const bool lat = row >= MCTX; const int t = (row - MCTX) & 4095;
#pragma unroll
                    for (int bj = 0; bj < 2; ++bj) { f32x4 v0 = acc[ai][bj][m][0] * mul, v1 = acc[ai][bj][m][1] * mul;
                        if (lat) { const int pos = bj ? (t & 63) : (t >> 6); const f32x4 cs = *(const f32x4*)(rcos + pos * 64 + f0), sn = *(const f32x4*)(rsin + pos * 64 + f0);
                            const f32x4 a0 = v0, a1 = v1;
                            v0[0] = a0[0] * cs[0] - a0[1] * sn[0]; v0[1] = a0[0] * sn[0] + a0[1] * cs[0]; v0[2] = a0[2] * cs[1] - a0[3] * sn[1]; v0[3] = a0[2] * sn[1] + a0[3] * cs[1];
                            v1[0] = a1[0] * cs[2] - a1[1] * sn[2]; v1[1] = a1[0] * sn[2] + a1[1] * cs[2]; v1[2] = a1[2] * cs[3] - a1[3] * sn[3]; v1[3] = a1[2] * sn[3] + a1[3] * cs[3]; }
                        u32x4 w; w.x = cvt_pk_bf16(v0[0], v0[1]); w.y = cvt_pk_bf16(v0[2], v0[3]); w.z = cvt_pk_bf16(v1[0], v1[1]); w.w = cvt_pk_bf16(v1[2], v1[3]);
                        *(u32x4*)(rowp + bj * 128) = w; } }
        }
    }
};
struct EpiGates {
    static constexpr bool PERM = true;
    bf16_t* GP;
    __device__ __forceinline__ void operator()(const f32x4 (&acc)[2][2][4][2], const pg8::Unit& u, int wr, int wc, int fr, int fq) const {
        const int row0 = u.pm * 256 + wr * 64 + fr, col0 = (u.pn & 1) * 1024 + (u.pn >> 1) * 256 + wc * 32 + 8 * fq;
#pragma unroll
        for (int ai = 0; ai < 2; ++ai)
#pragma unroll
            for (int m = 0; m < 4; ++m) { bf16_t* rowp = GP + (size_t)(row0 + ai * 128 + m * 16) * 2048 + col0;
#pragma unroll
                for (int bj = 0; bj < 2; ++bj) { const f32x4 v0 = acc[ai][bj][m][0], v1 = acc[ai][bj][m][1];
                    u32x4 w; w.x = cvt_pk_bf16(v0[0], v0[1]); w.y = cvt_pk_bf16(v0[2], v0[3]); w.z = cvt_pk_bf16(v1[0], v1[1]); w.w = cvt_pk_bf16(v1[2], v1[3]);
                    *(u32x4*)(rowp + bj * 128) = w; } }
    }
};

struct CvtJob { const float* src; bf16_t* dst; int K, N, ld, perm; };
__device__ __forceinline__ CvtJob get_job(const Args& a, int j) {
    bf16_t* wt = (bf16_t*)(a.ws + WS_WT); CvtJob r;
    if (j < 8)       { r.src = a.ffn_w_in + (size_t)j * 1024 * 5632; r.dst = wt + E_FFN_IN + (size_t)j * 5632 * 1024; r.K = 1024; r.N = 5632; r.ld = 5632; r.perm = 1; }
    else if (j < 16) { const int i = j - 8; r.src = a.ffn_w_out + (size_t)i * 2816 * 1024; r.dst = wt + E_FFN_OUT + (size_t)i * 1024 * 2816; r.K = 2816; r.N = 1024; r.ld = 1024; r.perm = 0; }
    else if (j < 18) { const int i = j - 16; r.src = a.ret_w_in + (size_t)i * 1024 * 6144; r.dst = wt + E_RET_IN + (size_t)i * 6144 * 1024; r.K = 1024; r.N = 6144; r.ld = 6144; r.perm = 2; }
    else if (j < 20) { const int i = j - 18; r.src = a.ret_w_out + (size_t)i * 2048 * 1024; r.dst = wt + E_RET_OUT + (size_t)i * 1024 * 2048; r.K = 2048; r.N = 1024; r.ld = 1024; r.perm = 0; }
    else if (j == 20) { r.src = a.na_w_qkv; r.dst = wt + E_NA_QKV; r.K = 1024; r.N = 3072; r.ld = 3072; r.perm = 0; }
    else if (j == 21) { r.src = a.na_w_out; r.dst = wt + E_NA_OUT; r.K = 1024; r.N = 1024; r.ld = 1024; r.perm = 0; }
    else if (j == 22) { r.src = a.lru_w_in; r.dst = wt + E_LRU_IN; r.K = 1024; r.N = 2048; r.ld = 2048; r.perm = 0; }
    else if (j == 23) { r.src = a.lru_w_out; r.dst = wt + E_LRU_OUT; r.K = 1024; r.N = 1024; r.ld = 1024; r.perm = 0; }
    else { const int gI = j - 24, dir = gI >> 3, type = (gI >> 2) & 1, k = gI & 3;
        r.src = (type ? a.lru_w_x : a.lru_w_a) + (size_t)(dir * 4 + k) * 256 * 256; r.dst = wt + E_GATES + (size_t)dir * 2048 * 256 + (size_t)((k * 2 + type) * 256) * 256; r.K = 256; r.N = 256; r.ld = 256; r.perm = 0; }
    return r;
}
__device__ __forceinline__ int perm_col(int perm, int n) {
    if (perm == 1) return ((n & 255) >> 7) * 2816 + (n >> 8) * 128 + (n & 127);
    if (perm == 2) { if (n < 2048) { const int hb = n >> 8, dp = n & 255, p = dp >> 1, e = dp & 1; const int d = (p < 64) ? (p + 64 * e) : (128 + (p - 64) + 64 * e); return hb * 256 + d; } return n; }
    return n;
}
__device__ __forceinline__ void phase_prologue(const Args& a, LAS unsigned char* lds) {
    const int tid = otid(), G = gridDim.x;
    { LAS bf16_t* tile = (LAS bf16_t*)lds;
      int cum = 0;
      for (int j = 0; j < 40; ++j) {
          const CvtJob jb = get_job(a, j);
          const int tn = jb.N >> 6, ntile = tn * (jb.K >> 6);
          const int first = (int)((blockIdx.x + G - (cum % G)) % G);
          for (int t = first; t < ntile; t += G) {
              const int n0 = (t % tn) * 64, k0 = (t / tn) * 64, c = tid & 63, kr = tid >> 6;
              const float* sp = jb.src + (size_t)k0 * jb.ld + perm_col(jb.perm, n0 + c);
              float v[8];
#pragma unroll
              for (int i = 0; i < 8; ++i) v[i] = sp[(size_t)(kr + 8 * i) * jb.ld];
#pragma unroll
              for (int i = 0; i < 8; ++i) tile[c * 72 + kr + 8 * i] = f2bf(v[i]);
              __syncthreads();
              const int row = tid >> 3, ch = tid & 7;
              const u32x4 w = *(const LAS u32x4*)(tile + row * 72 + ch * 8);
              *(u32x4*)(jb.dst + (size_t)(n0 + row) * jb.K + k0 + ch * 8) = w;
              __syncthreads();
          }
          cum += ntile;
      } }
    { LAS float* sv = (LAS float*)lds; LAS float* red = sv + 9 * 1024; float* MOD = (float*)(a.ws + WS_MOD);
      for (int i = tid; i < 9 * 1024; i += 512) { const int r = i >> 10, k = i & 1023; const float cv = (r < 8) ? a.c[r * 1024 + k] : a.c_ctx[k]; sv[i] = cv / (1.f + expf(-cv)); }
      __syncthreads();
      for (int it = blockIdx.x; it < 288; it += G) {
          const int l = it / 72, cb = it % 72, cl = tid & 127, kq = tid >> 7;
          const float* W = a.ada_w + (size_t)l * 1024 * 9216 + cb * 128 + cl;
          float acc[9];
#pragma unroll
          for (int r = 0; r < 9; ++r) acc[r] = 0.f;
          for (int k = kq * 256; k < kq * 256 + 256; k += 4) {
              float w[4];
#pragma unroll
              for (int q = 0; q < 4; ++q) w[q] = W[(size_t)(k + q) * 9216];
#pragma unroll
              for (int q = 0; q < 4; ++q)
#pragma unroll
                  for (int r = 0; r < 9; ++r) acc[r] += sv[r * 1024 + k + q] * w[q];
          }
#pragma unroll
          for (int r = 0; r < 9; ++r) red[(kq * 9 + r) * 128 + cl] = acc[r];
          __syncthreads();
          for (int o = tid; o < 9 * 128; o += 512) { const int r = o >> 7, cc = o & 127, col = cb * 128 + cc;
              const float s = (red[(0 * 9 + r) * 128 + cc] + red[(1 * 9 + r) * 128 + cc]) + (red[(2 * 9 + r) * 128 + cc] + red[(3 * 9 + r) * 128 + cc]);
              MOD[(size_t)(l * 9 + r) * 9216 + col] = s + a.ada_b[l * 9216 + col]; }
          __syncthreads();
      } }
    { float* rc = (float*)(a.ws + WS_ROPE); float* rs = rc + 4096;
      for (int i = blockIdx.x * 512 + tid; i < 4096; i += G * 512) { const int pos = i >> 6, f = i & 63; const float fr = expf(-(float)(2 * f) * (1.f / 128.f) * 9.210340371976184f); const float ang = (float)pos * fr;
          rc[i] = cosf(ang); rs[i] = sinf(ang); } }
}

__device__ __forceinline__ void phase_u0(const Args& a, const Grp& gp) {
    const float* MOD = (const float*)(a.ws + WS_MOD); bf16_t* U = (bf16_t*)(a.ws + WS_U);
    const int i0 = gp.rank * 512 + otid(), c8 = (i0 & 127) * 8;
    const bool uni = gp.nb == 1;
    const float* lsh = MOD + (size_t)((uni ? gp.b_lo : 0) * 9 + 0) * 1024 + c8;
    const f32x4 ls0 = *(const f32x4*)lsh, ls1 = *(const f32x4*)(lsh + 4), lc0 = *(const f32x4*)(lsh + 1024), lc1 = *(const f32x4*)(lsh + 1028);
    for (int i = i0; i < gp.nb * 4352 * 128; i += gp.gsize * 512) {
        const int row = grp_row(gp, i >> 7); const int r9 = row < MCTX ? 8 : (row - MCTX) >> 12;
        const float* hp = (row < MCTX ? a.ctx + (size_t)row * 1024 : a.x + (size_t)(row - MCTX) * 1024) + c8;
        const f32x4 h0 = *(const f32x4*)hp, h1 = *(const f32x4*)(hp + 4); f32x4 s0, s1, c0, c1;
        if (uni && row >= MCTX) { s0 = ls0; s1 = ls1; c0 = lc0; c1 = lc1; }
        else { const float* sh = MOD + (size_t)(r9 * 9 + 0) * 1024 + c8; const float* sc = sh + 1024; s0 = *(const f32x4*)sh; s1 = *(const f32x4*)(sh + 4); c0 = *(const f32x4*)sc; c1 = *(const f32x4*)(sc + 4); }
        const f32x4 o0 = h0 * (c0 + 1.f) + s0, o1 = h1 * (c1 + 1.f) + s1;
        u32x4 w; w.x = cvt_pk_bf16(o0[0], o0[1]); w.y = cvt_pk_bf16(o0[2], o0[3]); w.z = cvt_pk_bf16(o1[0], o1[1]); w.w = cvt_pk_bf16(o1[2], o1[3]);
        *(u32x4*)(U + (size_t)row * 1024 + c8) = w;
    }
}

__device__ __forceinline__ void phase_postnorm(const Args& a, bool first, const bf16_t* Y, const float* modl, int gate_j, float ymul, const float* lng, const float* lnb,
                                               const float* modn, int sh_j, int row_begin, const Grp& gp) {
    const int tid = otid(), lane = tid & 63, gw = gp.rank * 8 + (tid >> 6), nw = gp.gsize * 8;
    const int nrows = gp.nb * (row_begin ? 4096 : 4352);
    float* HC = (float*)(a.ws + WS_HC); bf16_t* U = (bf16_t*)(a.ws + WS_U);
    f32x4 hr[2][4]; u32x2 yr[2][4];
#define PN_MAP(lr) (row_begin ? grp_row_lat(gp, (lr)) : grp_row(gp, (lr)))
#define PN_ROW(t, lA) PN_MAP((t) ? (((lA) + nw < nrows) ? (lA) + nw : (lA)) : (lA))
#define PN_LOAD(dstH, dstY, rA) do { _Pragma("unroll") for (int t = 0; t < 2; ++t) { const int row = PN_ROW(t, rA); const bool isc = row < MCTX; \
        const float* hin = first ? (isc ? a.ctx + (size_t)row * 1024 : a.x + (size_t)(row - MCTX) * 1024) : (isc ? HC + (size_t)row * 1024 : a.out + (size_t)(row - MCTX) * 1024); \
        const bf16_t* yp = Y + (size_t)row * 1024; \
        _Pragma("unroll") for (int c = 0; c < 4; ++c) { const int col = c * 256 + lane * 4; dstH[t][c] = *(const f32x4*)(hin + col); dstY[t][c] = *(const u32x2*)(yp + col); } } } while (0)
    f32x4 gv[4], bv[4];
#pragma unroll
    for (int c = 0; c < 4; ++c) { gv[c] = *(const f32x4*)(lng + c * 256 + lane * 4); bv[c] = *(const f32x4*)(lnb + c * 256 + lane * 4); }
    const bool uni = gp.nb == 1;
    f32x4 gl[4], shl[4], scl[4];
#pragma unroll
    for (int c = 0; c < 4; ++c) { const int col = c * 256 + lane * 4; const int rl = uni ? gp.b_lo : 0;
        gl[c] = *(const f32x4*)(modl + (size_t)(rl * 9 + gate_j) * 1024 + col);
        shl[c] = *(const f32x4*)(modn + (size_t)(rl * 9 + (sh_j >= 0 ? sh_j : 0)) * 1024 + col); scl[c] = *(const f32x4*)(modn + (size_t)(rl * 9 + (sh_j >= 0 ? sh_j : 0) + 1) * 1024 + col); }
    int rowA = gw;
    if (rowA < nrows) PN_LOAD(hr, yr, rowA);
    for (; rowA < nrows; rowA += 2 * nw) {
        const bool hasB = rowA + nw < nrows;
        f32x4 v[2][4]; float s[2] = {0.f, 0.f}, q[2] = {0.f, 0.f};
#pragma unroll
        for (int t = 0; t < 2; ++t) { const int row = PN_ROW(t, rowA); const int r9 = row < MCTX ? 8 : (row - MCTX) >> 12;
            const float* gate = modl + (size_t)(r9 * 9 + gate_j) * 1024;
#pragma unroll
            for (int c = 0; c < 4; ++c) { const int col = c * 256 + lane * 4; const f32x4 gt = (uni && row >= MCTX) ? gl[c] : *(const f32x4*)(gate + col);
                const f32x4 y = {bflo(yr[t][c].x), bfhi(yr[t][c].x), bflo(yr[t][c].y), bfhi(yr[t][c].y)};
                v[t][c] = hr[t][c] * DN_ALPHA + gt * y * ymul; s[t] += (v[t][c][0] + v[t][c][1]) + (v[t][c][2] + v[t][c][3]);
                q[t] += (v[t][c][0] * v[t][c][0] + v[t][c][1] * v[t][c][1]) + (v[t][c][2] * v[t][c][2] + v[t][c][3] * v[t][c][3]); } }
        const int rowN = rowA + 2 * nw;
        if (rowN < nrows) PN_LOAD(hr, yr, rowN);
#pragma unroll
        for (int o = 32; o >= 1; o >>= 1) { const float s0 = shx(s[0], lane, o), s1 = shx(s[1], lane, o), q0 = shx(q[0], lane, o), q1 = shx(q[1], lane, o); s[0] += s0; s[1] += s1; q[0] += q0; q[1] += q1; }
#pragma unroll
        for (int t = 0; t < 2; ++t) { if (t && !hasB) break; const int row = PN_MAP(t ? rowA + nw : rowA);
            const bool isc = row < MCTX; const int r9 = isc ? 8 : (row - MCTX) >> 12;
            float* hout = isc ? HC + (size_t)row * 1024 : a.out + (size_t)(row - MCTX) * 1024;
            const float mean = s[t] * (1.f / 1024.f); const float var = fmaxf(q[t] * (1.f / 1024.f) - mean * mean, 0.f);
            const float rstd = 1.0f / sqrtf(var + LN_EPS);
#pragma unroll
            for (int c = 0; c < 4; ++c) { const int col = c * 256 + lane * 4;
                const f32x4 hn = (v[t][c] - mean) * rstd * gv[c] + bv[c]; *(f32x4*)(hout + col) = hn;
                if (sh_j >= 0) { f32x4 sh, sc; if (uni && !isc) { sh = shl[c]; sc = scl[c]; } else { sh = *(const f32x4*)(modn + (size_t)(r9 * 9 + sh_j) * 1024 + col); sc = *(const f32x4*)(modn + (size_t)(r9 * 9 + sh_j + 1) * 1024 + col); }
                    const f32x4 o = hn * (sc + 1.f) + sh; u32x2 w; w.x = cvt_pk_bf16(o[0], o[1]); w.y = cvt_pk_bf16(o[2], o[3]); *(u32x2*)(U + (size_t)row * 1024 + col) = w; } } }
    }
#undef PN_LOAD
#undef PN_ROW
#undef PN_MAP
}
template <int RABL>
__device__ __forceinline__ void phase_retention(const Args& a, LAS unsigned char* lds, const Grp& gp) {
    const bf16_t* Qg = (const bf16_t*)(a.ws + WS_BIG); const bf16_t* Kg = (const bf16_t*)(a.ws + WS_BIG + R1); const bf16_t* Vg = (const bf16_t*)(a.ws + WS_BIG + 2 * R1); bf16_t* Og = (bf16_t*)(a.ws + WS_BIG + 4 * R1);
    const int tid = otid(), w = __builtin_amdgcn_readfirstlane(tid >> 6), lane = tid & 63, c = lane & 15, g = lane >> 4;
    const int ib = w & 3, vh = w >> 2, vb2 = w & 3, dbase = (w >> 2) * 8;
    constexpr int QS = 0, KS = 32768, VS = 65536, ST = 73728;
    typedef short s16x4 __attribute__((ext_vector_type(4)));
    for (int item = gp.rank; item < gp.nb * 32; item += gp.gsize) {
        const int b = gp.b_lo + (item >> 5), h = (item >> 3) & 3, vs = item & 7;
        f32x4 accS[8]; u32x4 qreg[4], kreg[4], vreg; float lg = 0.f, g64 = 0.f;
        { const int row0 = b * 256;
#pragma unroll
          for (int i = 0; i < 4; ++i) { const int idx = tid + 512 * i, row = idx >> 5, ch = idx & 31; const size_t o = (size_t)(row0 + row) * 1024 + h * 256 + ch * 8; qreg[i] = *(const u32x4*)(Qg + o); kreg[i] = *(const u32x4*)(Kg + o); }
          vreg = *(const u32x4*)(Vg + (size_t)(row0 + (tid >> 3)) * 2048 + h * 512 + vs * 64 + (tid & 7) * 8); }
        for (int step = 0; step < 136; ++step) {
            const int dir = step >= 68 ? 1 : 0, s = step - 68 * dir;
            if (s == 0) {
#pragma unroll
                for (int x = 0; x < 8; ++x) accS[x] = (f32x4){0.f, 0.f, 0.f, 0.f};
                const int hh = dir ? 3 - h : h; lg = log2f(1.0f - exp2f(-5.0f - (float)hh)); g64 = exp2f(64.f * lg);
            }
            const int row0 = dir ? (s < 4 ? b * 256 + 64 * (3 - s) : MCTX + b * 4096 + 64 * (63 - (s - 4))) : (s < 4 ? b * 256 + 64 * s : MCTX + b * 4096 + 64 * (s - 4));
            __syncthreads();
            if (RABL != 1)
#pragma unroll
            for (int x = 0; x < 8; ++x) { const int d = 16 * (dbase + x) + c;
#pragma unroll
                for (int r = 0; r < 4; ++r) { const int v = 16 * vb2 + 4 * g + r; *(LAS bf16_t*)(lds + ST + v * 512 + (((d >> 3) ^ (v & 15)) << 4) + (d & 7) * 2) = f2bf(accS[x][r]); } }
#pragma unroll
            for (int i = 0; i < 4; ++i) { const int idx = tid + 512 * i, row = idx >> 5, ch = idx & 31; const int off = row * 512 + ((ch ^ (row & 15)) << 4);
                *(LAS u32x4*)(lds + QS + off) = qreg[i]; *(LAS u32x4*)(lds + KS + off) = kreg[i]; }
            { const int j = tid >> 3, ch = tid & 7; *(LAS u32x4*)(lds + VS + j * 128 + ((ch ^ ((j >> 1) & 7)) << 4)) = vreg; }
            __syncthreads();
            if (step + 1 < 136) { const int st2 = step + 1, dir2 = st2 >= 68 ? 1 : 0, s2 = st2 - 68 * dir2;
                const int nrow0 = dir2 ? (s2 < 4 ? b * 256 + 64 * (3 - s2) : MCTX + b * 4096 + 64 * (63 - (s2 - 4))) : (s2 < 4 ? b * 256 + 64 * s2 : MCTX + b * 4096 + 64 * (s2 - 4));
#pragma unroll
                for (int i = 0; i < 4; ++i) { const int idx = tid + 512 * i, row = idx >> 5, ch = idx & 31; const size_t o = (size_t)(nrow0 + row) * 1024 + h * 256 + ch * 8; qreg[i] = *(const u32x4*)(Qg + o); kreg[i] = *(const u32x4*)(Kg + o); }
                vreg = *(const u32x4*)(Vg + (size_t)(nrow0 + (tid >> 3)) * 2048 + h * 512 + vs * 64 + (tid & 7) * 8); }
            if (RABL == 2) continue;
            const int iq = 16 * ib + c;
            f32x4 accs[4], acco[2];
#pragma unroll
            for (int jb = 0; jb < 4; ++jb) accs[jb] = (f32x4){0.f, 0.f, 0.f, 0.f};
            acco[0] = (f32x4){0.f, 0.f, 0.f, 0.f}; acco[1] = (f32x4){0.f, 0.f, 0.f, 0.f};
#pragma unroll 1
            for (int ks = 0; ks < 8; ++ks) {
                const int sw = ((4 * ks + g) ^ c) << 4;
                const bf16x8 qf = *(const LAS bf16x8*)(lds + QS + iq * 512 + sw);
#pragma unroll
                for (int jb = 0; jb < 4; ++jb) { const bf16x8 kf = *(const LAS bf16x8*)(lds + KS + (16 * jb + c) * 512 + sw); accs[jb] = __builtin_amdgcn_mfma_f32_16x16x32_bf16(kf, qf, accs[jb], 0, 0, 0); }
#pragma unroll
                for (int vb = 0; vb < 2; ++vb) { const bf16x8 sf = *(const LAS bf16x8*)(lds + ST + (16 * (2 * vh + vb) + c) * 512 + sw); acco[vb] = __builtin_amdgcn_mfma_f32_16x16x32_bf16(sf, qf, acco[vb], 0, 0, 0); }
            }
            { const float qd = __builtin_amdgcn_exp2f(lg * (float)(dir ? 64 - iq : iq + 1)); acco[0] *= qd; acco[1] *= qd; }
#pragma unroll
            for (int jb = 0; jb < 4; ++jb)
#pragma unroll
                for (int r = 0; r < 4; ++r) { const int j = 16 * jb + 4 * g + r; const int df = dir ? j - iq : iq - j; const bool vis = dir ? (df > 0) : (df >= 0);
                    accs[jb][r] = vis ? accs[jb][r] * __builtin_amdgcn_exp2f(lg * (float)df) : 0.f; }
#pragma unroll
            for (int s2 = 0; s2 < 2; ++s2) {
                u32x4 pw; pw.x = cvt_pk_bf16(accs[2 * s2][0], accs[2 * s2][1]); pw.y = cvt_pk_bf16(accs[2 * s2][2], accs[2 * s2][3]); pw.z = cvt_pk_bf16(accs[2 * s2 + 1][0], accs[2 * s2 + 1][1]); pw.w = cvt_pk_bf16(accs[2 * s2 + 1][2], accs[2 * s2 + 1][3]);
                const bf16x8 pf = __builtin_bit_cast(bf16x8, pw);
#pragma unroll
                for (int vb = 0; vb < 2; ++vb) { const int vblk = 2 * vh + vb, ra = 32 * s2 + 4 * g + (c >> 2), rbb = ra + 16, cch = 2 * vblk + ((c & 3) >> 1);
                    const s16x4 lo = __builtin_amdgcn_ds_read_tr16_b64_v4i16((LAS s16x4*)(lds + VS + ra * 128 + ((cch ^ ((ra >> 1) & 7)) << 4) + 8 * (c & 1)));
                    const s16x4 hi = __builtin_amdgcn_ds_read_tr16_b64_v4i16((LAS s16x4*)(lds + VS + rbb * 128 + ((cch ^ ((rbb >> 1) & 7)) << 4) + 8 * (c & 1)));
                    const bf16x8 vf = {lo[0], lo[1], lo[2], lo[3], hi[0], hi[1], hi[2], hi[3]};
                    acco[vb] = __builtin_amdgcn_mfma_f32_16x16x32_bf16(vf, pf, acco[vb], 0, 0, 0); }
            }
#pragma unroll
            for (int vb = 0; vb < 2; ++vb) { bf16_t* op = Og + (size_t)(row0 + iq) * 2048 + h * 512 + vs * 64 + 16 * (2 * vh + vb) + 4 * g; f32x4 o = acco[vb];
                if (dir) { const u32x2 pv = *(const u32x2*)op; o[0] += bflo(pv.x); o[1] += bfhi(pv.x); o[2] += bflo(pv.y); o[3] += bfhi(pv.y); }
                u32x2 ow; ow.x = cvt_pk_bf16(o[0], o[1]); ow.y = cvt_pk_bf16(o[2], o[3]); *(u32x2*)op = ow; }
            { bf16x8 af[2];
              const int tq = c >> 2, tp = c & 3;
#pragma unroll
              for (int k2 = 0; k2 < 2; ++k2) { const int r0 = 32 * k2 + 8 * g + tq, r1 = r0 + 4, cch = 2 * vb2 + (tp >> 1);
                  const s16x4 t0 = __builtin_amdgcn_ds_read_tr16_b64_v4i16((LAS s16x4*)(lds + VS + r0 * 128 + ((cch ^ ((r0 >> 1) & 7)) << 4) + 8 * (tp & 1)));
                  const s16x4 t1 = __builtin_amdgcn_ds_read_tr16_b64_v4i16((LAS s16x4*)(lds + VS + r1 * 128 + ((cch ^ ((r1 >> 1) & 7)) << 4) + 8 * (tp & 1)));
                  const int j0 = 32 * k2 + 8 * g; float kd[8];
#pragma unroll
                  for (int e = 0; e < 8; ++e) kd[e] = __builtin_amdgcn_exp2f(lg * (float)(dir ? j0 + e : 63 - j0 - e));
                  u32x4 aw; aw.x = cvt_pk_bf16(bf2f((bf16_t)t0[0]) * kd[0], bf2f((bf16_t)t0[1]) * kd[1]); aw.y = cvt_pk_bf16(bf2f((bf16_t)t0[2]) * kd[2], bf2f((bf16_t)t0[3]) * kd[3]);
                  aw.z = cvt_pk_bf16(bf2f((bf16_t)t1[0]) * kd[4], bf2f((bf16_t)t1[1]) * kd[5]); aw.w = cvt_pk_bf16(bf2f((bf16_t)t1[2]) * kd[6], bf2f((bf16_t)t1[3]) * kd[7]);
                  af[k2] = __builtin_bit_cast(bf16x8, aw); }
#pragma unroll
              for (int x = 0; x < 8; ++x) { accS[x] *= g64; const int db = dbase + x;
#pragma unroll
                  for (int k2 = 0; k2 < 2; ++k2) { const int r0 = 32 * k2 + 8 * g + tq, r1 = r0 + 4;
                      const s16x4 t0 = __builtin_amdgcn_ds_read_tr16_b64_v4i16((LAS s16x4*)(lds + KS + r0 * 512 + (((2 * db + (tp >> 1)) ^ (r0 & 15)) << 4) + 8 * (tp & 1)));
                      const s16x4 t1 = __builtin_amdgcn_ds_read_tr16_b64_v4i16((LAS s16x4*)(lds + KS + r1 * 512 + (((2 * db + (tp >> 1)) ^ (r1 & 15)) << 4) + 8 * (tp & 1)));
                      const bf16x8 bfr = {t0[0], t0[1], t0[2], t0[3], t1[0], t1[1], t1[2], t1[3]};
                      accS[x] = __builtin_amdgcn_mfma_f32_16x16x32_bf16(af[k2], bfr, accS[x], 0, 0, 0); }
                  __builtin_amdgcn_sched_barrier(0); } }
        }
        __syncthreads();
    }
}

__device__ __forceinline__ void phase_ret_finish(const Args& a, int row_begin, const Grp& gp) {
    bf16_t* Og = (bf16_t*)(a.ws + WS_BIG + 4 * R1); const bf16_t* Gg = (const bf16_t*)(a.ws + WS_BIG);
    const int tid = otid(), lane = tid & 63, gw = gp.rank * 8 + (tid >> 6), nw = gp.gsize * 8, nrows = gp.nb * (row_begin ? 4096 : 4352);
    for (int lr = gw; lr < nrows; lr += nw) { const int row = row_begin ? grp_row_lat(gp, lr) : grp_row(gp, lr);
        const size_t base = (size_t)row * 2048 + (lane >> 4) * 512 + (lane & 15) * 32;
        float v[32]; float s = 0.f;
#pragma unroll
        for (int q = 0; q < 4; ++q) { const u32x4 w = *(const u32x4*)(Og + base + q * 8);
            v[q * 8 + 0] = bflo(w.x); v[q * 8 + 1] = bfhi(w.x); v[q * 8 + 2] = bflo(w.y); v[q * 8 + 3] = bfhi(w.y); v[q * 8 + 4] = bflo(w.z); v[q * 8 + 5] = bfhi(w.z); v[q * 8 + 6] = bflo(w.w); v[q * 8 + 7] = bfhi(w.w); }
#pragma unroll
        for (int i = 0; i < 32; ++i) s += v[i];
        s += shx(s, lane, 1); s += shx(s, lane, 2); s += shx(s, lane, 4); s += shx(s, lane, 8);
        const float mean = s * (1.f / 512.f); float qv = 0.f;
#pragma unroll
        for (int i = 0; i < 32; ++i) { const float d = v[i] - mean; qv += d * d; }
        qv += shx(qv, lane, 1); qv += shx(qv, lane, 2); qv += shx(qv, lane, 4); qv += shx(qv, lane, 8);
        const float rstd = 1.0f / sqrtf(qv * (1.f / 512.f) + LN_EPS);
#pragma unroll
        for (int q = 0; q < 4; ++q) { const u32x4 gwd = *(const u32x4*)(Gg + base + q * 8); const unsigned gw4[4] = {gwd.x, gwd.y, gwd.z, gwd.w}; unsigned ow[4];
#pragma unroll
            for (int p = 0; p < 4; ++p) { const float g0 = bflo(gw4[p]), g1 = bfhi(gw4[p]);
                ow[p] = cvt_pk_bf16(silu_f(g0) * (v[q * 8 + 2 * p] - mean) * rstd, silu_f(g1) * (v[q * 8 + 2 * p + 1] - mean) * rstd); }
            u32x4 o; o.x = ow[0]; o.y = ow[1]; o.z = ow[2]; o.w = ow[3]; *(u32x4*)(Og + base + q * 8) = o; }
    }
}

template <int ABL>
__device__ __forceinline__ void phase_na(const Args& a, LAS unsigned char* lds0, bf16_t* Odst, const Grp& gp) {
    const bf16_t* Qg = (const bf16_t*)(a.ws + WS_BIG); const bf16_t* Kg = (const bf16_t*)(a.ws + WS_BIG + R1); const bf16_t* Vg = (const bf16_t*)(a.ws + WS_BIG + 2 * R1);
    const int tid = otid(), w = __builtin_amdgcn_readfirstlane(tid >> 6), lane = tid & 63, c = lane & 15, g = lane >> 4, hb = w >> 2, w4 = w & 3, t2 = tid & 255;
    LAS unsigned char* lds = lds0 + hb * 65536;
    constexpr int QS = 0, KS = 32768, VT = 40960, RP = 49152;
    float mk[4][4]; int rco[4][4];
    { const int q0 = 16 * w4 + c, cs0 = min(max(q0 - 8, 0), 48);
#pragma unroll
      for (int kb = 0; kb < 4; ++kb)
#pragma unroll
          for (int e = 0; e < 4; ++e) { const int kc = 16 * kb + 4 * g + e; mk[kb][e] = (kc >= cs0 && kc < cs0 + 16) ? 0.f : -1e30f; rco[kb][e] = min(max(kc - q0 + 15, 0), 30) * 4; } }
    const int kb_lo = min(max(16 * w4 - 8, 0), 48) >> 4, kb_hi = (min(max(16 * w4 + 7, 0), 48) + 15) >> 4;
    for (int base_it = gp.rank * 2; base_it < gp.nb * 272; base_it += gp.gsize * 2) {
        const int it = base_it + hb, bb = it / 272, idx = it - bb * 272; const bool isl = (base_it % 272) < 256;
        const int b = gp.b_lo + bb; int h, r0 = 0, kr_lo = 0, kr_hi = 0;
        if (isl) { h = idx >> 4; r0 = (idx & 15) * 4; kr_lo = min(max(r0 - 4, 0), 56); kr_hi = min(max(r0 - 1, 0), 56) + 7; }
        else { h = idx - 256; }
        const int ntile = isl ? 15 : 4;
        __syncthreads();
#pragma unroll
        for (int i = 0; i < 8; ++i) { const int idx = t2 + 256 * i, row = idx >> 3, ch = idx & 7, rr = row >> 6, qi = row & 63;
            const int grow = isl ? MCTX + b * 4096 + (r0 + rr) * 64 + qi : b * 256 + rr * 64 + qi;
            *(LAS u32x4*)(lds + QS + row * 128 + ((ch ^ ((row >> 1) & 7)) << 4)) = *(const u32x4*)(Qg + (size_t)grow * 1024 + h * 64 + ch * 8); }
        for (int i = t2; i < 465; i += 256) *(LAS float*)(lds + RP + i * 4) = a.na_rpb[h * 465 + i];
        u32x4 kreg[2], vreg[2];
        { const int row0 = isl ? MCTX + b * 4096 + kr_lo * 64 : b * 256;
#pragma unroll
          for (int i = 0; i < 2; ++i) { const int idx = t2 + 256 * i, row = idx >> 3, ch = idx & 7; const size_t o = ((size_t)h * MTOT + row0 + row) * 64 + ch * 8; kreg[i] = *(const u32x4*)(Kg + o); vreg[i] = *(const u32x4*)(Vg + o); } }
        const int q = 16 * w4 + c;
        f32x4 oacc[4][4]; float mrun[4], lrun[4];
#pragma unroll
        for (int rr = 0; rr < 4; ++rr) { mrun[rr] = -1e30f; lrun[rr] = 0.f;
#pragma unroll
            for (int db = 0; db < 4; ++db) oacc[rr][db] = (f32x4){0.f, 0.f, 0.f, 0.f}; }
        for (int tl = 0; tl < ntile; ++tl) {
            if (ABL == 3) break;
            if (ABL == 4) { __syncthreads(); __syncthreads(); continue; }
            __syncthreads();
#pragma unroll
            for (int i = 0; i < 2; ++i) { const int idx = t2 + 256 * i, row = idx >> 3, ch = idx & 7;
                *(LAS u32x4*)(lds + KS + row * 128 + ((ch ^ ((row >> 1) & 7)) << 4)) = kreg[i];
                const unsigned vw[4] = {vreg[i].x, vreg[i].y, vreg[i].z, vreg[i].w};
#pragma unroll
                for (int e = 0; e < 8; ++e) { const int d = ch * 8 + e; const bf16_t val = (bf16_t)((e & 1) ? (vw[e >> 1] >> 16) : (vw[e >> 1] & 0xffffu));
                    *(LAS bf16_t*)(lds + VT + d * 128 + (((row >> 3) ^ ((d >> 1) & 7)) << 4) + (row & 7) * 2) = val; } }
            __syncthreads();
            if (tl + 1 < ntile) { const int t1 = tl + 1;
                const int row0 = isl ? (t1 < 11 ? MCTX + b * 4096 + min(kr_lo + t1, kr_hi) * 64 : b * 256 + (t1 - 11) * 64) : b * 256 + t1 * 64;
#pragma unroll
                for (int i = 0; i < 2; ++i) { const int idx = t2 + 256 * i, row = idx >> 3, ch = idx & 7; const size_t o = ((size_t)h * MTOT + row0 + row) * 64 + ch * 8; kreg[i] = *(const u32x4*)(Kg + o); vreg[i] = *(const u32x4*)(Vg + o); } }
            if (ABL == 2) continue;
            const bool local = isl && tl < 11; const int krow = kr_lo + tl;
            if (local && krow > kr_hi) continue;
#pragma unroll
            for (int rr = 0; rr < 4; ++rr) {
                const int r = r0 + rr, rs = min(max(r - 4, 0), 56);
                if (local && (krow < rs || krow >= rs + 8)) continue;
                bf16x8 qf[2];
#pragma unroll
                for (int ks = 0; ks < 2; ++ks) { const int qrow = rr * 64 + q; qf[ks] = *(const LAS bf16x8*)(lds + QS + qrow * 128 + (((4 * ks + g) ^ ((qrow >> 1) & 7)) << 4)); }
                f32x4 sT[4];
#pragma unroll
                for (int kb = 0; kb < 4; ++kb) { const bool skip = local && (kb < kb_lo || kb > kb_hi);
                    if (skip) { sT[kb] = (f32x4){-1e30f, -1e30f, -1e30f, -1e30f}; continue; }
                    sT[kb] = (f32x4){0.f, 0.f, 0.f, 0.f}; const int kr = 16 * kb + c;
#pragma unroll
                    for (int ks = 0; ks < 2; ++ks) { const bf16x8 kf = *(const LAS bf16x8*)(lds + KS + kr * 128 + (((4 * ks + g) ^ ((kr >> 1) & 7)) << 4)); sT[kb] = __builtin_amdgcn_mfma_f32_16x16x32_bf16(kf, qf[ks], sT[kb], 0, 0, 0); }
                    if (local) { const int rbase = RP + (krow - r + 7) * 124;
#pragma unroll
                        for (int e = 0; e < 4; ++e) sT[kb][e] = (sT[kb][e] + *(const LAS float*)(lds + rbase + rco[kb][e])) + mk[kb][e]; } }
                if (ABL == 1) { oacc[rr][0] += sT[0] + sT[1] + sT[2] + sT[3]; continue; }
                float mx = -1e30f;
#pragma unroll
                for (int kb = 0; kb < 4; ++kb) mx = fmaxf(mx, fmaxf(fmaxf(sT[kb][0], sT[kb][1]), fmaxf(sT[kb][2], sT[kb][3])));
                mx = fmaxf(mx, shx(mx, lane, 16)); mx = fmaxf(mx, shx(mx, lane, 32));
                const float mnew = fmaxf(mrun[rr], mx), alpha = __builtin_amdgcn_exp2f((mrun[rr] - mnew) * LOG2E); mrun[rr] = mnew;
                float ps = 0.f;
#pragma unroll
                for (int kb = 0; kb < 4; ++kb)
#pragma unroll
                    for (int e = 0; e < 4; ++e) { const float p = __builtin_amdgcn_exp2f((sT[kb][e] - mnew) * LOG2E); sT[kb][e] = p; ps += p; }
                ps += shx(ps, lane, 16); ps += shx(ps, lane, 32);
                lrun[rr] = lrun[rr] * alpha + ps;
#pragma unroll
                for (int db = 0; db < 4; ++db) oacc[rr][db] *= alpha;
#pragma unroll
                for (int s2 = 0; s2 < 2; ++s2) {
                    if (local && (2 * s2 + 1 < kb_lo || 2 * s2 > kb_hi)) continue;
                    u32x4 pw; pw.x = cvt_pk_bf16(sT[2 * s2][0], sT[2 * s2][1]); pw.y = cvt_pk_bf16(sT[2 * s2][2], sT[2 * s2][3]); pw.z = cvt_pk_bf16(sT[2 * s2 + 1][0], sT[2 * s2 + 1][1]); pw.w = cvt_pk_bf16(sT[2 * s2 + 1][2], sT[2 * s2 + 1][3]);
                    const bf16x8 pf = __builtin_bit_cast(bf16x8, pw);
#pragma unroll
                    for (int db = 0; db < 4; ++db) { const int vrow = 16 * db + c; const int sw = (vrow >> 1) & 7;
                        const u32x2 lo = *(const LAS u32x2*)(lds + VT + vrow * 128 + (((4 * s2 + (g >> 1)) ^ sw) << 4) + (g & 1) * 8);
                        const u32x2 hi = *(const LAS u32x2*)(lds + VT + vrow * 128 + (((4 * s2 + 2 + (g >> 1)) ^ sw) << 4) + (g & 1) * 8);
                        u32x4 vw; vw.x = lo.x; vw.y = lo.y; vw.z = hi.x; vw.w = hi.y;
                        oacc[rr][db] = __builtin_amdgcn_mfma_f32_16x16x32_bf16(__builtin_bit_cast(bf16x8, vw), pf, oacc[rr][db], 0, 0, 0); }
                }
            }
        }
        __syncthreads();
#pragma unroll
        for (int rr = 0; rr < 4; ++rr) { const float inv = 1.0f / lrun[rr]; const int orow = rr * 64 + q;
#pragma unroll
            for (int db = 0; db < 4; ++db) { const f32x4 o = oacc[rr][db] * inv; u32x2 ow; ow.x = cvt_pk_bf16(o[0], o[1]); ow.y = cvt_pk_bf16(o[2], o[3]);
                *(LAS u32x2*)(lds + QS + orow * 128 + (((2 * db + (g >> 1)) ^ ((orow >> 1) & 7)) << 4) + (g & 1) * 8) = ow; } }
        __syncthreads();
#pragma unroll
        for (int i = 0; i < 8; ++i) { const int idx = t2 + 256 * i, row = idx >> 3, ch = idx & 7, rr = row >> 6, qi = row & 63;
            const int grow = isl ? MCTX + b * 4096 + (r0 + rr) * 64 + qi : b * 256 + rr * 64 + qi;
            *(u32x4*)(Odst + (size_t)grow * 1024 + h * 64 + ch * 8) = *(const LAS u32x4*)(lds + QS + row * 128 + ((ch ^ ((row >> 1) & 7)) << 4)); }
    }
    __syncthreads();
}

__device__ __forceinline__ void phase_lru_conv(const Args& a, const Grp& gp) {
    const bf16_t* XR = (const bf16_t*)(a.ws + WS_BIG + R1); bf16_t* XC = (bf16_t*)(a.ws + WS_BIG + 2 * R1);
    const int i0 = gp.rank * 512 + otid(), c8 = (i0 & 127) * 8;
    const f32x4 b0 = *(const f32x4*)(a.lru_conv_b + c8), b1 = *(const f32x4*)(a.lru_conv_b + c8 + 4);
    f32x4 w0[4], w1[4];
#pragma unroll
    for (int j = 0; j < 4; ++j) { w0[j] = *(const f32x4*)(a.lru_conv_w + j * 1024 + c8); w1[j] = *(const f32x4*)(a.lru_conv_w + j * 1024 + c8 + 4); }
    for (int i = i0; i < gp.nb * 4352 * 128; i += gp.gsize * 512) {
        const int row = grp_row(gp, i >> 7); const bool isc = row < MCTX; const int t = isc ? (row & 255) : ((row - MCTX) & 4095), len = isc ? 256 : 4096;
        float acc[8] = {b0[0], b0[1], b0[2], b0[3], b1[0], b1[1], b1[2], b1[3]};
#pragma unroll
        for (int j = 0; j < 4; ++j) { const int tt = t - 2 + j;
            if (tt >= 0 && tt < len) { const u32x4 xw = *(const u32x4*)(XR + (size_t)(row - 2 + j) * 1024 + c8);
                acc[0] += w0[j][0] * bflo(xw.x); acc[1] += w0[j][1] * bfhi(xw.x); acc[2] += w0[j][2] * bflo(xw.y); acc[3] += w0[j][3] * bfhi(xw.y);
                acc[4] += w1[j][0] * bflo(xw.z); acc[5] += w1[j][1] * bfhi(xw.z); acc[6] += w1[j][2] * bflo(xw.w); acc[7] += w1[j][3] * bfhi(xw.w); } }
        u32x4 o; o.x = cvt_pk_bf16(acc[0], acc[1]); o.y = cvt_pk_bf16(acc[2], acc[3]); o.z = cvt_pk_bf16(acc[4], acc[5]); o.w = cvt_pk_bf16(acc[6], acc[7]);
        *(u32x4*)(XC + (size_t)row * 1024 + c8) = o;
    }
}
__device__ __forceinline__ void phase_lru_scan(const Args& a, int dir, int pass, const Grp& gp) {
    const bf16_t* GATE = (const bf16_t*)(a.ws + WS_BIG); bf16_t* HF = (bf16_t*)(a.ws + WS_BIG + R1); const bf16_t* XC = (const bf16_t*)(a.ws + WS_BIG + 2 * R1); const bf16_t* GP = (const bf16_t*)(a.ws + WS_BIG + 3 * R1);
    float* CARRY = (float*)(a.ws + WS_CARRY);
    for (int idx = gp.rank * 512 + otid(); idx < gp.nb * 64 * 256; idx += gp.gsize * 512) {
        const int cq = idx & 255, chunk = (idx >> 8) & 63, b = gp.b_lo + (idx >> 14), c0 = cq * 4;
        float ba[4], bx[4], sp[4], h[4], P[4];
        { const f32x4 t0 = *(const f32x4*)(a.lru_b_a + dir * 1024 + c0), t1 = *(const f32x4*)(a.lru_b_x + dir * 1024 + c0), t2 = *(const f32x4*)(a.lru_lam + dir * 1024 + c0);
#pragma unroll
          for (int k = 0; k < 4; ++k) { ba[k] = t0[k]; bx[k] = t1[k]; sp[k] = -8.f * log1pf(expf(-t2[k])); h[k] = 0.f; P[k] = 1.f; } }
        if (pass == 2) { for (int cc = 0; cc < chunk; ++cc) { const float* cp = CARRY + ((size_t)(b * 64 + cc) * 256 + cq) * 8; const f32x4 pp = *(const f32x4*)cp, ll = *(const f32x4*)(cp + 4);
#pragma unroll
            for (int k = 0; k < 4; ++k) h[k] = pp[k] * h[k] + ll[k]; } }
        for (int t4 = 0; t4 < 17; ++t4) {
            u32x2 rw[4], iw[4], xw[4], hw[4], gw[4]; int rows[4];
#pragma unroll
            for (int j = 0; j < 4; ++j) { const int p = chunk * 68 + t4 * 4 + j;
                const int row = dir ? (p < 256 ? b * 256 + (255 - p) : MCTX + b * 4096 + (4095 - (p - 256))) : (p < 256 ? b * 256 + p : MCTX + b * 4096 + (p - 256));
                rows[j] = row;
                rw[j] = *(const u32x2*)(GP + (size_t)row * 2048 + c0); iw[j] = *(const u32x2*)(GP + (size_t)row * 2048 + 1024 + c0); xw[j] = *(const u32x2*)(XC + (size_t)row * 1024 + c0);
                if (pass == 2 && dir == 1) { hw[j] = *(const u32x2*)(HF + (size_t)row * 1024 + c0); gw[j] = *(const u32x2*)(GATE + (size_t)row * 1024 + c0); } }
#pragma unroll
            for (int j = 0; j < 4; ++j) {
                const float rp[4] = {bflo(rw[j].x), bfhi(rw[j].x), bflo(rw[j].y), bfhi(rw[j].y)}, ip[4] = {bflo(iw[j].x), bfhi(iw[j].x), bflo(iw[j].y), bfhi(iw[j].y)}, xv[4] = {bflo(xw[j].x), bfhi(xw[j].x), bflo(xw[j].y), bfhi(xw[j].y)};
#pragma unroll
                for (int k = 0; k < 4; ++k) { const float la = sp[k] * sigmoid_f(rp[k] + ba[k]); const float av = __expf(la); const float m = sqrtf(fmaxf(-expm1f(2.f * la), 0.f));
                    h[k] = av * h[k] + m * sigmoid_f(ip[k] + bx[k]) * xv[k]; if (pass == 1) P[k] *= av; }
                if (pass == 2) { bf16_t* hp = HF + (size_t)rows[j] * 1024 + c0; u32x2 o;
                    if (dir == 0) { o.x = cvt_pk_bf16(h[0], h[1]); o.y = cvt_pk_bf16(h[2], h[3]); }
                    else { o.x = cvt_pk_bf16(gelu_tanh_f(bflo(gw[j].x)) * (bflo(hw[j].x) + h[0]), gelu_tanh_f(bfhi(gw[j].x)) * (bfhi(hw[j].x) + h[1]));
                           o.y = cvt_pk_bf16(gelu_tanh_f(bflo(gw[j].y)) * (bflo(hw[j].y) + h[2]), gelu_tanh_f(bfhi(gw[j].y)) * (bfhi(hw[j].y) + h[3])); }
                    *(u32x2*)hp = o; }
            }
        }
        if (pass == 1) { float* cp = CARRY + ((size_t)(b * 64 + chunk) * 256 + cq) * 8; *(f32x4*)cp = (f32x4){P[0], P[1], P[2], P[3]}; *(f32x4*)(cp + 4) = (f32x4){h[0], h[1], h[2], h[3]}; }
    }
}
constexpr int NPHASE = 52;
enum { OP_PROLOGUE, OP_U0, OP_GEMM_SWIGLU, OP_GEMM_PLAIN, OP_GEMM_RETIN, OP_GEMM_GATES, OP_POSTNORM, OP_RETSCAN, OP_RETFIN, OP_NAATT, OP_LRUCONV, OP_LRUSCAN };

typedef const Args __attribute__((address_space(4)))* KArgsPtr;
__global__ void __launch_bounds__(512) hybrid_fwd(Args a_in) {
    extern __shared__ __attribute__((aligned(16))) unsigned char lds_raw[];
    LAS unsigned char* lds = (LAS unsigned char*)lds_raw;
    const int ph_lo = a_in.ph_lo, ph_hi = a_in.ph_hi;
    volatile LAS unsigned* xb_st = (volatile LAS unsigned*)(lds + LDS_BYTES - 16);
    unsigned* xb_bar = (unsigned*)(a_in.ws + WS_BAR);
    if (threadIdx.x < 4) xb_st[threadIdx.x] = 0u;
    __syncthreads();
    if (threadIdx.x == 0) { const unsigned x = xb_xcc_id(); const unsigned r = xb_add(&xb_bar[XB_XCNT(x)], 1u); xb_st[2] = r | (x << 8); }
    int nexec = 0;
#ifdef PROBE_DBL
    for (int pp = 2 * ph_lo; pp < 2 * ph_hi; ++pp) { const int p = pp >> 1;
#else
    for (int p = ph_lo; p < ph_hi; ++p) {
#endif
#if defined(__HIP_DEVICE_COMPILE__)
        KArgsPtr ka = (KArgsPtr)__builtin_amdgcn_kernarg_segment_ptr(); asm volatile("" : "+s"(ka));
        Args a; __builtin_memcpy(&a, ka, sizeof(Args));
#else
        const Args a = a_in;
#endif
        bf16_t* WT = (bf16_t*)(a.ws + WS_WT); bf16_t* U = (bf16_t*)(a.ws + WS_U); unsigned char* BIG = a.ws + WS_BIG; const float* MOD = (const float*)(a.ws + WS_MOD);
        int op = OP_PROLOGUE, l = 0, s = 0, kind = 0, mi = 0, rb = 0, gsel = 0, sdir = 0, spass = 0; bool mixpn = false;
        if (p == 0) op = OP_PROLOGUE;
        else if (p == 1) op = OP_U0;
        else {
            const int q = p - 2; int li;
            if (q < 12) { l = 0; li = q; } else if (q < 22) { l = 1; li = q - 12; } else if (q < 38) { l = 2; li = q - 22; } else { l = 3; li = q - 38; }
            kind = l % 3; mi = l / 3; const int nmix = kind == 0 ? 6 : (kind == 1 ? 4 : 10);
            rb = (l == 3 && li >= 5) ? MCTX : 0;
            if (li < 3 || li >= 3 + nmix) {
                s = li < 3 ? 0 : 1; const int fs = li < 3 ? li : li - 3 - nmix;
                if (fs == 0) op = OP_GEMM_SWIGLU; else if (fs == 1) { op = OP_GEMM_PLAIN; gsel = 0; } else op = OP_POSTNORM;
            } else {
                const int ms = li - 3;
                if (ms == nmix - 1) { op = OP_POSTNORM; mixpn = true; }
                else if (kind == 0) { if (ms == 0) op = OP_GEMM_RETIN; else if (ms == 1) op = OP_RETSCAN; else if (ms == 2) { op = OP_GEMM_PLAIN; gsel = 1; } else if (ms == 3) op = OP_RETFIN; else { op = OP_GEMM_PLAIN; gsel = 2; } }
                else if (kind == 1) { if (ms == 0) { op = OP_GEMM_PLAIN; gsel = 3; } else if (ms == 1) op = OP_NAATT; else { op = OP_GEMM_PLAIN; gsel = 4; } }
                else { if (ms == 0) { op = OP_GEMM_PLAIN; gsel = 5; } else if (ms == 1) op = OP_LRUCONV; else if (ms == 2 || ms == 5) { op = OP_GEMM_GATES; sdir = ms == 5 ? 1 : 0; }
                       else if (ms == 3 || ms == 4) { op = OP_LRUSCAN; sdir = 0; spass = ms - 2; } else if (ms == 6 || ms == 7) { op = OP_LRUSCAN; sdir = 1; spass = ms - 5; } else { op = OP_GEMM_PLAIN; gsel = 6; } }
            }
        }
#ifdef PROBE_DBL
#if PROBE_DBL == 10
        if ((pp & 1) && p != 0) continue;
#else
        if (pp & 1) { const bool pdbl = (PROBE_DBL == 1) ? (op == OP_GEMM_SWIGLU || op == OP_GEMM_PLAIN || op == OP_GEMM_RETIN || op == OP_GEMM_GATES)
                        : (PROBE_DBL == 3) ? (op == OP_RETSCAN) : (PROBE_DBL == 10) ? (op == OP_PROLOGUE) : (PROBE_DBL == 8) ? (op == OP_GEMM_SWIGLU) : (PROBE_DBL == 5) ? (op == OP_NAATT) : (PROBE_DBL == 6) ? (op == OP_LRUCONV || (op == OP_LRUSCAN && !(sdir == 1 && spass == 2))) : (PROBE_DBL == 2) ? (op == OP_POSTNORM && l == 0 && s == 0 && !mixpn) : false;
            if (!pdbl) continue; }
#endif
#endif
        { const unsigned xm = (unsigned)__builtin_amdgcn_readfirstlane((int)xb_st[3]);
          const bool relayout = (op == OP_GEMM_SWIGLU && s == 1) || op == OP_GEMM_RETIN || (op == OP_GEMM_PLAIN && (gsel == 1 || gsel == 3 || gsel == 5));
          if (nexec == 1) cg::this_grid().sync();
          else if (nexec > 1) { if (xm && !relayout) xcd_local_barrier((unsigned*)(a.ws + WS_BAR), ((unsigned)__builtin_amdgcn_readfirstlane((int)xb_st[2]) >> 8) & 0xffu, 32u);
                                else xcd_barrier((unsigned*)(a.ws + WS_BAR), xb_st); } }
        if (nexec == 1 && ph_lo == 0) {
            if (threadIdx.x == 0) { bool ok = gridDim.x == 256;
                for (unsigned j = 0; j < 16; ++j) { const unsigned cnt = xb_ld(&xb_bar[XB_XCNT(j)]); ok = ok && (j < 8 ? cnt == 32u : cnt == 0u); }
#ifdef PROBE_NO_XMODE
                ok = false;
#endif
                xb_st[3] = ok ? 1u : 0u; }
            __syncthreads(); }
        ++nexec;
        const unsigned gword = (unsigned)__builtin_amdgcn_readfirstlane((int)xb_st[2]), xmode = (unsigned)__builtin_amdgcn_readfirstlane((int)xb_st[3]);
        Grp grp; if (xmode) { grp.b_lo = (int)((gword >> 8) & 0xffu); grp.nb = 1; grp.rank = (int)(gword & 0xffu); grp.gsize = 32; } else { grp.b_lo = 0; grp.nb = 8; grp.rank = (int)blockIdx.x; grp.gsize = (int)gridDim.x; }
        switch (op) {
#ifndef NO_OP_PROLOGUE
            case OP_PROLOGUE: phase_prologue(a, lds); break;
#endif
#ifndef NO_OP_U0
            case OP_U0: phase_u0(a, grp); break;
#endif
#ifndef NO_OP_GEMM_SWIGLU
            case OP_GEMM_SWIGLU: { const pg8::Gemm gg{U, WT + E_FFN_IN + (size_t)(l * 2 + s) * 5632 * 1024, MTOT, 5632, 1024, 1024, 0, 0};
                pg8::GroupOrder S; S.init(grp.nb, grp.b_lo, rb != 0, gg.N, grp.gsize, grp.rank); EpiSwiGLU E{(bf16_t*)BIG, 0}; pg8::gemm_phase<EpiSwiGLU, pg8::GroupOrder>(lds, gg, S, E); } break;
#endif
#ifndef NO_OP_GEMM_PLAIN
            case OP_GEMM_PLAIN: { const bf16_t* gA; const bf16_t* gB; int gN, gK, glda; bf16_t* eO; int eldc = 1024, esplit = 0, ehm = 0; size_t estride = 0; float escale = 1.f;
                if (gsel == 0)      { gA = (const bf16_t*)BIG; gB = WT + E_FFN_OUT + (size_t)(l * 2 + s) * 1024 * 2816; gN = 1024; gK = 2816; glda = 2816; eO = (bf16_t*)(BIG + 3 * R1); }
                else if (gsel == 1) { gA = U; gB = WT + E_RET_IN + (size_t)mi * 6144 * 1024 + (size_t)4096 * 1024; gN = 2048; gK = 1024; glda = 1024; eO = (bf16_t*)BIG; eldc = 2048; }
                else if (gsel == 2) { gA = (const bf16_t*)(BIG + 4 * R1); gB = WT + E_RET_OUT + (size_t)mi * 1024 * 2048; gN = 1024; gK = 2048; glda = 2048; eO = (bf16_t*)(BIG + 2 * R1); }
                else if (gsel == 3) { gA = U; gB = WT + E_NA_QKV; gN = 3072; gK = 1024; glda = 1024; eO = (bf16_t*)BIG; esplit = 1024; estride = R1 / 2; escale = 0.125f; ehm = 1; }
                else if (gsel == 4) { gA = (const bf16_t*)BIG; gB = WT + E_NA_OUT; gN = 1024; gK = 1024; glda = 1024; eO = (bf16_t*)(BIG + 3 * R1); }
                else if (gsel == 5) { gA = U; gB = WT + E_LRU_IN; gN = 2048; gK = 1024; glda = 1024; eO = (bf16_t*)BIG; esplit = 1024; estride = R1 / 2; }
                else                { gA = (const bf16_t*)(BIG + R1); gB = WT + E_LRU_OUT; gN = 1024; gK = 1024; glda = 1024; eO = (bf16_t*)(BIG + 2 * R1); }
                const pg8::Gemm gg{gA, gB, MTOT, gN, gK, glda, 0, 0}; pg8::GroupOrder S; S.init(grp.nb, grp.b_lo, rb != 0, gg.N, grp.gsize, grp.rank);
                EpiPlain E{eO, eldc, 0, esplit, estride, escale, ehm}; pg8::gemm_phase<EpiPlain, pg8::GroupOrder>(lds, gg, S, E); } break;
#endif
#ifndef NO_OP_GEMM_RETIN
            case OP_GEMM_RETIN: { const pg8::Gemm gg{U, WT + E_RET_IN + (size_t)mi * 6144 * 1024, MTOT, 4096, 1024, 1024, 0, 0}; pg8::GroupOrder S; S.init(grp.nb, grp.b_lo, false, gg.N, grp.gsize, grp.rank);
                EpiRetIn E{(bf16_t*)BIG, (bf16_t*)(BIG + R1), (bf16_t*)(BIG + 2 * R1), (const float*)(a.ws + WS_ROPE), (const float*)(a.ws + WS_ROPE) + 4096}; pg8::gemm_phase<EpiRetIn, pg8::GroupOrder>(lds, gg, S, E); } break;
#endif
#ifndef NO_OP_GEMM_GATES
            case OP_GEMM_GATES: { const pg8::Gemm gg{(const bf16_t*)(BIG + 2 * R1), WT + E_GATES + (size_t)sdir * 2048 * 256, MTOT, 2048, 256, 1024, 1, 256}; pg8::GroupOrder S; S.init(grp.nb, grp.b_lo, false, gg.N, grp.gsize, grp.rank);
                EpiGates E{(bf16_t*)(BIG + 3 * R1)}; pg8::gemm_phase<EpiGates, pg8::GroupOrder>(lds, gg, S, E); } break;
#endif
#ifndef NO_OP_POSTNORM
            case OP_POSTNORM: { const float* modl = MOD + (size_t)l * 9 * 9216;
                if (mixpn) phase_postnorm(a, false, (const bf16_t*)(BIG + (kind == 1 ? 3 : 2) * R1), modl, 5, 1.f, a.ln_g + (size_t)(l * 3 + 1) * 1024, a.ln_b + (size_t)(l * 3 + 1) * 1024, modl, 6, rb, grp);
                else { const int li3 = l * 3 + (s == 0 ? 0 : 2); const float* modn = (s == 0) ? modl : MOD + (size_t)(l < 3 ? l + 1 : l) * 9 * 9216; const int psh = (s == 0) ? 3 : (l < 3 ? 0 : -1);
                    phase_postnorm(a, l == 0 && s == 0, (const bf16_t*)(BIG + 3 * R1), modl, s == 0 ? 2 : 8, 0.5f, a.ln_g + (size_t)li3 * 1024, a.ln_b + (size_t)li3 * 1024, modn, psh, rb, grp); } } break;
#endif
#ifndef NO_OP_RETSCAN
#if defined(PROBE_DBL) && PROBE_DBL == 3
#ifndef PROBE_RET_ABL
#define PROBE_RET_ABL 0
#endif
            case OP_RETSCAN: if (pp & 1) phase_retention<0>(a, lds, grp); else phase_retention<PROBE_RET_ABL>(a, lds, grp); break;
#else
            case OP_RETSCAN: phase_retention<0>(a, lds, grp); break;
#endif
#endif
#ifndef NO_OP_RETFIN
            case OP_RETFIN: phase_ret_finish(a, rb, grp); break;
#endif
#ifndef NO_OP_NAATT
#if defined(PROBE_DBL) && PROBE_DBL == 5
#ifndef PROBE_NA_ABL
#define PROBE_NA_ABL 0
#endif
            case OP_NAATT: if (pp & 1) phase_na<0>(a, lds, (bf16_t*)BIG, grp); else phase_na<PROBE_NA_ABL>(a, lds, (bf16_t*)(BIG + 3 * R1), grp); break;
#else
            case OP_NAATT: phase_na<0>(a, lds, (bf16_t*)BIG, grp); break;
#endif
#endif
#ifndef NO_OP_LRUCONV
            case OP_LRUCONV: phase_lru_conv(a, grp); break;
#endif
#ifndef NO_OP_LRUSCAN
            case OP_LRUSCAN: phase_lru_scan(a, sdir, spass, grp); break;
#endif
            default: break;
        }
    }
}

#ifndef MK_PER_PHASE
#define MK_PER_PHASE 0
#endif
extern "C" void kernel_launch(void* const* d_in, const int* in_sizes, int n_in, void* d_out, int out_size, void* d_ws, size_t ws_size, hipStream_t stream) {
    static int grid = 0;
    if (grid == 0) {
        if (n_in != 24 || out_size != MLAT * 1024 || ws_size < WS_END) { fprintf(stderr, "kernel_launch: unexpected shapes: n_in %d out %d ws %zu (need %zu)\n", n_in, out_size, ws_size, (size_t)WS_END); grid = -1; return; }
        int dev = 0, cus = 0, per_cu = 0;
        if (hipGetDevice(&dev) != hipSuccess || hipDeviceGetAttribute(&cus, hipDeviceAttributeMultiprocessorCount, dev) != hipSuccess) { grid = -1; return; }
        if (hipFuncSetAttribute((const void*)hybrid_fwd, hipFuncAttributeMaxDynamicSharedMemorySize, LDS_BYTES) != hipSuccess) { fprintf(stderr, "kernel_launch: hipFuncSetAttribute failed\n"); grid = -1; return; }
        if (hipOccupancyMaxActiveBlocksPerMultiprocessor(&per_cu, (const void*)hybrid_fwd, 512, LDS_BYTES) != hipSuccess || per_cu < 1) { fprintf(stderr, "kernel_launch: occupancy query says %d\n", per_cu); per_cu = 1; }
        (void)hipGetLastError();
        grid = cus * 1;
    }
    if (grid < 0) return;
    if (hipMemsetAsync((char*)d_ws + WS_BAR, 0, 16384, stream) != hipSuccess) { fprintf(stderr, "kernel_launch: barrier memset failed\n"); return; }
    Args a{};
    const float** pp = (const float**)&a;
    for (int i = 0; i < 24; ++i) pp[i] = (const float*)d_in[i];
    a.out = (float*)d_out; a.ws = (unsigned char*)d_ws;
#if MK_PER_PHASE
    for (int p = 0; p < NPHASE; ++p) { a.ph_lo = p; a.ph_hi = p + 1; hipLaunchKernelGGL(hybrid_fwd, dim3(grid), dim3(512), LDS_BYTES, stream, a); }
#else
    a.ph_lo = 0; a.ph_hi = NPHASE;
    void* args[] = {&a};
    hipError_t e = hipLaunchCooperativeKernel((const void*)hybrid_fwd, dim3(grid), dim3(512), args, LDS_BYTES, stream);
    if (e != hipSuccess) fprintf(stderr, "cooperative launch failed: %s (grid %d)\n", hipGetErrorString(e), grid);
#endif
}
```

```cpp
#include <hip/hip_runtime.h>
#include <hip/hip_cooperative_groups.h>
#include <cstdio>
namespace cg = cooperative_groups;

#define LAS __attribute__((address_space(3)))
typedef unsigned short bf16_t;
typedef short bf16x8 __attribute__((ext_vector_type(8)));
typedef float f32x4 __attribute__((ext_vector_type(4)));
typedef unsigned u32x4 __attribute__((ext_vector_type(4)));
typedef unsigned u32x2 __attribute__((ext_vector_type(2)));

constexpr int DM = 1024, NB = 8, SEQ = 4096, CTXL = 256, DFF = 2816;
constexpr int MCTX = NB * CTXL, MLAT = NB * SEQ, MTOT = MCTX + MLAT;
constexpr int NMOD = 9;
constexpr float DN_ALPHA = 1.681792830507429f;
constexpr float LN_EPS = 1e-5f;
constexpr float LOG2E = 1.4426950408889634f;
constexpr int LDS_BYTES = 147456;

constexpr size_t E_FFN_IN = 0;
constexpr size_t E_FFN_OUT = E_FFN_IN + (size_t)8 * 5632 * 1024;
constexpr size_t E_RET_IN = E_FFN_OUT + (size_t)8 * 1024 * 2816;
constexpr size_t E_RET_OUT = E_RET_IN + (size_t)2 * 6144 * 1024;
constexpr size_t E_NA_QKV = E_RET_OUT + (size_t)2 * 1024 * 2048;
constexpr size_t E_NA_OUT = E_NA_QKV + (size_t)3072 * 1024;
constexpr size_t E_LRU_IN = E_NA_OUT + (size_t)1024 * 1024;
constexpr size_t E_LRU_OUT = E_LRU_IN + (size_t)2048 * 1024;
constexpr size_t E_GATES = E_LRU_OUT + (size_t)1024 * 1024;
constexpr size_t E_WT_END = E_GATES + (size_t)2 * 2048 * 256;
constexpr size_t R1 = (size_t)MTOT * 1024 * 2;
constexpr size_t WS_WT = 0;
constexpr size_t WS_U = WS_WT + E_WT_END * 2;
constexpr size_t WS_HC = WS_U + R1;
constexpr size_t WS_MOD = WS_HC + (size_t)MCTX * 1024 * 4;
constexpr size_t WS_ROPE = WS_MOD + (size_t)4 * 9 * 9216 * 4;
constexpr size_t WS_CARRY = WS_ROPE + (size_t)2 * 4096 * 4;
constexpr size_t WS_BAR = WS_CARRY + (size_t)NB * 68 * 1024 * 2 * 4;
constexpr size_t WS_BIG = WS_BAR + 16384;
constexpr size_t WS_END = WS_BIG + 6 * R1;

struct Args {
    const float* x; const float* c; const float* ctx; const float* c_ctx; const float* ada_w; const float* ada_b; const float* ln_g; const float* ln_b;
    const float* ffn_w_in; const float* ffn_w_out; const float* ret_w_in; const float* ret_w_out; const float* na_w_qkv; const float* na_rpb; const float* na_w_out;
    const float* lru_w_in; const float* lru_conv_w; const float* lru_conv_b; const float* lru_w_a; const float* lru_b_a; const float* lru_w_x; const float* lru_b_x;
    const float* lru_lam; const float* lru_w_out;
    float* out; unsigned char* ws; int ph_lo, ph_hi;
};

struct Grp { int b_lo, nb, rank, gsize; };
__device__ __forceinline__ int grp_row(const Grp& g, int lr) { const int b = g.b_lo + lr / 4352, t = lr % 4352; return t < 256 ? b * 256 + t : MCTX + b * 4096 + (t - 256); }
__device__ __forceinline__ int grp_row_lat(const Grp& g, int lr) { return MCTX + (g.b_lo + (lr >> 12)) * 4096 + (lr & 4095); }
__device__ __forceinline__ int otid() { int t = threadIdx.x; asm volatile("" : "+v"(t)); return t; }
__device__ __forceinline__ float shx(float v, int lane, int m) { return __int_as_float(__builtin_amdgcn_ds_bpermute((lane ^ m) << 2, __float_as_int(v))); }
__device__ __forceinline__ unsigned cvt_pk_bf16(float lo, float hi) { unsigned r; asm volatile("v_cvt_pk_bf16_f32 %0, %1, %2" : "=v"(r) : "v"(lo), "v"(hi)); return r; }
__device__ __forceinline__ float bflo(unsigned w) { return __uint_as_float(w << 16); }
__device__ __forceinline__ float bfhi(unsigned w) { return __uint_as_float(w & 0xffff0000u); }
__device__ __forceinline__ float bf2f(bf16_t b) { return __uint_as_float(((unsigned)b) << 16); }
__device__ __forceinline__ bf16_t f2bf(float f) { return (bf16_t)(cvt_pk_bf16(f, 0.f) & 0xffffu); }
__device__ __forceinline__ float silu_f(float x) { return x * __builtin_amdgcn_rcpf(1.f + __expf(-x)); }
__device__ __forceinline__ float sigmoid_f(float x) { return __builtin_amdgcn_rcpf(1.f + __expf(-x)); }
__device__ __forceinline__ float gelu_tanh_f(float x) { const float z = 0.7978845608028654f * (x + 0.044715f * x * x * x); const float t = 1.f - 2.f * __builtin_amdgcn_rcpf(__expf(2.f * z) + 1.f); return 0.5f * x * (1.f + t); }

namespace pg8 {
constexpr int BM = 256, BK = 64, HALF = 128, HTB = HALF * BK * 2  , STAGE_BYTES = 8 * HTB, NXCD = 8, WGM = 8;
__host__ __device__ __forceinline__ int lds_byte(int r, int c) { const int st = (r >> 4) * 2 + (c >> 5), rr = r & 15, cc = c & 31, ob = rr * 64 + cc * 2; return st * 1024 + (ob ^ (((ob >> 9) & 1) << 5)); }
__host__ __device__ __forceinline__ void stage_rc(int b, int& R, int& C) { const int st = b / 1024, sb = b % 1024, swz = sb ^ (((sb >> 9) & 1) << 5); R = (st >> 1) * 16 + swz / 64; C = (st & 1) * 32 + (swz % 64) / 2; }
__host__ __device__ __forceinline__ int perm32(int rho) { const int n = rho >> 4, i = rho & 15; return 8 * (i >> 2) + 4 * n + (i & 3); }

struct Unit { int pm, pn; };
struct Gemm { const bf16_t* A; const bf16_t* Bt; int M, N, K, lda, a_sh, a_cols; };

struct StaticOrder {
    int nM, nN, nwg, G, c;
    __host__ __device__ void init(int M, int N, int G_, int c_) { nM = M / BM; nN = N / BM; nwg = nM * nN; G = G_; c = c_; }
    __host__ __device__ bool next(int i, Unit& u) const {
        const long L = (long)i * G + c; if (L >= nwg) return false;
        int wgid = (int)L; { const int q = nwg / NXCD, r = nwg % NXCD, xcd = wgid % NXCD, off = wgid / NXCD; wgid = (xcd < r ? xcd * (q + 1) : r * (q + 1) + (xcd - r) * q) + off; }
        const int nig = WGM * nN, gid = wgid / nig, fm = gid * WGM, gsz = (nM - fm) < WGM ? (nM - fm) : WGM;
        u.pm = fm + ((wgid % nig) % gsz); u.pn = (wgid % nig) / gsz; return true;
    }
    __device__ __forceinline__ void a_ready(const Unit&) const {}
    __device__ __forceinline__ void done(const Unit&) const {}
};

struct GroupOrder {
    int nP, nN, nwg, G, c, b_lo, per, W;
    __device__ void init(int nb, int b_lo_, bool skipctx, int N, int G_, int c_) { per = skipctx ? 16 : 17; nP = nb * per; nN = N / BM; nwg = nP * nN; G = G_; c = c_; b_lo = b_lo_;
        const int ng = (nP + WGM - 1) / WGM; W = (nP + ng - 1) / ng; }
    __device__ bool next(int i, Unit& u) const {
        const long L = (long)i * G + c; if (L >= nwg) return false;
        const int wgid = (int)L, nig = W * nN, gid = wgid / nig, fm = gid * W, gsz = (nP - fm) < W ? (nP - fm) : W;
        const int lp = fm + ((wgid % nig) % gsz); u.pn = (wgid % nig) / gsz;
        const int b = b_lo + lp / per, j = lp % per;
        u.pm = (per == 16) ? 8 + 16 * b + j : (j == 0 ? b : 8 + 16 * b + j - 1);
        return true;
    }
    __device__ __forceinline__ void a_ready(const Unit&) const {}
    __device__ __forceinline__ void done(const Unit&) const {}
};

template <class Epi, class Sched>
__device__ __forceinline__ void gemm_phase(LAS unsigned char* lds, const Gemm g, const Sched& S, const Epi& E) {
    const int tid = otid(), wid = __builtin_amdgcn_readfirstlane(tid >> 6), lane = tid & 63, wr = wid >> 2, wc = wid & 3, fr = lane & 15, fq = lane >> 4;
    const int K = g.K, nt = K / BK, lda = g.lda;
    unsigned voffA[2], voffB[2];
#pragma unroll
    for (int i = 0; i < 2; ++i) { int R, C; stage_rc(tid * 16 + i * 8192, R, C); const int Rb = Epi::PERM ? ((R & ~31) + perm32(R & 31)) : R;
        voffA[i] = (unsigned)(R * lda + C) * 2u; voffB[i] = (unsigned)(Rb * K + C) * 2u; }
    const size_t kstep = (size_t)(BK * 2);
    const size_t hstepA = (size_t)HALF * lda * 2, hstepB = (size_t)HALF * K * 2;
    const size_t tstepA = 2 * hstepA, tstepB = 2 * hstepB;
    const unsigned ldsw = (unsigned)wid * 1024u;
    const int aoff = lds_byte(wr * 64 + fr, fq * 8), boff = lds_byte(wc * 32 + fr, fq * 8);
#define PG8_SA(b, h) (((b) * 2 + (h)) * HTB)
#define PG8_SB(b, h) ((4 + (b) * 2 + (h)) * HTB)
#define PG8_STAGE(bufoff, gbase, voff) do { _Pragma("unroll") for (int _i = 0; _i < 2; ++_i) \
        __builtin_amdgcn_global_load_lds((const unsigned*)((const char*)(gbase) + (voff)[_i]), (LAS unsigned*)(lds + (bufoff) + ldsw + _i * 8192), 16, 0, 0); } while (0)
#define PG8_LDA(dst, b, h) do { _Pragma("unroll") for (int m = 0; m < 4; ++m) _Pragma("unroll") for (int k = 0; k < 2; ++k) dst[m][k] = *(const LAS bf16x8*)(lds + PG8_SA(b, h) + aoff + m * 2048 + k * 1024); } while (0)
#define PG8_LDB(dst, b, h) do { _Pragma("unroll") for (int n = 0; n < 2; ++n) _Pragma("unroll") for (int k = 0; k < 2; ++k) dst[n][k] = *(const LAS bf16x8*)(lds + PG8_SB(b, h) + boff + n * 2048 + k * 1024); } while (0)
#define PG8_MMA(ai, bj, At, Bt) do { __builtin_amdgcn_s_setprio(1); _Pragma("unroll") for (int m = 0; m < 4; ++m) _Pragma("unroll") for (int n = 0; n < 2; ++n) _Pragma("unroll") for (int k = 0; k < 2; ++k) \
        acc[ai][bj][m][n] = __builtin_amdgcn_mfma_f32_16x16x32_bf16(Bt[n][k], At[m][k], acc[ai][bj][m][n], 0, 0, 0); __builtin_amdgcn_s_setprio(0); } while (0)
#define PG8_WAIT_V(n) asm volatile("s_waitcnt vmcnt(" #n ")" ::: "memory")
#define PG8_WAIT_L(n) asm volatile("s_waitcnt lgkmcnt(" #n ")" ::: "memory")
#define PG8_BAR __builtin_amdgcn_s_barrier()
#define PG8_SCHED __builtin_amdgcn_sched_barrier(0)
#define PG8_AOFF(u) ((size_t)(u).pm * tstepA + (size_t)(((u).pn >> g.a_sh) * g.a_cols) * 2)
    Unit cur, nxt; int ui = 0;
    if (!S.next(0, cur)) return;
    f32x4 acc[2][2][4][2];
#pragma unroll
    for (int a = 0; a < 2; ++a)
#pragma unroll
        for (int b = 0; b < 2; ++b)
#pragma unroll
            for (int m = 0; m < 4; ++m)
#pragma unroll
                for (int n = 0; n < 2; ++n) acc[a][b][m][n] = (f32x4){0.f, 0.f, 0.f, 0.f};
    bf16x8 At[4][2], B0[2][2], B1[2][2];
    const char* cA = (const char*)g.A + PG8_AOFF(cur); const char* cB = (const char*)g.Bt + (size_t)cur.pn * tstepB;
    S.a_ready(cur);
    PG8_STAGE(PG8_SB(0, 0), cB, voffB); PG8_STAGE(PG8_SA(0, 0), cA, voffA); PG8_STAGE(PG8_SB(0, 1), cB + hstepB, voffB); PG8_STAGE(PG8_SA(0, 1), cA + hstepA, voffA);
    if (wr == 1) PG8_BAR;
    PG8_WAIT_V(4); PG8_BAR;
    PG8_STAGE(PG8_SB(1, 0), cB + kstep, voffB); PG8_STAGE(PG8_SA(1, 0), cA + kstep, voffA); PG8_STAGE(PG8_SB(1, 1), cB + hstepB + kstep, voffB);
    PG8_WAIT_V(6); PG8_BAR;
    for (;;) {
        const bool has_next = S.next(ui + 1, nxt);
        const char* nA = has_next ? (const char*)g.A + PG8_AOFF(nxt) : cA; const char* nB = has_next ? (const char*)g.Bt + (size_t)nxt.pn * tstepB : cB;
        for (int t = 0; t < nt; t += 2) {
            const bool last = (t == nt - 2);
            const char* a1 = cA + (size_t)(t + 1) * kstep;
            const char* a2 = last ? nA : cA + (size_t)(t + 2) * kstep; const char* b2 = last ? nB : cB + (size_t)(t + 2) * kstep;
            const char* a3 = a2 + kstep; const char* b3 = b2 + kstep;
            if (last && has_next) S.a_ready(nxt);
            PG8_LDB(B0, 0, 0); PG8_SCHED; PG8_LDA(At, 0, 0); PG8_STAGE(PG8_SA(1, 1), a1 + hstepA, voffA);
            PG8_WAIT_L(8); PG8_BAR; PG8_WAIT_L(0); PG8_MMA(0, 0, At, B0); PG8_BAR; PG8_SCHED;
            PG8_LDB(B1, 0, 1); PG8_STAGE(PG8_SB(0, 0), b2, voffB);
            PG8_BAR; PG8_WAIT_L(0); PG8_MMA(0, 1, At, B1); PG8_BAR;
            PG8_LDA(At, 0, 1); PG8_STAGE(PG8_SA(0, 0), a2, voffA);
            PG8_BAR; PG8_WAIT_L(0); PG8_MMA(1, 0, At, B0); PG8_BAR; PG8_SCHED;
            PG8_STAGE(PG8_SB(0, 1), b2 + hstepB, voffB);
            PG8_WAIT_V(6); PG8_BAR; PG8_MMA(1, 1, At, B1); PG8_BAR;
            PG8_LDB(B0, 1, 0); PG8_SCHED; PG8_LDA(At, 1, 0); PG8_STAGE(PG8_SA(0, 1), a2 + hstepA, voffA);
            PG8_WAIT_L(8); PG8_BAR; PG8_WAIT_L(0); PG8_MMA(0, 0, At, B0); PG8_BAR; PG8_SCHED;
            PG8_LDB(B1, 1, 1); PG8_STAGE(PG8_SB(1, 0), b3, voffB);
            PG8_BAR; PG8_WAIT_L(0); PG8_MMA(0, 1, At, B1); PG8_BAR;
            PG8_LDA(At, 1, 1); PG8_STAGE(PG8_SA(1, 0), a3, voffA);
            PG8_BAR; PG8_WAIT_L(0); PG8_MMA(1, 0, At, B0); PG8_BAR; PG8_SCHED;
            PG8_STAGE(PG8_SB(1, 1), b3 + hstepB, voffB);
            PG8_WAIT_V(6); PG8_BAR; PG8_MMA(1, 1, At, B1); PG8_BAR;
        }
        E(acc, cur, wr, wc, fr, fq); S.done(cur);
        if (!has_next) break;
#pragma unroll
        for (int a = 0; a < 2; ++a)
#pragma unroll
            for (int b = 0; b < 2; ++b)
#pragma unroll
                for (int m = 0; m < 4; ++m)
#pragma unroll
                    for (int n = 0; n < 2; ++n) acc[a][b][m][n] = (f32x4){0.f, 0.f, 0.f, 0.f};
        cur = nxt; cA = nA; cB = nB; ++ui;
    }
    PG8_WAIT_V(0);
    if (wr == 0) PG8_BAR;
    PG8_BAR;
#undef PG8_SA
#undef PG8_SB
#undef PG8_STAGE
#undef PG8_LDA
#undef PG8_LDB
#undef PG8_MMA
#undef PG8_WAIT_V
#undef PG8_WAIT_L
#undef PG8_BAR
#undef PG8_SCHED
#undef PG8_AOFF
}
}

#define XB_TMO      128
#define XB_XCNT(j)  (256  + 64 * (j))
#define XB_XSUB(j)  (1280 + 64 * (j))
#define XB_XGEN(j)  (2304 + 64 * (j))
#define XB_TOP      3328
#define XB_TOPGEN   3392
#define XCD_BAR_WORDS 3456
#define XB_LSUB(j)  (3456 + 64 * (j))
#define XB_LGEN(j)  (3488 + 64 * (j))
#define XB_SPIN_CAP (1u << 21)
__device__ __forceinline__ unsigned xb_ld(unsigned* p)              { return __hip_atomic_load(p, __ATOMIC_RELAXED, __HIP_MEMORY_SCOPE_AGENT); }
__device__ __forceinline__ unsigned xb_add(unsigned* p, unsigned v) { return __hip_atomic_fetch_add(p, v, __ATOMIC_RELAXED, __HIP_MEMORY_SCOPE_AGENT); }
__device__ __forceinline__ unsigned xb_xcc_id() { return (unsigned)__builtin_amdgcn_s_getreg((3 << 11) | 20) & 0xFu; }
#define XB_SPIN(cond, bar) do { unsigned _sp = 0; while (cond) { __builtin_amdgcn_s_sleep(1); \
    if ((++_sp & 255u) == 0u) { if (xb_ld(&(bar)[XB_TMO])) break; if (_sp > XB_SPIN_CAP) { atomicAdd(&(bar)[XB_TMO], 1u); break; } } } } while (0)
__device__ __forceinline__ void xcd_barrier_complete(unsigned* bar, unsigned x, unsigned& nloc, unsigned& nx) {
    const unsigned G = gridDim.x * gridDim.y * gridDim.z;
    unsigned sum, cnt, mine, sp = 0u;
    for (;;) {
        sum = 0u; cnt = 0u; mine = 0u;
#pragma unroll
        for (unsigned j = 0; j < 16; ++j) { const unsigned c = xb_ld(&bar[XB_XCNT(j)]); sum += c; cnt += (c > 0u) ? 1u : 0u; mine = (j == x) ? c : mine; }
        if (sum == G) break;
        __builtin_amdgcn_s_sleep(1);
        if ((++sp & 255u) == 0u) { if (xb_ld(&bar[XB_TMO])) break; if (sp > XB_SPIN_CAP) { atomicAdd(&bar[XB_TMO], 1u); break; } }
    }
    nloc = mine > 0u ? mine : 1u; nx = cnt > 0u ? cnt : 1u;
}
__device__ __forceinline__ void xcd_barrier(unsigned* bar, volatile LAS unsigned* st) {
    asm volatile("s_waitcnt vmcnt(0)" ::: "memory");
    __syncthreads();
    if (threadIdx.x == 0) {
        const unsigned x = xb_xcc_id();
        __builtin_amdgcn_s_waitcnt(0);
        unsigned nloc = st[0], nx = st[1];
        if (nloc == 0u) { xcd_barrier_complete(bar, x, nloc, nx); st[0] = nloc; st[1] = nx; }
        const unsigned old = xb_add(&bar[XB_XSUB(x)], 1u);
        const unsigned gen = old / nloc;
        if (old + 1u == (gen + 1u) * nloc) {
            __builtin_amdgcn_fence(__ATOMIC_RELEASE, "agent");
            asm volatile("s_waitcnt vmcnt(0)" ::: "memory");
            const unsigned og = xb_add(&bar[XB_TOP], 1u);
            const unsigned tg = og / nx;
            if (og + 1u == (tg + 1u) * nx) xb_add(&bar[XB_TOPGEN], 1u);
            else XB_SPIN(xb_ld(&bar[XB_TOPGEN]) == tg, bar);
            __builtin_amdgcn_fence(__ATOMIC_ACQUIRE, "agent");
            xb_add(&bar[XB_XGEN(x)], 1u);
            asm volatile("s_waitcnt vmcnt(0)" ::: "memory");
        } else {
            XB_SPIN(xb_ld(&bar[XB_XGEN(x)]) == gen, bar);
            __builtin_amdgcn_fence(__ATOMIC_ACQUIRE, "agent");
            asm volatile("s_waitcnt vmcnt(0)" ::: "memory");
        }
    }
    __syncthreads();
}

__device__ __forceinline__ void xcd_local_barrier(unsigned* bar, unsigned x, unsigned nloc) {
    asm volatile("s_waitcnt vmcnt(0)" ::: "memory");
    __syncthreads();
    if (threadIdx.x == 0) {
        __builtin_amdgcn_s_waitcnt(0);
        const unsigned old = xb_add(&bar[XB_LSUB(x)], 1u), gen = old / nloc;
        if (old + 1u == (gen + 1u) * nloc) xb_add(&bar[XB_LGEN(x)], 1u);
        else XB_SPIN(xb_ld(&bar[XB_LGEN(x)]) == gen, bar);
        __builtin_amdgcn_fence(__ATOMIC_ACQUIRE, "agent");
        asm volatile("s_waitcnt vmcnt(0)" ::: "memory");
    }
    __syncthreads();
}
struct EpiSwiGLU {
    static constexpr bool PERM = true;
    bf16_t* H; int row_off;
    __device__ __forceinline__ void operator()(const f32x4 (&acc)[2][2][4][2], const pg8::Unit& u, int wr, int wc, int fr, int fq) const {
        const int row0 = row_off + u.pm * 256 + wr * 64 + fr, hc = u.pn * 128 + wc * 32 + 8 * fq;
#pragma unroll
        for (int ai = 0; ai < 2; ++ai)
#pragma unroll
            for (int m = 0; m < 4; ++m) {
                bf16_t* rowp = H + (size_t)(row0 + ai * 128 + m * 16) * DFF + hc;
                const f32x4 g0 = acc[ai][0][m][0], g1 = acc[ai][0][m][1], u0 = acc[ai][1][m][0], u1 = acc[ai][1][m][1];
                u32x4 w;
                w.x = cvt_pk_bf16(silu_f(g0[0]) * u0[0], silu_f(g0[1]) * u0[1]); w.y = cvt_pk_bf16(silu_f(g0[2]) * u0[2], silu_f(g0[3]) * u0[3]);
                w.z = cvt_pk_bf16(silu_f(g1[0]) * u1[0], silu_f(g1[1]) * u1[1]); w.w = cvt_pk_bf16(silu_f(g1[2]) * u1[2], silu_f(g1[3]) * u1[3]);
                *(u32x4*)rowp = w;
            }
    }
};
struct EpiPlain {
    static constexpr bool PERM = true;
    bf16_t* O; int ldc; int row_off; int split_cols; size_t split_stride; float scale0; int headmajor;
    __device__ __forceinline__ void operator()(const f32x4 (&acc)[2][2][4][2], const pg8::Unit& u, int wr, int wc, int fr, int fq) const {
        const int row0 = row_off + u.pm * 256 + wr * 64 + fr; int colt = u.pn * 256; bf16_t* base = O; float sc = scale0; int t = 0;
        if (split_cols) { t = colt / split_cols; base += (size_t)t * split_stride; colt -= t * split_cols; if (t) sc = 1.f; }
        const int col0 = colt + wc * 32 + 8 * fq; const bool hm = headmajor && t > 0;
        const size_t rstride = hm ? 64 : (size_t)ldc;
        const size_t cofs0 = hm ? (size_t)(col0 >> 6) * MTOT * 64 + (col0 & 63) : (size_t)col0, cofs1 = hm ? (size_t)((col0 + 128) >> 6) * MTOT * 64 + ((col0 + 128) & 63) : (size_t)col0 + 128;
#pragma unroll
        for (int ai = 0; ai < 2; ++ai)
#pragma unroll
            for (int m = 0; m < 4; ++m) { bf16_t* rowp = base + (size_t)(row0 + ai * 128 + m * 16) * rstride;
#pragma unroll
                for (int bj = 0; bj < 2; ++bj) { const f32x4 v0 = acc[ai][bj][m][0] * sc, v1 = acc[ai][bj][m][1] * sc;
                    u32x4 w; w.x = cvt_pk_bf16(v0[0], v0[1]); w.y = cvt_pk_bf16(v0[2], v0[3]); w.z = cvt_pk_bf16(v1[0], v1[1]); w.w = cvt_pk_bf16(v1[2], v1[3]);
                    *(u32x4*)(rowp + (bj ? cofs1 : cofs0)) = w; } }
    }
};
struct EpiRetIn {
    static constexpr bool PERM = true;
    bf16_t* Q; bf16_t* K; bf16_t* V; const float* rcos; const float* rsin;
    __device__ __forceinline__ void operator()(const f32x4 (&acc)[2][2][4][2], const pg8::Unit& u, int wr, int wc, int fr, int fq) const {
        const int row0 = u.pm * 256 + wr * 64 + fr, cin = wc * 32 + 8 * fq;
        if (u.pn >= 8) {
#pragma unroll
            for (int ai = 0; ai < 2; ++ai)
#pragma unroll
                for (int m = 0; m < 4; ++m) { bf16_t* rowp = V + (size_t)(row0 + ai * 128 + m * 16) * 2048 + (u.pn - 8) * 256 + cin;
#pragma unroll
                    for (int bj = 0; bj < 2; ++bj) { const f32x4 v0 = acc[ai][bj][m][0], v1 = acc[ai][bj][m][1];
                        u32x4 w; w.x = cvt_pk_bf16(v0[0], v0[1]); w.y = cvt_pk_bf16(v0[2], v0[3]); w.z = cvt_pk_bf16(v1[0], v1[1]); w.w = cvt_pk_bf16(v1[2], v1[3]);
                        *(u32x4*)(rowp + bj * 128) = w; } }
        } else {
            bf16_t* T = (u.pn < 4) ? Q : K; const float mul = (u.pn < 4) ? 1.f : 0.0625f; const int f0 = wc * 16 + 4 * fq;
#pragma unroll
            for (int ai = 0; ai < 2; ++ai)
#pragma unroll
                for (int m = 0; m < 4; ++m) { const int row = row0 + ai * 128 + m * 16; bf16_t* rowp = T + (size_t)row * 1024 + (u.pn & 3) * 256 + cin;
                    const bool lat = row >= MCTX; const int t = (row - MCTX) & 4095;
#pragma unroll
                    for (int bj = 0; bj < 2; ++bj) { f32x4 v0 = acc[ai][bj][m][0] * mul, v1 = acc[ai][bj][m][1] * mul;
                        if (lat) { const int pos = bj ? (t & 63) : (t >> 6); const f32x4 cs = *(const f32x4*)(rcos + pos * 64 + f0), sn = *(const f32x4*)(rsin + pos * 64 + f0);
                            const f32x4 a0 = v0, a1 = v1;
                            v0[0] = a0[0] * cs[0] - a0[1] * sn[0]; v0[1] = a0[0] * sn[0] + a0[1] * cs[0]; v0[2] = a0[2] * cs[1] - a0[3] * sn[1]; v0[3] = a0[2] * sn[1] + a0[3] * cs[1];
                            v1[0] = a1[0] * cs[2] - a1[1] * sn[2]; v1[1] = a1[0] * sn[2] + a1[1] * cs[2]; v1[2] = a1[2] * cs[3] - a1[3] * sn[3]; v1[3] = a1[2] * sn[3] + a1[3] * cs[3]; }
                        u32x4 w; w.x = cvt_pk_bf16(v0[0], v0[1]); w.y = cvt_pk_bf16(v0[2], v0[3]); w.z = cvt_pk_bf16(v1[0], v1[1]); w.w = cvt_pk_bf16(v1[2], v1[3]);
                        *(u32x4*)(rowp + bj * 128) = w; } }
        }
    }
};
struct EpiGates {
    static constexpr bool PERM = true;
    bf16_t* GP;
    __device__ __forceinline__ void operator()(const f32x4 (&acc)[2][2][4][2], const pg8::Unit& u, int wr, int wc, int fr, int fq) const {
        const int row0 = u.pm * 256 + wr * 64 + fr, col0 = (u.pn & 1) * 1024 + (u.pn >> 1) * 256 + wc * 32 + 8 * fq;
#pragma unroll
        for (int ai = 0; ai < 2; ++ai)
#pragma unroll
            for (int m = 0; m < 4; ++m) { bf16_t* rowp = GP + (size_t)(row0 + ai * 128 + m * 16) * 2048 + col0;
#pragma unroll
                for (int bj = 0; bj < 2; ++bj) { const f32x4 v0 = acc[ai][bj][m][0], v1 = acc[ai][bj][m][1];
                    u32x4 w; w.x = cvt_pk_bf16(v0[0], v0[1]); w.y = cvt_pk_bf16(v0[2], v0[3]); w.z = cvt_pk_bf16(v1[0], v1[1]); w.w = cvt_pk_bf16(v1[2], v1[3]);
                    *(u32x4*)(rowp + bj * 128) = w; } }
    }
};

struct CvtJob { const float* src; bf16_t* dst; int K, N, ld, perm; };
__device__ __forceinline__ CvtJob get_job(const Args& a, int j) {
    bf16_t* wt = (bf16_t*)(a.ws + WS_WT); CvtJob r;
    if (j < 8)       { r.src = a.ffn_w_in + (size_t)j * 1024 * 5632; r.dst = wt + E_FFN_IN + (size_t)j * 5632 * 1024; r.K = 1024; r.N = 5632; r.ld = 5632; r.perm = 1; }
    else if (j < 16) { const int i = j - 8; r.src = a.ffn_w_out + (size_t)i * 2816 * 1024; r.dst = wt + E_FFN_OUT + (size_t)i * 1024 * 2816; r.K = 2816; r.N = 1024; r.ld = 1024; r.perm = 0; }
    else if (j < 18) { const int i = j - 16; r.src = a.ret_w_in + (size_t)i * 1024 * 6144; r.dst = wt + E_RET_IN + (size_t)i * 6144 * 1024; r.K = 1024; r.N = 6144; r.ld = 6144; r.perm = 2; }
    else if (j < 20) { const int i = j - 18; r.src = a.ret_w_out + (size_t)i * 2048 * 1024; r.dst = wt + E_RET_OUT + (size_t)i * 1024 * 2048; r.K = 2048; r.N = 1024; r.ld = 1024; r.perm = 0; }
    else if (j == 20) { r.src = a.na_w_qkv; r.dst = wt + E_NA_QKV; r.K = 1024; r.N = 3072; r.ld = 3072; r.perm = 0; }
    else if (j == 21) { r.src = a.na_w_out; r.dst = wt + E_NA_OUT; r.K = 1024; r.N = 1024; r.ld = 1024; r.perm = 0; }
    else if (j == 22) { r.src = a.lru_w_in; r.dst = wt + E_LRU_IN; r.K = 1024; r.N = 2048; r.ld = 2048; r.perm = 0; }
    else if (j == 23) { r.src = a.lru_w_out; r.dst = wt + E_LRU_OUT; r.K = 1024; r.N = 1024; r.ld = 1024; r.perm = 0; }
    else { const int gI = j - 24, dir = gI >> 3, type = (gI >> 2) & 1, k = gI & 3;
        r.src = (type ? a.lru_w_x : a.lru_w_a) + (size_t)(dir * 4 + k) * 256 * 256; r.dst = wt + E_GATES + (size_t)dir * 2048 * 256 + (size_t)((k * 2 + type) * 256) * 256; r.K = 256; r.N = 256; r.ld = 256; r.perm = 0; }
    return r;
}
__device__ __forceinline__ int perm_col(int perm, int n) {
    if (perm == 1) return ((n & 255) >> 7) * 2816 + (n >> 8) * 128 + (n & 127);
    if (perm == 2) { if (n < 2048) { const int hb = n >> 8, dp = n & 255, p = dp >> 1, e = dp & 1; const int d = (p < 64) ? (p + 64 * e) : (128 + (p - 64) + 64 * e); return hb * 256 + d; } return n; }
    return n;
}
__device__ __forceinline__ void phase_prologue(const Args& a, LAS unsigned char* lds) {
    const int tid = otid(), G = gridDim.x;
    { LAS bf16_t* tile = (LAS bf16_t*)lds;
      int cum = 0;
      for (int j = 0; j < 40; ++j) {
          const CvtJob jb = get_job(a, j);
          const int tn = jb.N >> 6, ntile = tn * (jb.K >> 6);
          const int first = (int)((blockIdx.x + G - (cum % G)) % G);
          for (int t = first; t < ntile; t += G) {
              const int n0 = (t % tn) * 64, k0 = (t / tn) * 64, c = tid & 63, kr = tid >> 6;
              const float* sp = jb.src + (size_t)k0 * jb.ld + perm_col(jb.perm, n0 + c);
              float v[8];
#pragma unroll
              for (int i = 0; i < 8; ++i) v[i] = sp[(size_t)(kr + 8 * i) * jb.ld];
#pragma unroll
              for (int i = 0; i < 8; ++i) tile[c * 72 + kr + 8 * i] = f2bf(v[i]);
              __syncthreads();
              const int row = tid >> 3, ch = tid & 7;
              const u32x4 w = *(const LAS u32x4*)(tile + row * 72 + ch * 8);
              *(u32x4*)(jb.dst + (size_t)(n0 + row) * jb.K + k0 + ch * 8) = w;
              __syncthreads();
          }
          cum += ntile;
      } }
    { LAS float* sv = (LAS float*)lds; LAS float* red = sv + 9 * 1024; float* MOD = (float*)(a.ws + WS_MOD);
      for (int i = tid; i < 9 * 1024; i += 512) { const int r = i >> 10, k = i & 1023; const float cv = (r < 8) ? a.c[r * 1024 + k] : a.c_ctx[k]; sv[i] = cv / (1.f + expf(-cv)); }
      __syncthreads();
      for (int it = blockIdx.x; it < 288; it += G) {
          const int l = it / 72, cb = it % 72, cl = tid & 127, kq = tid >> 7;
          const float* W = a.ada_w + (size_t)l * 1024 * 9216 + cb * 128 + cl;
          float acc[9];
#pragma unroll
          for (int r = 0; r < 9; ++r) acc[r] = 0.f;
          for (int k = kq * 256; k < kq * 256 + 256; k += 4) {
              float w[4];
#pragma unroll
              for (int q = 0; q < 4; ++q) w[q] = W[(size_t)(k + q) * 9216];
#pragma unroll
              for (int q = 0; q < 4; ++q)
#pragma unroll
                  for (int r = 0; r < 9; ++r) acc[r] += sv[r * 1024 + k + q] * w[q];
          }
#pragma unroll
          for (int r = 0; r < 9; ++r) red[(kq * 9 + r) * 128 + cl] = acc[r];
          __syncthreads();
          for (int o = tid; o < 9 * 128; o += 512) { const int r = o >> 7, cc = o & 127, col = cb * 128 + cc;
              const float s = (red[(0 * 9 + r) * 128 + cc] + red[(1 * 9 + r) * 128 + cc]) + (red[(2 * 9 + r) * 128 + cc] + red[(3 * 9 + r) * 128 + cc]);
              MOD[(size_t)(l * 9 + r) * 9216 + col] = s + a.ada_b[l * 9216 + col]; }
          __syncthreads();
      } }
    { float* rc = (float*)(a.ws + WS_ROPE); float* rs = rc + 4096;
      for (int i = blockIdx.x * 512 + tid; i < 4096; i += G * 512) { const int pos = i >> 6, f = i & 63; const float fr = expf(-(float)(2 * f) * (1.f / 128.f) * 9.210340371976184f); const float ang = (float)pos * fr;
          rc[i] = cosf(ang); rs[i] = sinf(ang); } }
}

__device__ __forceinline__ void phase_u0(const Args& a, const Grp& gp) {
    const float* MOD = (const float*)(a.ws + WS_MOD); bf16_t* U = (bf16_t*)(a.ws + WS_U);
    const int i0 = gp.rank * 512 + otid(), c8 = (i0 & 127) * 8;
    const bool uni = gp.nb == 1;
    const float* lsh = MOD + (size_t)((uni ? gp.b_lo : 0) * 9 + 0) * 1024 + c8;
    const f32x4 ls0 = *(const f32x4*)lsh, ls1 = *(const f32x4*)(lsh + 4), lc0 = *(const f32x4*)(lsh + 1024), lc1 = *(const f32x4*)(lsh + 1028);
    for (int i = i0; i < gp.nb * 4352 * 128; i += gp.gsize * 512) {
        const int row = grp_row(gp, i >> 7); const int r9 = row < MCTX ? 8 : (row - MCTX) >> 12;
        const float* hp = (row < MCTX ? a.ctx + (size_t)row * 1024 : a.x + (size_t)(row - MCTX) * 1024) + c8;
        const f32x4 h0 = *(const f32x4*)hp, h1 = *(const f32x4*)(hp + 4); f32x4 s0, s1, c0, c1;
        if (uni && row >= MCTX) { s0 = ls0; s1 = ls1; c0 = lc0; c1 = lc1; }
        else { const float* sh = MOD + (size_t)(r9 * 9 + 0) * 1024 + c8; const float* sc = sh + 1024; s0 = *(const f32x4*)sh; s1 = *(const f32x4*)(sh + 4); c0 = *(const f32x4*)sc; c1 = *(const f32x4*)(sc + 4); }
        const f32x4 o0 = h0 * (c0 + 1.f) + s0, o1 = h1 * (c1 + 1.f) + s1;
        u32x4 w; w.x = cvt_pk_bf16(o0[0], o0[1]); w.y = cvt_pk_bf16(o0[2], o0[3]); w.z = cvt_pk_bf16(o1[0], o1[1]); w.w = cvt_pk_bf16(o1[2], o1[3]);
        *(u32x4*)(U + (size_t)row * 1024 + c8) = w;
    }
}

__device__ __forceinline__ void phase_postnorm(const Args& a, bool first, const bf16_t* Y, const float* modl, int gate_j, float ymul, const float* lng, const float* lnb,
                                               const float* modn, int sh_j, int row_begin, const Grp& gp) {
    const int tid = otid(), lane = tid & 63, gw = gp.rank * 8 + (tid >> 6), nw = gp.gsize * 8;
    const int nrows = gp.nb * (row_begin ? 4096 : 4352);
    float* HC = (float*)(a.ws + WS_HC); bf16_t* U = (bf16_t*)(a.ws + WS_U);
    f32x4 hr[2][4]; u32x2 yr[2][4];
#define PN_MAP(lr) (row_begin ? grp_row_lat(gp, (lr)) : grp_row(gp, (lr)))
#define PN_ROW(t, lA) PN_MAP((t) ? (((lA) + nw < nrows) ? (lA) + nw : (lA)) : (lA))
#define PN_LOAD(dstH, dstY, rA) do { _Pragma("unroll") for (int t = 0; t < 2; ++t) { const int row = PN_ROW(t, rA); const bool isc = row < MCTX; \
        const float* hin = first ? (isc ? a.ctx + (size_t)row * 1024 : a.x + (size_t)(row - MCTX) * 1024) : (isc ? HC + (size_t)row * 1024 : a.out + (size_t)(row - MCTX) * 1024); \
        const bf16_t* yp = Y + (size_t)row * 1024; \
        _Pragma("unroll") for (int c = 0; c < 4; ++c) { const int col = c * 256 + lane * 4; dstH[t][c] = *(const f32x4*)(hin + col); dstY[t][c] = *(const u32x2*)(yp + col); } } } while (0)
    f32x4 gv[4], bv[4];
#pragma unroll
    for (int c = 0; c < 4; ++c) { gv[c] = *(const f32x4*)(lng + c * 256 + lane * 4); bv[c] = *(const f32x4*)(lnb + c * 256 + lane * 4); }
    const bool uni = gp.nb == 1;
    f32x4 gl[4], shl[4], scl[4];
#pragma unroll
    for (int c = 0; c < 4; ++c) { const int col = c * 256 + lane * 4; const int rl = uni ? gp.b_lo : 0;
        gl[c] = *(const f32x4*)(modl + (size_t)(rl * 9 + gate_j) * 1024 + col);
        shl[c] = *(const f32x4*)(modn + (size_t)(rl * 9 + (sh_j >= 0 ? sh_j : 0)) * 1024 + col); scl[c] = *(const f32x4*)(modn + (size_t)(rl * 9 + (sh_j >= 0 ? sh_j : 0) + 1) * 1024 + col); }
    int rowA = gw;
    if (rowA < nrows) PN_LOAD(hr, yr, rowA);
    for (; rowA < nrows; rowA += 2 * nw) {
        const bool hasB = rowA + nw < nrows;
        f32x4 v[2][4]; float s[2] = {0.f, 0.f}, q[2] = {0.f, 0.f};
#pragma unroll
        for (int t = 0; t < 2; ++t) { const int row = PN_ROW(t, rowA); const int r9 = row < MCTX ? 8 : (row - MCTX) >> 12;
            const float* gate = modl + (size_t)(r9 * 9 + gate_j) * 1024;
#pragma unroll
            for (int c = 0; c < 4; ++c) { const int col = c * 256 + lane * 4; const f32x4 gt = (uni && row >= MCTX) ? gl[c] : *(const f32x4*)(gate + col);
                const f32x4 y = {bflo(yr[t][c].x), bfhi(yr[t][c].x), bflo(yr[t][c].y), bfhi(yr[t][c].y)};
                v[t][c] = hr[t][c] * DN_ALPHA + gt * y * ymul; s[t] += (v[t][c][0] + v[t][c][1]) + (v[t][c][2] + v[t][c][3]);
                q[t] += (v[t][c][0] * v[t][c][0] + v[t][c][1] * v[t][c][1]) + (v[t][c][2] * v[t][c][2] + v[t][c][3] * v[t][c][3]); } }
        const int rowN = rowA + 2 * nw;
        if (rowN < nrows) PN_LOAD(hr, yr, rowN);
#pragma unroll
        for (int o = 32; o >= 1; o >>= 1) { const float s0 = shx(s[0], lane, o), s1 = shx(s[1], lane, o), q0 = shx(q[0], lane, o), q1 = shx(q[1], lane, o); s[0] += s0; s[1] += s1; q[0] += q0; q[1] += q1; }
#pragma unroll
        for (int t = 0; t < 2; ++t) { if (t && !hasB) break; const int row = PN_MAP(t ? rowA + nw : rowA);
            const bool isc = row < MCTX; const int r9 = isc ? 8 : (row - MCTX) >> 12;
            float* hout = isc ? HC + (size_t)row * 1024 : a.out + (size_t)(row - MCTX) * 1024;
            const float mean = s[t] * (1.f / 1024.f); const float var = fmaxf(q[t] * (1.f / 1024.f) - mean * mean, 0.f);
            const float rstd = 1.0f / sqrtf(var + LN_EPS);
#pragma unroll
            for (int c = 0; c < 4; ++c) { const int col = c * 256 + lane * 4;
                const f32x4 hn = (v[t][c] - mean) * rstd * gv[c] + bv[c]; *(f32x4*)(hout + col) = hn;
                if (sh_j >= 0) { f32x4 sh, sc; if (uni && !isc) { sh = shl[c]; sc = scl[c]; } else { sh = *(const f32x4*)(modn + (size_t)(r9 * 9 + sh_j) * 1024 + col); sc = *(const f32x4*)(modn + (size_t)(r9 * 9 + sh_j + 1) * 1024 + col); }
                    const f32x4 o = hn * (sc + 1.f) + sh; u32x2 w; w.x = cvt_pk_bf16(o[0], o[1]); w.y = cvt_pk_bf16(o[2], o[3]); *(u32x2*)(U + (size_t)row * 1024 + col) = w; } } }
    }
#undef PN_LOAD
#undef PN_ROW
#undef PN_MAP
}
template <int RABL>
__device__ __forceinline__ void phase_retention(const Args& a, LAS unsigned char* lds, const Grp& gp, bool ctx_o_dead) {
    const bf16_t* Qg = (const bf16_t*)(a.ws + WS_BIG); const bf16_t* Kg = (const bf16_t*)(a.ws + WS_BIG + R1); const bf16_t* Vg = (const bf16_t*)(a.ws + WS_BIG + 2 * R1); bf16_t* Og = (bf16_t*)(a.ws + WS_BIG + 4 * R1);
    const int tid = otid(), w = __builtin_amdgcn_readfirstlane(tid >> 6), lane = tid & 63, c = lane & 15, g = lane >> 4;
    const int ib = w & 3, vh = w >> 2, vb2 = w & 3, dbase = (w >> 2) * 8;
    constexpr int QS = 0, KS = 32768, VS = 65536, ST = 73728;
    typedef short s16x4 __attribute__((ext_vector_type(4)));
    for (int item = gp.rank; item < gp.nb * 32; item += gp.gsize) {
        const int b = gp.b_lo + (item >> 5), h = (item >> 3) & 3, vs = item & 7;
        f32x4 accS[8]; u32x4 qreg[4], kreg[4], vreg; float lg = 0.f, g64 = 0.f;
        { const int row0 = b * 256;
#pragma unroll
          for (int i = 0; i < 4; ++i) { const int idx = tid + 512 * i, row = idx >> 5, ch = idx & 31; const size_t o = (size_t)(row0 + row) * 1024 + h * 256 + ch * 8; qreg[i] = *(const u32x4*)(Qg + o); kreg[i] = *(const u32x4*)(Kg + o); }
          vreg = *(const u32x4*)(Vg + (size_t)(row0 + (tid >> 3)) * 2048 + h * 512 + vs * 64 + (tid & 7) * 8); }
        for (int step = 0; step < 136; ++step) {
            const int dir = step >= 68 ? 1 : 0, s = step - 68 * dir;
            if (s == 0) {
#pragma unroll
                for (int x = 0; x < 8; ++x) accS[x] = (f32x4){0.f, 0.f, 0.f, 0.f};
                const int hh = dir ? 3 - h : h; lg = log2f(1.0f - exp2f(-5.0f - (float)hh)); g64 = exp2f(64.f * lg);
            }
            const int row0 = dir ? (s < 4 ? b * 256 + 64 * (3 - s) : MCTX + b * 4096 + 64 * (63 - (s - 4))) : (s < 4 ? b * 256 + 64 * s : MCTX + b * 4096 + 64 * (s - 4));
            __syncthreads();
            if (RABL != 1)
#pragma unroll
            for (int x = 0; x < 8; ++x) { const int d = 16 * (dbase + x) + c;
#pragma unroll
                for (int r = 0; r < 4; ++r) { const int v = 16 * vb2 + 4 * g + r; *(LAS bf16_t*)(lds + ST + v * 512 + (((d >> 3) ^ (v & 15)) << 4) + (d & 7) * 2) = f2bf(accS[x][r]); } }
#pragma unroll
            for (int i = 0; i < 4; ++i) { const int idx = tid + 512 * i, row = idx >> 5, ch = idx & 31; const int off = row * 512 + ((ch ^ (row & 15)) << 4);
                *(LAS u32x4*)(lds + QS + off) = qreg[i]; *(LAS u32x4*)(lds + KS + off) = kreg[i]; }
            { const int j = tid >> 3, ch = tid & 7; *(LAS u32x4*)(lds + VS + j * 128 + ((ch ^ ((j >> 1) & 7)) << 4)) = vreg; }
            __syncthreads();
            if (step + 1 < 136) { const int st2 = step + 1, dir2 = st2 >= 68 ? 1 : 0, s2 = st2 - 68 * dir2;
                const int nrow0 = dir2 ? (s2 < 4 ? b * 256 + 64 * (3 - s2) : MCTX + b * 4096 + 64 * (63 - (s2 - 4))) : (s2 < 4 ? b * 256 + 64 * s2 : MCTX + b * 4096 + 64 * (s2 - 4));
#pragma unroll
                for (int i = 0; i < 4; ++i) { const int idx = tid + 512 * i, row = idx >> 5, ch = idx & 31; const size_t o = (size_t)(nrow0 + row) * 1024 + h * 256 + ch * 8; qreg[i] = *(const u32x4*)(Qg + o); kreg[i] = *(const u32x4*)(Kg + o); }
                vreg = *(const u32x4*)(Vg + (size_t)(nrow0 + (tid >> 3)) * 2048 + h * 512 + vs * 64 + (tid & 7) * 8); }
            if (RABL == 2) continue;
            if (!(ctx_o_dead && s < 4)) {
            const int iq = 16 * ib + c;
            f32x4 accs[4], acco[2];
#pragma unroll
            for (int jb = 0; jb < 4; ++jb) accs[jb] = (f32x4){0.f, 0.f, 0.f, 0.f};
            acco[0] = (f32x4){0.f, 0.f, 0.f, 0.f}; acco[1] = (f32x4){0.f, 0.f, 0.f, 0.f};
#pragma unroll 1
            for (int ks = 0; ks < 8; ++ks) {
                const int sw = ((4 * ks + g) ^ c) << 4;
                const bf16x8 qf = *(const LAS bf16x8*)(lds + QS + iq * 512 + sw);
#pragma unroll
                for (int jb = 0; jb < 4; ++jb) { const bf16x8 kf = *(const LAS bf16x8*)(lds + KS + (16 * jb + c) * 512 + sw); accs[jb] = __builtin_amdgcn_mfma_f32_16x16x32_bf16(kf, qf, accs[jb], 0, 0, 0); }
#pragma unroll
                for (int vb = 0; vb < 2; ++vb) { const bf16x8 sf = *(const LAS bf16x8*)(lds + ST + (16 * (2 * vh + vb) + c) * 512 + sw); acco[vb] = __builtin_amdgcn_mfma_f32_16x16x32_bf16(sf, qf, acco[vb], 0, 0, 0); }
            }
            { const float qd = __builtin_amdgcn_exp2f(lg * (float)(dir ? 64 - iq : iq + 1)); acco[0] *= qd; acco[1] *= qd; }
#pragma unroll
            for (int jb = 0; jb < 4; ++jb)
#pragma unroll
                for (int r = 0; r < 4; ++r) { const int j = 16 * jb + 4 * g + r; const int df = dir ? j - iq : iq - j; const bool vis = dir ? (df > 0) : (df >= 0);
                    accs[jb][r] = vis ? accs[jb][r] * __builtin_amdgcn_exp2f(lg * (float)df) : 0.f; }
#pragma unroll
            for (int s2 = 0; s2 < 2; ++s2) {
                u32x4 pw; pw.x = cvt_pk_bf16(accs[2 * s2][0], accs[2 * s2][1]); pw.y = cvt_pk_bf16(accs[2 * s2][2], accs[2 * s2][3]); pw.z = cvt_pk_bf16(accs[2 * s2 + 1][0], accs[2 * s2 + 1][1]); pw.w = cvt_pk_bf16(accs[2 * s2 + 1][2], accs[2 * s2 + 1][3]);
                const bf16x8 pf = __builtin_bit_cast(bf16x8, pw);
#pragma unroll
                for (int vb = 0; vb < 2; ++vb) { const int vblk = 2 * vh + vb, ra = 32 * s2 + 4 * g + (c >> 2), rbb = ra + 16, cch = 2 * vblk + ((c & 3) >> 1);
                    const s16x4 lo = __builtin_amdgcn_ds_read_tr16_b64_v4i16((LAS s16x4*)(lds + VS + ra * 128 + ((cch ^ ((ra >> 1) & 7)) << 4) + 8 * (c & 1)));
                    const s16x4 hi = __builtin_amdgcn_ds_read_tr16_b64_v4i16((LAS s16x4*)(lds + VS + rbb * 128 + ((cch ^ ((rbb >> 1) & 7)) << 4) + 8 * (c & 1)));
                    const bf16x8 vf = {lo[0], lo[1], lo[2], lo[3], hi[0], hi[1], hi[2], hi[3]};
                    acco[vb] = __builtin_amdgcn_mfma_f32_16x16x32_bf16(vf, pf, acco[vb], 0, 0, 0); }
            }
#pragma unroll
            for (int vb = 0; vb < 2; ++vb) { bf16_t* op = Og + (size_t)(row0 + iq) * 2048 + h * 512 + vs * 64 + 16 * (2 * vh + vb) + 4 * g; f32x4 o = acco[vb];
                if (dir) { const u32x2 pv = *(const u32x2*)op; o[0] += bflo(pv.x); o[1] += bfhi(pv.x); o[2] += bflo(pv.y); o[3] += bfhi(pv.y); }
                u32x2 ow; ow.x = cvt_pk_bf16(o[0], o[1]); ow.y = cvt_pk_bf16(o[2], o[3]); *(u32x2*)op = ow; }
            }
            { bf16x8 af[2];
              const int tq = c >> 2, tp = c & 3;
#pragma unroll
              for (int k2 = 0; k2 < 2; ++k2) { const int r0 = 32 * k2 + 8 * g + tq, r1 = r0 + 4, cch = 2 * vb2 + (tp >> 1);
                  const s16x4 t0 = __builtin_amdgcn_ds_read_tr16_b64_v4i16((LAS s16x4*)(lds + VS + r0 * 128 + ((cch ^ ((r0 >> 1) & 7)) << 4) + 8 * (tp & 1)));
                  const s16x4 t1 = __builtin_amdgcn_ds_read_tr16_b64_v4i16((LAS s16x4*)(lds + VS + r1 * 128 + ((cch ^ ((r1 >> 1) & 7)) << 4) + 8 * (tp & 1)));
                  const int j0 = 32 * k2 + 8 * g; float kd[8];
#pragma unroll
                  for (int e = 0; e < 8; ++e) kd[e] = __builtin_amdgcn_exp2f(lg * (float)(dir ? j0 + e : 63 - j0 - e));
                  u32x4 aw; aw.x = cvt_pk_bf16(bf2f((bf16_t)t0[0]) * kd[0], bf2f((bf16_t)t0[1]) * kd[1]); aw.y = cvt_pk_bf16(bf2f((bf16_t)t0[2]) * kd[2], bf2f((bf16_t)t0[3]) * kd[3]);
                  aw.z = cvt_pk_bf16(bf2f((bf16_t)t1[0]) * kd[4], bf2f((bf16_t)t1[1]) * kd[5]); aw.w = cvt_pk_bf16(bf2f((bf16_t)t1[2]) * kd[6], bf2f((bf16_t)t1[3]) * kd[7]);
                  af[k2] = __builtin_bit_cast(bf16x8, aw); }
#pragma unroll
              for (int x = 0; x < 8; ++x) { accS[x] *= g64; const int db = dbase + x;
#pragma unroll
                  for (int k2 = 0; k2 < 2; ++k2) { const int r0 = 32 * k2 + 8 * g + tq, r1 = r0 + 4;
                      const s16x4 t0 = __builtin_amdgcn_ds_read_tr16_b64_v4i16((LAS s16x4*)(lds + KS + r0 * 512 + (((2 * db + (tp >> 1)) ^ (r0 & 15)) << 4) + 8 * (tp & 1)));
                      const s16x4 t1 = __builtin_amdgcn_ds_read_tr16_b64_v4i16((LAS s16x4*)(lds + KS + r1 * 512 + (((2 * db + (tp >> 1)) ^ (r1 & 15)) << 4) + 8 * (tp & 1)));
                      const bf16x8 bfr = {t0[0], t0[1], t0[2], t0[3], t1[0], t1[1], t1[2], t1[3]};
                      accS[x] = __builtin_amdgcn_mfma_f32_16x16x32_bf16(af[k2], bfr, accS[x], 0, 0, 0); }
                  __builtin_amdgcn_sched_barrier(0); } }
        }
        __syncthreads();
    }
}

__device__ __forceinline__ void phase_ret_finish(const Args& a, int row_begin, const Grp& gp) {
    bf16_t* Og = (bf16_t*)(a.ws + WS_BIG + 4 * R1); const bf16_t* Gg = (const bf16_t*)(a.ws + WS_BIG);
    const int tid = otid(), lane = tid & 63, gw = gp.rank * 8 + (tid >> 6), nw = gp.gsize * 8, nrows = gp.nb * (row_begin ? 4096 : 4352);
    for (int lr = gw; lr < nrows; lr += nw) { const int row = row_begin ? grp_row_lat(gp, lr) : grp_row(gp, lr);
        const size_t base = (size_t)row * 2048 + (lane >> 4) * 512 + (lane & 15) * 32;
        float v[32]; float s = 0.f;
#pragma unroll
        for (int q = 0; q < 4; ++q) { const u32x4 w = *(const u32x4*)(Og + base + q * 8);
            v[q * 8 + 0] = bflo(w.x); v[q * 8 + 1] = bfhi(w.x); v[q * 8 + 2] = bflo(w.y); v[q * 8 + 3] = bfhi(w.y); v[q * 8 + 4] = bflo(w.z); v[q * 8 + 5] = bfhi(w.z); v[q * 8 + 6] = bflo(w.w); v[q * 8 + 7] = bfhi(w.w); }
#pragma unroll
        for (int i = 0; i < 32; ++i) s += v[i];
        s += shx(s, lane, 1); s += shx(s, lane, 2); s += shx(s, lane, 4); s += shx(s, lane, 8);
        const float mean = s * (1.f / 512.f); float qv = 0.f;
#pragma unroll
        for (int i = 0; i < 32; ++i) { const float d = v[i] - mean; qv += d * d; }
        qv += shx(qv, lane, 1); qv += shx(qv, lane, 2); qv += shx(qv, lane, 4); qv += shx(qv, lane, 8);
        const float rstd = 1.0f / sqrtf(qv * (1.f / 512.f) + LN_EPS);
#pragma unroll
        for (int q = 0; q < 4; ++q) { const u32x4 gwd = *(const u32x4*)(Gg + base + q * 8); const unsigned gw4[4] = {gwd.x, gwd.y, gwd.z, gwd.w}; unsigned ow[4];
#pragma unroll
            for (int p = 0; p < 4; ++p) { const float g0 = bflo(gw4[p]), g1 = bfhi(gw4[p]);
                ow[p] = cvt_pk_bf16(silu_f(g0) * (v[q * 8 + 2 * p] - mean) * rstd, silu_f(g1) * (v[q * 8 + 2 * p + 1] - mean) * rstd); }
            u32x4 o; o.x = ow[0]; o.y = ow[1]; o.z = ow[2]; o.w = ow[3]; *(u32x4*)(Og + base + q * 8) = o; }
    }
}

template <int ABL>
__device__ __forceinline__ void phase_na(const Args& a, LAS unsigned char* lds0, bf16_t* Odst, const Grp& gp) {
    const bf16_t* Qg = (const bf16_t*)(a.ws + WS_BIG); const bf16_t* Kg = (const bf16_t*)(a.ws + WS_BIG + R1); const bf16_t* Vg = (const bf16_t*)(a.ws + WS_BIG + 2 * R1);
    const int tid = otid(), w = __builtin_amdgcn_readfirstlane(tid >> 6), lane = tid & 63, c = lane & 15, g = lane >> 4, hb = w >> 2, w4 = w & 3, t2 = tid & 255;
    LAS unsigned char* lds = lds0 + hb * 65536;
    constexpr int QS = 0, KS = 32768, VT = 40960, RP = 49152;
    float mk[4][4]; int rco[4][4];
    { const int q0 = 16 * w4 + c, cs0 = min(max(q0 - 8, 0), 48);
#pragma unroll
      for (int kb = 0; kb < 4; ++kb)
#pragma unroll
          for (int e = 0; e < 4; ++e) { const int kc = 16 * kb + 4 * g + e; mk[kb][e] = (kc >= cs0 && kc < cs0 + 16) ? 0.f : -1e30f; rco[kb][e] = min(max(kc - q0 + 15, 0), 30) * 4; } }
    const int kb_lo = min(max(16 * w4 - 8, 0), 48) >> 4, kb_hi = (min(max(16 * w4 + 7, 0), 48) + 15) >> 4;
    for (int base_it = gp.rank * 2; base_it < gp.nb * 272; base_it += gp.gsize * 2) {
        const int it = base_it + hb, bb = it / 272, idx = it - bb * 272; const bool isl = (base_it % 272) < 256;
        const int b = gp.b_lo + bb; int h, r0 = 0, kr_lo = 0, kr_hi = 0;
        if (isl) { h = idx >> 4; r0 = (idx & 15) * 4; kr_lo = min(max(r0 - 4, 0), 56); kr_hi = min(max(r0 - 1, 0), 56) + 7; }
        else { h = idx - 256; }
        const int ntile = isl ? 15 : 4;
        __syncthreads();
#pragma unroll
        for (int i = 0; i < 8; ++i) { const int idx = t2 + 256 * i, row = idx >> 3, ch = idx & 7, rr = row >> 6, qi = row & 63;
            const int grow = isl ? MCTX + b * 4096 + (r0 + rr) * 64 + qi : b * 256 + rr * 64 + qi;
            *(LAS u32x4*)(lds + QS + row * 128 + ((ch ^ ((row >> 1) & 7)) << 4)) = *(const u32x4*)(Qg + (size_t)grow * 1024 + h * 64 + ch * 8); }
        for (int i = t2; i < 465; i += 256) *(LAS float*)(lds + RP + i * 4) = a.na_rpb[h * 465 + i];
        u32x4 kreg[2], vreg[2];
        { const int row0 = isl ? MCTX + b * 4096 + kr_lo * 64 : b * 256;
#pragma unroll
          for (int i = 0; i < 2; ++i) { const int idx = t2 + 256 * i, row = idx >> 3, ch = idx & 7; const size_t o = ((size_t)h * MTOT + row0 + row) * 64 + ch * 8; kreg[i] = *(const u32x4*)(Kg + o); vreg[i] = *(const u32x4*)(Vg + o); } }
        const int q = 16 * w4 + c;
        f32x4 oacc[4][4]; float mrun[4], lrun[4];
#pragma unroll
        for (int rr = 0; rr < 4; ++rr) { mrun[rr] = -1e30f; lrun[rr] = 0.f;
#pragma unroll
            for (int db = 0; db < 4; ++db) oacc[rr][db] = (f32x4){0.f, 0.f, 0.f, 0.f}; }
        for (int tl = 0; tl < ntile; ++tl) {
            if (ABL == 3) break;
            if (ABL == 4) { __syncthreads(); __syncthreads(); continue; }
            __syncthreads();
#pragma unroll
            for (int i = 0; i < 2; ++i) { const int idx = t2 + 256 * i, row = idx >> 3, ch = idx & 7;
                *(LAS u32x4*)(lds + KS + row * 128 + ((ch ^ ((row >> 1) & 7)) << 4)) = kreg[i];
                const unsigned vw[4] = {vreg[i].x, vreg[i].y, vreg[i].z, vreg[i].w};
#pragma unroll
                for (int e = 0; e < 8; ++e) { const int d = ch * 8 + e; const bf16_t val = (bf16_t)((e & 1) ? (vw[e >> 1] >> 16) : (vw[e >> 1] & 0xffffu));
                    *(LAS bf16_t*)(lds + VT + d * 128 + (((row >> 3) ^ ((d >> 1) & 7)) << 4) + (row & 7) * 2) = val; } }
            __syncthreads();
            if (tl + 1 < ntile) { const int t1 = tl + 1;
                const int row0 = isl ? (t1 < 11 ? MCTX + b * 4096 + min(kr_lo + t1, kr_hi) * 64 : b * 256 + (t1 - 11) * 64) : b * 256 + t1 * 64;
#pragma unroll
                for (int i = 0; i < 2; ++i) { const int idx = t2 + 256 * i, row = idx >> 3, ch = idx & 7; const size_t o = ((size_t)h * MTOT + row0 + row) * 64 + ch * 8; kreg[i] = *(const u32x4*)(Kg + o); vreg[i] = *(const u32x4*)(Vg + o); } }
            if (ABL == 2) continue;
            const bool local = isl && tl < 11; const int krow = kr_lo + tl;
            if (local && krow > kr_hi) continue;
#pragma unroll
            for (int rr = 0; rr < 4; ++rr) {
                const int r = r0 + rr, rs = min(max(r - 4, 0), 56);
                if (local && (krow < rs || krow >= rs + 8)) continue;
                bf16x8 qf[2];
#pragma unroll
                for (int ks = 0; ks < 2; ++ks) { const int qrow = rr * 64 + q; qf[ks] = *(const LAS bf16x8*)(lds + QS + qrow * 128 + (((4 * ks + g) ^ ((qrow >> 1) & 7)) << 4)); }
                f32x4 sT[4];
#pragma unroll
                for (int kb = 0; kb < 4; ++kb) { const bool skip = local && (kb < kb_lo || kb > kb_hi);
                    if (skip) { sT[kb] = (f32x4){-1e30f, -1e30f, -1e30f, -1e30f}; continue; }
                    sT[kb] = (f32x4){0.f, 0.f, 0.f, 0.f}; const int kr = 16 * kb + c;
#pragma unroll
                    for (int ks = 0; ks < 2; ++ks) { const bf16x8 kf = *(const LAS bf16x8*)(lds + KS + kr * 128 + (((4 * ks + g) ^ ((kr >> 1) & 7)) << 4)); sT[kb] = __builtin_amdgcn_mfma_f32_16x16x32_bf16(kf, qf[ks], sT[kb], 0, 0, 0); }
                    if (local) { const int rbase = RP + (krow - r + 7) * 124;
#pragma unroll
                        for (int e = 0; e < 4; ++e) sT[kb][e] = (sT[kb][e] + *(const LAS float*)(lds + rbase + rco[kb][e])) + mk[kb][e]; } }
                if (ABL == 1) { oacc[rr][0] += sT[0] + sT[1] + sT[2] + sT[3]; continue; }
                float mx = -1e30f;
#pragma unroll
                for (int kb = 0; kb < 4; ++kb) mx = fmaxf(mx, fmaxf(fmaxf(sT[kb][0], sT[kb][1]), fmaxf(sT[kb][2], sT[kb][3])));
                mx = fmaxf(mx, shx(mx, lane, 16)); mx = fmaxf(mx, shx(mx, lane, 32));
                const float mnew = fmaxf(mrun[rr], mx), alpha = __builtin_amdgcn_exp2f((mrun[rr] - mnew) * LOG2E); mrun[rr] = mnew;
                float ps = 0.f;
#pragma unroll
                for (int kb = 0; kb < 4; ++kb)
#pragma unroll
                    for (int e = 0; e < 4; ++e) { const float p = __builtin_amdgcn_exp2f((sT[kb][e] - mnew) * LOG2E); sT[kb][e] = p; ps += p; }
                ps += shx(ps, lane, 16); ps += shx(ps, lane, 32);
                lrun[rr] = lrun[rr] * alpha + ps;
#pragma unroll
                for (int db = 0; db < 4; ++db) oacc[rr][db] *= alpha;
#pragma unroll
                for (int s2 = 0; s2 < 2; ++s2) {
                    if (local && (2 * s2 + 1 < kb_lo || 2 * s2 > kb_hi)) continue;
                    u32x4 pw; pw.x = cvt_pk_bf16(sT[2 * s2][0], sT[2 * s2][1]); pw.y = cvt_pk_bf16(sT[2 * s2][2], sT[2 * s2][3]); pw.z = cvt_pk_bf16(sT[2 * s2 + 1][0], sT[2 * s2 + 1][1]); pw.w = cvt_pk_bf16(sT[2 * s2 + 1][2], sT[2 * s2 + 1][3]);
                    const bf16x8 pf = __builtin_bit_cast(bf16x8, pw);
#pragma unroll
                    for (int db = 0; db < 4; ++db) { const int vrow = 16 * db + c; const int sw = (vrow >> 1) & 7;
                        const u32x2 lo = *(const LAS u32x2*)(lds + VT + vrow * 128 + (((4 * s2 + (g >> 1)) ^ sw) << 4) + (g & 1) * 8);
                        const u32x2 hi = *(const LAS u32x2*)(lds + VT + vrow * 128 + (((4 * s2 + 2 + (g >> 1)) ^ sw) << 4) + (g & 1) * 8);
                        u32x4 vw; vw.x = lo.x; vw.y = lo.y; vw.z = hi.x; vw.w = hi.y;
                        oacc[rr][db] = __builtin_amdgcn_mfma_f32_16x16x32_bf16(__builtin_bit_cast(bf16x8, vw), pf, oacc[rr][db], 0, 0, 0); }
                }
            }
        }
        __syncthreads();
#pragma unroll
        for (int rr = 0; rr < 4; ++rr) { const float inv = 1.0f / lrun[rr]; const int orow = rr * 64 + q;
#pragma unroll
            for (int db = 0; db < 4; ++db) { const f32x4 o = oacc[rr][db] * inv; u32x2 ow; ow.x = cvt_pk_bf16(o[0], o[1]); ow.y = cvt_pk_bf16(o[2], o[3]);
                *(LAS u32x2*)(lds + QS + orow * 128 + (((2 * db + (g >> 1)) ^ ((orow >> 1) & 7)) << 4) + (g & 1) * 8) = ow; } }
        __syncthreads();
#pragma unroll
        for (int i = 0; i < 8; ++i) { const int idx = t2 + 256 * i, row = idx >> 3, ch = idx & 7, rr = row >> 6, qi = row & 63;
            const int grow = isl ? MCTX + b * 4096 + (r0 + rr) * 64 + qi : b * 256 + rr * 64 + qi;
            *(u32x4*)(Odst + (size_t)grow * 1024 + h * 64 + ch * 8) = *(const LAS u32x4*)(lds + QS + row * 128 + ((ch ^ ((row >> 1) & 7)) << 4)); }
    }
    __syncthreads();
}

__device__ __forceinline__ void phase_lru_conv(const Args& a, const Grp& gp) {
    const bf16_t* XR = (const bf16_t*)(a.ws + WS_BIG + R1); bf16_t* XC = (bf16_t*)(a.ws + WS_BIG + 2 * R1);
    const int i0 = gp.rank * 512 + otid(), c8 = (i0 & 127) * 8;
    const f32x4 b0 = *(const f32x4*)(a.lru_conv_b + c8), b1 = *(const f32x4*)(a.lru_conv_b + c8 + 4);
    f32x4 w0[4], w1[4];
#pragma unroll
    for (int j = 0; j < 4; ++j) { w0[j] = *(const f32x4*)(a.lru_conv_w + j * 1024 + c8); w1[j] = *(const f32x4*)(a.lru_conv_w + j * 1024 + c8 + 4); }
    for (int i = i0; i < gp.nb * 4352 * 128; i += gp.gsize * 512) {
        const int row = grp_row(gp, i >> 7); const bool isc = row < MCTX; const int t = isc ? (row & 255) : ((row - MCTX) & 4095), len = isc ? 256 : 4096;
        float acc[8] = {b0[0], b0[1], b0[2], b0[3], b1[0], b1[1], b1[2], b1[3]};
#pragma unroll
        for (int j = 0; j < 4; ++j) { const int tt = t - 2 + j;
            if (tt >= 0 && tt < len) { const u32x4 xw = *(const u32x4*)(XR + (size_t)(row - 2 + j) * 1024 + c8);
                acc[0] += w0[j][0] * bflo(xw.x); acc[1] += w0[j][1] * bfhi(xw.x); acc[2] += w0[j][2] * bflo(xw.y); acc[3] += w0[j][3] * bfhi(xw.y);
                acc[4] += w1[j][0] * bflo(xw.z); acc[5] += w1[j][1] * bfhi(xw.z); acc[6] += w1[j][2] * bflo(xw.w); acc[7] += w1[j][3] * bfhi(xw.w); } }
        u32x4 o; o.x = cvt_pk_bf16(acc[0], acc[1]); o.y = cvt_pk_bf16(acc[2], acc[3]); o.z = cvt_pk_bf16(acc[4], acc[5]); o.w = cvt_pk_bf16(acc[6], acc[7]);
        *(u32x4*)(XC + (size_t)row * 1024 + c8) = o;
    }
}
__device__ __forceinline__ void phase_lru_scan(const Args& a, int dir, int pass, const Grp& gp) {
    const bf16_t* GATE = (const bf16_t*)(a.ws + WS_BIG); bf16_t* HF = (bf16_t*)(a.ws + WS_BIG + R1); const bf16_t* XC = (const bf16_t*)(a.ws + WS_BIG + 2 * R1); const bf16_t* GP = (const bf16_t*)(a.ws + WS_BIG + 3 * R1);
    float* CARRY = (float*)(a.ws + WS_CARRY);
    for (int idx = gp.rank * 512 + otid(); idx < gp.nb * 64 * 256; idx += gp.gsize * 512) {
        const int cq = idx & 255, chunk = (idx >> 8) & 63, b = gp.b_lo + (idx >> 14), c0 = cq * 4;
        float ba[4], bx[4], sp[4], h[4], P[4];
        { const f32x4 t0 = *(const f32x4*)(a.lru_b_a + dir * 1024 + c0), t1 = *(const f32x4*)(a.lru_b_x + dir * 1024 + c0), t2 = *(const f32x4*)(a.lru_lam + dir * 1024 + c0);
#pragma unroll
          for (int k = 0; k < 4; ++k) { ba[k] = t0[k]; bx[k] = t1[k]; sp[k] = -8.f * log1pf(expf(-t2[k])); h[k] = 0.f; P[k] = 1.f; } }
        if (pass == 2) { for (int cc = 0; cc < chunk; ++cc) { const float* cp = CARRY + ((size_t)(b * 64 + cc) * 256 + cq) * 8; const f32x4 pp = *(const f32x4*)cp, ll = *(const f32x4*)(cp + 4);
#pragma unroll
            for (int k = 0; k < 4; ++k) h[k] = pp[k] * h[k] + ll[k]; } }
        for (int t4 = 0; t4 < 17; ++t4) {
            u32x2 rw[4], iw[4], xw[4], hw[4], gw[4]; int rows[4];
#pragma unroll
            for (int j = 0; j < 4; ++j) { const int p = chunk * 68 + t4 * 4 + j;
                const int row = dir ? (p < 256 ? b * 256 + (255 - p) : MCTX + b * 4096 + (4095 - (p - 256))) : (p < 256 ? b * 256 + p : MCTX + b * 4096 + (p - 256));
                rows[j] = row;
                rw[j] = *(const u32x2*)(GP + (size_t)row * 2048 + c0); iw[j] = *(const u32x2*)(GP + (size_t)row * 2048 + 1024 + c0); xw[j] = *(const u32x2*)(XC + (size_t)row * 1024 + c0);
                if (pass == 2 && dir == 1) { hw[j] = *(const u32x2*)(HF + (size_t)row * 1024 + c0); gw[j] = *(const u32x2*)(GATE + (size_t)row * 1024 + c0); } }
#pragma unroll
            for (int j = 0; j < 4; ++j) {
                const float rp[4] = {bflo(rw[j].x), bfhi(rw[j].x), bflo(rw[j].y), bfhi(rw[j].y)}, ip[4] = {bflo(iw[j].x), bfhi(iw[j].x), bflo(iw[j].y), bfhi(iw[j].y)}, xv[4] = {bflo(xw[j].x), bfhi(xw[j].x), bflo(xw[j].y), bfhi(xw[j].y)};
#pragma unroll
                for (int k = 0; k < 4; ++k) { const float la = sp[k] * sigmoid_f(rp[k] + ba[k]); const float av = __expf(la); const float m = sqrtf(fmaxf(-expm1f(2.f * la), 0.f));
                    h[k] = av * h[k] + m * sigmoid_f(ip[k] + bx[k]) * xv[k]; if (pass == 1) P[k] *= av; }
                if (pass == 2) { bf16_t* hp = HF + (size_t)rows[j] * 1024 + c0; u32x2 o;
                    if (dir == 0) { o.x = cvt_pk_bf16(h[0], h[1]); o.y = cvt_pk_bf16(h[2], h[3]); }
                    else { o.x = cvt_pk_bf16(gelu_tanh_f(bflo(gw[j].x)) * (bflo(hw[j].x) + h[0]), gelu_tanh_f(bfhi(gw[j].x)) * (bfhi(hw[j].x) + h[1]));
                           o.y = cvt_pk_bf16(gelu_tanh_f(bflo(gw[j].y)) * (bflo(hw[j].y) + h[2]), gelu_tanh_f(bfhi(gw[j].y)) * (bfhi(hw[j].y) + h[3])); }
                    *(u32x2*)hp = o; }
            }
        }
        if (pass == 1) { float* cp = CARRY + ((size_t)(b * 64 + chunk) * 256 + cq) * 8; *(f32x4*)cp = (f32x4){P[0], P[1], P[2], P[3]}; *(f32x4*)(cp + 4) = (f32x4){h[0], h[1], h[2], h[3]}; }
    }
}
constexpr int NPHASE = 52;
enum { OP_PROLOGUE, OP_U0, OP_GEMM_SWIGLU, OP_GEMM_PLAIN, OP_GEMM_RETIN, OP_GEMM_GATES, OP_POSTNORM, OP_RETSCAN, OP_RETFIN, OP_NAATT, OP_LRUCONV, OP_LRUSCAN };

typedef const Args __attribute__((address_space(4)))* KArgsPtr;
__global__ void __launch_bounds__(512) hybrid_fwd(Args a_in) {
    extern __shared__ __attribute__((aligned(16))) unsigned char lds_raw[];
    LAS unsigned char* lds = (LAS unsigned char*)lds_raw;
    const int ph_lo = a_in.ph_lo, ph_hi = a_in.ph_hi;
    volatile LAS unsigned* xb_st = (volatile LAS unsigned*)(lds + LDS_BYTES - 16);
    unsigned* xb_bar = (unsigned*)(a_in.ws + WS_BAR);
    if (threadIdx.x < 4) xb_st[threadIdx.x] = 0u;
    __syncthreads();
    if (threadIdx.x == 0) { const unsigned x = xb_xcc_id(); const unsigned r = xb_add(&xb_bar[XB_XCNT(x)], 1u); xb_st[2] = r | (x << 8); }
    int nexec = 0;
#ifdef PROBE_DBL
    for (int pp = 2 * ph_lo; pp < 2 * ph_hi; ++pp) { const int p = pp >> 1;
#else
    for (int p = ph_lo; p < ph_hi; ++p) {
#endif
#if defined(__HIP_DEVICE_COMPILE__)
        KArgsPtr ka = (KArgsPtr)__builtin_amdgcn_kernarg_segment_ptr(); asm volatile("" : "+s"(ka));
        Args a; __builtin_memcpy(&a, ka, sizeof(Args));
#else
        const Args a = a_in;
#endif
        bf16_t* WT = (bf16_t*)(a.ws + WS_WT); bf16_t* U = (bf16_t*)(a.ws + WS_U); unsigned char* BIG = a.ws + WS_BIG; const float* MOD = (const float*)(a.ws + WS_MOD);
        int op = OP_PROLOGUE, l = 0, s = 0, kind = 0, mi = 0, rb = 0, gsel = 0, sdir = 0, spass = 0; bool mixpn = false;
        if (p == 0) op = OP_PROLOGUE;
        else if (p == 1) op = OP_U0;
        else {
            const int q = p - 2; int li;
            if (q < 12) { l = 0; li = q; } else if (q < 22) { l = 1; li = q - 12; } else if (q < 38) { l = 2; li = q - 22; } else { l = 3; li = q - 38; }
            kind = l % 3; mi = l / 3; const int nmix = kind == 0 ? 6 : (kind == 1 ? 4 : 10);
            rb = (l == 3 && li >= 5) ? MCTX : 0;
            if (li < 3 || li >= 3 + nmix) {
                s = li < 3 ? 0 : 1; const int fs = li < 3 ? li : li - 3 - nmix;
                if (fs == 0) op = OP_GEMM_SWIGLU; else if (fs == 1) { op = OP_GEMM_PLAIN; gsel = 0; } else op = OP_POSTNORM;
            } else {
                const int ms = li - 3;
                if (ms == nmix - 1) { op = OP_POSTNORM; mixpn = true; }
                else if (kind == 0) { if (ms == 0) op = OP_GEMM_RETIN; else if (ms == 1) op = OP_RETSCAN; else if (ms == 2) { op = OP_GEMM_PLAIN; gsel = 1; } else if (ms == 3) op = OP_RETFIN; else { op = OP_GEMM_PLAIN; gsel = 2; } }
                else if (kind == 1) { if (ms == 0) { op = OP_GEMM_PLAIN; gsel = 3; } else if (ms == 1) op = OP_NAATT; else { op = OP_GEMM_PLAIN; gsel = 4; } }
                else { if (ms == 0) { op = OP_GEMM_PLAIN; gsel = 5; } else if (ms == 1) op = OP_LRUCONV; else if (ms == 2 || ms == 5) { op = OP_GEMM_GATES; sdir = ms == 5 ? 1 : 0; }
                       else if (ms == 3 || ms == 4) { op = OP_LRUSCAN; sdir = 0; spass = ms - 2; } else if (ms == 6 || ms == 7) { op = OP_LRUSCAN; sdir = 1; spass = ms - 5; } else { op = OP_GEMM_PLAIN; gsel = 6; } }
            }
        }
#ifdef PROBE_DBL
#if PROBE_DBL == 10
        if ((pp & 1) && p != 0) continue;
#else
        if (pp & 1) { const bool pdbl = (PROBE_DBL == 1) ? (op == OP_GEMM_SWIGLU || op == OP_GEMM_PLAIN || op == OP_GEMM_RETIN || op == OP_GEMM_GATES)
                        : (PROBE_DBL == 3) ? (op == OP_RETSCAN) : (PROBE_DBL == 10) ? (op == OP_PROLOGUE) : (PROBE_DBL == 8) ? (op == OP_GEMM_SWIGLU) : (PROBE_DBL == 5) ? (op == OP_NAATT) : (PROBE_DBL == 6) ? (op == OP_LRUCONV || (op == OP_LRUSCAN && !(sdir == 1 && spass == 2))) : (PROBE_DBL == 2) ? (op == OP_POSTNORM && l == 0 && s == 0 && !mixpn) : false;
            if (!pdbl) continue; }
#endif
#endif
        { const unsigned xm = (unsigned)__builtin_amdgcn_readfirstlane((int)xb_st[3]);
          const bool relayout = (op == OP_GEMM_SWIGLU && s == 1) || op == OP_GEMM_RETIN || (op == OP_GEMM_PLAIN && (gsel == 1 || gsel == 3 || gsel == 5));
          if (nexec == 1) cg::this_grid().sync();
          else if (nexec > 1) { if (xm && !relayout) xcd_local_barrier((unsigned*)(a.ws + WS_BAR), ((unsigned)__builtin_amdgcn_readfirstlane((int)xb_st[2]) >> 8) & 0xffu, 32u);
                                else xcd_barrier((unsigned*)(a.ws + WS_BAR), xb_st); } }
        if (nexec == 1 && ph_lo == 0) {
            if (threadIdx.x == 0) { bool ok = gridDim.x == 256;
                for (unsigned j = 0; j < 16; ++j) { const unsigned cnt = xb_ld(&xb_bar[XB_XCNT(j)]); ok = ok && (j < 8 ? cnt == 32u : cnt == 0u); }
#ifdef PROBE_NO_XMODE
                ok = false;
#endif
                xb_st[3] = ok ? 1u : 0u; }
            __syncthreads(); }
        ++nexec;
        const unsigned gword = (unsigned)__builtin_amdgcn_readfirstlane((int)xb_st[2]), xmode = (unsigned)__builtin_amdgcn_readfirstlane((int)xb_st[3]);
        Grp grp; if (xmode) { grp.b_lo = (int)((gword >> 8) & 0xffu); grp.nb = 1; grp.rank = (int)(gword & 0xffu); grp.gsize = 32; } else { grp.b_lo = 0; grp.nb = 8; grp.rank = (int)blockIdx.x; grp.gsize = (int)gridDim.x; }
        switch (op) {
#ifndef NO_OP_PROLOGUE
            case OP_PROLOGUE: phase_prologue(a, lds); break;
#endif
#ifndef NO_OP_U0
            case OP_U0: phase_u0(a, grp); break;
#endif
#ifndef NO_OP_GEMM_SWIGLU
            case OP_GEMM_SWIGLU: { const pg8::Gemm gg{U, WT + E_FFN_IN + (size_t)(l * 2 + s) * 5632 * 1024, MTOT, 5632, 1024, 1024, 0, 0};
                pg8::GroupOrder S; S.init(grp.nb, grp.b_lo, rb != 0, gg.N, grp.gsize, grp.rank); EpiSwiGLU E{(bf16_t*)BIG, 0}; pg8::gemm_phase<EpiSwiGLU, pg8::GroupOrder>(lds, gg, S, E); } break;
#endif
#ifndef NO_OP_GEMM_PLAIN
            case OP_GEMM_PLAIN: { const bf16_t* gA; const bf16_t* gB; int gN, gK, glda; bf16_t* eO; int eldc = 1024, esplit = 0, ehm = 0; size_t estride = 0; float escale = 1.f;
                if (gsel == 0)      { gA = (const bf16_t*)BIG; gB = WT + E_FFN_OUT + (size_t)(l * 2 + s) * 1024 * 2816; gN = 1024; gK = 2816; glda = 2816; eO = (bf16_t*)(BIG + 3 * R1); }
                else if (gsel == 1) { gA = U; gB = WT + E_RET_IN + (size_t)mi * 6144 * 1024 + (size_t)4096 * 1024; gN = 2048; gK = 1024; glda = 1024; eO = (bf16_t*)BIG; eldc = 2048; }
                else if (gsel == 2) { gA = (const bf16_t*)(BIG + 4 * R1); gB = WT + E_RET_OUT + (size_t)mi * 1024 * 2048; gN = 1024; gK = 2048; glda = 2048; eO = (bf16_t*)(BIG + 2 * R1); }
                else if (gsel == 3) { gA = U; gB = WT + E_NA_QKV; gN = 3072; gK = 1024; glda = 1024; eO = (bf16_t*)BIG; esplit = 1024; estride = R1 / 2; escale = 0.125f; ehm = 1; }
                else if (gsel == 4) { gA = (const bf16_t*)BIG; gB = WT + E_NA_OUT; gN = 1024; gK = 1024; glda = 1024; eO = (bf16_t*)(BIG + 3 * R1); }
                else if (gsel == 5) { gA = U; gB = WT + E_LRU_IN; gN = 2048; gK = 1024; glda = 1024; eO = (bf16_t*)BIG; esplit = 1024; estride = R1 / 2; }
                else                { gA = (const bf16_t*)(BIG + R1); gB = WT + E_LRU_OUT; gN = 1024; gK = 1024; glda = 1024; eO = (bf16_t*)(BIG + 2 * R1); }
                const pg8::Gemm gg{gA, gB, MTOT, gN, gK, glda, 0, 0}; pg8::GroupOrder S; S.init(grp.nb, grp.b_lo, rb != 0, gg.N, grp.gsize, grp.rank);
                EpiPlain E{eO, eldc, 0, esplit, estride, escale, ehm}; pg8::gemm_phase<EpiPlain, pg8::GroupOrder>(lds, gg, S, E); } break;
#endif
#ifndef NO_OP_GEMM_RETIN
            case OP_GEMM_RETIN: { const pg8::Gemm gg{U, WT + E_RET_IN + (size_t)mi * 6144 * 1024, MTOT, 4096, 1024, 1024, 0, 0}; pg8::GroupOrder S; S.init(grp.nb, grp.b_lo, false, gg.N, grp.gsize, grp.rank);
                EpiRetIn E{(bf16_t*)BIG, (bf16_t*)(BIG + R1), (bf16_t*)(BIG + 2 * R1), (const float*)(a.ws + WS_ROPE), (const float*)(a.ws + WS_ROPE) + 4096}; pg8::gemm_phase<EpiRetIn, pg8::GroupOrder>(lds, gg, S, E); } break;
#endif
#ifndef NO_OP_GEMM_GATES
            case OP_GEMM_GATES: { const pg8::Gemm gg{(const bf16_t*)(BIG + 2 * R1), WT + E_GATES + (size_t)sdir * 2048 * 256, MTOT, 2048, 256, 1024, 1, 256}; pg8::GroupOrder S; S.init(grp.nb, grp.b_lo, false, gg.N, grp.gsize, grp.rank);
                EpiGates E{(bf16_t*)(BIG + 3 * R1)}; pg8::gemm_phase<EpiGates, pg8::GroupOrder>(lds, gg, S, E); } break;
#endif
#ifndef NO_OP_POSTNORM
            case OP_POSTNORM: { const float* modl = MOD + (size_t)l * 9 * 9216;
                if (mixpn) phase_postnorm(a, false, (const bf16_t*)(BIG + (kind == 1 ? 3 : 2) * R1), modl, 5, 1.f, a.ln_g + (size_t)(l * 3 + 1) * 1024, a.ln_b + (size_t)(l * 3 + 1) * 1024, modl, 6, rb, grp);
                else { const int li3 = l * 3 + (s == 0 ? 0 : 2); const float* modn = (s == 0) ? modl : MOD + (size_t)(l < 3 ? l + 1 : l) * 9 * 9216; const int psh = (s == 0) ? 3 : (l < 3 ? 0 : -1);
                    phase_postnorm(a, l == 0 && s == 0, (const bf16_t*)(BIG + 3 * R1), modl, s == 0 ? 2 : 8, 0.5f, a.ln_g + (size_t)li3 * 1024, a.ln_b + (size_t)li3 * 1024, modn, psh, rb, grp); } } break;
#endif
#ifndef NO_OP_RETSCAN
#if defined(PROBE_DBL) && PROBE_DBL == 3
#ifndef PROBE_RET_ABL
#define PROBE_RET_ABL 0
#endif
            case OP_RETSCAN: if (pp & 1) phase_retention<0>(a, lds, grp, l == 3); else phase_retention<PROBE_RET_ABL>(a, lds, grp, l == 3); break;
#else
            case OP_RETSCAN: phase_retention<0>(a, lds, grp, l == 3); break;
#endif
#endif
#ifndef NO_OP_RETFIN
            case OP_RETFIN: phase_ret_finish(a, rb, grp); break;
#endif
#ifndef NO_OP_NAATT
#if defined(PROBE_DBL) && PROBE_DBL == 5
#ifndef PROBE_NA_ABL
#define PROBE_NA_ABL 0
#endif
            case OP_NAATT: if (pp & 1) phase_na<0>(a, lds, (bf16_t*)BIG, grp); else phase_na<PROBE_NA_ABL>(a, lds, (bf16_t*)(BIG + 3 * R1), grp); break;
#else
            case OP_NAATT: phase_na<0>(a, lds, (bf16_t*)BIG, grp); break;
#endif
#endif
#ifndef NO_OP_LRUCONV
            case OP_LRUCONV: phase_lru_conv(a, grp); break;
#endif
#ifndef NO_OP_LRUSCAN
            case OP_LRUSCAN: phase_lru_scan(a, sdir, spass, grp); break;
#endif
            default: break;
        }
    }
}

#ifndef MK_PER_PHASE
#define MK_PER_PHASE 0
#endif
extern "C" void kernel_launch(void* const* d_in, const int* in_sizes, int n_in, void* d_out, int out_size, void* d_ws, size_t ws_size, hipStream_t stream) {
    static int grid = 0;
    if (grid == 0) {
        if (n_in != 24 || out_size != MLAT * 1024 || ws_size < WS_END) { fprintf(stderr, "kernel_launch: unexpected shapes: n_in %d out %d ws %zu (need %zu)\n", n_in, out_size, ws_size, (size_t)WS_END); grid = -1; return; }
        int dev = 0, cus = 0, per_cu = 0;
        if (hipGetDevice(&dev) != hipSuccess || hipDeviceGetAttribute(&cus, hipDeviceAttributeMultiprocessorCount, dev) != hipSuccess) { grid = -1; return; }
        if (hipFuncSetAttribute((const void*)hybrid_fwd, hipFuncAttributeMaxDynamicSharedMemorySize, LDS_BYTES) != hipSuccess) { fprintf(stderr, "kernel_launch: hipFuncSetAttribute failed\n"); grid = -1; return; }
        if (hipOccupancyMaxActiveBlocksPerMultiprocessor(&per_cu, (const void*)hybrid_fwd, 512, LDS_BYTES) != hipSuccess || per_cu < 1) { fprintf(stderr, "kernel_launch: occupancy query says %d\n", per_cu); per_cu = 1; }
        (void)hipGetLastError();
        grid = cus * 1;
    }
    if (grid < 0) return;
    if (hipMemsetAsync((char*)d_ws + WS_BAR, 0, 16384, stream) != hipSuccess) { fprintf(stderr, "kernel_launch: barrier memset failed\n"); return; }
    Args a{};
    const float** pp = (const float**)&a;
    for (int i = 0; i < 24; ++i) pp[i] = (const float*)d_in[i];
    a.out = (float*)d_out; a.ws = (unsigned char*)d_ws;
#if MK_PER_PHASE
    for (int p = 0; p < NPHASE; ++p) { a.ph_lo = p; a.ph_hi = p + 1; hipLaunchKernelGGL(hybrid_fwd, dim3(grid), dim3(512), LDS_BYTES, stream, a); }
#else
    a.ph_lo = 0; a.ph_hi = NPHASE;
    void* args[] = {&a};
    hipError_t e = hipLaunchCooperativeKernel((const void*)hybrid_fwd, dim3(grid), dim3(512), args, LDS_BYTES, stream);
    if (e != hipSuccess) fprintf(stderr, "cooperative launch failed: %s (grid %d)\n", hipGetErrorString(e), grid);
#endif
}
```

```cpp
#include <hip/hip_runtime.h>
#include <hip/hip_cooperative_groups.h>
#include <cstdio>
namespace cg = cooperative_groups;

#define LAS __attribute__((address_space(3)))
typedef unsigned short bf16_t;
typedef short bf16x8 __attribute__((ext_vector_type(8)));
typedef float f32x4 __attribute__((ext_vector_type(4)));
typedef unsigned u32x4 __attribute__((ext_vector_type(4)));
typedef unsigned u32x2 __attribute__((ext_vector_type(2)));

constexpr int DM = 1024, NB = 8, SEQ = 4096, CTXL = 256, DFF = 2816;
constexpr int MCTX = NB * CTXL, MLAT = NB * SEQ, MTOT = MCTX + MLAT;
constexpr int NMOD = 9;
constexpr float DN_ALPHA = 1.681792830507429f;
constexpr float LN_EPS = 1e-5f;
constexpr float LOG2E = 1.4426950408889634f;
constexpr int LDS_BYTES = 147456;

constexpr size_t E_FFN_IN = 0;
constexpr size_t E_FFN_OUT = E_FFN_IN + (size_t)8 * 5632 * 1024;
constexpr size_t E_RET_IN = E_FFN_OUT + (size_t)8 * 1024 * 2816;
constexpr size_t E_RET_OUT = E_RET_IN + (size_t)2 * 6144 * 1024;
constexpr size_t E_NA_QKV = E_RET_OUT + (size_t)2 * 1024 * 2048;
constexpr size_t E_NA_OUT = E_NA_QKV + (size_t)3072 * 1024;
constexpr size_t E_LRU_IN = E_NA_OUT + (size_t)1024 * 1024;
constexpr size_t E_LRU_OUT = E_LRU_IN + (size_t)2048 * 1024;
constexpr size_t E_GATES = E_LRU_OUT + (size_t)1024 * 1024;
constexpr size_t E_WT_END = E_GATES + (size_t)2 * 2048 * 256;
constexpr size_t R1 = (size_t)MTOT * 1024 * 2;
constexpr size_t WS_WT = 0;
constexpr size_t WS_U = WS_WT + E_WT_END * 2;
constexpr size_t WS_HC = WS_U + R1;
constexpr size_t WS_MOD = WS_HC + (size_t)MCTX * 1024 * 4;
constexpr size_t WS_ROPE = WS_MOD + (size_t)4 * 9 * 9216 * 4;
constexpr size_t WS_CARRY = WS_ROPE + (size_t)2 * 4096 * 4;
constexpr size_t WS_BAR = WS_CARRY + (size_t)NB * 68 * 1024 * 2 * 4;
constexpr size_t WS_BIG = WS_BAR + 16384;
constexpr size_t WS_END = WS_BIG + 6 * R1;

struct Args {
    const float* x; const float* c; const float* ctx; const float* c_ctx; const float* ada_w; const float* ada_b; const float* ln_g; const float* ln_b;
    const float* ffn_w_in; const float* ffn_w_out; const float* ret_w_in; const float* ret_w_out; const float* na_w_qkv; const float* na_rpb; const float* na_w_out;
    const float* lru_w_in; const float* lru_conv_w; const float* lru_conv_b; const float* lru_w_a; const float* lru_b_a; const float* lru_w_x; const float* lru_b_x;
    const float* lru_lam; const float* lru_w_out;
    float* out; unsigned char* ws; int ph_lo, ph_hi;
};

struct Grp { int b_lo, nb, rank, gsize; };
__device__ __forceinline__ int grp_row(const Grp& g, int lr) { const int b = g.b_lo + lr / 4352, t = lr % 4352; return t < 256 ? b * 256 + t : MCTX + b * 4096 + (t - 256); }
__device__ __forceinline__ int grp_row_lat(const Grp& g, int lr) { return MCTX + (g.b_lo + (lr >> 12)) * 4096 + (lr & 4095); }
__device__ __forceinline__ int otid() { int t = threadIdx.x; asm volatile("" : "+v"(t)); return t; }
__device__ __forceinline__ float shx(float v, int lane, int m) { return __int_as_float(__builtin_amdgcn_ds_bpermute((lane ^ m) << 2, __float_as_int(v))); }
__device__ __forceinline__ unsigned cvt_pk_bf16(float lo, float hi) { unsigned r; asm volatile("v_cvt_pk_bf16_f32 %0, %1, %2" : "=v"(r) : "v"(lo), "v"(hi)); return r; }
__device__ __forceinline__ float bflo(unsigned w) { return __uint_as_float(w << 16); }
__device__ __forceinline__ float bfhi(unsigned w) { return __uint_as_float(w & 0xffff0000u); }
__device__ __forceinline__ float bf2f(bf16_t b) { return __uint_as_float(((unsigned)b) << 16); }
__device__ __forceinline__ bf16_t f2bf(float f) { return (bf16_t)(cvt_pk_bf16(f, 0.f) & 0xffffu); }
__device__ __forceinline__ float silu_f(float x) { return x * __builtin_amdgcn_rcpf(1.f + __expf(-x)); }
__device__ __forceinline__ float sigmoid_f(float x) { return __builtin_amdgcn_rcpf(1.f + __expf(-x)); }
__device__ __forceinline__ float gelu_tanh_f(float x) { const float z = 0.7978845608028654f * (x + 0.044715f * x * x * x); const float t = 1.f - 2.f * __builtin_amdgcn_rcpf(__expf(2.f * z) + 1.f); return 0.5f * x * (1.f + t); }

namespace pg8 {
constexpr int BM = 256, BK = 64, HALF = 128, HTB = HALF * BK * 2  , STAGE_BYTES = 8 * HTB, NXCD = 8, WGM = 8;
__host__ __device__ __forceinline__ int lds_byte(int r, int c) { const int st = (r >> 4) * 2 + (c >> 5), rr = r & 15, cc = c & 31, ob = rr * 64 + cc * 2; return st * 1024 + (ob ^ (((ob >> 9) & 1) << 5)); }
__host__ __device__ __forceinline__ void stage_rc(int b, int& R, int& C) { const int st = b / 1024, sb = b % 1024, swz = sb ^ (((sb >> 9) & 1) << 5); R = (st >> 1) * 16 + swz / 64; C = (st & 1) * 32 + (swz % 64) / 2; }
__host__ __device__ __forceinline__ int perm32(int rho) { const int n = rho >> 4, i = rho & 15; return 8 * (i >> 2) + 4 * n + (i & 3); }

struct Unit { int pm, pn; };
struct Gemm { const bf16_t* A; const bf16_t* Bt; int M, N, K, lda, a_sh, a_cols; };

struct StaticOrder {
    int nM, nN, nwg, G, c;
    __host__ __device__ void init(int M, int N, int G_, int c_) { nM = M / BM; nN = N / BM; nwg = nM * nN; G = G_; c = c_; }
    __host__ __device__ bool next(int i, Unit& u) const {
        const long L = (long)i * G + c; if (L >= nwg) return false;
        int wgid = (int)L; { const int q = nwg / NXCD, r = nwg % NXCD, xcd = wgid % NXCD, off = wgid / NXCD; wgid = (xcd < r ? xcd * (q + 1) : r * (q + 1) + (xcd - r) * q) + off; }
        const int nig = WGM * nN, gid = wgid / nig, fm = gid * WGM, gsz = (nM - fm) < WGM ? (nM - fm) : WGM;
        u.pm = fm + ((wgid % nig) % gsz); u.pn = (wgid % nig) / gsz; return true;
    }
    __device__ __forceinline__ void a_ready(const Unit&) const {}
    __device__ __forceinline__ void done(const Unit&) const {}
};

struct GroupOrder {
    int nP, nN, nwg, G, c, b_lo, per, W;
    __device__ void init(int nb, int b_lo_, bool skipctx, int N, int G_, int c_) { per = skipctx ? 16 : 17; nP = nb * per; nN = N / BM; nwg = nP * nN; G = G_; c = c_; b_lo = b_lo_;
        const int ng = (nP + WGM - 1) / WGM; W = (nP + ng - 1) / ng; }
    __device__ bool next(int i, Unit& u) const {
        const long L = (long)i * G + c; if (L >= nwg) return false;
        const int wgid = (int)L, nig = W * nN, gid = wgid / nig, fm = gid * W, gsz = (nP - fm) < W ? (nP - fm) : W;
        const int lp = fm + ((wgid % nig) % gsz); u.pn = (wgid % nig) / gsz;
        const int b = b_lo + lp / per, j = lp % per;
        u.pm = (per == 16) ? 8 + 16 * b + j : (j == 0 ? b : 8 + 16 * b + j - 1);
        return true;
    }
    __device__ __forceinline__ void a_ready(const Unit&) const {}
    __device__ __forceinline__ void done(const Unit&) const {}
};

template <class Epi, class Sched>
__device__ __forceinline__ void gemm_phase(LAS unsigned char* lds, const Gemm g, const Sched& S, const Epi& E) {
    const int tid = otid(), wid = __builtin_amdgcn_readfirstlane(tid >> 6), lane = tid & 63, wr = wid >> 2, wc = wid & 3, fr = lane & 15, fq = lane >> 4;
    const int K = g.K, nt = K / BK, lda = g.lda;
    unsigned voffA[2], voffB[2];
#pragma unroll
    for (int i = 0; i < 2; ++i) { int R, C; stage_rc(tid * 16 + i * 8192, R, C); const int Rb = Epi::PERM ? ((R & ~31) + perm32(R & 31)) : R;
        voffA[i] = (unsigned)(R * lda + C) * 2u; voffB[i] = (unsigned)(Rb * K + C) * 2u; }
    const size_t kstep = (size_t)(BK * 2);
    const size_t hstepA = (size_t)HALF * lda * 2, hstepB = (size_t)HALF * K * 2;
    const size_t tstepA = 2 * hstepA, tstepB = 2 * hstepB;
    const unsigned ldsw = (unsigned)wid * 1024u;
    const int aoff = lds_byte(wr * 64 + fr, fq * 8), boff = lds_byte(wc * 32 + fr, fq * 8);
#define PG8_SA(b, h) (((b) * 2 + (h)) * HTB)
#define PG8_SB(b, h) ((4 + (b) * 2 + (h)) * HTB)
#define PG8_STAGE(bufoff, gbase, voff) do { _Pragma("unroll") for (int _i = 0; _i < 2; ++_i) \
        __builtin_amdgcn_global_load_lds((const unsigned*)((const char*)(gbase) + (voff)[_i]), (LAS unsigned*)(lds + (bufoff) + ldsw + _i * 8192), 16, 0, 0); } while (0)
#define PG8_LDA(dst, b, h) do { _Pragma("unroll") for (int m = 0; m < 4; ++m) _Pragma("unroll") for (int k = 0; k < 2; ++k) dst[m][k] = *(const LAS bf16x8*)(lds + PG8_SA(b, h) + aoff + m * 2048 + k * 1024); } while (0)
#define PG8_LDB(dst, b, h) do { _Pragma("unroll") for (int n = 0; n < 2; ++n) _Pragma("unroll") for (int k = 0; k < 2; ++k) dst[n][k] = *(const LAS bf16x8*)(lds + PG8_SB(b, h) + boff + n * 2048 + k * 1024); } while (0)
#define PG8_MMA(ai, bj, At, Bt) do { __builtin_amdgcn_s_setprio(1); _Pragma("unroll") for (int m = 0; m < 4; ++m) _Pragma("unroll") for (int n = 0; n < 2; ++n) _Pragma("unroll") for (int k = 0; k < 2; ++k) \
        acc[ai][bj][m][n] = __builtin_amdgcn_mfma_f32_16x16x32_bf16(Bt[n][k], At[m][k], acc[ai][bj][m][n], 0, 0, 0); __builtin_amdgcn_s_setprio(0); } while (0)
#define PG8_WAIT_V(n) asm volatile("s_waitcnt vmcnt(" #n ")" ::: "memory")
#define PG8_WAIT_L(n) asm volatile("s_waitcnt lgkmcnt(" #n ")" ::: "memory")
#define PG8_BAR __builtin_amdgcn_s_barrier()
#define PG8_SCHED __builtin_amdgcn_sched_barrier(0)
#define PG8_AOFF(u) ((size_t)(u).pm * tstepA + (size_t)(((u).pn >> g.a_sh) * g.a_cols) * 2)
    Unit cur, nxt; int ui = 0;
    if (!S.next(0, cur)) return;
    f32x4 acc[2][2][4][2];
#pragma unroll
    for (int a = 0; a < 2; ++a)
#pragma unroll
        for (int b = 0; b < 2; ++b)
#pragma unroll
            for (int m = 0; m < 4; ++m)
#pragma unroll
                for (int n = 0; n < 2; ++n) acc[a][b][m][n] = (f32x4){0.f, 0.f, 0.f, 0.f};
    bf16x8 At[4][2], B0[2][2], B1[2][2];
    const char* cA = (const char*)g.A + PG8_AOFF(cur); const char* cB = (const char*)g.Bt + (size_t)cur.pn * tstepB;
    S.a_ready(cur);
    PG8_STAGE(PG8_SB(0, 0), cB, voffB); PG8_STAGE(PG8_SA(0, 0), cA, voffA); PG8_STAGE(PG8_SB(0, 1), cB + hstepB, voffB); PG8_STAGE(PG8_SA(0, 1), cA + hstepA, voffA);
    if (wr == 1) PG8_BAR;
    PG8_WAIT_V(4); PG8_BAR;
    PG8_STAGE(PG8_SB(1, 0), cB + kstep, voffB); PG8_STAGE(PG8_SA(1, 0), cA + kstep, voffA); PG8_STAGE(PG8_SB(1, 1), cB + hstepB + kstep, voffB);
    PG8_WAIT_V(6); PG8_BAR;
    for (;;) {
        const bool has_next = S.next(ui + 1, nxt);
        const char* nA = has_next ? (const char*)g.A + PG8_AOFF(nxt) : cA; const char* nB = has_next ? (const char*)g.Bt + (size_t)nxt.pn * tstepB : cB;
        for (int t = 0; t < nt; t += 2) {
            const bool last = (t == nt - 2);
            const char* a1 = cA + (size_t)(t + 1) * kstep;
            const char* a2 = last ? nA : cA + (size_t)(t + 2) * kstep; const char* b2 = last ? nB : cB + (size_t)(t + 2) * kstep;
            const char* a3 = a2 + kstep; const char* b3 = b2 + kstep;
            if (last && has_next) S.a_ready(nxt);
            PG8_LDB(B0, 0, 0); PG8_SCHED; PG8_LDA(At, 0, 0); PG8_STAGE(PG8_SA(1, 1), a1 + hstepA, voffA);
            PG8_WAIT_L(8); PG8_BAR; PG8_WAIT_L(0); PG8_MMA(0, 0, At, B0); PG8_BAR; PG8_SCHED;
            PG8_LDB(B1, 0, 1); PG8_STAGE(PG8_SB(0, 0), b2, voffB);
            PG8_BAR; PG8_WAIT_L(0); PG8_MMA(0, 1, At, B1); PG8_BAR;
            PG8_LDA(At, 0, 1); PG8_STAGE(PG8_SA(0, 0), a2, voffA);
            PG8_BAR; PG8_WAIT_L(0); PG8_MMA(1, 0, At, B0); PG8_BAR; PG8_SCHED;
            PG8_STAGE(PG8_SB(0, 1), b2 + hstepB, voffB);
            PG8_WAIT_V(6); PG8_BAR; PG8_MMA(1, 1, At, B1); PG8_BAR;
            PG8_LDB(B0, 1, 0); PG8_SCHED; PG8_LDA(At, 1, 0); PG8_STAGE(PG8_SA(0, 1), a2 + hstepA, voffA);
            PG8_WAIT_L(8); PG8_BAR; PG8_WAIT_L(0); PG8_MMA(0, 0, At, B0); PG8_BAR; PG8_SCHED;
            PG8_LDB(B1, 1, 1); PG8_STAGE(PG8_SB(1, 0), b3, voffB);
            PG8_BAR; PG8_WAIT_L(0); PG8_MMA(0, 1, At, B1); PG8_BAR;
            PG8_LDA(At, 1, 1); PG8_STAGE(PG8_SA(1, 0), a3, voffA);
            PG8_BAR; PG8_WAIT_L(0); PG8_MMA(1, 0, At, B0); PG8_BAR; PG8_SCHED;
            PG8_STAGE(PG8_SB(1, 1), b3 + hstepB, voffB);
            PG8_WAIT_V(6); PG8_BAR; PG8_MMA(1, 1, At, B1); PG8_BAR;
        }
        E(acc, cur, wr, wc, fr, fq); S.done(cur);
        if (!has_next) break;
#pragma unroll
        for (int a = 0; a < 2; ++a)
#pragma unroll
            for (int b = 0; b < 2; ++b)
#pragma unroll
                for (int m = 0; m < 4; ++m)
#pragma unroll
                    for (int n = 0; n < 2; ++n) acc[a][b][m][n] = (f32x4){0.f, 0.f, 0.f, 0.f};
        cur = nxt; cA = nA; cB = nB; ++ui;
    }
    PG8_WAIT_V(0);
    if (wr == 0) PG8_BAR;
    PG8_BAR;
#undef PG8_SA
#undef PG8_SB
#undef PG8_STAGE
#undef PG8_LDA
#undef PG8_LDB
#undef PG8_MMA
#undef PG8_WAIT_V
#undef PG8_WAIT_L
#undef PG8_BAR
#undef PG8_SCHED
#undef PG8_AOFF
}
}

#define XB_TMO      128
#define XB_XCNT(j)  (256  + 64 * (j))
#define XB_XSUB(j)  (1280 + 64 * (j))
#define XB_XGEN(j)  (2304 + 64 * (j))
#define XB_TOP      3328
#define XB_TOPGEN   3392
#define XCD_BAR_WORDS 3456
#define XB_LSUB(j)  (3456 + 64 * (j))
#define XB_LGEN(j)  (3488 + 64 * (j))
#define XB_SPIN_CAP (1u << 21)
__device__ __forceinline__ unsigned xb_ld(unsigned* p)              { return __hip_atomic_load(p, __ATOMIC_RELAXED, __HIP_MEMORY_SCOPE_AGENT); }
__device__ __forceinline__ unsigned xb_add(unsigned* p, unsigned v) { return __hip_atomic_fetch_add(p, v, __ATOMIC_RELAXED, __HIP_MEMORY_SCOPE_AGENT); }
__device__ __forceinline__ unsigned xb_xcc_id() { return (unsigned)__builtin_amdgcn_s_getreg((3 << 11) | 20) & 0xFu; }
#define XB_SPIN(cond, bar) do { unsigned _sp = 0; while (cond) { __builtin_amdgcn_s_sleep(1); \
    if ((++_sp & 255u) == 0u) { if (xb_ld(&(bar)[XB_TMO])) break; if (_sp > XB_SPIN_CAP) { atomicAdd(&(bar)[XB_TMO], 1u); break; } } } } while (0)
__device__ __forceinline__ void xcd_barrier_complete(unsigned* bar, unsigned x, unsigned& nloc, unsigned& nx) {
    const unsigned G = gridDim.x * gridDim.y * gridDim.z;
    unsigned sum, cnt, mine, sp = 0u;
    for (;;) {
        sum = 0u; cnt = 0u; mine = 0u;
#pragma unroll
        for (unsigned j = 0; j < 16; ++j) { const unsigned c = xb_ld(&bar[XB_XCNT(j)]); sum += c; cnt += (c > 0u) ? 1u : 0u; mine = (j == x) ? c : mine; }
        if (sum == G) break;
        __builtin_amdgcn_s_sleep(1);
        if ((++sp & 255u) == 0u) { if (xb_ld(&bar[XB_TMO])) break; if (sp > XB_SPIN_CAP) { atomicAdd(&bar[XB_TMO], 1u); break; } }
    }
    nloc = mine > 0u ? mine : 1u; nx = cnt > 0u ? cnt : 1u;
}
__device__ __forceinline__ void xcd_barrier(unsigned* bar, volatile LAS unsigned* st) {
    asm volatile("s_waitcnt vmcnt(0)" ::: "memory");
    __syncthreads();
    if (threadIdx.x == 0) {
        const unsigned x = xb_xcc_id();
        __builtin_amdgcn_s_waitcnt(0);
        unsigned nloc = st[0], nx = st[1];
        if (nloc == 0u) { xcd_barrier_complete(bar, x, nloc, nx); st[0] = nloc; st[1] = nx; }
        const unsigned old = xb_add(&bar[XB_XSUB(x)], 1u);
        const unsigned gen = old / nloc;
        if (old + 1u == (gen + 1u) * nloc) {
            __builtin_amdgcn_fence(__ATOMIC_RELEASE, "agent");
            asm volatile("s_waitcnt vmcnt(0)" ::: "memory");
            const unsigned og = xb_add(&bar[XB_TOP], 1u);
            const unsigned tg = og / nx;
            if (og + 1u == (tg + 1u) * nx) xb_add(&bar[XB_TOPGEN], 1u);
            else XB_SPIN(xb_ld(&bar[XB_TOPGEN]) == tg, bar);
            __builtin_amdgcn_fence(__ATOMIC_ACQUIRE, "agent");
            xb_add(&bar[XB_XGEN(x)], 1u);
            asm volatile("s_waitcnt vmcnt(0)" ::: "memory");
        } else {
            XB_SPIN(xb_ld(&bar[XB_XGEN(x)]) == gen, bar);
            __builtin_amdgcn_fence(__ATOMIC_ACQUIRE, "agent");
            asm volatile("s_waitcnt vmcnt(0)" ::: "memory");
        }
    }
    __syncthreads();
}

__device__ __forceinline__ void xcd_local_barrier(unsigned* bar, unsigned x, unsigned nloc) {
    asm volatile("s_waitcnt vmcnt(0)" ::: "memory");
    __syncthreads();
    if (threadIdx.x == 0) {
        __builtin_amdgcn_s_waitcnt(0);
        const unsigned old = xb_add(&bar[XB_LSUB(x)], 1u), gen = old / nloc;
        if (old + 1u == (gen + 1u) * nloc) xb_add(&bar[XB_LGEN(x)], 1u);
        else XB_SPIN(xb_ld(&bar[XB_LGEN(x)]) == gen, bar);
        __builtin_amdgcn_fence(__ATOMIC_ACQUIRE, "agent");
        asm volatile("s_waitcnt vmcnt(0)" ::: "memory");
    }
    __syncthreads();
}
struct EpiSwiGLU {
    static constexpr bool PERM = true;
    bf16_t* H; int row_off;
    __device__ __forceinline__ void operator()(const f32x4 (&acc)[2][2][4][2], const pg8::Unit& u, int wr, int wc, int fr, int fq) const {
        const int row0 = row_off + u.pm * 256 + wr * 64 + fr, hc = u.pn * 128 + wc * 32 + 8 * fq;
#pragma unroll
        for (int ai = 0; ai < 2; ++ai)
#pragma unroll
            for (int m = 0; m < 4; ++m) {
                bf16_t* rowp = H + (size_t)(row0 + ai * 128 + m * 16) * DFF + hc;
                const f32x4 g0 = acc[ai][0][m][0], g1 = acc[ai][0][m][1], u0 = acc[ai][1][m][0], u1 = acc[ai][1][m][1];
                u32x4 w;
                w.x = cvt_pk_bf16(silu_f(g0[0]) * u0[0], silu_f(g0[1]) * u0[1]); w.y = cvt_pk_bf16(silu_f(g0[2]) * u0[2], silu_f(g0[3]) * u0[3]);
                w.z = cvt_pk_bf16(silu_f(g1[0]) * u1[0], silu_f(g1[1]) * u1[1]); w.w = cvt_pk_bf16(silu_f(g1[2]) * u1[2], silu_f(g1[3]) * u1[3]);
                *(u32x4*)rowp = w;
            }
    }
};
struct EpiPlain {
    static constexpr bool PERM = true;
    bf16_t* O; int ldc; int row_off; int split_cols; size_t split_stride; float scale0; int headmajor;
    __device__ __forceinline__ void operator()(const f32x4 (&acc)[2][2][4][2], const pg8::Unit& u, int wr, int wc, int fr, int fq) const {
        const int row0 = row_off + u.pm * 256 + wr * 64 + fr; int colt = u.pn * 256; bf16_t* base = O; float sc = scale0; int t = 0;
        if (split_cols) { t = colt / split_cols; base += (size_t)t * split_stride; colt -= t * split_cols; if (t) sc = 1.f; }
        const int col0 = colt + wc * 32 + 8 * fq; const bool hm = headmajor && t > 0;
        const size_t rstride = hm ? 64 : (size_t)ldc;
        const size_t cofs0 = hm ? (size_t)(col0 >> 6) * MTOT * 64 + (col0 & 63) : (size_t)col0, cofs1 = hm ? (size_t)((col0 + 128) >> 6) * MTOT * 64 + ((col0 + 128) & 63) : (size_t)col0 + 128;
#pragma unroll
        for (int ai = 0; ai < 2; ++ai)
#pragma unroll
            for (int m = 0; m < 4; ++m) { bf16_t* rowp = base + (size_t)(row0 + ai * 128 + m * 16) * rstride;
#pragma unroll
                for (int bj = 0; bj < 2; ++bj) { const f32x4 v0 = acc[ai][bj][m][0] * sc, v1 = acc[ai][bj][m][1] * sc;
                    u32x4 w; w.x = cvt_pk_bf16(v0[0], v0[1]); w.y = cvt_pk_bf16(v0[2], v0[3]); w.z = cvt_pk_bf16(v1[0], v1[1]); w.w = cvt_pk_bf16(v1[2], v1[3]);
                    *(u32x4*)(rowp + (bj ? cofs1 : cofs0)) = w; } }
    }
};
struct EpiRetIn {
    static constexpr bool PERM = true;
    bf16_t* Q; bf16_t* K; bf16_t* V; const float* rcos; const float* rsin;
    __device__ __forceinline__ void operator()(const f32x4 (&acc)[2][2][4][2], const pg8::Unit& u, int wr, int wc, int fr, int fq) const {
        const int row0 = u.pm * 256 + wr * 64 + fr, cin = wc * 32 + 8 * fq;
        if (u.pn >= 8) {
#pragma unroll
            for (int ai = 0; ai < 2; ++ai)
#pragma unroll
                for (int m = 0; m < 4; ++m) { bf16_t* rowp = V + (size_t)(row0 + ai * 128 + m * 16) * 2048 + (u.pn - 8) * 256 + cin;
#pragma unroll
                    for (int bj = 0; bj < 2; ++bj) { const f32x4 v0 = acc[ai][bj][m][0], v1 = acc[ai][bj][m][1];
                        u32x4 w; w.x = cvt_pk_bf16(v0[0], v0[1]); w.y = cvt_pk_bf16(v0[2], v0[3]); w.z = cvt_pk_bf16(v1[0], v1[1]); w.w = cvt_pk_bf16(v1[2], v1[3]);
                        *(u32x4*)(rowp + bj * 128) = w; } }
        } else {
            bf16_t* T = (u.pn < 4) ? Q : K; const float mul = (u.pn < 4) ? 1.f : 0.0625f; const int f0 = wc * 16 + 4 * fq;
#pragma unroll
            for (int ai = 0; ai < 2; ++ai)
#pragma unroll
                for (int m = 0; m < 4; ++m) { const int row = row0 + ai * 128 + m * 16; bf16_t* rowp = T + (size_t)row * 1024 + (u.pn & 3) * 256 + cin;
                    const bool lat = row >= MCTX; const int t = (row - MCTX) & 4095;
#pragma unroll
                    for (int bj = 0; bj < 2; ++bj) { f32x4 v0 = acc[ai][bj][m][0] * mul, v1 = acc[ai][bj][m][1] * mul;
                        if (lat) { const int pos = bj ? (t & 63) : (t >> 6); const f32x4 cs = *(const f32x4*)(rcos + pos * 64 + f0), sn = *(const f32x4*)(rsin + pos * 64 + f0);
                            const f32x4 a0 = v0, a1 = v1;
                            v0[0] = a0[0] * cs[0] - a0[1] * sn[0]; v0[1] = a0[0] * sn[0] + a0[1] * cs[0]; v0[2] = a0[2] * cs[1] - a0[3] * sn[1]; v0[3] = a0[2] * sn[1] + a0[3] * cs[1];
                            v1[0] = a1[0] * cs[2] - a1[1] * sn[2]; v1[1] = a1[0] * sn[2] + a1[1] * cs[2]; v1[2] = a1[2] * cs[3] - a1[3] * sn[3]; v1[3] = a1[2] * sn[3] + a1[3] * cs[3]; }
                        u32x4 w; w.x = cvt_pk_bf16(v0[0], v0[1]); w.y = cvt_pk_bf16(v0[2], v0[3]); w.z = cvt_pk_bf16(v1[0], v1[1]); w.w = cvt_pk_bf16(v1[2], v1[3]);
                        *(u32x4*)(rowp + bj * 128) = w; } }
        }
    }
};
struct EpiGates {
    static constexpr bool PERM = true;
    bf16_t* GP;
    __device__ __forceinline__ void operator()(const f32x4 (&acc)[2][2][4][2], const pg8::Unit& u, int wr, int wc, int fr, int fq) const {
        const int row0 = u.pm * 256 + wr * 64 + fr, col0 = (u.pn & 1) * 1024 + (u.pn >> 1) * 256 + wc * 32 + 8 * fq;
#pragma unroll
        for (int ai = 0; ai < 2; ++ai)
#pragma unroll
            for (int m = 0; m < 4; ++m) { bf16_t* rowp = GP + (size_t)(row0 + ai * 128 + m * 16) * 2048 + col0;
#pragma unroll
                for (int bj = 0; bj < 2; ++bj) { const f32x4 v0 = acc[ai][bj][m][0], v1 = acc[ai][bj][m][1];
                    u32x4 w; w.x = cvt_pk_bf16(v0[0], v0[1]); w.y = cvt_pk_bf16(v0[2], v0[3]); w.z = cvt_pk_bf16(v1[0], v1[1]); w.w = cvt_pk_bf16(v1[2], v1[3]);
                    *(u32x4*)(rowp + bj * 128) = w; } }
    }
};

struct CvtJob { const float* src; bf16_t* dst; int K, N, ld, perm; };
__device__ __forceinline__ CvtJob get_job(const Args& a, int j) {
    bf16_t* wt = (bf16_t*)(a.ws + WS_WT); CvtJob r;
    if (j < 8)       { r.src = a.ffn_w_in + (size_t)j * 1024 * 5632; r.dst = wt + E_FFN_IN + (size_t)j * 5632 * 1024; r.K = 1024; r.N = 5632; r.ld = 5632; r.perm = 1; }
    else if (j < 16) { const int i = j - 8; r.src = a.ffn_w_out + (size_t)i * 2816 * 1024; r.dst = wt + E_FFN_OUT + (size_t)i * 1024 * 2816; r.K = 2816; r.N = 1024; r.ld = 1024; r.perm = 0; }
    else if (j < 18) { const int i = j - 16; r.src = a.ret_w_in + (size_t)i * 1024 * 6144; r.dst = wt + E_RET_IN + (size_t)i * 6144 * 1024; r.K = 1024; r.N = 6144; r.ld = 6144; r.perm = 2; }
    else if (j < 20) { const int i = j - 18; r.src = a.ret_w_out + (size_t)i * 2048 * 1024; r.dst = wt + E_RET_OUT + (size_t)i * 1024 * 2048; r.K = 2048; r.N = 1024; r.ld = 1024; r.perm = 0; }
    else if (j == 20) { r.src = a.na_w_qkv; r.dst = wt + E_NA_QKV; r.K = 1024; r.N = 3072; r.ld = 3072; r.perm = 0; }
    else if (j == 21) { r.src = a.na_w_out; r.dst = wt + E_NA_OUT; r.K = 1024; r.N = 1024; r.ld = 1024; r.perm = 0; }
    else if (j == 22) { r.src = a.lru_w_in; r.dst = wt + E_LRU_IN; r.K = 1024; r.N = 2048; r.ld = 2048; r.perm = 0; }
    else if (j == 23) { r.src = a.lru_w_out; r.dst = wt + E_LRU_OUT; r.K = 1024; r.N = 1024; r.ld = 1024; r.perm = 0; }
    else { const int gI = j - 24, dir = gI >> 3, type = (gI >> 2) & 1, k = gI & 3;
        r.src = (type ? a.lru_w_x : a.lru_w_a) + (size_t)(dir * 4 + k) * 256 * 256; r.dst = wt + E_GATES + (size_t)dir * 2048 * 256 + (size_t)((k * 2 + type) * 256) * 256; r.K = 256; r.N = 256; r.ld = 256; r.perm = 0; }
    return r;
}
__device__ __forceinline__ int perm_col(int perm, int n) {
    if (perm == 1) return ((n & 255) >> 7) * 2816 + (n >> 8) * 128 + (n & 127);
    if (perm == 2) { if (n < 2048) { const int hb = n >> 8, dp = n & 255, p = dp >> 1, e = dp & 1; const int d = (p < 64) ? (p + 64 * e) : (128 + (p - 64) + 64 * e); return hb * 256 + d; } return n; }
    return n;
}
__device__ __forceinline__ void phase_prologue(const Args& a, LAS unsigned char* lds) {
    const int tid = otid(), G = gridDim.x;
    { LAS bf16_t* tile = (LAS bf16_t*)lds;
      int cum = 0;
      for (int j = 0; j < 40; ++j) {
          const CvtJob jb = get_job(a, j);
          const int tn = jb.N >> 6, ntile = tn * (jb.K >> 6);
          const int first = (int)((blockIdx.x + G - (cum % G)) % G);
          for (int t = first; t < ntile; t += G) {
              const int n0 = (t % tn) * 64, k0 = (t / tn) * 64, c = tid & 63, kr = tid >> 6;
              const float* sp = jb.src + (size_t)k0 * jb.ld + perm_col(jb.perm, n0 + c);
              float v[8];
#pragma unroll
              for (int i = 0; i < 8; ++i) v[i] = sp[(size_t)(kr + 8 * i) * jb.ld];
#pragma unroll
              for (int i = 0; i < 8; ++i) tile[c * 72 + kr + 8 * i] = f2bf(v[i]);
              __syncthreads();
              const int row = tid >> 3, ch = tid & 7;
              const u32x4 w = *(const LAS u32x4*)(tile + row * 72 + ch * 8);
              *(u32x4*)(jb.dst + (size_t)(n0 + row) * jb.K + k0 + ch * 8) = w;
              __syncthreads();
          }
          cum += ntile;
      } }
    { LAS float* sv = (LAS float*)lds; LAS float* red = sv + 9 * 1024; float* MOD = (float*)(a.ws + WS_MOD);
      for (int i = tid; i < 9 * 1024; i += 512) { const int r = i >> 10, k = i & 1023; const float cv = (r < 8) ? a.c[r * 1024 + k] : a.c_ctx[k]; sv[i] = cv / (1.f + expf(-cv)); }
      __syncthreads();
      for (int it = blockIdx.x; it < 288; it += G) {
          const int l = it / 72, cb = it % 72, cl = tid & 127, kq = tid >> 7;
          const float* W = a.ada_w + (size_t)l * 1024 * 9216 + cb * 128 + cl;
          float acc[9];
#pragma unroll
          for (int r = 0; r < 9; ++r) acc[r] = 0.f;
          for (int k = kq * 256; k < kq * 256 + 256; k += 4) {
              float w[4];
#pragma unroll
              for (int q = 0; q < 4; ++q) w[q] = W[(size_t)(k + q) * 9216];
#pragma unroll
              for (int q = 0; q < 4; ++q)
#pragma unroll
                  for (int r = 0; r < 9; ++r) acc[r] += sv[r * 1024 + k + q] * w[q];
          }
#pragma unroll
          for (int r = 0; r < 9; ++r) red[(kq * 9 + r) * 128 + cl] = acc[r];
          __syncthreads();
          for (int o = tid; o < 9 * 128; o += 512) { const int r = o >> 7, cc = o & 127, col = cb * 128 + cc;
              const float s = (red[(0 * 9 + r) * 128 + cc] + red[(1 * 9 + r) * 128 + cc]) + (red[(2 * 9 + r) * 128 + cc] + red[(3 * 9 + r) * 128 + cc]);
              MOD[(size_t)(l * 9 + r) * 9216 + col] = s + a.ada_b[l * 9216 + col]; }
          __syncthreads();
      } }
    { float* rc = (float*)(a.ws + WS_ROPE); float* rs = rc + 4096;
      for (int i = blockIdx.x * 512 + tid; i < 4096; i += G * 512) { const int pos = i >> 6, f = i & 63; const float fr = expf(-(float)(2 * f) * (1.f / 128.f) * 9.210340371976184f); const float ang = (float)pos * fr;
          rc[i] = cosf(ang); rs[i] = sinf(ang); } }
}

__device__ __forceinline__ void phase_u0(const Args& a, const Grp& gp) {
    const float* MOD = (const float*)(a.ws + WS_MOD); bf16_t* U = (bf16_t*)(a.ws + WS_U);
    const int i0 = gp.rank * 512 + otid(), c8 = (i0 & 127) * 8;
    const bool uni = gp.nb == 1;
    const float* lsh = MOD + (size_t)((uni ? gp.b_lo : 0) * 9 + 0) * 1024 + c8;
    const f32x4 ls0 = *(const f32x4*)lsh, ls1 = *(const f32x4*)(lsh + 4), lc0 = *(const f32x4*)(lsh + 1024), lc1 = *(const f32x4*)(lsh + 1028);
    for (int i = i0; i < gp.nb * 4352 * 128; i += gp.gsize * 512) {
        const int row = grp_row(gp, i >> 7); const int r9 = row < MCTX ? 8 : (row - MCTX) >> 12;
        const float* hp = (row < MCTX ? a.ctx + (size_t)row * 1024 : a.x + (size_t)(row - MCTX) * 1024) + c8;
        const f32x4 h0 = *(const f32x4*)hp, h1 = *(const f32x4*)(hp + 4); f32x4 s0, s1, c0, c1;
        if (uni && row >= MCTX) { s0 = ls0; s1 = ls1; c0 = lc0; c1 = lc1; }
        else { const float* sh = MOD + (size_t)(r9 * 9 + 0) * 1024 + c8; const float* sc = sh + 1024; s0 = *(const f32x4*)sh; s1 = *(const f32x4*)(sh + 4); c0 = *(const f32x4*)sc; c1 = *(const f32x4*)(sc + 4); }
        const f32x4 o0 = h0 * (c0 + 1.f) + s0, o1 = h1 * (c1 + 1.f) + s1;
        u32x4 w; w.x = cvt_pk_bf16(o0[0], o0[1]); w.y = cvt_pk_bf16(o0[2], o0[3]); w.z = cvt_pk_bf16(o1[0], o1[1]); w.w = cvt_pk_bf16(o1[2], o1[3]);
        *(u32x4*)(U + (size_t)row * 1024 + c8) = w;
    }
}

__device__ __forceinline__ void phase_postnorm(const Args& a, bool first, const bf16_t* Y, const float* modl, int gate_j, float ymul, const float* lng, const float* lnb,
                                               const float* modn, int sh_j, int row_begin, const Grp& gp) {
    const int tid = otid(), lane = tid & 63, gw = gp.rank * 8 + (tid >> 6), nw = gp.gsize * 8;
    const int nrows = gp.nb * (row_begin ? 4096 : 4352);
    float* HC = (float*)(a.ws + WS_HC); bf16_t* U = (bf16_t*)(a.ws + WS_U);
    f32x4 hr[2][4]; u32x2 yr[2][4];
#define PN_MAP(lr) (row_begin ? grp_row_lat(gp, (lr)) : grp_row(gp, (lr)))
#define PN_ROW(t, lA) PN_MAP((t) ? (((lA) + nw < nrows) ? (lA) + nw : (lA)) : (lA))
#define PN_LOAD(dstH, dstY, rA) do { _Pragma("unroll") for (int t = 0; t < 2; ++t) { const int row = PN_ROW(t, rA); const bool isc = row < MCTX; \
        const float* hin = first ? (isc ? a.ctx + (size_t)row * 1024 : a.x + (size_t)(row - MCTX) * 1024) : (isc ? HC + (size_t)row * 1024 : a.out + (size_t)(row - MCTX) * 1024); \
        const bf16_t* yp = Y + (size_t)row * 1024; \
        _Pragma("unroll") for (int c = 0; c < 4; ++c) { const int col = c * 256 + lane * 4; dstH[t][c] = *(const f32x4*)(hin + col); dstY[t][c] = *(const u32x2*)(yp + col); } } } while (0)
    f32x4 gv[4], bv[4];
#pragma unroll
    for (int c = 0; c < 4; ++c) { gv[c] = *(const f32x4*)(lng + c * 256 + lane * 4); bv[c] = *(const f32x4*)(lnb + c * 256 + lane * 4); }
    const bool uni = gp.nb == 1;
    f32x4 gl[4], shl[4], scl[4];
#pragma unroll
    for (int c = 0; c < 4; ++c) { const int col = c * 256 + lane * 4; const int rl = uni ? gp.b_lo : 0;
        gl[c] = *(const f32x4*)(modl + (size_t)(rl * 9 + gate_j) * 1024 + col);
        shl[c] = *(const f32x4*)(modn + (size_t)(rl * 9 + (sh_j >= 0 ? sh_j : 0)) * 1024 + col); scl[c] = *(const f32x4*)(modn + (size_t)(rl * 9 + (sh_j >= 0 ? sh_j : 0) + 1) * 1024 + col); }
    int rowA = gw;
    if (rowA < nrows) PN_LOAD(hr, yr, rowA);
    for (; rowA < nrows; rowA += 2 * nw) {
        const bool hasB = rowA + nw < nrows;
        f32x4 v[2][4]; float s[2] = {0.f, 0.f}, q[2] = {0.f, 0.f};
#pragma unroll
        for (int t = 0; t < 2; ++t) { const int row = PN_ROW(t, rowA); const int r9 = row < MCTX ? 8 : (row - MCTX) >> 12;
            const float* gate = modl + (size_t)(r9 * 9 + gate_j) * 1024;
#pragma unroll
            for (int c = 0; c < 4; ++c) { const int col = c * 256 + lane * 4; const f32x4 gt = (uni && row >= MCTX) ? gl[c] : *(const f32x4*)(gate + col);
                const f32x4 y = {bflo(yr[t][c].x), bfhi(yr[t][c].x), bflo(yr[t][c].y), bfhi(yr[t][c].y)};
                v[t][c] = hr[t][c] * DN_ALPHA + gt * y * ymul; s[t] += (v[t][c][0] + v[t][c][1]) + (v[t][c][2] + v[t][c][3]);
                q[t] += (v[t][c][0] * v[t][c][0] + v[t][c][1] * v[t][c][1]) + (v[t][c][2] * v[t][c][2] + v[t][c][3] * v[t][c][3]); } }
        const int rowN = rowA + 2 * nw;
        if (rowN < nrows) PN_LOAD(hr, yr, rowN);
#pragma unroll
        for (int o = 32; o >= 1; o >>= 1) { const float s0 = shx(s[0], lane, o), s1 = shx(s[1], lane, o), q0 = shx(q[0], lane, o), q1 = shx(q[1], lane, o); s[0] += s0; s[1] += s1; q[0] += q0; q[1] += q1; }
#pragma unroll
        for (int t = 0; t < 2; ++t) { if (t && !hasB) break; const int row = PN_MAP(t ? rowA + nw : rowA);
            const bool isc = row < MCTX; const int r9 = isc ? 8 : (row - MCTX) >> 12;
            float* hout = isc ? HC + (size_t)row * 1024 : a.out + (size_t)(row - MCTX) * 1024;
            const float mean = s[t] * (1.f / 1024.f); const float var = fmaxf(q[t] * (1.f / 1024.f) - mean * mean, 0.f);
            const float rstd = 1.0f / sqrtf(var + LN_EPS);
#pragma unroll
            for (int c = 0; c < 4; ++c) { const int col = c * 256 + lane * 4;
                const f32x4 hn = (v[t][c] - mean) * rstd * gv[c] + bv[c]; *(f32x4*)(hout + col) = hn;
                if (sh_j >= 0) { f32x4 sh, sc; if (uni && !isc) { sh = shl[c]; sc = scl[c]; } else { sh = *(const f32x4*)(modn + (size_t)(r9 * 9 + sh_j) * 1024 + col); sc = *(const f32x4*)(modn + (size_t)(r9 * 9 + sh_j + 1) * 1024 + col); }
                    const f32x4 o = hn * (sc + 1.f) + sh; u32x2 w; w.x = cvt_pk_bf16(o[0], o[1]); w.y = cvt_pk_bf16(o[2], o[3]); *(u32x2*)(U + (size_t)row * 1024 + col) = w; } } }
    }
#undef PN_LOAD
#undef PN_ROW
#undef PN_MAP
}
template <int RABL>
__device__ __forceinline__ void phase_retention(const Args& a, LAS unsigned char* lds, const Grp& gp, bool ctx_o_dead) {
    const bf16_t* Qg = (const bf16_t*)(a.ws + WS_BIG); const bf16_t* Kg = (const bf16_t*)(a.ws + WS_BIG + R1); const bf16_t* Vg = (const bf16_t*)(a.ws + WS_BIG + 2 * R1); bf16_t* Og = (bf16_t*)(a.ws + WS_BIG + 4 * R1);
    const int tid = otid(), w = __builtin_amdgcn_readfirstlane(tid >> 6), lane = tid & 63, c = lane & 15, g = lane >> 4;
    const int ib = w & 3, vh = w >> 2, vb2 = w & 3, dbase = (w >> 2) * 8;
    constexpr int QS = 0, KS = 32768, VS = 65536, ST = 73728;
    typedef short s16x4 __attribute__((ext_vector_type(4)));
    for (int item = gp.rank; item < gp.nb * 32; item += gp.gsize) {
        const int b = gp.b_lo + (item >> 5), h = (item >> 3) & 3, vs = item & 7;
        f32x4 accS[8]; u32x4 qreg[4], kreg[4], vreg; float lg = 0.f, g64 = 0.f;
        { const int row0 = b * 256;
#pragma unroll
          for (int i = 0; i < 4; ++i) { const int idx = tid + 512 * i, row = idx >> 5, ch = idx & 31; const size_t o = (size_t)(row0 + row) * 1024 + h * 256 + ch * 8; qreg[i] = *(const u32x4*)(Qg + o); kreg[i] = *(const u32x4*)(Kg + o); }
          vreg = *(const u32x4*)(Vg + (size_t)(row0 + (tid >> 3)) * 2048 + h * 512 + vs * 64 + (tid & 7) * 8); }
        for (int step = 0; step < 136; ++step) {
            const int dir = step >= 68 ? 1 : 0, s = step - 68 * dir;
            if (s == 0) {
#pragma unroll
                for (int x = 0; x < 8; ++x) accS[x] = (f32x4){0.f, 0.f, 0.f, 0.f};
                const int hh = dir ? 3 - h : h; lg = log2f(1.0f - exp2f(-5.0f - (float)hh)); g64 = exp2f(64.f * lg);
            }
            const int row0 = dir ? (s < 4 ? b * 256 + 64 * (3 - s) : MCTX + b * 4096 + 64 * (63 - (s - 4))) : (s < 4 ? b * 256 + 64 * s : MCTX + b * 4096 + 64 * (s - 4));
            __syncthreads();
            if (RABL != 1)
#pragma unroll
            for (int x = 0; x < 8; ++x) { const int d = 16 * (dbase + x) + c;
#pragma unroll
                for (int r = 0; r < 4; ++r) { const int v = 16 * vb2 + 4 * g + r; *(LAS bf16_t*)(lds + ST + v * 512 + (((d >> 3) ^ (v & 15)) << 4) + (d & 7) * 2) = f2bf(accS[x][r]); } }
#pragma unroll
            for (int i = 0; i < 4; ++i) { const int idx = tid + 512 * i, row = idx >> 5, ch = idx & 31; const int off = row * 512 + ((ch ^ (row & 15)) << 4);
                *(LAS u32x4*)(lds + QS + off) = qreg[i]; *(LAS u32x4*)(lds + KS + off) = kreg[i]; }
            { const int j = tid >> 3, ch = tid & 7; *(LAS u32x4*)(lds + VS + j * 128 + ((ch ^ ((j >> 1) & 7)) << 4)) = vreg; }
            __syncthreads();
            if (step + 1 < 136) { const int st2 = step + 1, dir2 = st2 >= 68 ? 1 : 0, s2 = st2 - 68 * dir2;
                const int nrow0 = dir2 ? (s2 < 4 ? b * 256 + 64 * (3 - s2) : MCTX + b * 4096 + 64 * (63 - (s2 - 4))) : (s2 < 4 ? b * 256 + 64 * s2 : MCTX + b * 4096 + 64 * (s2 - 4));
#pragma unroll
                for (int i = 0; i < 4; ++i) { const int idx = tid + 512 * i, row = idx >> 5, ch = idx & 31; const size_t o = (size_t)(nrow0 + row) * 1024 + h * 256 + ch * 8; qreg[i] = *(const u32x4*)(Qg + o); kreg[i] = *(const u32x4*)(Kg + o); }
                vreg = *(const u32x4*)(Vg + (size_t)(nrow0 + (tid >> 3)) * 2048 + h * 512 + vs * 64 + (tid & 7) * 8); }
            if (RABL == 2) continue;
            const bool have_o = !(ctx_o_dead && s < 4);
            f32x4 osave[2]; u32x2 pv[2];
            if (have_o) {
            const int iq = 16 * ib + c;
            if (dir) {
#pragma unroll
                for (int vb = 0; vb < 2; ++vb) pv[vb] = *(const u32x2*)(Og + (size_t)(row0 + iq) * 2048 + h * 512 + vs * 64 + 16 * (2 * vh + vb) + 4 * g); }
            f32x4 accs[4], acco[2];
#pragma unroll
            for (int jb = 0; jb < 4; ++jb) accs[jb] = (f32x4){0.f, 0.f, 0.f, 0.f};
            acco[0] = (f32x4){0.f, 0.f, 0.f, 0.f}; acco[1] = (f32x4){0.f, 0.f, 0.f, 0.f};
#pragma unroll 1
            for (int ks = 0; ks < 8; ++ks) {
                const int sw = ((4 * ks + g) ^ c) << 4;
                const bf16x8 qf = *(const LAS bf16x8*)(lds + QS + iq * 512 + sw);
#pragma unroll
                for (int jb = 0; jb < 4; ++jb) { const bf16x8 kf = *(const LAS bf16x8*)(lds + KS + (16 * jb + c) * 512 + sw); accs[jb] = __builtin_amdgcn_mfma_f32_16x16x32_bf16(kf, qf, accs[jb], 0, 0, 0); }
#pragma unroll
                for (int vb = 0; vb < 2; ++vb) { const bf16x8 sf = *(const LAS bf16x8*)(lds + ST + (16 * (2 * vh + vb) + c) * 512 + sw); acco[vb] = __builtin_amdgcn_mfma_f32_16x16x32_bf16(sf, qf, acco[vb], 0, 0, 0); }
            }
            { const float qd = __builtin_amdgcn_exp2f(lg * (float)(dir ? 64 - iq : iq + 1)); acco[0] *= qd; acco[1] *= qd; }
#pragma unroll
            for (int jb = 0; jb < 4; ++jb)
#pragma unroll
                for (int r = 0; r < 4; ++r) { const int j = 16 * jb + 4 * g + r; const int df = dir ? j - iq : iq - j; const bool vis = dir ? (df > 0) : (df >= 0);
                    accs[jb][r] = vis ? accs[jb][r] * __builtin_amdgcn_exp2f(lg * (float)df) : 0.f; }
#pragma unroll
            for (int s2 = 0; s2 < 2; ++s2) {
                u32x4 pw; pw.x = cvt_pk_bf16(accs[2 * s2][0], accs[2 * s2][1]); pw.y = cvt_pk_bf16(accs[2 * s2][2], accs[2 * s2][3]); pw.z = cvt_pk_bf16(accs[2 * s2 + 1][0], accs[2 * s2 + 1][1]); pw.w = cvt_pk_bf16(accs[2 * s2 + 1][2], accs[2 * s2 + 1][3]);
                const bf16x8 pf = __builtin_bit_cast(bf16x8, pw);
#pragma unroll
                for (int vb = 0; vb < 2; ++vb) { const int vblk = 2 * vh + vb, ra = 32 * s2 + 4 * g + (c >> 2), rbb = ra + 16, cch = 2 * vblk + ((c & 3) >> 1);
                    const s16x4 lo = __builtin_amdgcn_ds_read_tr16_b64_v4i16((LAS s16x4*)(lds + VS + ra * 128 + ((cch ^ ((ra >> 1) & 7)) << 4) + 8 * (c & 1)));
                    const s16x4 hi = __builtin_amdgcn_ds_read_tr16_b64_v4i16((LAS s16x4*)(lds + VS + rbb * 128 + ((cch ^ ((rbb >> 1) & 7)) << 4) + 8 * (c & 1)));
                    const bf16x8 vf = {lo[0], lo[1], lo[2], lo[3], hi[0], hi[1], hi[2], hi[3]};
                    acco[vb] = __builtin_amdgcn_mfma_f32_16x16x32_bf16(vf, pf, acco[vb], 0, 0, 0); }
            }
            osave[0] = acco[0]; osave[1] = acco[1];
            }
            { bf16x8 af[2];
              const int tq = c >> 2, tp = c & 3;
#pragma unroll
              for (int k2 = 0; k2 < 2; ++k2) { const int r0 = 32 * k2 + 8 * g + tq, r1 = r0 + 4, cch = 2 * vb2 + (tp >> 1);
                  const s16x4 t0 = __builtin_amdgcn_ds_read_tr16_b64_v4i16((LAS s16x4*)(lds + VS + r0 * 128 + ((cch ^ ((r0 >> 1) & 7)) << 4) + 8 * (tp & 1)));
                  const s16x4 t1 = __builtin_amdgcn_ds_read_tr16_b64_v4i16((LAS s16x4*)(lds + VS + r1 * 128 + ((cch ^ ((r1 >> 1) & 7)) << 4) + 8 * (tp & 1)));
                  const int j0 = 32 * k2 + 8 * g; float kd[8];
#pragma unroll
                  for (int e = 0; e < 8; ++e) kd[e] = __builtin_amdgcn_exp2f(lg * (float)(dir ? j0 + e : 63 - j0 - e));
                  u32x4 aw; aw.x = cvt_pk_bf16(bf2f((bf16_t)t0[0]) * kd[0], bf2f((bf16_t)t0[1]) * kd[1]); aw.y = cvt_pk_bf16(bf2f((bf16_t)t0[2]) * kd[2], bf2f((bf16_t)t0[3]) * kd[3]);
                  aw.z = cvt_pk_bf16(bf2f((bf16_t)t1[0]) * kd[4], bf2f((bf16_t)t1[1]) * kd[5]); aw.w = cvt_pk_bf16(bf2f((bf16_t)t1[2]) * kd[6], bf2f((bf16_t)t1[3]) * kd[7]);
                  af[k2] = __builtin_bit_cast(bf16x8, aw); }
#pragma unroll
              for (int x = 0; x < 8; ++x) { accS[x] *= g64; const int db = dbase + x;
#pragma unroll
                  for (int k2 = 0; k2 < 2; ++k2) { const int r0 = 32 * k2 + 8 * g + tq, r1 = r0 + 4;
                      const s16x4 t0 = __builtin_amdgcn_ds_read_tr16_b64_v4i16((LAS s16x4*)(lds + KS + r0 * 512 + (((2 * db + (tp >> 1)) ^ (r0 & 15)) << 4) + 8 * (tp & 1)));
                      const s16x4 t1 = __builtin_amdgcn_ds_read_tr16_b64_v4i16((LAS s16x4*)(lds + KS + r1 * 512 + (((2 * db + (tp >> 1)) ^ (r1 & 15)) << 4) + 8 * (tp & 1)));
                      const bf16x8 bfr = {t0[0], t0[1], t0[2], t0[3], t1[0], t1[1], t1[2], t1[3]};
                      accS[x] = __builtin_amdgcn_mfma_f32_16x16x32_bf16(af[k2], bfr, accS[x], 0, 0, 0); }
                  __builtin_amdgcn_sched_barrier(0); } }
            if (have_o) {
#pragma unroll
                for (int vb = 0; vb < 2; ++vb) { bf16_t* op = Og + (size_t)(row0 + 16 * ib + c) * 2048 + h * 512 + vs * 64 + 16 * (2 * vh + vb) + 4 * g; f32x4 o = osave[vb];
                    if (dir) { o[0] += bflo(pv[vb].x); o[1] += bfhi(pv[vb].x); o[2] += bflo(pv[vb].y); o[3] += bfhi(pv[vb].y); }
                    u32x2 ow; ow.x = cvt_pk_bf16(o[0], o[1]); ow.y = cvt_pk_bf16(o[2], o[3]); *(u32x2*)op = ow; } }
        }
        __syncthreads();
    }
}

__device__ __forceinline__ void phase_ret_finish(const Args& a, int row_begin, const Grp& gp) {
    bf16_t* Og = (bf16_t*)(a.ws + WS_BIG + 4 * R1); const bf16_t* Gg = (const bf16_t*)(a.ws + WS_BIG);
    const int tid = otid(), lane = tid & 63, gw = gp.rank * 8 + (tid >> 6), nw = gp.gsize * 8, nrows = gp.nb * (row_begin ? 4096 : 4352);
    for (int lr = gw; lr < nrows; lr += nw) { const int row = row_begin ? grp_row_lat(gp, lr) : grp_row(gp, lr);
        const size_t base = (size_t)row * 2048 + (lane >> 4) * 512 + (lane & 15) * 32;
        float v[32]; float s = 0.f;
#pragma unroll
        for (int q = 0; q < 4; ++q) { const u32x4 w = *(const u32x4*)(Og + base + q * 8);
            v[q * 8 + 0] = bflo(w.x); v[q * 8 + 1] = bfhi(w.x); v[q * 8 + 2] = bflo(w.y); v[q * 8 + 3] = bfhi(w.y); v[q * 8 + 4] = bflo(w.z); v[q * 8 + 5] = bfhi(w.z); v[q * 8 + 6] = bflo(w.w); v[q * 8 + 7] = bfhi(w.w); }
#pragma unroll
        for (int i = 0; i < 32; ++i) s += v[i];
        s += shx(s, lane, 1); s += shx(s, lane, 2); s += shx(s, lane, 4); s += shx(s, lane, 8);
        const float mean = s * (1.f / 512.f); float qv = 0.f;
#pragma unroll
        for (int i = 0; i < 32; ++i) { const float d = v[i] - mean; qv += d * d; }
        qv += shx(qv, lane, 1); qv += shx(qv, lane, 2); qv += shx(qv, lane, 4); qv += shx(qv, lane, 8);
        const float rstd = 1.0f / sqrtf(qv * (1.f / 512.f) + LN_EPS);
#pragma unroll
        for (int q = 0; q < 4; ++q) { const u32x4 gwd = *(const u32x4*)(Gg + base + q * 8); const unsigned gw4[4] = {gwd.x, gwd.y, gwd.z, gwd.w}; unsigned ow[4];
#pragma unroll
            for (int p = 0; p < 4; ++p) { const float g0 = bflo(gw4[p]), g1 = bfhi(gw4[p]);
                ow[p] = cvt_pk_bf16(silu_f(g0) * (v[q * 8 + 2 * p] - mean) * rstd, silu_f(g1) * (v[q * 8 + 2 * p + 1] - mean) * rstd); }
            u32x4 o; o.x = ow[0]; o.y = ow[1]; o.z = ow[2]; o.w = ow[3]; *(u32x4*)(Og + base + q * 8) = o; }
    }
}

template <int ABL>
__device__ __forceinline__ void phase_na(const Args& a, LAS unsigned char* lds0, bf16_t* Odst, const Grp& gp) {
    const bf16_t* Qg = (const bf16_t*)(a.ws + WS_BIG); const bf16_t* Kg = (const bf16_t*)(a.ws + WS_BIG + R1); const bf16_t* Vg = (const bf16_t*)(a.ws + WS_BIG + 2 * R1);
    const int tid = otid(), w = __builtin_amdgcn_readfirstlane(tid >> 6), lane = tid & 63, c = lane & 15, g = lane >> 4, hb = w >> 2, w4 = w & 3, t2 = tid & 255;
    LAS unsigned char* lds = lds0 + hb * 65536;
    constexpr int QS = 0, KS = 32768, VT = 40960, RP = 49152;
    float mk[4][4]; int rco[4][4];
    { const int q0 = 16 * w4 + c, cs0 = min(max(q0 - 8, 0), 48);
#pragma unroll
      for (int kb = 0; kb < 4; ++kb)
#pragma unroll
          for (int e = 0; e < 4; ++e) { const int kc = 16 * kb + 4 * g + e; mk[kb][e] = (kc >= cs0 && kc < cs0 + 16) ? 0.f : -1e30f; rco[kb][e] = min(max(kc - q0 + 15, 0), 30) * 4; } }
    const int kb_lo = min(max(16 * w4 - 8, 0), 48) >> 4, kb_hi = (min(max(16 * w4 + 7, 0), 48) + 15) >> 4;
    for (int base_it = gp.rank * 2; base_it < gp.nb * 272; base_it += gp.gsize * 2) {
        const int it = base_it + hb, bb = it / 272, idx = it - bb * 272; const bool isl = (base_it % 272) < 256;
        const int b = gp.b_lo + bb; int h, r0 = 0, kr_lo = 0, kr_hi = 0;
        if (isl) { h = idx >> 4; r0 = (idx & 15) * 4; kr_lo = min(max(r0 - 4, 0), 56); kr_hi = min(max(r0 - 1, 0), 56) + 7; }
        else { h = idx - 256; }
        const int ntile = isl ? 15 : 4;
        __syncthreads();
#pragma unroll
        for (int i = 0; i < 8; ++i) { const int idx = t2 + 256 * i, row = idx >> 3, ch = idx & 7, rr = row >> 6, qi = row & 63;
            const int grow = isl ? MCTX + b * 4096 + (r0 + rr) * 64 + qi : b * 256 + rr * 64 + qi;
            *(LAS u32x4*)(lds + QS + row * 128 + ((ch ^ ((row >> 1) & 7)) << 4)) = *(const u32x4*)(Qg + (size_t)grow * 1024 + h * 64 + ch * 8); }
        for (int i = t2; i < 465; i += 256) *(LAS float*)(lds + RP + i * 4) = a.na_rpb[h * 465 + i];
        u32x4 kreg[2], vreg[2];
        { const int row0 = isl ? MCTX + b * 4096 + kr_lo * 64 : b * 256;
#pragma unroll
          for (int i = 0; i < 2; ++i) { const int idx = t2 + 256 * i, row = idx >> 3, ch = idx & 7; const size_t o = ((size_t)h * MTOT + row0 + row) * 64 + ch * 8; kreg[i] = *(const u32x4*)(Kg + o); vreg[i] = *(const u32x4*)(Vg + o); } }
        const int q = 16 * w4 + c;
        f32x4 oacc[4][4]; float mrun[4], lrun[4];
#pragma unroll
        for (int rr = 0; rr < 4; ++rr) { mrun[rr] = -1e30f; lrun[rr] = 0.f;
#pragma unroll
            for (int db = 0; db < 4; ++db) oacc[rr][db] = (f32x4){0.f, 0.f, 0.f, 0.f}; }
        for (int tl = 0; tl < ntile; ++tl) {
            if (ABL == 3) break;
            if (ABL == 4) { __syncthreads(); __syncthreads(); continue; }
            __syncthreads();
#pragma unroll
            for (int i = 0; i < 2; ++i) { const int idx = t2 + 256 * i, row = idx >> 3, ch = idx & 7;
                *(LAS u32x4*)(lds + KS + row * 128 + ((ch ^ ((row >> 1) & 7)) << 4)) = kreg[i];
                const unsigned vw[4] = {vreg[i].x, vreg[i].y, vreg[i].z, vreg[i].w};
#pragma unroll
                for (int e = 0; e < 8; ++e) { const int d = ch * 8 + e; const bf16_t val = (bf16_t)((e & 1) ? (vw[e >> 1] >> 16) : (vw[e >> 1] & 0xffffu));
                    *(LAS bf16_t*)(lds + VT + d * 128 + (((row >> 3) ^ ((d >> 1) & 7)) << 4) + (row & 7) * 2) = val; } }
            __syncthreads();
            if (tl + 1 < ntile) { const int t1 = tl + 1;
                const int row0 = isl ? (t1 < 11 ? MCTX + b * 4096 + min(kr_lo + t1, kr_hi) * 64 : b * 256 + (t1 - 11) * 64) : b * 256 + t1 * 64;
#pragma unroll
                for (int i = 0; i < 2; ++i) { const int idx = t2 + 256 * i, row = idx >> 3, ch = idx & 7; const size_t o = ((size_t)h * MTOT + row0 + row) * 64 + ch * 8; kreg[i] = *(const u32x4*)(Kg + o); vreg[i] = *(const u32x4*)(Vg + o); } }
            if (ABL == 2) continue;
            const bool local = isl && tl < 11; const int krow = kr_lo + tl;
            if (local && krow > kr_hi) continue;
#pragma unroll
            for (int rr = 0; rr < 4; ++rr) {
                const int r = r0 + rr, rs = min(max(r - 4, 0), 56);
                if (local && (krow < rs || krow >= rs + 8)) continue;
                bf16x8 qf[2];
#pragma unroll
                for (int ks = 0; ks < 2; ++ks) { const int qrow = rr * 64 + q; qf[ks] = *(const LAS bf16x8*)(lds + QS + qrow * 128 + (((4 * ks + g) ^ ((qrow >> 1) & 7)) << 4)); }
                f32x4 sT[4];
#pragma unroll
                for (int kb = 0; kb < 4; ++kb) { const bool skip = local && (kb < kb_lo || kb > kb_hi);
                    if (skip) { sT[kb] = (f32x4){-1e30f, -1e30f, -1e30f, -1e30f}; continue; }
                    sT[kb] = (f32x4){0.f, 0.f, 0.f, 0.f}; const int kr = 16 * kb + c;
#pragma unroll
                    for (int ks = 0; ks < 2; ++ks) { const bf16x8 kf = *(const LAS bf16x8*)(lds + KS + kr * 128 + (((4 * ks + g) ^ ((kr >> 1) & 7)) << 4)); sT[kb] = __builtin_amdgcn_mfma_f32_16x16x32_bf16(kf, qf[ks], sT[kb], 0, 0, 0); }
                    if (local) { const int rbase = RP + (krow - r + 7) * 124;
#pragma unroll
                        for (int e = 0; e < 4; ++e) sT[kb][e] = (sT[kb][e] + *(const LAS float*)(lds + rbase + rco[kb][e])) + mk[kb][e]; } }
                if (ABL == 1) { oacc[rr][0] += sT[0] + sT[1] + sT[2] + sT[3]; continue; }
                float mx = -1e30f;
#pragma unroll
                for (int kb = 0; kb < 4; ++kb) mx = fmaxf(mx, fmaxf(fmaxf(sT[kb][0], sT[kb][1]), fmaxf(sT[kb][2], sT[kb][3])));
                mx = fmaxf(mx, shx(mx, lane, 16)); mx = fmaxf(mx, shx(mx, lane, 32));
                const float mnew = fmaxf(mrun[rr], mx), alpha = __builtin_amdgcn_exp2f((mrun[rr] - mnew) * LOG2E); mrun[rr] = mnew;
                float ps = 0.f;
#pragma unroll
                for (int kb = 0; kb < 4; ++kb)
#pragma unroll
                    for (int e = 0; e < 4; ++e) { const float p = __builtin_amdgcn_exp2f((sT[kb][e] - mnew) * LOG2E); sT[kb][e] = p; ps += p; }
                ps += shx(ps, lane, 16); ps += shx(ps, lane, 32);
                lrun[rr] = lrun[rr] * alpha + ps;
#pragma unroll
                for (int db = 0; db < 4; ++db) oacc[rr][db] *= alpha;
#pragma unroll
                for (int s2 = 0; s2 < 2; ++s2) {
                    if (local && (2 * s2 + 1 < kb_lo || 2 * s2 > kb_hi)) continue;
                    u32x4 pw; pw.x = cvt_pk_bf16(sT[2 * s2][0], sT[2 * s2][1]); pw.y = cvt_pk_bf16(sT[2 * s2][2], sT[2 * s2][3]); pw.z = cvt_pk_bf16(sT[2 * s2 + 1][0], sT[2 * s2 + 1][1]); pw.w = cvt_pk_bf16(sT[2 * s2 + 1][2], sT[2 * s2 + 1][3]);
                    const bf16x8 pf = __builtin_bit_cast(bf16x8, pw);
#pragma unroll
                    for (int db = 0; db < 4; ++db) { const int vrow = 16 * db + c; const int sw = (vrow >> 1) & 7;
                        const u32x2 lo = *(const LAS u32x2*)(lds + VT + vrow * 128 + (((4 * s2 + (g >> 1)) ^ sw) << 4) + (g & 1) * 8);
                        const u32x2 hi = *(const LAS u32x2*)(lds + VT + vrow * 128 + (((4 * s2 + 2 + (g >> 1)) ^ sw) << 4) + (g & 1) * 8);
                        u32x4 vw; vw.x = lo.x; vw.y = lo.y; vw.z = hi.x; vw.w = hi.y;
                        oacc[rr][db] = __builtin_amdgcn_mfma_f32_16x16x32_bf16(__builtin_bit_cast(bf16x8, vw), pf, oacc[rr][db], 0, 0, 0); }
                }
            }
        }
        __syncthreads();
#pragma unroll
        for (int rr = 0; rr < 4; ++rr) { const float inv = 1.0f / lrun[rr]; const int orow = rr * 64 + q;
#pragma unroll
            for (int db = 0; db < 4; ++db) { const f32x4 o = oacc[rr][db] * inv; u32x2 ow; ow.x = cvt_pk_bf16(o[0], o[1]); ow.y = cvt_pk_bf16(o[2], o[3]);
                *(LAS u32x2*)(lds + QS + orow * 128 + (((2 * db + (g >> 1)) ^ ((orow >> 1) & 7)) << 4) + (g & 1) * 8) = ow; } }
        __syncthreads();
#pragma unroll
        for (int i = 0; i < 8; ++i) { const int idx = t2 + 256 * i, row = idx >> 3, ch = idx & 7, rr = row >> 6, qi = row & 63;
            const int grow = isl ? MCTX + b * 4096 + (r0 + rr) * 64 + qi : b * 256 + rr * 64 + qi;
            *(u32x4*)(Odst + (size_t)grow * 1024 + h * 64 + ch * 8) = *(const LAS u32x4*)(lds + QS + row * 128 + ((ch ^ ((row >> 1) & 7)) << 4)); }
    }
    __syncthreads();
}

__device__ __forceinline__ void phase_lru_conv(const Args& a, const Grp& gp) {
    const bf16_t* XR = (const bf16_t*)(a.ws + WS_BIG + R1); bf16_t* XC = (bf16_t*)(a.ws + WS_BIG + 2 * R1);
    const int i0 = gp.rank * 512 + otid(), c8 = (i0 & 127) * 8;
    const f32x4 b0 = *(const f32x4*)(a.lru_conv_b + c8), b1 = *(const f32x4*)(a.lru_conv_b + c8 + 4);
    f32x4 w0[4], w1[4];
#pragma unroll
    for (int j = 0; j < 4; ++j) { w0[j] = *(const f32x4*)(a.lru_conv_w + j * 1024 + c8); w1[j] = *(const f32x4*)(a.lru_conv_w + j * 1024 + c8 + 4); }
    for (int i = i0; i < gp.nb * 4352 * 128; i += gp.gsize * 512) {
        const int row = grp_row(gp, i >> 7); const bool isc = row < MCTX; const int t = isc ? (row & 255) : ((row - MCTX) & 4095), len = isc ? 256 : 4096;
        float acc[8] = {b0[0], b0[1], b0[2], b0[3], b1[0], b1[1], b1[2], b1[3]};
#pragma unroll
        for (int j = 0; j < 4; ++j) { const int tt = t - 2 + j;
            if (tt >= 0 && tt < len) { const u32x4 xw = *(const u32x4*)(XR + (size_t)(row - 2 + j) * 1024 + c8);
                acc[0] += w0[j][0] * bflo(xw.x); acc[1] += w0[j][1] * bfhi(xw.x); acc[2] += w0[j][2] * bflo(xw.y); acc[3] += w0[j][3] * bfhi(xw.y);
                acc[4] += w1[j][0] * bflo(xw.z); acc[5] += w1[j][1] * bfhi(xw.z); acc[6] += w1[j][2] * bflo(xw.w); acc[7] += w1[j][3] * bfhi(xw.w); } }
        u32x4 o; o.x = cvt_pk_bf16(acc[0], acc[1]); o.y = cvt_pk_bf16(acc[2], acc[3]); o.z = cvt_pk_bf16(acc[4], acc[5]); o.w = cvt_pk_bf16(acc[6], acc[7]);
        *(u32x4*)(XC + (size_t)row * 1024 + c8) = o;
    }
}
__device__ __forceinline__ void phase_lru_scan(const Args& a, int dir, int pass, const Grp& gp) {
    const bf16_t* GATE = (const bf16_t*)(a.ws + WS_BIG); bf16_t* HF = (bf16_t*)(a.ws + WS_BIG + R1); const bf16_t* XC = (const bf16_t*)(a.ws + WS_BIG + 2 * R1); const bf16_t* GP = (const bf16_t*)(a.ws + WS_BIG + 3 * R1);
    float* CARRY = (float*)(a.ws + WS_CARRY);
    for (int idx = gp.rank * 512 + otid(); idx < gp.nb * 64 * 256; idx += gp.gsize * 512) {
        const int cq = idx & 255, chunk = (idx >> 8) & 63, b = gp.b_lo + (idx >> 14), c0 = cq * 4;
        float ba[4], bx[4], sp[4], h[4], P[4];
        { const f32x4 t0 = *(const f32x4*)(a.lru_b_a + dir * 1024 + c0), t1 = *(const f32x4*)(a.lru_b_x + dir * 1024 + c0), t2 = *(const f32x4*)(a.lru_lam + dir * 1024 + c0);
#pragma unroll
          for (int k = 0; k < 4; ++k) { ba[k] = t0[k]; bx[k] = t1[k]; sp[k] = -8.f * log1pf(expf(-t2[k])); h[k] = 0.f; P[k] = 1.f; } }
        if (pass == 2) { for (int cc = 0; cc < chunk; ++cc) { const float* cp = CARRY + ((size_t)(b * 64 + cc) * 256 + cq) * 8; const f32x4 pp = *(const f32x4*)cp, ll = *(const f32x4*)(cp + 4);
#pragma unroll
            for (int k = 0; k < 4; ++k) h[k] = pp[k] * h[k] + ll[k]; } }
        for (int t4 = 0; t4 < 17; ++t4) {
            u32x2 rw[4], iw[4], xw[4], hw[4], gw[4]; int rows[4];
#pragma unroll
            for (int j = 0; j < 4; ++j) { const int p = chunk * 68 + t4 * 4 + j;
                const int row = dir ? (p < 256 ? b * 256 + (255 - p) : MCTX + b * 4096 + (4095 - (p - 256))) : (p < 256 ? b * 256 + p : MCTX + b * 4096 + (p - 256));
                rows[j] = row;
                rw[j] = *(const u32x2*)(GP + (size_t)row * 2048 + c0); iw[j] = *(const u32x2*)(GP + (size_t)row * 2048 + 1024 + c0); xw[j] = *(const u32x2*)(XC + (size_t)row * 1024 + c0);
                if (pass == 2 && dir == 1) { hw[j] = *(const u32x2*)(HF + (size_t)row * 1024 + c0); gw[j] = *(const u32x2*)(GATE + (size_t)row * 1024 + c0); } }
#pragma unroll
            for (int j = 0; j < 4; ++j) {
                const float rp[4] = {bflo(rw[j].x), bfhi(rw[j].x), bflo(rw[j].y), bfhi(rw[j].y)}, ip[4] = {bflo(iw[j].x), bfhi(iw[j].x), bflo(iw[j].y), bfhi(iw[j].y)}, xv[4] = {bflo(xw[j].x), bfhi(xw[j].x), bflo(xw[j].y), bfhi(xw[j].y)};
#pragma unroll
                for (int k = 0; k < 4; ++k) { const float la = sp[k] * sigmoid_f(rp[k] + ba[k]); const float av = __expf(la); const float m = sqrtf(fmaxf(-expm1f(2.f * la), 0.f));
                    h[k] = av * h[k] + m * sigmoid_f(ip[k] + bx[k]) * xv[k]; if (pass == 1) P[k] *= av; }
                if (pass == 2) { bf16_t* hp = HF + (size_t)rows[j] * 1024 + c0; u32x2 o;
                    if (dir == 0) { o.x = cvt_pk_bf16(h[0], h[1]); o.y = cvt_pk_bf16(h[2], h[3]); }
                    else { o.x = cvt_pk_bf16(gelu_tanh_f(bflo(gw[j].x)) * (bflo(hw[j].x) + h[0]), gelu_tanh_f(bfhi(gw[j].x)) * (bfhi(hw[j].x) + h[1]));
                           o.y = cvt_pk_bf16(gelu_tanh_f(bflo(gw[j].y)) * (bflo(hw[j].y) + h[2]), gelu_tanh_f(bfhi(gw[j].y)) * (bfhi(hw[j].y) + h[3])); }
                    *(u32x2*)hp = o; }
            }
        }
        if (pass == 1) { float* cp = CARRY + ((size_t)(b * 64 + chunk) * 256 + cq) * 8; *(f32x4*)cp = (f32x4){P[0], P[1], P[2], P[3]}; *(f32x4*)(cp + 4) = (f32x4){h[0], h[1], h[2], h[3]}; }
    }
}
constexpr int NPHASE = 52;
enum { OP_PROLOGUE, OP_U0, OP_GEMM_SWIGLU, OP_GEMM_PLAIN, OP_GEMM_RETIN, OP_GEMM_GATES, OP_POSTNORM, OP_RETSCAN, OP_RETFIN, OP_NAATT, OP_LRUCONV, OP_LRUSCAN };

typedef const Args __attribute__((address_space(4)))* KArgsPtr;
__global__ void __launch_bounds__(512) hybrid_fwd(Args a_in) {
    extern __shared__ __attribute__((aligned(16))) unsigned char lds_raw[];
    LAS unsigned char* lds = (LAS unsigned char*)lds_raw;
    const int ph_lo = a_in.ph_lo, ph_hi = a_in.ph_hi;
    volatile LAS unsigned* xb_st = (volatile LAS unsigned*)(lds + LDS_BYTES - 16);
    unsigned* xb_bar = (unsigned*)(a_in.ws + WS_BAR);
    if (threadIdx.x < 4) xb_st[threadIdx.x] = 0u;
    __syncthreads();
    if (threadIdx.x == 0) { const unsigned x = xb_xcc_id(); const unsigned r = xb_add(&xb_bar[XB_XCNT(x)], 1u); xb_st[2] = r | (x << 8); }
    int nexec = 0;
#ifdef PROBE_DBL
    for (int pp = 2 * ph_lo; pp < 2 * ph_hi; ++pp) { const int p = pp >> 1;
#else
    for (int p = ph_lo; p < ph_hi; ++p) {
#endif
#if defined(__HIP_DEVICE_COMPILE__)
        KArgsPtr ka = (KArgsPtr)__builtin_amdgcn_kernarg_segment_ptr(); asm volatile("" : "+s"(ka));
        Args a; __builtin_memcpy(&a, ka, sizeof(Args));
#else
        const Args a = a_in;
#endif
        bf16_t* WT = (bf16_t*)(a.ws + WS_WT); bf16_t* U = (bf16_t*)(a.ws + WS_U); unsigned char* BIG = a.ws + WS_BIG; const float* MOD = (const float*)(a.ws + WS_MOD);
        int op = OP_PROLOGUE, l = 0, s = 0, kind = 0, mi = 0, rb = 0, gsel = 0, sdir = 0, spass = 0; bool mixpn = false;
        if (p == 0) op = OP_PROLOGUE;
        else if (p == 1) op = OP_U0;
        else {
            const int q = p - 2; int li;
            if (q < 12) { l = 0; li = q; } else if (q < 22) { l = 1; li = q - 12; } else if (q < 38) { l = 2; li = q - 22; } else { l = 3; li = q - 38; }
            kind = l % 3; mi = l / 3; const int nmix = kind == 0 ? 6 : (kind == 1 ? 4 : 10);
            rb = (l == 3 && li >= 5) ? MCTX : 0;
            if (li < 3 || li >= 3 + nmix) {
                s = li < 3 ? 0 : 1; const int fs = li < 3 ? li : li - 3 - nmix;
                if (fs == 0) op = OP_GEMM_SWIGLU; else if (fs == 1) { op = OP_GEMM_PLAIN; gsel = 0; } else op = OP_POSTNORM;
            } else {
                const int ms = li - 3;
                if (ms == nmix - 1) { op = OP_POSTNORM; mixpn = true; }
                else if (kind == 0) { if (ms == 0) op = OP_GEMM_RETIN; else if (ms == 1) op = OP_RETSCAN; else if (ms == 2) { op = OP_GEMM_PLAIN; gsel = 1; } else if (ms == 3) op = OP_RETFIN; else { op = OP_GEMM_PLAIN; gsel = 2; } }
                else if (kind == 1) { if (ms == 0) { op = OP_GEMM_PLAIN; gsel = 3; } else if (ms == 1) op = OP_NAATT; else { op = OP_GEMM_PLAIN; gsel = 4; } }
                else { if (ms == 0) { op = OP_GEMM_PLAIN; gsel = 5; } else if (ms == 1) op = OP_LRUCONV; else if (ms == 2 || ms == 5) { op = OP_GEMM_GATES; sdir = ms == 5 ? 1 : 0; }
                       else if (ms == 3 || ms == 4) { op = OP_LRUSCAN; sdir = 0; spass = ms - 2; } else if (ms == 6 || ms == 7) { op = OP_LRUSCAN; sdir = 1; spass = ms - 5; } else { op = OP_GEMM_PLAIN; gsel = 6; } }
            }
        }
#ifdef PROBE_DBL
#if PROBE_DBL == 10
        if ((pp & 1) && p != 0) continue;
#else
        if (pp & 1) { const bool pdbl = (PROBE_DBL == 1) ? (op == OP_GEMM_SWIGLU || op == OP_GEMM_PLAIN || op == OP_GEMM_RETIN || op == OP_GEMM_GATES)
                        : (PROBE_DBL == 3) ? (op == OP_RETSCAN) : (PROBE_DBL == 10) ? (op == OP_PROLOGUE) : (PROBE_DBL == 8) ? (op == OP_GEMM_SWIGLU) : (PROBE_DBL == 5) ? (op == OP_NAATT) : (PROBE_DBL == 6) ? (op == OP_LRUCONV || (op == OP_LRUSCAN && !(sdir == 1 && spass == 2))) : (PROBE_DBL == 2) ? (op == OP_POSTNORM && l == 0 && s == 0 && !mixpn) : false;
            if (!pdbl) continue; }
#endif
#endif
        { const unsigned xm = (unsigned)__builtin_amdgcn_readfirstlane((int)xb_st[3]);
          const bool relayout = (op == OP_GEMM_SWIGLU && s == 1) || op == OP_GEMM_RETIN || (op == OP_GEMM_PLAIN && (gsel == 1 || gsel == 3 || gsel == 5));
          if (nexec == 1) cg::this_grid().sync();
          else if (nexec > 1) { if (xm && !relayout) xcd_local_barrier((unsigned*)(a.ws + WS_BAR), ((unsigned)__builtin_amdgcn_readfirstlane((int)xb_st[2]) >> 8) & 0xffu, 32u);
                                else xcd_barrier((unsigned*)(a.ws + WS_BAR), xb_st); } }
        if (nexec == 1 && ph_lo == 0) {
            if (threadIdx.x == 0) { bool ok = gridDim.x == 256;
                for (unsigned j = 0; j < 16; ++j) { const unsigned cnt = xb_ld(&xb_bar[XB_XCNT(j)]); ok = ok && (j < 8 ? cnt == 32u : cnt == 0u); }
#ifdef PROBE_NO_XMODE
                ok = false;
#endif
                xb_st[3] = ok ? 1u : 0u; }
            __syncthreads(); }
        ++nexec;
        const unsigned gword = (unsigned)__builtin_amdgcn_readfirstlane((int)xb_st[2]), xmode = (unsigned)__builtin_amdgcn_readfirstlane((int)xb_st[3]);
        Grp grp; if (xmode) { grp.b_lo = (int)((gword >> 8) & 0xffu); grp.nb = 1; grp.rank = (int)(gword & 0xffu); grp.gsize = 32; } else { grp.b_lo = 0; grp.nb = 8; grp.rank = (int)blockIdx.x; grp.gsize = (int)gridDim.x; }
        switch (op) {
#ifndef NO_OP_PROLOGUE
            case OP_PROLOGUE: phase_prologue(a, lds); break;
#endif
#ifndef NO_OP_U0
            case OP_U0: phase_u0(a, grp); break;
#endif
#ifndef NO_OP_GEMM_SWIGLU
            case OP_GEMM_SWIGLU: { const pg8::Gemm gg{U, WT + E_FFN_IN + (size_t)(l * 2 + s) * 5632 * 1024, MTOT, 5632, 1024, 1024, 0, 0};
                pg8::GroupOrder S; S.init(grp.nb, grp.b_lo, rb != 0, gg.N, grp.gsize, grp.rank); EpiSwiGLU E{(bf16_t*)BIG, 0}; pg8::gemm_phase<EpiSwiGLU, pg8::GroupOrder>(lds, gg, S, E); } break;
#endif
#ifndef NO_OP_GEMM_PLAIN
            case OP_GEMM_PLAIN: { const bf16_t* gA; const bf16_t* gB; int gN, gK, glda; bf16_t* eO; int eldc = 1024, esplit = 0, ehm = 0; size_t estride = 0; float escale = 1.f;
                if (gsel == 0)      { gA = (const bf16_t*)BIG; gB = WT + E_FFN_OUT + (size_t)(l * 2 + s) * 1024 * 2816; gN = 1024; gK = 2816; glda = 2816; eO = (bf16_t*)(BIG + 3 * R1); }
                else if (gsel == 1) { gA = U; gB = WT + E_RET_IN + (size_t)mi * 6144 * 1024 + (size_t)4096 * 1024; gN = 2048; gK = 1024; glda = 1024; eO = (bf16_t*)BIG; eldc = 2048; }
                else if (gsel == 2) { gA = (const bf16_t*)(BIG + 4 * R1); gB = WT + E_RET_OUT + (size_t)mi * 1024 * 2048; gN = 1024; gK = 2048; glda = 2048; eO = (bf16_t*)(BIG + 2 * R1); }
                else if (gsel == 3) { gA = U; gB = WT + E_NA_QKV; gN = 3072; gK = 1024; glda = 1024; eO = (bf16_t*)BIG; esplit = 1024; estride = R1 / 2; escale = 0.125f; ehm = 1; }
                else if (gsel == 4) { gA = (const bf16_t*)BIG; gB = WT + E_NA_OUT; gN = 1024; gK = 1024; glda = 1024; eO = (bf16_t*)(BIG + 3 * R1); }
                else if (gsel == 5) { gA = U; gB = WT + E_LRU_IN; gN = 2048; gK = 1024; glda = 1024; eO = (bf16_t*)BIG; esplit = 1024; estride = R1 / 2; }
                else                { gA = (const bf16_t*)(BIG + R1); gB = WT + E_LRU_OUT; gN = 1024; gK = 1024; glda = 1024; eO = (bf16_t*)(BIG + 2 * R1); }
                const pg8::Gemm gg{gA, gB, MTOT, gN, gK, glda, 0, 0}; pg8::GroupOrder S; S.init(grp.nb, grp.b_lo, rb != 0, gg.N, grp.gsize, grp.rank);
                EpiPlain E{eO, eldc, 0, esplit, estride, escale, ehm}; pg8::gemm_phase<EpiPlain, pg8::GroupOrder>(lds, gg, S, E); } break;
#endif
#ifndef NO_OP_GEMM_RETIN
            case OP_GEMM_RETIN: { const pg8::Gemm gg{U, WT + E_RET_IN + (size_t)mi * 6144 * 1024, MTOT, 4096, 1024, 1024, 0, 0}; pg8::GroupOrder S; S.init(grp.nb, grp.b_lo, false, gg.N, grp.gsize, grp.rank);
                EpiRetIn E{(bf16_t*)BIG, (bf16_t*)(BIG + R1), (bf16_t*)(BIG + 2 * R1), (const float*)(a.ws + WS_ROPE), (const float*)(a.ws + WS_ROPE) + 4096}; pg8::gemm_phase<EpiRetIn, pg8::GroupOrder>(lds, gg, S, E); } break;
#endif
#ifndef NO_OP_GEMM_GATES
            case OP_GEMM_GATES: { const pg8::Gemm gg{(const bf16_t*)(BIG + 2 * R1), WT + E_GATES + (size_t)sdir * 2048 * 256, MTOT, 2048, 256, 1024, 1, 256}; pg8::GroupOrder S; S.init(grp.nb, grp.b_lo, false, gg.N, grp.gsize, grp.rank);
                EpiGates E{(bf16_t*)(BIG + 3 * R1)}; pg8::gemm_phase<EpiGates, pg8::GroupOrder>(lds, gg, S, E); } break;
#endif
#ifndef NO_OP_POSTNORM
            case OP_POSTNORM: { const float* modl = MOD + (size_t)l * 9 * 9216;
                if (mixpn) phase_postnorm(a, false, (const bf16_t*)(BIG + (kind == 1 ? 3 : 2) * R1), modl, 5, 1.f, a.ln_g + (size_t)(l * 3 + 1) * 1024, a.ln_b + (size_t)(l * 3 + 1) * 1024, modl, 6, rb, grp);
                else { const int li3 = l * 3 + (s == 0 ? 0 : 2); const float* modn = (s == 0) ? modl : MOD + (size_t)(l < 3 ? l + 1 : l) * 9 * 9216; const int psh = (s == 0) ? 3 : (l < 3 ? 0 : -1);
                    phase_postnorm(a, l == 0 && s == 0, (const bf16_t*)(BIG + 3 * R1), modl, s == 0 ? 2 : 8, 0.5f, a.ln_g + (size_t)li3 * 1024, a.ln_b + (size_t)li3 * 1024, modn, psh, rb, grp); } } break;
#endif
#ifndef NO_OP_RETSCAN
#if defined(PROBE_DBL) && PROBE_DBL == 3
#ifndef PROBE_RET_ABL
#define PROBE_RET_ABL 0
#endif
            case OP_RETSCAN: if (pp & 1) phase_retention<0>(a, lds, grp, l == 3); else phase_retention<PROBE_RET_ABL>(a, lds, grp, l == 3); break;
#else
            case OP_RETSCAN: phase_retention<0>(a, lds, grp, l == 3); break;
#endif
#endif
#ifndef NO_OP_RETFIN
            case OP_RETFIN: phase_ret_finish(a, rb, grp); break;
#endif
#ifndef NO_OP_NAATT
#if defined(PROBE_DBL) && PROBE_DBL == 5
#ifndef PROBE_NA_ABL
#define PROBE_NA_ABL 0
#endif
            case OP_NAATT: if (pp & 1) phase_na<0>(a, lds, (bf16_t*)BIG, grp); else phase_na<PROBE_NA_ABL>(a, lds, (bf16_t*)(BIG + 3 * R1), grp); break;
#else
            case OP_NAATT: phase_na<0>(a, lds, (bf16_t*)BIG, grp); break;
#endif
#endif
#ifndef NO_OP_LRUCONV
            case OP_LRUCONV: phase_lru_conv(a, grp); break;
#endif
#ifndef NO_OP_LRUSCAN
            case OP_LRUSCAN: phase_lru_scan(a, sdir, spass, grp); break;
#endif
            default: break;
        }
    }
}

#ifndef MK_PER_PHASE
#define MK_PER_PHASE 0
#endif
extern "C" void kernel_launch(void* const* d_in, const int* in_sizes, int n_in, void* d_out, int out_size, void* d_ws, size_t ws_size, hipStream_t stream) {
    static int grid = 0;
    if (grid == 0) {
        if (n_in != 24 || out_size != MLAT * 1024 || ws_size < WS_END) { fprintf(stderr, "kernel_launch: unexpected shapes: n_in %d out %d ws %zu (need %zu)\n", n_in, out_size, ws_size, (size_t)WS_END); grid = -1; return; }
        int dev = 0, cus = 0, per_cu = 0;
        if (hipGetDevice(&dev) != hipSuccess || hipDeviceGetAttribute(&cus, hipDeviceAttributeMultiprocessorCount, dev) != hipSuccess) { grid = -1; return; }
        if (hipFuncSetAttribute((const void*)hybrid_fwd, hipFuncAttributeMaxDynamicSharedMemorySize, LDS_BYTES) != hipSuccess) { fprintf(stderr, "kernel_launch: hipFuncSetAttribute failed\n"); grid = -1; return; }
        if (hipOccupancyMaxActiveBlocksPerMultiprocessor(&per_cu, (const void*)hybrid_fwd, 512, LDS_BYTES) != hipSuccess || per_cu < 1) { fprintf(stderr, "kernel_launch: occupancy query says %d\n", per_cu); per_cu = 1; }
        (void)hipGetLastError();
        grid = cus * 1;
    }
    if (grid < 0) return;
    if (hipMemsetAsync((char*)d_ws + WS_BAR, 0, 16384, stream) != hipSuccess) { fprintf(stderr, "kernel_launch: barrier memset failed\n"); return; }
    Args a{};
    const float** pp = (const float**)&a;
    for (int i = 0; i < 24; ++i) pp[i] = (const float*)d_in[i];
    a.out = (float*)d_out; a.ws = (unsigned char*)d_ws;
#if MK_PER_PHASE
    for (int p = 0; p < NPHASE; ++p) { a.ph_lo = p; a.ph_hi = p + 1; hipLaunchKernelGGL(hybrid_fwd, dim3(grid), dim3(512), LDS_BYTES, stream, a); }
#else
    a.ph_lo = 0; a.ph_hi = NPHASE;
    void* args[] = {&a};
    hipError_t e = hipLaunchCooperativeKernel((const void*)hybrid_fwd, dim3(grid), dim3(512), args, LDS_BYTES, stream);
    if (e != hipSuccess) fprintf(stderr, "cooperative launch failed: %s (grid %d)\n", hipGetErrorString(e), grid);
#endif
}
```
